# Optimizing an MI355X kernel written in HIP

```python
import jax
import jax.numpy as jnp
from jax import lax
import numpy as np

D_MODEL = 1024
BATCH = 16
SEQ = 2048
DEPTH = 2

N_EVEN = (DEPTH + 1) // 2
N_ODD = DEPTH // 2

A_WIDTH = 512
A_GROUPS = 4
A_CHUNK = 128
B_WIDTH = 512
CONV_WIDTH = 31
N_HEADS = 8
HEAD_DIM = D_MODEL // N_HEADS
MOBA_BLOCK = 256
MOBA_TOPK = 3
MOBA_QCHUNK = 64
N_GROUPS = 4
EXPERTS_PER_GROUP = 4
N_EXPERTS = N_GROUPS * EXPERTS_PER_GROUP
EXPERT_TOPK = 2
D_EXPERT = 512
DN_ALPHA = (2.0 * DEPTH) ** 0.25
DN_BETA = (8.0 * DEPTH) ** -0.25
LN_EPS = 1e-5

kernel_name = 'hybrid_sgu_conv_moba_hmoe_block'


def layer_norm(x, g, b):
    xf = x.astype(jnp.float32)
    mu = xf.mean(-1, keepdims=True)
    var = jnp.square(xf - mu).mean(-1, keepdims=True)
    return ((xf - mu) * lax.rsqrt(var + LN_EPS) * g.astype(jnp.float32) + b.astype(jnp.float32)).astype(x.dtype)


def spatial_gating(z, ln_g, ln_b, w_s, b_s):
    bsz, t, _ = z.shape
    u, v = jnp.split(z, 2, axis=-1)
    v = layer_norm(v, ln_g, ln_b)
    n_chunks = t // A_CHUNK
    v = v.reshape(bsz, n_chunks, A_CHUNK, A_GROUPS, A_WIDTH // A_GROUPS)
    causal = jnp.tril(jnp.ones((A_CHUNK, A_CHUNK), dtype=bool))
    w = jnp.where(causal[None], w_s, 0)
    s = jnp.einsum('gpq,bcqgd->bcpgd', w, v) + b_s.T[:, :, None]
    return u * s.reshape(bsz, t, A_WIDTH)


def conv_module(z, w_dw, b_dw, ln_g, ln_b):
    a, gate = jnp.split(z, 2, axis=-1)
    a = a * jax.nn.sigmoid(gate)
    y = lax.conv_general_dilated(
        a, w_dw[:, None, :], window_strides=(1,), padding=[(CONV_WIDTH - 1, 0)],
        dimension_numbers=('NWC', 'WIO', 'NWC'), feature_group_count=B_WIDTH) + b_dw
    return jax.nn.silu(layer_norm(y, ln_g, ln_b))


def even_mixer(h, w_in, sgu_ln_g, sgu_ln_b, w_s, b_s, w_dw, b_dw, conv_ln_g, conv_ln_b, w_out):
    z = h @ w_in
    z_a, z_b = jnp.split(z, [2 * A_WIDTH], axis=-1)
    y_a = spatial_gating(jax.nn.gelu(z_a, approximate=False), sgu_ln_g, sgu_ln_b, w_s, b_s)
    y_b = conv_module(z_b, w_dw, b_dw, conv_ln_g, conv_ln_b)
    return jnp.concatenate([y_a, y_b], axis=-1) @ w_out


def moba_attention(q, k, v):
    bsz, t, h, dh = q.shape
    n_blocks = -(-t // MOBA_BLOCK)
    tp = n_blocks * MOBA_BLOCK
    pad = ((0, 0), (0, tp - t), (0, 0), (0, 0))
    q, k, v = jnp.pad(q, pad), jnp.pad(k, pad), jnp.pad(v, pad)
    kb = k.reshape(bsz, n_blocks, MOBA_BLOCK, h, dh).transpose(0, 3, 1, 2, 4)
    vb = v.reshape(bsz, n_blocks, MOBA_BLOCK, h, dh).transpose(0, 3, 1, 2, 4)
    own = jnp.arange(tp) // MOBA_BLOCK
    own_idx = jnp.broadcast_to(own[None, :, None, None], (bsz, tp, h, 1))
    own_valid = jnp.ones((bsz, tp, h, 1), dtype=bool)
    n_sel = min(MOBA_TOPK, n_blocks - 1)
    if n_sel > 0:
        k_mean = kb.astype(jnp.float32).mean(axis=3)
        gate = jnp.einsum('bthd,bhnd->bthn', q.astype(jnp.float32), k_mean)
        past = jnp.arange(n_blocks)[None, :] < own[:, None]
        gate = jnp.where(past[None, :, None, :], gate, -jnp.inf)
        _, top_idx = lax.top_k(gate, n_sel)
        sel_idx = jnp.concatenate([top_idx, own_idx], axis=-1)
        sel_valid = jnp.concatenate([top_idx < own[None, :, None, None], own_valid], axis=-1)
    else:
        sel_idx, sel_valid = own_idx, own_valid
    n_s = sel_idx.shape[-1]
    n_q = tp // MOBA_QCHUNK
    qs = q.reshape(bsz * n_q, MOBA_QCHUNK, h, dh)
    idxs = sel_idx.reshape(bsz * n_q, MOBA_QCHUNK, h, n_s)
    valids = sel_valid.reshape(bsz * n_q, MOBA_QCHUNK, h, n_s)
    b_ids = jnp.repeat(jnp.arange(bsz), n_q)
    j_ids = jnp.tile(jnp.arange(n_q), bsz)
    heads = jnp.arange(h)[None, :, None]
    offs = jnp.arange(MOBA_BLOCK)
    scale = dh ** -0.5

    def attend_chunk(args):
        b, j, qc, idx, valid = args
        k_sel = kb[b][heads, idx]
        v_sel = vb[b][heads, idx]
        s = jnp.einsum('qhd,qhspd->qhsp', qc.astype(jnp.float32), k_sel.astype(jnp.float32)) * scale
        qpos = j * MOBA_QCHUNK + jnp.arange(MOBA_QCHUNK)
        kpos = idx[..., None] * MOBA_BLOCK + offs
        mask = valid[..., None] & (kpos <= qpos[:, None, None, None])
        s = jnp.where(mask, s, -jnp.inf).reshape(MOBA_QCHUNK, h, n_s * MOBA_BLOCK)
        p = jax.nn.softmax(s, axis=-1)
        o = jnp.einsum('qhk,qhkd->qhd', p,
                       v_sel.reshape(MOBA_QCHUNK, h, n_s * MOBA_BLOCK, dh).astype(jnp.float32))
        return o.astype(qc.dtype)

    out = lax.map(attend_chunk, (b_ids, j_ids, qs, idxs, valids))
    return out.reshape(bsz, tp, h, dh)[:, :t]


def odd_mixer(h, w_qkv, w_out):
    bsz, t, _ = h.shape
    qkv = (h @ w_qkv).reshape(bsz, t, 3, N_HEADS, HEAD_DIM)
    o = moba_attention(qkv[:, :, 0], qkv[:, :, 1], qkv[:, :, 2])
    return o.reshape(bsz, t, N_HEADS * HEAD_DIM) @ w_out


def hier_moe(h, w_grp, b_grp, w_er, b_er, w_gate, w_up, w_down):
    x = h.reshape(-1, h.shape[-1])
    n = x.shape[0]
    xf = x.astype(jnp.float32)
    grp_logits = xf @ w_grp.astype(jnp.float32) + b_grp.astype(jnp.float32)
    grp_prob = jax.nn.softmax(grp_logits, axis=-1)
    g_w, g_sel = lax.top_k(grp_prob, 1)
    exp_logits = jnp.einsum('nd,gde->nge', xf, w_er.astype(jnp.float32)) + b_er.astype(jnp.float32)
    in_grp = jnp.take_along_axis(exp_logits, g_sel[:, :, None], axis=1)[:, 0]
    top_v, top_i = lax.top_k(in_grp, EXPERT_TOPK)
    top_w = jax.nn.softmax(top_v, axis=-1) * g_w
    expert_id = g_sel * EXPERTS_PER_GROUP + top_i
    combine = jnp.einsum('nk,nke->ne', top_w, jax.nn.one_hot(expert_id, N_EXPERTS, dtype=jnp.float32))
    out = jnp.zeros((n, x.shape[-1]), jnp.float32)
    for e in range(N_EXPERTS):
        hid = jax.nn.silu(x @ w_gate[e]) * (x @ w_up[e])
        out = out + combine[:, e:e + 1] * (hid @ w_down[e]).astype(jnp.float32)
    return out.astype(h.dtype).reshape(h.shape)


def setup_inputs(seed: int = 0) -> dict:
    key = jax.random.key(seed)
    ks = iter(jax.random.split(key, 32))
    d = D_MODEL

    def nrm(shape, s):
        return jax.random.normal(next(ks), shape, jnp.float32) * s

    return {
        'x': nrm((BATCH, SEQ, d), 1.0),
        'c': nrm((BATCH, d), 1.0),
        'ada_w': nrm((DEPTH, d, 6 * d), 0.1 * d ** -0.5),
        'ada_b': nrm((DEPTH, 6 * d), 0.01),
        'ln_mix_g': 1.0 + nrm((DEPTH, d), 0.02),
        'ln_mix_b': nrm((DEPTH, d), 0.02),
        'ln_ffn_g': 1.0 + nrm((DEPTH, d), 0.02),
        'ln_ffn_b': nrm((DEPTH, d), 0.02),
        'ev_w_in': nrm((N_EVEN, d, 2 * A_WIDTH + 2 * B_WIDTH), d ** -0.5),
        'ev_sgu_ln_g': 1.0 + nrm((N_EVEN, A_WIDTH), 0.02),
        'ev_sgu_ln_b': nrm((N_EVEN, A_WIDTH), 0.02),
        'ev_w_s': nrm((N_EVEN, A_GROUPS, A_CHUNK, A_CHUNK), A_CHUNK ** -0.5),
        'ev_b_s': 1.0 + nrm((N_EVEN, A_GROUPS, A_CHUNK), 0.02),
        'ev_w_dw': nrm((N_EVEN, CONV_WIDTH, B_WIDTH), CONV_WIDTH ** -0.5),
        'ev_b_dw': nrm((N_EVEN, B_WIDTH), 0.02),
        'ev_conv_ln_g': 1.0 + nrm((N_EVEN, B_WIDTH), 0.02),
        'ev_conv_ln_b': nrm((N_EVEN, B_WIDTH), 0.02),
        'ev_w_out': nrm((N_EVEN, A_WIDTH + B_WIDTH, d), DN_BETA * (A_WIDTH + B_WIDTH) ** -0.5),
        'od_w_qkv': nrm((N_ODD, d, 3 * N_HEADS * HEAD_DIM), d ** -0.5),
        'od_w_out': nrm((N_ODD, N_HEADS * HEAD_DIM, d), DN_BETA * (N_HEADS * HEAD_DIM) ** -0.5),
        'moe_w_grp': nrm((DEPTH, d, N_GROUPS), d ** -0.5),
        'moe_b_grp': nrm((DEPTH, N_GROUPS), 0.01),
        'moe_w_er': nrm((DEPTH, N_GROUPS, d, EXPERTS_PER_GROUP), d ** -0.5),
        'moe_b_er': nrm((DEPTH, N_GROUPS, EXPERTS_PER_GROUP), 0.01),
        'moe_w_gate': nrm((DEPTH, N_EXPERTS, d, D_EXPERT), d ** -0.5),
        'moe_w_up': nrm((DEPTH, N_EXPERTS, d, D_EXPERT), d ** -0.5),
        'moe_w_down': nrm((DEPTH, N_EXPERTS, D_EXPERT, d), DN_BETA * D_EXPERT ** -0.5),
    }


def reference(x, c, ada_w, ada_b, ln_mix_g, ln_mix_b, ln_ffn_g, ln_ffn_b,
              ev_w_in, ev_sgu_ln_g, ev_sgu_ln_b, ev_w_s, ev_b_s, ev_w_dw, ev_b_dw,
              ev_conv_ln_g, ev_conv_ln_b, ev_w_out, od_w_qkv, od_w_out,
              moe_w_grp, moe_b_grp, moe_w_er, moe_b_er, moe_w_gate, moe_w_up, moe_w_down):
    c_act = jax.nn.silu(c)
    for i in range(DEPTH):
        cond = c_act @ ada_w[i] + ada_b[i]
        sh_m, sc_m, g_m, sh_f, sc_f, g_f = jnp.split(cond[:, None, :], 6, axis=-1)
        h = x * (1.0 + sc_m) + sh_m
        j = i // 2
        if i % 2 == 0:
            y = even_mixer(h, ev_w_in[j], ev_sgu_ln_g[j], ev_sgu_ln_b[j], ev_w_s[j], ev_b_s[j],
                           ev_w_dw[j], ev_b_dw[j], ev_conv_ln_g[j], ev_conv_ln_b[j], ev_w_out[j])
        else:
            y = odd_mixer(h, od_w_qkv[j], od_w_out[j])
        x = layer_norm(DN_ALPHA * x + (1.0 + g_m) * y, ln_mix_g[i], ln_mix_b[i])
        h = x * (1.0 + sc_f) + sh_f
        y = hier_moe(h, moe_w_grp[i], moe_b_grp[i], moe_w_er[i], moe_b_er[i],
                     moe_w_gate[i], moe_w_up[i], moe_w_down[i])
        x = layer_norm(DN_ALPHA * x + (1.0 + g_f) * y, ln_ffn_g[i], ln_ffn_b[i])
    return x
```

```cpp
#include <hip/hip_runtime.h>
#include <cstdio>
#include <cstdint>
#ifndef MK_ONE_LAUNCH
#define MK_ONE_LAUNCH 0
#endif
namespace pg8 {
#define PG8_LAS __attribute__((address_space(3)))
typedef unsigned short bf16_t;
typedef short bf16x8 __attribute__((ext_vector_type(8)));
typedef float f32x4 __attribute__((ext_vector_type(4)));
typedef unsigned u32x4 __attribute__((ext_vector_type(4)));
constexpr int BM = 256, BK = 64, HALF = 128, HTB = HALF * BK * 2  , STAGE_BYTES = 8 * HTB, NXCD = 8, WGM = 8;

__host__ __device__ __forceinline__ int lds_byte(int r, int c) { const int st = (r >> 4) * 2 + (c >> 5), rr = r & 15, cc = c & 31, ob = rr * 64 + cc * 2; return st * 1024 + (ob ^ (((ob >> 9) & 1) << 5)); }
__host__ __device__ __forceinline__ void stage_rc(int b, int& R, int& C) { const int st = b / 1024, sb = b % 1024, swz = sb ^ (((sb >> 9) & 1) << 5); R = (st >> 1) * 16 + swz / 64; C = (st & 1) * 32 + (swz % 64) / 2; }
__host__ __device__ __forceinline__ int perm32(int rho) { const int n = rho >> 4, i = rho & 15; return 8 * (i >> 2) + 4 * n + (i & 3); }

struct Unit { int pm, pn; };
struct Gemm { const bf16_t* A; const bf16_t* Bt; int M, N, K; };

struct StaticOrder {
    int nM, nN, nwg, G, c;
    __host__ __device__ void init(int M, int N, int G_, int c_) { nM = M / BM; nN = N / BM; nwg = nM * nN; G = G_; c = c_; }
    __host__ __device__ bool next(int i, Unit& u) const {
        const long L = (long)i * G + c; if (L >= nwg) return false;
        int wgid = (int)L; { const int q = nwg / NXCD, r = nwg % NXCD, xcd = wgid % NXCD, off = wgid / NXCD; wgid = (xcd < r ? xcd * (q + 1) : r * (q + 1) + (xcd - r) * q) + off; }
        const int nig = WGM * nN, gid = wgid / nig, fm = gid * WGM, gsz = (nM - fm) < WGM ? (nM - fm) : WGM;
        u.pm = fm + ((wgid % nig) % gsz); u.pn = (wgid % nig) / gsz; return true;
    }
    __device__ __forceinline__ void a_ready(const Unit&) const {}
    __device__ __forceinline__ const char* bptr(const Gemm& g, const Unit& u, size_t tstep) const { return (const char*)g.Bt + (size_t)u.pn * tstep; }
    __device__ __forceinline__ void done(const Unit&) const {}
};

__device__ __forceinline__ unsigned cvt_pk_bf16(float lo, float hi) { unsigned r; asm volatile("v_cvt_pk_bf16_f32 %0, %1, %2" : "=v"(r) : "v"(lo), "v"(hi)); return r; }
typedef float f32x2 __attribute__((ext_vector_type(2)));
__device__ __forceinline__ f32x2 gelu_pk(f32x2 v) {
    const f32x2 av = __builtin_elementwise_abs(v), d = av * 0.2316418882f + 1.0f;
    f32x2 t; t.x = __builtin_amdgcn_rcpf(d.x); t.y = __builtin_amdgcn_rcpf(d.y);
    f32x2 q = t * 0.5307027145f + (-0.7265760135f); q = q * t + 0.7107068705f; q = q * t + (-0.142248368f); q = q * t + 0.127414796f; q = q * t;
    const f32x2 s = (v * v) * (-0.72134752044f);
    f32x2 e; e.x = __builtin_amdgcn_exp2f(s.x); e.y = __builtin_amdgcn_exp2f(s.y);
    const f32x2 m = v * (q * e), r = v - m;
    f32x2 o; o.x = v.x < 0.f ? m.x : r.x; o.y = v.y < 0.f ? m.y : r.y; return o;
}

template <int ACT  > struct EpiBf16 {
    static constexpr bool PERM = true, AFTER_DRAIN = false; static_assert(ACT == 0 || ACT == 1, "EpiBf16: ACT is 0 (none) or 1 (gelu_pk)");
    bf16_t* O; int ldc; const float* bias; int split_cols; size_t split_stride; float scale0;
    __device__ __forceinline__ void operator()(const f32x4 (&acc)[2][2][4][2], const Unit& u, int wr, int wc, int fr, int fq) const {
        const int row0 = u.pm * BM + wr * 64 + fr; int colt = u.pn * BM; bf16_t* base = O;
        float sc = 1.f; if (split_cols) { const int t = colt / split_cols; base += (size_t)t * split_stride; colt -= t * split_cols; if (t == 0) sc = scale0; }
        const int col0 = colt + wc * 32 + 8 * fq, bcol0 = u.pn * BM + wc * 32 + 8 * fq;
        f32x4 bv[2][2];
#pragma unroll
        for (int bj = 0; bj < 2; ++bj)
#pragma unroll
            for (int n = 0; n < 2; ++n) bv[bj][n] = bias ? *(const f32x4*)(bias + bcol0 + bj * HALF + 4 * n) : (f32x4){0.f, 0.f, 0.f, 0.f};
#pragma unroll
        for (int ai = 0; ai < 2; ++ai)
#pragma unroll
            for (int m = 0; m < 4; ++m) { bf16_t* rowp = base + (size_t)(row0 + ai * HALF + m * 16) * ldc + col0;
#pragma unroll
                for (int bj = 0; bj < 2; ++bj) { f32x4 v0 = acc[ai][bj][m][0] + bv[bj][0], v1 = acc[ai][bj][m][1] + bv[bj][1];
                    if (ACT == 1) { f32x2 a = gelu_pk((f32x2){v0[0], v0[1]}), b = gelu_pk((f32x2){v0[2], v0[3]}), c = gelu_pk((f32x2){v1[0], v1[1]}), d = gelu_pk((f32x2){v1[2], v1[3]});
                        v0 = (f32x4){a.x, a.y, b.x, b.y}; v1 = (f32x4){c.x, c.y, d.x, d.y}; }
                    v0 = v0 * sc; v1 = v1 * sc; u32x4 w; w.x = cvt_pk_bf16(v0[0], v0[1]); w.y = cvt_pk_bf16(v0[2], v0[3]); w.z = cvt_pk_bf16(v1[0], v1[1]); w.w = cvt_pk_bf16(v1[2], v1[3]);
                    *(u32x4*)(rowp + bj * HALF) = w; } }
    }
};
template <class Epi, class Sched, bool ALIGN_EPI = false, bool SP2 = false>
__device__ __forceinline__ void gemm_phase(PG8_LAS unsigned char* lds, const Gemm g, const Sched& S, const Epi& E) {
    const int tid = threadIdx.x, wid = __builtin_amdgcn_readfirstlane(tid >> 6), lane = tid & 63, wr = wid >> 2, wc = wid & 3, fr = lane & 15, fq = lane >> 4;
    const int K = g.K, nt = K / BK;
    unsigned voffA[2], voffB[2];
#pragma unroll
    for (int i = 0; i < 2; ++i) { int R, C; stage_rc(tid * 16 + i * 8192, R, C); const int Rb = Epi::PERM ? ((R & ~31) + perm32(R & 31)) : R;
        voffA[i] = (unsigned)(R * K + C) * 2u; voffB[i] = (unsigned)(Rb * K + C) * 2u; }
    const size_t kstep = (size_t)(BK * 2);
    const size_t hstep = (size_t)HALF * K * 2;
    const size_t tstep = 2 * hstep;
    const unsigned ldsw = (unsigned)wid * 1024u;
    const int aoff = lds_byte(wr * 64 + fr, fq * 8), boff = lds_byte(wc * 32 + fr, fq * 8);
#define PG8_SA(b, h) (((b) * 2 + (h)) * HTB)
#define PG8_SB(b, h) ((4 + (b) * 2 + (h)) * HTB)
#define PG8_STAGE(bufoff, gbase, voff) do { _Pragma("unroll") for (int _i = 0; _i < 2; ++_i) \
        __builtin_amdgcn_global_load_lds((const unsigned*)((const char*)(gbase) + (voff)[_i]), (PG8_LAS unsigned*)(lds + (bufoff) + ldsw + _i * 8192), 16, 0, 0); } while (0)
#define PG8_LDA(dst, b, h) do { _Pragma("unroll") for (int m = 0; m < 4; ++m) _Pragma("unroll") for (int k = 0; k < 2; ++k) dst[m][k] = *(const PG8_LAS bf16x8*)(lds + PG8_SA(b, h) + aoff + m * 2048 + k * 1024); } while (0)
#define PG8_LDB(dst, b, h) do { _Pragma("unroll") for (int n = 0; n < 2; ++n) _Pragma("unroll") for (int k = 0; k < 2; ++k) dst[n][k] = *(const PG8_LAS bf16x8*)(lds + PG8_SB(b, h) + boff + n * 2048 + k * 1024); } while (0)
#define PG8_MMA(ai, bj, At, Bt) do { __builtin_amdgcn_s_setprio(1); _Pragma("unroll") for (int m = 0; m < 4; ++m) _Pragma("unroll") for (int n = 0; n < 2; ++n) _Pragma("unroll") for (int k = 0; k < 2; ++k) \
        acc[ai][bj][m][n] = __builtin_amdgcn_mfma_f32_16x16x32_bf16(Bt[n][k], At[m][k], acc[ai][bj][m][n], 0, 0, 0); __builtin_amdgcn_s_setprio(0); } while (0)
#define PG8_WAIT_V(n) asm volatile("s_waitcnt vmcnt(" #n ")" ::: "memory")
#define PG8_WAIT_L(n) asm volatile("s_waitcnt lgkmcnt(" #n ")" ::: "memory")
#define PG8_BAR __builtin_amdgcn_s_barrier()
#define PG8_SCHED __builtin_amdgcn_sched_barrier(0)
    Unit cur, nxt; int ui = 0;
    if (!S.next(0, cur)) return;
    f32x4 acc[2][2][4][2];
#pragma unroll
    for (int a = 0; a < 2; ++a)
#pragma unroll
        for (int b = 0; b < 2; ++b)
#pragma unroll
            for (int m = 0; m < 4; ++m)
#pragma unroll
                for (int n = 0; n < 2; ++n) acc[a][b][m][n] = (f32x4){0.f, 0.f, 0.f, 0.f};
    bf16x8 At[4][2], B0[2][2], B1[2][2];
    const char* cA = (const char*)g.A + (size_t)cur.pm * tstep; const char* cB = S.bptr(g, cur, tstep);
    S.a_ready(cur);
    if constexpr (SP2) {
        PG8_STAGE(PG8_SB(0, 0), cB, voffB); PG8_STAGE(PG8_SB(0, 1), cB + hstep, voffB); PG8_STAGE(PG8_SA(0, 0), cA, voffA); PG8_STAGE(PG8_SA(0, 1), cA + hstep, voffA);
        if (wr == 1) PG8_BAR;
        PG8_WAIT_V(2); PG8_BAR;
        PG8_STAGE(PG8_SB(1, 0), cB + kstep, voffB); PG8_STAGE(PG8_SA(1, 0), cA + kstep, voffA); PG8_STAGE(PG8_SB(1, 1), cB + hstep + kstep, voffB);
        PG8_WAIT_V(6); PG8_BAR;
    } else {
        PG8_STAGE(PG8_SB(0, 0), cB, voffB); PG8_STAGE(PG8_SA(0, 0), cA, voffA); PG8_STAGE(PG8_SB(0, 1), cB + hstep, voffB); PG8_STAGE(PG8_SA(0, 1), cA + hstep, voffA);
        if (wr == 1) PG8_BAR;
        PG8_WAIT_V(4); PG8_BAR;
        PG8_STAGE(PG8_SB(1, 0), cB + kstep, voffB); PG8_STAGE(PG8_SA(1, 0), cA + kstep, voffA); PG8_STAGE(PG8_SB(1, 1), cB + hstep + kstep, voffB);
        PG8_WAIT_V(6); PG8_BAR;
    }
    for (;;) {
        const bool has_next = S.next(ui + 1, nxt);
        const char* nA = has_next ? (const char*)g.A + (size_t)nxt.pm * tstep : cA; const char* nB = has_next ? S.bptr(g, nxt, tstep) : cB;
        for (int t = 0; t < nt; t += 2) {
            const bool last = (t == nt - 2);
            const char* a1 = cA + (size_t)(t + 1) * kstep;
            const char* a2 = last ? nA : cA + (size_t)(t + 2) * kstep; const char* b2 = last ? nB : cB + (size_t)(t + 2) * kstep;
            const char* a3 = a2 + kstep; const char* b3 = b2 + kstep;
            if (last && has_next) S.a_ready(nxt);
            if constexpr (SP2) {
            PG8_LDB(B0, 0, 0); PG8_LDB(B1, 0, 1); PG8_SCHED; PG8_LDA(At, 0, 0); PG8_STAGE(PG8_SA(1, 1), a1 + hstep, voffA);
            PG8_WAIT_V(8); PG8_WAIT_L(0); PG8_BAR; PG8_MMA(0, 0, At, B0); PG8_MMA(0, 1, At, B1); PG8_BAR; PG8_SCHED;
            PG8_LDA(At, 0, 1); PG8_STAGE(PG8_SB(0, 0), b2, voffB); PG8_STAGE(PG8_SB(0, 1), b2 + hstep, voffB); PG8_STAGE(PG8_SA(0, 0), a2, voffA);
            PG8_WAIT_V(8); PG8_WAIT_L(0); PG8_BAR; PG8_MMA(1, 0, At, B0); PG8_MMA(1, 1, At, B1); PG8_BAR; PG8_SCHED;
            PG8_LDB(B0, 1, 0); PG8_LDB(B1, 1, 1); PG8_SCHED; PG8_LDA(At, 1, 0); PG8_STAGE(PG8_SA(0, 1), a2 + hstep, voffA);
            PG8_WAIT_V(8); PG8_WAIT_L(0); PG8_BAR; PG8_MMA(0, 0, At, B0); PG8_MMA(0, 1, At, B1); PG8_BAR; PG8_SCHED;
            PG8_LDA(At, 1, 1); PG8_STAGE(PG8_SB(1, 0), b3, voffB); PG8_STAGE(PG8_SB(1, 1), b3 + hstep, voffB); PG8_STAGE(PG8_SA(1, 0), a3, voffA);
            PG8_WAIT_V(8); PG8_WAIT_L(0); PG8_BAR; PG8_MMA(1, 0, At, B0); PG8_MMA(1, 1, At, B1); PG8_BAR; PG8_SCHED;
            } else {
            PG8_LDB(B0, 0, 0); PG8_SCHED; PG8_LDA(At, 0, 0); PG8_STAGE(PG8_SA(1, 1), a1 + hstep, voffA);
            PG8_WAIT_L(8); PG8_BAR; PG8_WAIT_L(0); PG8_MMA(0, 0, At, B0); PG8_BAR; PG8_SCHED;
            PG8_LDB(B1, 0, 1); PG8_STAGE(PG8_SB(0, 0), b2, voffB);
            PG8_BAR; PG8_WAIT_L(0); PG8_MMA(0, 1, At, B1); PG8_BAR;
            PG8_LDA(At, 0, 1); PG8_STAGE(PG8_SA(0, 0), a2, voffA);
            PG8_BAR; PG8_WAIT_L(0); PG8_MMA(1, 0, At, B0); PG8_BAR; PG8_SCHED;
            PG8_STAGE(PG8_SB(0, 1), b2 + hstep, voffB);
            PG8_WAIT_V(6); PG8_BAR; PG8_MMA(1, 1, At, B1); PG8_BAR;
            PG8_LDB(B0, 1, 0); PG8_SCHED; PG8_LDA(At, 1, 0); PG8_STAGE(PG8_SA(0, 1), a2 + hstep, voffA);
            PG8_WAIT_L(8); PG8_BAR; PG8_WAIT_L(0); PG8_MMA(0, 0, At, B0); PG8_BAR; PG8_SCHED;
            PG8_LDB(B1, 1, 1); PG8_STAGE(PG8_SB(1, 0), b3, voffB);
            PG8_BAR; PG8_WAIT_L(0); PG8_MMA(0, 1, At, B1); PG8_BAR;
            PG8_LDA(At, 1, 1); PG8_STAGE(PG8_SA(1, 0), a3, voffA);
            PG8_BAR; PG8_WAIT_L(0); PG8_MMA(1, 0, At, B0); PG8_BAR; PG8_SCHED;
            PG8_STAGE(PG8_SB(1, 1), b3 + hstep, voffB);
            PG8_WAIT_V(6); PG8_BAR; PG8_MMA(1, 1, At, B1); PG8_BAR;
            }
        }
        if constexpr (ALIGN_EPI) { if (wr == 0) PG8_BAR; }
        if constexpr (!Epi::AFTER_DRAIN) { E(acc, cur, wr, wc, fr, fq); S.done(cur); }
        if (!has_next) break;
#pragma unroll
        for (int a = 0; a < 2; ++a)
#pragma unroll
            for (int b = 0; b < 2; ++b)
#pragma unroll
                for (int m = 0; m < 4; ++m)
#pragma unroll
                    for (int n = 0; n < 2; ++n) acc[a][b][m][n] = (f32x4){0.f, 0.f, 0.f, 0.f};
        cur = nxt; cA = nA; cB = nB; ++ui;
        if constexpr (ALIGN_EPI) { if (wr == 1) PG8_BAR; }
    }
    PG8_WAIT_V(0);
    if constexpr (!ALIGN_EPI) { if (wr == 0) PG8_BAR; }
    PG8_BAR;
    if constexpr (Epi::AFTER_DRAIN) { E.fused(acc, cur, wr, wc, fr, fq, lds, wid, lane); S.done(cur); }
#undef PG8_SA
#undef PG8_SB
#undef PG8_STAGE
#undef PG8_LDA
#undef PG8_LDB
#undef PG8_MMA
#undef PG8_WAIT_V
#undef PG8_WAIT_L
#undef PG8_BAR
#undef PG8_SCHED
}
}
namespace pg8 {
__device__ __forceinline__ float sigm(float v) { return __builtin_amdgcn_rcpf(1.0f + __builtin_amdgcn_exp2f(-1.4426950408889634f * v)); }
struct EpiIn {
    static constexpr bool PERM = true, AFTER_DRAIN = false;
    bf16_t* U; bf16_t* V; bf16_t* G;
    __device__ __forceinline__ void operator()(const f32x4 (&acc)[2][2][4][2], const Unit& u, int wr, int wc, int fr, int fq) const {
        const int row0 = u.pm * BM + wr * 64 + fr;
        if (u.pn < 4) {
            bf16_t* base = (u.pn < 2) ? U : V; const int col0 = (u.pn & 1) * 256 + wc * 32 + 8 * fq;
#pragma unroll
            for (int ai = 0; ai < 2; ++ai)
#pragma unroll
                for (int m = 0; m < 4; ++m) { bf16_t* rowp = base + (size_t)(row0 + ai * HALF + m * 16) * 512 + col0;
#pragma unroll
                    for (int bj = 0; bj < 2; ++bj) { f32x4 v0 = acc[ai][bj][m][0], v1 = acc[ai][bj][m][1];
                        f32x2 a = gelu_pk((f32x2){v0[0], v0[1]}), b = gelu_pk((f32x2){v0[2], v0[3]}), c = gelu_pk((f32x2){v1[0], v1[1]}), d = gelu_pk((f32x2){v1[2], v1[3]});
                        u32x4 w; w.x = cvt_pk_bf16(a.x, a.y); w.y = cvt_pk_bf16(b.x, b.y); w.z = cvt_pk_bf16(c.x, c.y); w.w = cvt_pk_bf16(d.x, d.y);
                        *(u32x4*)(rowp + bj * HALF) = w; } }
        } else {
            const int col0 = (u.pn - 4) * 128 + wc * 32 + 8 * fq;
#pragma unroll
            for (int ai = 0; ai < 2; ++ai)
#pragma unroll
                for (int m = 0; m < 4; ++m) { bf16_t* rowp = G + (size_t)(row0 + ai * HALF + m * 16) * 512 + col0;
                    const f32x4 a0 = acc[ai][0][m][0], a1 = acc[ai][0][m][1], g0 = acc[ai][1][m][0], g1 = acc[ai][1][m][1];
                    u32x4 w; w.x = cvt_pk_bf16(a0[0] * sigm(g0[0]), a0[1] * sigm(g0[1])); w.y = cvt_pk_bf16(a0[2] * sigm(g0[2]), a0[3] * sigm(g0[3]));
                    w.z = cvt_pk_bf16(a1[0] * sigm(g1[0]), a1[1] * sigm(g1[1])); w.w = cvt_pk_bf16(a1[2] * sigm(g1[2]), a1[3] * sigm(g1[3]));
                    *(u32x4*)rowp = w; }
        }
    }
};
struct EpiSwiGLU {
    static constexpr bool PERM = true, AFTER_DRAIN = false;
    bf16_t* Hid;
    __device__ __forceinline__ void operator()(const f32x4 (&acc)[2][2][4][2], const Unit& u, int wr, int wc, int fr, int fq) const {
        const int row0 = u.pm * BM + wr * 64 + fr, col0 = u.pn * 128 + wc * 32 + 8 * fq;
#pragma unroll
        for (int ai = 0; ai < 2; ++ai)
#pragma unroll
            for (int m = 0; m < 4; ++m) { bf16_t* rowp = Hid + (size_t)(row0 + ai * HALF + m * 16) * 512 + col0;
                const f32x4 g0 = acc[ai][0][m][0], g1 = acc[ai][0][m][1], u0 = acc[ai][1][m][0], u1 = acc[ai][1][m][1];
                u32x4 w; w.x = cvt_pk_bf16(g0[0] * sigm(g0[0]) * u0[0], g0[1] * sigm(g0[1]) * u0[1]); w.y = cvt_pk_bf16(g0[2] * sigm(g0[2]) * u0[2], g0[3] * sigm(g0[3]) * u0[3]);
                w.z = cvt_pk_bf16(g1[0] * sigm(g1[0]) * u1[0], g1[1] * sigm(g1[1]) * u1[1]); w.w = cvt_pk_bf16(g1[2] * sigm(g1[2]) * u1[2], g1[3] * sigm(g1[3]) * u1[3]);
                *(u32x4*)rowp = w; }
    }
};
struct GroupedOrder {
    const int* tile_e; int nwg, nN, G, c; size_t estride;
    __device__ __forceinline__ void init(const int* te, int ntiles, int nN_, int G_, int blk, size_t es) { tile_e = te; nN = nN_; nwg = ntiles * nN_; G = G_; estride = es;
        c = (G_ % 8 == 0) ? (blk % 8) * (G_ / 8) + blk / 8 : blk; }
    __device__ __forceinline__ bool next(int i, Unit& u) const { const long L = (long)i * G + c; if (L >= nwg) return false; u.pm = (int)(L / nN); u.pn = (int)(L % nN); return true; }
    __device__ __forceinline__ void a_ready(const Unit&) const {}
    __device__ __forceinline__ const char* bptr(const Gemm& g, const Unit& u, size_t tstep) const {
        const int e = __builtin_amdgcn_readfirstlane(__hip_atomic_load(tile_e + u.pm, __ATOMIC_RELAXED, __HIP_MEMORY_SCOPE_AGENT)); return (const char*)g.Bt + (size_t)e * estride + (size_t)u.pn * tstep; }
    __device__ __forceinline__ void done(const Unit&) const {}
};
}
namespace att {
typedef unsigned short bf16;
constexpr int D = 128, PITCH = 1024;
constexpr float SCALE = 0.08838834764831845f;
constexpr float THR = 8.f;
constexpr int NW = 8, QBLK = 32, KVBLK = 64, QB = NW * QBLK;
constexpr int SHM_V = KVBLK * D * 2, SHM_K = KVBLK * D * 2;
constexpr int LDS_BYTES = 2 * SHM_V + 2 * SHM_K + NW * 64 * 4;
typedef short bf16x8 __attribute__((ext_vector_type(8)));
typedef short s16x4 __attribute__((ext_vector_type(4)));
typedef float f32x16 __attribute__((ext_vector_type(16)));
typedef float f32x4 __attribute__((ext_vector_type(4)));
typedef unsigned u32x4 __attribute__((ext_vector_type(4)));
#define KSWZ(row, colB) ((row) * 256 + ((colB) ^ (((row) & 7) << 4)))
#define SBAR() __builtin_amdgcn_sched_barrier(0)
__device__ __forceinline__ int v_st(int k, int c) { const int kk = (k & ~0xC) | ((k & 4) << 1) | ((k & 8) >> 1); return ((kk >> 3) * 4 + (c >> 5)) * 512 + ((kk & 7) * 32 + (c & 31)) * 2; }
__device__ __forceinline__ int v_rd_base(int lane) { return ((lane & 3) << 3) | (((lane >> 2) & 3) << 6) | (((lane >> 4) & 1) << 5) | (((lane >> 5) & 1) << 8); }
constexpr int v_rd_off(int d0, int ks, int half) { return d0 * 512 + ks * 4096 + half * 2048; }
__device__ __forceinline__ int crow(int r, int hi) { return (r & 3) + 8 * (r >> 2) + 4 * hi; }
__device__ __forceinline__ unsigned cvtpk(float lo, float hi) { unsigned r; asm volatile("v_cvt_pk_bf16_f32 %0, %1, %2" : "=v"(r) : "v"(lo), "v"(hi)); return r; }
__device__ __forceinline__ bf16x8 load8(const bf16* p) { return *reinterpret_cast<const bf16x8*>(p); }
__device__ __forceinline__ void mask_tile(f32x16& p0, f32x16& p1, int dq) {
    const float NEG = -__builtin_inff();
#pragma unroll
    for (int r = 0; r < 16; ++r) {
        const int c = (r & 3) + 8 * (r >> 2);
        if (dq - c < 0) p0[r] = NEG;
        if (dq - c - 32 < 0) p1[r] = NEG;
    }
}
__device__ __forceinline__ void partialSM(f32x16& p0, f32x16& p1, float& m_reg, float& mn, float& alpha, bool keep) {
    float pmax = p0[0]; for (int r = 1; r < 16; ++r) pmax = fmaxf(pmax, p0[r]); for (int r = 0; r < 16; ++r) pmax = fmaxf(pmax, p1[r]);
    pmax = keep ? pmax : -__builtin_inff();
    { auto rr = __builtin_amdgcn_permlane32_swap(__float_as_uint(pmax), __float_as_uint(pmax), false, false);
      pmax = fmaxf(__uint_as_float(rr[0]), __uint_as_float(rr[1])); }
    constexpr float C2 = 1.4426950408889634f * SCALE;
    if (__builtin_expect(__all((pmax - m_reg) * SCALE <= THR), 1)) { mn = m_reg; alpha = 1.f; }
    else { mn = fmaxf(m_reg, pmax); alpha = __builtin_amdgcn_exp2f((m_reg - mn) * C2); m_reg = mn; }
    const float mnL = keep ? -mn * C2 : -__builtin_inff();
    for (int r = 0; r < 16; ++r) p0[r] = fmaf(p0[r], C2, mnL); for (int r = 0; r < 16; ++r) p1[r] = fmaf(p1[r], C2, mnL);
    for (int r = 0; r < 16; ++r) p0[r] = __builtin_amdgcn_exp2f(p0[r]);
}
__device__ __forceinline__ void finishSM(f32x16& p0, f32x16& p1, float alpha, float& l_reg, bf16x8& pa0, bf16x8& pa1, bf16x8& pa2, bf16x8& pa3) {
    for (int r = 0; r < 16; ++r) p1[r] = __builtin_amdgcn_exp2f(p1[r]);
    float ps = 0; for (int r = 0; r < 16; ++r) ps += p0[r]; for (int r = 0; r < 16; ++r) ps += p1[r];
    { auto rr = __builtin_amdgcn_permlane32_swap(__float_as_uint(ps), __float_as_uint(ps), false, false);
      ps = __uint_as_float(rr[0]) + __uint_as_float(rr[1]); }
    l_reg = l_reg * alpha + ps;
#define PK4(P, B_, OUT) do { unsigned a0 = cvtpk(P[B_+0], P[B_+1]), a1 = cvtpk(P[B_+2], P[B_+3]);                          \
        unsigned b0 = cvtpk(P[B_+4], P[B_+5]), b1 = cvtpk(P[B_+6], P[B_+7]);                                             \
        auto r0 = __builtin_amdgcn_permlane32_swap(a0, b0, false, false); auto r1 = __builtin_amdgcn_permlane32_swap(a1, b1, false, false); \
        u32x4 w = {r0[0], r1[0], r0[1], r1[1]}; OUT = *reinterpret_cast<bf16x8*>(&w); } while (0)
    PK4(p0, 0, pa0); PK4(p0, 8, pa1); PK4(p1, 0, pa2); PK4(p1, 8, pa3);
#undef PK4
}
template <int KB>
__device__ __forceinline__ void qkt(f32x16& p0, f32x16& p1, const char* K_lds, int r32, int hi, const bf16x8* qr) {
    p0 = f32x16{}; p1 = f32x16{};
    const char* kb[4];
#pragma unroll
    for (int dd = 0; dd < 4; ++dd) kb[dd] = K_lds + KB * SHM_K + KSWZ(r32, (dd * 16 + hi * 8) * 2);
#pragma unroll
    for (int d0 = 0; d0 < 8; ++d0) { const char* a = kb[d0 & 3] + (d0 >> 2) * 128;
        bf16x8 b0 = *reinterpret_cast<const bf16x8*>(a);
        bf16x8 b1 = *reinterpret_cast<const bf16x8*>(a + 32 * 256);
        p0 = __builtin_amdgcn_mfma_f32_32x32x16_bf16(b0, qr[d0], p0, 0, 0, 0);
        p1 = __builtin_amdgcn_mfma_f32_32x32x16_bf16(b1, qr[d0], p1, 0, 0, 0); }
}
template <int VB>
__device__ __forceinline__ void pv_tile(f32x16* o, int vb0, bf16x8 pa0, bf16x8 pa1, bf16x8 pa2, bf16x8 pa3) {
#define TRRD(dst, off) asm volatile("ds_read_b64_tr_b16 %0, %1 offset:%2" : "=&v"(dst) : "v"(vb0), "i"(off) : "memory")
#define PV_D0(d0) do { s16x4 l0, l1, l2, l3, h0, h1, h2, h3; constexpr int b_ = VB * SHM_V + v_rd_off(d0, 0, 0);  \
        TRRD(l0, b_); TRRD(h0, b_ + 2048); TRRD(l1, b_ + 4096); TRRD(h1, b_ + 6144); TRRD(l2, b_ + 8192); TRRD(h2, b_ + 10240); TRRD(l3, b_ + 12288); TRRD(h3, b_ + 14336); \
        asm volatile("s_waitcnt lgkmcnt(0)" ::: "memory"); SBAR();   \
        o[d0] = __builtin_amdgcn_mfma_f32_32x32x16_bf16(pa0, (bf16x8){l0[0], l0[1], l0[2], l0[3], h0[0], h0[1], h0[2], h0[3]}, o[d0], 0, 0, 0);   \
        o[d0] = __builtin_amdgcn_mfma_f32_32x32x16_bf16(pa1, (bf16x8){l1[0], l1[1], l1[2], l1[3], h1[0], h1[1], h1[2], h1[3]}, o[d0], 0, 0, 0);   \
        o[d0] = __builtin_amdgcn_mfma_f32_32x32x16_bf16(pa2, (bf16x8){l2[0], l2[1], l2[2], l2[3], h2[0], h2[1], h2[2], h2[3]}, o[d0], 0, 0, 0);   \
        o[d0] = __builtin_amdgcn_mfma_f32_32x32x16_bf16(pa3, (bf16x8){l3[0], l3[1], l3[2], l3[3], h3[0], h3[1], h3[2], h3[3]}, o[d0], 0, 0, 0); } while (0)
    PV_D0(0); PV_D0(1); PV_D0(2); PV_D0(3);
#undef PV_D0
#undef TRRD
}
struct BlockRef { const bf16* Q; const bf16* K; const bf16* V; bf16* O; const unsigned char* Sel; int P0; };
struct Seam { bf16x8 qr[8]; bf16x8 st_v0, st_v1, st_k0, st_k1; };
#define ROW(p, k0, rr) ((p) + (unsigned)(((k0) + (rr)) * PITCH + sc))
#define VMW() asm volatile("s_waitcnt vmcnt(0)" ::: "memory")
#define VMWN(n) asm volatile("s_waitcnt vmcnt(%0)" :: "i"(n) : "memory")
#define SLOAD_H(Kp, Vp, k0) do { S.st_v0 = load8(ROW(Vp, k0, sr)); S.st_v1 = load8(ROW(Vp, k0, 32 + sr));              \
                         S.st_k0 = load8(ROW(Kp, k0, sr)); S.st_k1 = load8(ROW(Kp, k0, 32 + sr)); } while (0)
#define SWRITE_HK(bf) do { *(bf16x8*)(K_lds + (bf) * SHM_K + kws) = S.st_k0; *(bf16x8*)(K_lds + (bf) * SHM_K + kws + 32 * 256) = S.st_k1; } while (0)
#define SWRITE_HV(bf) do { *(bf16x8*)(V_lds + (bf) * SHM_V + vst0) = S.st_v0; *(bf16x8*)(V_lds + (bf) * SHM_V + vst1) = S.st_v1; } while (0)
#define SWRITE_H(bf) do { SWRITE_HV(bf); SWRITE_HK(bf); } while (0)
__device__ __forceinline__ void moba_prime(const BlockRef& cur, char* lds, Seam& S) {
    const int tid = threadIdx.x, wid = __builtin_amdgcn_readfirstlane(tid >> 6), lane = tid & 63, r32 = lane & 31, hi = lane >> 5;
    const int sr = tid >> 4, sc = (tid & 15) * 8, kws = KSWZ(sr, sc * 2); char* K_lds = lds + 2 * SHM_V;
    for (int d0 = 0; d0 < 8; ++d0) S.qr[d0] = load8(cur.Q + (unsigned)((wid * QBLK + r32) * PITCH + hi * 8) + d0 * 16);
    SLOAD_H(cur.K, cur.V, 0); VMW(); SWRITE_HK(0);
    __syncthreads();
}
__device__ __forceinline__ void moba_block(const BlockRef& cur, const BlockRef& nxt, char* lds, Seam& S) {
    const int tid = threadIdx.x, wid = __builtin_amdgcn_readfirstlane(tid >> 6), lane = tid & 63, r32 = lane & 31, hi = lane >> 5;
    const int NT = cur.P0 / KVBLK + 4;
    const int qlo = cur.P0 + wid * QBLK, qm = qlo + r32 - 4 * hi;
    const unsigned selfull = (unsigned)cur.Sel[(unsigned)((wid * QBLK + r32) * 8)] | (0xFFu << (cur.P0 >> 8));
    char* V_lds = lds; char* K_lds = lds + 2 * SHM_V;
    float* ws = (float*)(lds + 2 * SHM_V + 2 * SHM_K) + wid * 64; float* li_l = ws, * al_l = ws + 32;
    float m_reg = -1e30f, l_reg = 0; f32x16 o[4] = {};
    const int sr = tid >> 4, sc = (tid & 15) * 8, vst0 = v_st(sr, sc), vst1 = v_st(32 + sr, sc), kws = KSWZ(sr, sc * 2);
    const int vb0 = (int)(uintptr_t)V_lds + v_rd_base(lane);
    const bf16* Kh = cur.K; const bf16* Vh = cur.V;
#define RESC(a) do { if (__any((a) < 1.f)) { if (hi == 0) al_l[r32] = (a); asm volatile("s_waitcnt lgkmcnt(0)" ::: "memory");              \
                     for (int d_ = 0; d_ < 4; ++d_) for (int r = 0; r < 16; ++r) o[d_][r] *= al_l[crow(r, hi)]; } } while (0)
#define KBASE(t) ((t) * KVBLK)
#define KEEP(t) (((selfull >> (KBASE(t) >> 8)) & 1u) != 0u)
#define MASKT(P0_, P1_, t) do { const int kb_ = KBASE(t); if (kb_ + KVBLK - 1 > qlo) mask_tile(P0_, P1_, qm - kb_); } while (0)
    constexpr int NQL = 8;
#define SEAM_K0() do { VMWN(NQL); SWRITE_HK(0); SBAR(); } while (0)
    f32x16 pA0, pA1, pB0, pB1; float mnA, mnB, alA, alB; bf16x8 pa0, pa1, pa2, pa3;
    SWRITE_HV(0); SBAR();
    if (NT > 1) { SLOAD_H(Kh, Vh, KBASE(1)); }
    SBAR(); qkt<0>(pA0, pA1, K_lds, r32, hi, S.qr);
    MASKT(pA0, pA1, 0); partialSM(pA0, pA1, m_reg, mnA, alA, KEEP(0));
    if (NT > 1) { VMW(); SWRITE_H(1); }
    __syncthreads();
#define HALF_STEP(PX0, PX1, mnX, alX, PY0, PY1, alY, t, KB, VB, SB) do {                                                      \
        SBAR(); qkt<KB>(PX0, PX1, K_lds, r32, hi, S.qr);                                             \
        finishSM(PY0, PY1, alY, l_reg, pa0, pa1, pa2, pa3); SBAR();                                                           \
        if ((t) + 1 < NT) { SLOAD_H(Kh, Vh, KBASE((t) + 1)); SBAR(); }                                               \
        pv_tile<VB>(o, vb0, pa0, pa1, pa2, pa3); MASKT(PX0, PX1, (t)); partialSM(PX0, PX1, m_reg, mnX, alX, KEEP(t));                                        \
        __syncthreads();                                                                                                      \
        if ((t) + 1 < NT) { VMW(); SWRITE_H(SB); }                                                                          \
        RESC(alX); __syncthreads(); } while (0)
    for (int t = 1; t + 1 < NT; t += 2) {
        HALF_STEP(pB0, pB1, mnB, alB, pA0, pA1, alA, t, 1, 0, 0);
        HALF_STEP(pA0, pA1, mnA, alA, pB0, pB1, alB, t + 1, 0, 1, 1);
    }
    const bool even = (NT & 1) == 0;
    if (even) { SBAR(); qkt<1>(pB0, pB1, K_lds, r32, hi, S.qr); SBAR(); }
    SLOAD_H(nxt.K, nxt.V, 0); SBAR();
#pragma unroll
    for (int d0 = 0; d0 < 8; ++d0) S.qr[d0] = load8(nxt.Q + (unsigned)((wid * QBLK + r32) * PITCH + hi * 8) + d0 * 16);
    SBAR();
    finishSM(pA0, pA1, alA, l_reg, pa0, pa1, pa2, pa3); SBAR();
    pv_tile<0>(o, vb0, pa0, pa1, pa2, pa3);
    if (even) { MASKT(pB0, pB1, NT - 1); partialSM(pB0, pB1, m_reg, mnB, alB, KEEP(NT - 1)); __syncthreads(); RESC(alB);
        finishSM(pB0, pB1, alB, l_reg, pa0, pa1, pa2, pa3); SBAR(); pv_tile<1>(o, vb0, pa0, pa1, pa2, pa3); }
    SBAR(); SEAM_K0();
    if (hi == 0) li_l[r32] = l_reg; asm volatile("s_waitcnt lgkmcnt(0)" ::: "memory");
    float rli[16];
#pragma unroll
    for (int r = 0; r < 16; ++r) rli[r] = __builtin_amdgcn_rcpf(li_l[crow(r, hi)]);
    unsigned ooff = (unsigned)(((wid * QBLK + 4 * hi) * PITCH + r32) * 2);
#pragma unroll
    for (int r = 0; r < 16; ++r) { char* prow = (char*)cur.O + ooff;
#pragma unroll
        for (int d0 = 0; d0 < 4; ++d0) { const float v = o[d0][r] * rli[r];
            const float vn = __shfl_xor(v, 1);
            if ((r32 & 1) == 0) *(unsigned*)(prow + d0 * 64) = cvtpk(v, vn); }
        ooff += (unsigned)(((r & 3) == 3 ? 5 : 1) * PITCH * 2); asm volatile("" : "+v"(ooff)); }
    __syncthreads();
#undef RESC
#undef KBASE
#undef KEEP
#undef MASKT
#undef SEAM_K0
#undef HALF_STEP
}
#undef ROW
#undef VMW
#undef VMWN
#undef SLOAD_H
#undef SWRITE_HK
#undef SWRITE_HV
#undef SWRITE_H
}
#define GAS __attribute__((address_space(1)))
#define LAS __attribute__((address_space(3)))
typedef unsigned short bf16;
typedef unsigned v4u __attribute__((ext_vector_type(4)));
typedef float f32x4 __attribute__((ext_vector_type(4)));
typedef short bf16x8 __attribute__((ext_vector_type(8)));
typedef GAS unsigned gu32;
typedef GAS unsigned long long gu64;
#define RLX_AGENT __ATOMIC_RELAXED, __HIP_MEMORY_SCOPE_AGENT
#define LDS_WAIT() asm volatile("s_waitcnt lgkmcnt(0)" ::: "memory")
#define VM_WAIT() asm volatile("s_waitcnt vmcnt(0)" ::: "memory")
__device__ __forceinline__ unsigned long long rt() { return __builtin_amdgcn_s_memrealtime(); }
__device__ __forceinline__ unsigned f2bf(float f) { unsigned u = __builtin_bit_cast(unsigned, f); return (u + 0x7fffu + ((u >> 16) & 1u)) >> 16; }
__device__ __forceinline__ unsigned pk2(float lo, float hi) { return f2bf(lo) | (f2bf(hi) << 16); }

#define XB_TMO      128
#define XB_XCNT(j)  (256  + 64 * (j))
#define XB_XSUB(j)  (1280 + 64 * (j))
#define XB_XGEN(j)  (2304 + 64 * (j))
#define XB_TOP      3328
#define XB_TOPGEN   3392
#define XCD_BAR_WORDS 3456
#define XB_SPIN_CAP (1u << 18)

__device__ __forceinline__ unsigned xb_ld(unsigned* p)              { return __hip_atomic_load(p, __ATOMIC_RELAXED, __HIP_MEMORY_SCOPE_AGENT); }
__device__ __forceinline__ unsigned xb_add(unsigned* p, unsigned v) { return __hip_atomic_fetch_add(p, v, __ATOMIC_RELAXED, __HIP_MEMORY_SCOPE_AGENT); }
__device__ __forceinline__ unsigned xb_xcc_id() { return (unsigned)__builtin_amdgcn_s_getreg((3 << 11) | 20) & 0xFu; }
#define XB_SPIN(cond, bar) do { unsigned _sp = 0; while (cond) { __builtin_amdgcn_s_sleep(1); \
    if ((++_sp & 255u) == 0u) { if (xb_ld(&(bar)[XB_TMO])) break; if (_sp > XB_SPIN_CAP) { atomicAdd(&(bar)[XB_TMO], 1u); break; } } } } while (0)

struct XcdBarrier {
    unsigned* bar; unsigned x;
    volatile LAS unsigned* st;
};

__device__ __forceinline__ XcdBarrier xcd_barrier_post(unsigned* bar, volatile LAS unsigned* st) {
    XcdBarrier b; b.bar = bar; b.x = xb_xcc_id(); b.st = st;
    if (threadIdx.x == 0) (void)xb_add(&bar[XB_XCNT(b.x)], 1u);
    return b;
}
__device__ __forceinline__ void xcd_barrier_complete(unsigned* bar, unsigned x, unsigned& nloc, unsigned& nx) {
    const unsigned G = gridDim.x * gridDim.y * gridDim.z;
    unsigned sum, cnt, mine, sp = 0u;
    for (;;) {
        sum = 0u; cnt = 0u; mine = 0u;
#pragma unroll
        for (unsigned j = 0; j < 16; ++j) { const unsigned c = xb_ld(&bar[XB_XCNT(j)]); sum += c; cnt += (c > 0u) ? 1u : 0u; mine = (j == x) ? c : mine; }
        if (sum == G) break;
        __builtin_amdgcn_s_sleep(1);
        if ((++sp & 255u) == 0u) { if (xb_ld(&bar[XB_TMO])) break; if (sp > XB_SPIN_CAP) { atomicAdd(&bar[XB_TMO], 1u); break; } }
    }
    nloc = mine > 0u ? mine : 1u; nx = cnt > 0u ? cnt : 1u;
}

__device__ __forceinline__ void xcd_barrier(const XcdBarrier& b) {
    asm volatile("s_waitcnt vmcnt(0)" ::: "memory");
    __syncthreads();
    if (threadIdx.x == 0) {
        unsigned* bar = b.bar;
        __builtin_amdgcn_s_waitcnt(0);
        unsigned nloc = b.st[0], nx = b.st[1];
        if (nloc == 0u) { xcd_barrier_complete(bar, b.x, nloc, nx); b.st[0] = nloc; b.st[1] = nx; }
        const unsigned old = xb_add(&bar[XB_XSUB(b.x)], 1u);
        const unsigned gen = old / nloc;
        if (old + 1u == (gen + 1u) * nloc) {
            __builtin_amdgcn_fence(__ATOMIC_RELEASE, "agent");
            asm volatile("s_waitcnt vmcnt(0)" ::: "memory");
            const unsigned og = xb_add(&bar[XB_TOP], 1u);
            const unsigned tg = og / nx;
            if (og + 1u == (tg + 1u) * nx) xb_add(&bar[XB_TOPGEN], 1u);
            else XB_SPIN(xb_ld(&bar[XB_TOPGEN]) == tg, bar);
            __builtin_amdgcn_fence(__ATOMIC_ACQUIRE, "agent");
            xb_add(&bar[XB_XGEN(b.x)], 1u);
            asm volatile("s_waitcnt vmcnt(0)" ::: "memory");
        } else {
            XB_SPIN(xb_ld(&bar[XB_XGEN(b.x)]) == gen, bar);
            __builtin_amdgcn_fence(__ATOMIC_ACQUIRE, "agent");
            asm volatile("s_waitcnt vmcnt(0)" ::: "memory");
        }
    }
    __syncthreads();
}
constexpr int NB = 16, T = 2048, D = 1024, M = NB * T;
constexpr int NEXP = 16, DEXP = 512;
constexpr int MAXT = 272, MSORT = MAXT * 256;
constexpr float LN_EPS = 1e-5f, DN_ALPHA = 1.4142135623730951f;
constexpr int NWAVES = 8;
constexpr size_t MiB = 1u << 20;
constexpr size_t WS_CTL = 0, CTL_ZERO_BYTES = 1 * MiB;
constexpr size_t WS_COND = 1 * MiB;
constexpr size_t WS_KMEAN = 2 * MiB;
constexpr size_t WS_ROUTE_E = 3 * MiB;
constexpr size_t WS_ROUTE_W = WS_ROUTE_E + 128 * 1024;
constexpr size_t WS_POS = WS_ROUTE_W + 256 * 1024;
constexpr size_t WS_CNT = WS_POS + 256 * 1024;
constexpr size_t WS_TILE = WS_CNT + 16 * 1024;
constexpr size_t WS_SEL = 4 * MiB;
constexpr size_t WS_WIN = 8 * MiB, WS_WOUT = 12 * MiB, WS_WQKV = 14 * MiB, WS_WO2 = 20 * MiB;
constexpr size_t WS_WGU = 22 * MiB;
constexpr size_t WS_WD = 86 * MiB;
constexpr size_t WS_XA = 118 * MiB;
constexpr size_t WS_H = 246 * MiB;
constexpr size_t WS_BIG = 310 * MiB;
constexpr size_t WS_END = 502 * MiB;
constexpr int CW_BAR = 4096;

typedef unsigned v2u __attribute__((ext_vector_type(2)));
typedef float f32x2 __attribute__((ext_vector_type(2)));
__device__ __forceinline__ float bflo(unsigned w) { return __builtin_bit_cast(float, w << 16); }
__device__ __forceinline__ float bfhi(unsigned w) { return __builtin_bit_cast(float, w & 0xffff0000u); }
__device__ __forceinline__ float wave_sum(float v) {
#pragma unroll
    for (int o = 1; o < 64; o <<= 1) v += __shfl_xor(v, o);
    return v;
}
struct Params { const float* in[27]; float* out; unsigned char* ws; int ph_lo, ph_hi, li, pad; };
enum { I_X = 0, I_C, I_ADAW, I_ADAB, I_LNMG, I_LNMB, I_LNFG, I_LNFB, I_WIN, I_SLNG, I_SLNB, I_WS, I_BS, I_WDW, I_BDW, I_CLNG, I_CLNB, I_WOUT, I_WQKV, I_WO2,
       I_WGRP, I_BGRP, I_WER, I_BER, I_WGATE, I_WUP, I_WDOWN };
struct Frame {
    LAS unsigned char* lds;
    int tid, lane, wave, vcu, G;
};

__device__ __forceinline__ void p0_cond(const Frame& F, const float* c, const float* ada_w, const float* ada_b, float* cond) {
    LAS float* sc = (LAS float*)F.lds;
    LAS float* red = (LAS float*)(F.lds + 65536);
    bool loaded = false;
    for (int it = blockIdx.x; it < 192; it += F.G) {
        if (!loaded) { for (int i = F.tid; i < 16384; i += 512) { const int b = i >> 10, k = i & 1023; const float v = c[i]; sc[k * 16 + b] = v / (1.0f + __expf(-v)); } __syncthreads(); loaded = true; }
        const int L = it / 96, j0 = (it % 96) * 64, col = F.tid & 63, ks = F.tid >> 6;
        float acc[16];
#pragma unroll
        for (int b = 0; b < 16; ++b) acc[b] = 0.f;
        const float* w = ada_w + (size_t)L * 1024 * 6144 + (size_t)(ks * 128) * 6144 + j0 + col;
#pragma unroll 8
        for (int k = 0; k < 128; ++k) { const float wv = w[(size_t)k * 6144]; const LAS f32x4* s4 = (const LAS f32x4*)(sc + (ks * 128 + k) * 16);
#pragma unroll
            for (int q = 0; q < 4; ++q) { const f32x4 s = s4[q]; acc[4 * q + 0] += s[0] * wv; acc[4 * q + 1] += s[1] * wv; acc[4 * q + 2] += s[2] * wv; acc[4 * q + 3] += s[3] * wv; } }
#pragma unroll
        for (int b = 0; b < 16; ++b) red[(ks * 16 + b) * 64 + col] = acc[b];
        __syncthreads();
        for (int o = F.tid; o < 1024; o += 512) { const int b = o >> 6, cc = o & 63; float s = ada_b[L * 6144 + j0 + cc];
#pragma unroll
            for (int k2 = 0; k2 < 8; ++k2) s += red[(k2 * 16 + b) * 64 + cc];
            cond[(size_t)(L * 16 + b) * 6144 + j0 + cc] = s; }
        __syncthreads();
    }
}
__device__ __forceinline__ void transpose_item(const float* W, int srcN, bf16* WT, int dstK, int k0, int n0, int drow0, LAS float* scr, int lane) {
#pragma unroll 8
    for (int i = 0; i < 32; ++i) { const int kk = 2 * i + (lane >> 5); scr[kk * 33 + (lane & 31)] = W[(size_t)(k0 + kk) * srcN + n0 + (lane & 31)]; }
    LDS_WAIT(); asm volatile("" ::: "memory");
    const int c = lane & 7;
#pragma unroll
    for (int j = 0; j < 4; ++j) { const int n = (lane >> 3) + 8 * j; const LAS float* s = scr + (8 * c) * 33 + n;
        v4u o; o.x = pk2(s[0 * 33], s[1 * 33]); o.y = pk2(s[2 * 33], s[3 * 33]); o.z = pk2(s[4 * 33], s[5 * 33]); o.w = pk2(s[6 * 33], s[7 * 33]);
        *(GAS v4u*)(WT + (size_t)(drow0 + n) * dstK + k0 + 8 * c) = o; }
    LDS_WAIT(); asm volatile("" ::: "memory");
}
__device__ __forceinline__ void p0_weights(const Frame& F, const Params& P) {
    LAS float* scr = (LAS float*)(F.lds + F.wave * 16384);
    unsigned char* ws = P.ws;
    const int gw = F.vcu * NWAVES + F.wave, NGW = F.G * NWAVES;
    constexpr int S0 = 1024, S1 = S0 + 512, S2 = S1 + 1536, S3 = S2 + 512, S4 = S3 + 8192, S5 = S4 + 8192, S6 = S5 + 8192;
    for (int it = gw; it < S6; it += NGW) {
        if (it < S0) { const int r = it, kb = r >> 6, nb = r & 63, n0 = nb * 32;
            const int drow = n0 < 1024 ? n0 : (n0 < 1536 ? (4 + ((n0 - 1024) >> 7)) * 256 + ((n0 - 1024) & 127) : (4 + ((n0 - 1536) >> 7)) * 256 + 128 + ((n0 - 1536) & 127));
            transpose_item(P.in[I_WIN], 2048, (bf16*)(ws + WS_WIN), 1024, kb * 64, n0, drow, scr, F.lane); }
        else if (it < S1) { const int r = it - S0, kb = r >> 5, nb = r & 31; transpose_item(P.in[I_WOUT], 1024, (bf16*)(ws + WS_WOUT), 1024, kb * 64, nb * 32, nb * 32, scr, F.lane); }
        else if (it < S2) { const int r = it - S1, kb = r / 96, nb = r % 96; transpose_item(P.in[I_WQKV], 3072, (bf16*)(ws + WS_WQKV), 1024, kb * 64, nb * 32, nb * 32, scr, F.lane); }
        else if (it < S3) { const int r = it - S2, kb = r >> 5, nb = r & 31; transpose_item(P.in[I_WO2], 1024, (bf16*)(ws + WS_WO2), 1024, kb * 64, nb * 32, nb * 32, scr, F.lane); }
        else if (it < S5) { const bool up = it >= S4; const int r = it - (up ? S4 : S3), le = r >> 8, q = r & 255, kb = q >> 4, nb = q & 15, n0 = nb * 32;
            const int drow = (n0 >> 7) * 256 + (up ? 128 : 0) + (n0 & 127);
            transpose_item(P.in[up ? I_WUP : I_WGATE] + (size_t)le * 1024 * 512, 512, (bf16*)(ws + WS_WGU) + (size_t)le * 1024 * 1024, 1024, kb * 64, n0, drow, scr, F.lane); }
        else { const int r = it - S5, le = r >> 8, q = r & 255, kb = q >> 5, nb = q & 31;
            transpose_item(P.in[I_WDOWN] + (size_t)le * 512 * 1024, 1024, (bf16*)(ws + WS_WD) + (size_t)le * 1024 * 512, 512, kb * 64, nb * 32, nb * 32, scr, F.lane); }
    }
}
__device__ __forceinline__ void p_modulate(const Frame& F, const float* x, const float* cond_l  , int sh_off, bf16* H) {
    const int gw = F.vcu * NWAVES + F.wave, NGW = F.G * NWAVES;
    for (int ch = gw; ch < M / 16; ch += NGW) {
        const int r0 = ch * 16, b = r0 / T; const float* cb = cond_l + (size_t)b * 6144 + sh_off;
        f32x4 sh[4], sc[4];
#pragma unroll
        for (int j = 0; j < 4; ++j) { sh[j] = *(const f32x4*)(cb + 4 * F.lane + 256 * j); sc[j] = *(const f32x4*)(cb + 1024 + 4 * F.lane + 256 * j) + 1.0f; }
#pragma unroll 4
        for (int i = 0; i < 16; ++i) { const float* xr = x + (size_t)(r0 + i) * D + 4 * F.lane; bf16* hr = H + (size_t)(r0 + i) * D + 4 * F.lane;
#pragma unroll
            for (int j = 0; j < 4; ++j) { const f32x4 v = *(const f32x4*)(xr + 256 * j) * sc[j] + sh[j]; v2u o; o.x = pk2(v[0], v[1]); o.y = pk2(v[2], v[3]); *(v2u*)(hr + 256 * j) = o; } }
    }
}
__device__ __forceinline__ void p_sgu_item(const Frame& F, const Params& P, int it, const bf16* U, const bf16* V, bf16* YC) {
    const int bc = it >> 2, g = it & 3, r0 = bc * 128;
    LAS bf16* Vt = (LAS bf16*)F.lds;
    LAS bf16* Wl = (LAS bf16*)(F.lds + 34816);
    const float* lng = P.in[I_SLNG]; const float* lnb = P.in[I_SLNB];
    for (int i = 0; i < 16; ++i) { const int q = F.wave * 16 + i;
        const v4u raw = *(const v4u*)(V + (size_t)(r0 + q) * 512 + 8 * F.lane);
        float v[8] = {bflo(raw.x), bfhi(raw.x), bflo(raw.y), bfhi(raw.y), bflo(raw.z), bfhi(raw.z), bflo(raw.w), bfhi(raw.w)};
        float s = 0.f;
#pragma unroll
        for (int j = 0; j < 8; ++j) s += v[j];
        const float mean = wave_sum(s) * (1.0f / 512.0f); float s2 = 0.f;
#pragma unroll
        for (int j = 0; j < 8; ++j) { v[j] -= mean; s2 += v[j] * v[j]; }
        const float rstd = 1.0f / sqrtf(wave_sum(s2) * (1.0f / 512.0f) + LN_EPS);
        if ((F.lane >> 4) == g) { const int d0 = 8 * (F.lane & 15);
            const f32x4 g0 = *(const f32x4*)(lng + 8 * F.lane), g1 = *(const f32x4*)(lng + 8 * F.lane + 4), b0 = *(const f32x4*)(lnb + 8 * F.lane), b1 = *(const f32x4*)(lnb + 8 * F.lane + 4);
#pragma unroll
            for (int j = 0; j < 8; ++j) { const float gg = j < 4 ? g0[j & 3] : g1[j & 3], bb = j < 4 ? b0[j & 3] : b1[j & 3]; Vt[(d0 + j) * 136 + q] = (bf16)f2bf(v[j] * rstd * gg + bb); } }
    }
    { const float* wsg = P.in[I_WS] + (size_t)g * 128 * 128;
        for (int i = F.tid; i < 4096; i += 512) { const int p = i >> 5, q4 = (i & 31) * 4; f32x4 w = *(const f32x4*)(wsg + p * 128 + q4);
            v2u o; o.x = pk2(q4 + 0 <= p ? w[0] : 0.f, q4 + 1 <= p ? w[1] : 0.f); o.y = pk2(q4 + 2 <= p ? w[2] : 0.f, q4 + 3 <= p ? w[3] : 0.f);
            *(LAS v2u*)(Wl + p * 136 + q4) = o; } }
    __syncthreads();
    const int fr = F.lane & 15, fq = F.lane >> 4, w16 = F.wave * 16;
    f32x4 acc[8];
#pragma unroll
    for (int nt = 0; nt < 8; ++nt) acc[nt] = (f32x4){0.f, 0.f, 0.f, 0.f};
#pragma unroll
    for (int ks = 0; ks < 4; ++ks) { if (32 * ks <= w16 + 15) {
        const bf16x8 wf = *(const LAS bf16x8*)(Wl + (w16 + fr) * 136 + 32 * ks + 8 * fq);
#pragma unroll
        for (int nt = 0; nt < 8; ++nt) { const bf16x8 vf = *(const LAS bf16x8*)(Vt + (16 * nt + fr) * 136 + 32 * ks + 8 * fq);
            acc[nt] = __builtin_amdgcn_mfma_f32_16x16x32_bf16(vf, wf, acc[nt], 0, 0, 0); } } }
    const int row = r0 + w16 + fr; const float bs = P.in[I_BS][g * 128 + w16 + fr];
#pragma unroll
    for (int nt = 0; nt < 8; ++nt) { const int ch = 128 * g + 16 * nt + 4 * fq; const v2u uu = *(const v2u*)(U + (size_t)row * 512 + ch);
        v2u o; o.x = pk2(bflo(uu.x) * (acc[nt][0] + bs), bfhi(uu.x) * (acc[nt][1] + bs)); o.y = pk2(bflo(uu.y) * (acc[nt][2] + bs), bfhi(uu.y) * (acc[nt][3] + bs));
        *(v2u*)(YC + (size_t)row * D + ch) = o; }
    __syncthreads();
}
__device__ __forceinline__ void p_conv_item(const Frame& F, const Params& P, int ci, const bf16* Gb, bf16* YC) {
    const int R0 = ci * 32, b = R0 / T, t0 = R0 % T;
    LAS bf16* Gin = (LAS bf16*)F.lds;
    LAS float* Yc = (LAS float*)(F.lds + 63488);
    for (int i = F.tid; i < 62 * 64; i += 512) { const int r = i >> 6, cc = i & 63, t = t0 - 30 + r;
        v4u v = (v4u){0u, 0u, 0u, 0u}; if (t >= 0) v = *(const v4u*)(Gb + (size_t)(b * T + t) * 512 + cc * 8);
        *(LAS v4u*)(Gin + r * 512 + cc * 8) = v; }
    __syncthreads();
    { const int c = F.tid; const float* wdw = P.in[I_WDW];
        float w[31];
#pragma unroll
        for (int k = 0; k < 31; ++k) w[k] = wdw[k * 512 + c];
        const float bd = P.in[I_BDW][c];
#pragma unroll 1
        for (int blk = 0; blk < 4; ++blk) { const int o0 = 8 * blk; float a[8];
#pragma unroll
            for (int o = 0; o < 8; ++o) a[o] = bd;
#pragma unroll
            for (int i = 0; i < 38; ++i) { const float v = __builtin_bit_cast(float, (unsigned)(*(const LAS unsigned short*)(Gin + (o0 + i) * 512 + c)) << 16);
#pragma unroll
                for (int o = 0; o < 8; ++o) { const int k = i - o; if (k >= 0 && k < 31) a[o] += w[k] * v; } }
#pragma unroll
            for (int o = 0; o < 8; ++o) Yc[(o0 + o) * 512 + c] = a[o]; }
    }
    __syncthreads();
    { const float* lng = P.in[I_CLNG]; const float* lnb = P.in[I_CLNB];
        const f32x4 g0 = *(const f32x4*)(lng + 8 * F.lane), g1 = *(const f32x4*)(lng + 8 * F.lane + 4), b0 = *(const f32x4*)(lnb + 8 * F.lane), b1 = *(const f32x4*)(lnb + 8 * F.lane + 4);
        for (int i = 0; i < 4; ++i) { const int r = F.wave * 4 + i; const f32x4 y0 = *(const LAS f32x4*)(Yc + r * 512 + 8 * F.lane), y1 = *(const LAS f32x4*)(Yc + r * 512 + 8 * F.lane + 4);
            float v[8] = {y0[0], y0[1], y0[2], y0[3], y1[0], y1[1], y1[2], y1[3]}; float s = 0.f;
#pragma unroll
            for (int j = 0; j < 8; ++j) s += v[j];
            const float mean = wave_sum(s) * (1.0f / 512.0f); float s2 = 0.f;
#pragma unroll
            for (int j = 0; j < 8; ++j) { v[j] -= mean; s2 += v[j] * v[j]; }
            const float rstd = 1.0f / sqrtf(wave_sum(s2) * (1.0f / 512.0f) + LN_EPS);
#pragma unroll
            for (int j = 0; j < 8; ++j) { const float z = v[j] * rstd * (j < 4 ? g0[j & 3] : g1[j & 3]) + (j < 4 ? b0[j & 3] : b1[j & 3]); v[j] = z / (1.0f + __expf(-z)); }
            v4u o; o.x = pk2(v[0], v[1]); o.y = pk2(v[2], v[3]); o.z = pk2(v[4], v[5]); o.w = pk2(v[6], v[7]);
            *(v4u*)(YC + (size_t)(R0 + r) * D + 512 + 8 * F.lane) = o; }
    }
    __syncthreads();
}
struct RowVec { f32x4 v[4]; };
__device__ __forceinline__ void ln_affine(RowVec& t, const float* lng, const float* lnb, int lane) {
    float s = 0.f;
#pragma unroll
    for (int j = 0; j < 4; ++j) s += (t.v[j][0] + t.v[j][1]) + (t.v[j][2] + t.v[j][3]);
    const float mean = wave_sum(s) * (1.0f / D); float s2 = 0.f;
#pragma unroll
    for (int j = 0; j < 4; ++j) { t.v[j] = t.v[j] - mean; s2 += (t.v[j][0] * t.v[j][0] + t.v[j][1] * t.v[j][1]) + (t.v[j][2] * t.v[j][2] + t.v[j][3] * t.v[j][3]); }
    const float rstd = 1.0f / sqrtf(wave_sum(s2) * (1.0f / D) + LN_EPS);
#pragma unroll
    for (int j = 0; j < 4; ++j) t.v[j] = t.v[j] * rstd * *(const f32x4*)(lng + 4 * lane + 256 * j) + *(const f32x4*)(lnb + 4 * lane + 256 * j);
}
__device__ __forceinline__ void p_ln_route(const Frame& F, const Params& P, int layer, const float* xin, const bf16* Y, float* xout, bf16* H) {
    unsigned char* ws = P.ws;
    LAS float* Wr = (LAS float*)F.lds;
    LAS int* cntl = (LAS int*)(F.lds + 81920);
    const float* wg = P.in[I_WGRP] + (size_t)layer * D * 4; const float* we = P.in[I_WER] + (size_t)layer * 4 * D * 4;
    for (int d = F.tid; d < D; d += 512) { const f32x4 a = *(const f32x4*)(wg + d * 4);
#pragma unroll
        for (int o = 0; o < 4; ++o) Wr[o * D + d] = a[o];
#pragma unroll
        for (int g = 0; g < 4; ++g) { const f32x4 e = *(const f32x4*)(we + ((size_t)g * D + d) * 4);
#pragma unroll
            for (int o = 0; o < 4; ++o) Wr[(4 + 4 * g + o) * D + d] = e[o]; } }
    const float* bg = P.in[I_BGRP] + layer * 4; const float* be = P.in[I_BER] + layer * 16;
    const float* cond_l = (const float*)(ws + WS_COND) + (size_t)layer * 16 * 6144;
    const float* lng = P.in[I_LNMG] + layer * D; const float* lnb = P.in[I_LNMB] + layer * D;
    int* route_e = (int*)(ws + WS_ROUTE_E); f32x2* route_w = (f32x2*)(ws + WS_ROUTE_W); int* cnt = (int*)(ws + WS_CNT);
    for (int it = F.vcu; it < 256; it += F.G) {
        if (F.tid < 16) cntl[F.tid] = 0;
        __syncthreads();
        const int rbase = it * 128 + F.wave * 16, b = rbase / T; const float* cb = cond_l + (size_t)b * 6144;
        for (int i = 0; i < 16; ++i) { const int r = rbase + i; RowVec t;
#pragma unroll
            for (int j = 0; j < 4; ++j) { const int col = 4 * F.lane + 256 * j; const f32x4 xv = *(const f32x4*)(xin + (size_t)r * D + col); const v2u yy = *(const v2u*)(Y + (size_t)r * D + col);
                const f32x4 gm = *(const f32x4*)(cb + 2048 + col) + 1.0f; const f32x4 yv = (f32x4){bflo(yy.x), bfhi(yy.x), bflo(yy.y), bfhi(yy.y)};
                t.v[j] = xv * DN_ALPHA + gm * yv; }
            ln_affine(t, lng, lnb, F.lane);
            float lg[20];
#pragma unroll
            for (int o = 0; o < 20; ++o) lg[o] = 0.f;
#pragma unroll
            for (int j = 0; j < 4; ++j) { const int col = 4 * F.lane + 256 * j; *(f32x4*)(xout + (size_t)r * D + col) = t.v[j];
                const f32x4 hv = t.v[j] * (*(const f32x4*)(cb + 4096 + col) + 1.0f) + *(const f32x4*)(cb + 3072 + col);
                v2u o2; o2.x = pk2(hv[0], hv[1]); o2.y = pk2(hv[2], hv[3]); *(v2u*)(H + (size_t)r * D + col) = o2;
#pragma unroll
                for (int o = 0; o < 20; ++o) { const f32x4 w = *(const LAS f32x4*)(Wr + o * D + col); lg[o] += (hv[0] * w[0] + hv[1] * w[1]) + (hv[2] * w[2] + hv[3] * w[3]); } }
#pragma unroll
            for (int o = 0; o < 20; ++o) lg[o] = wave_sum(lg[o]);
            int gs = 0; float gmx = lg[0] + bg[0];
#pragma unroll
            for (int j = 1; j < 4; ++j) { const float v = lg[j] + bg[j]; if (v > gmx) { gmx = v; gs = j; } }
            float den = 0.f;
#pragma unroll
            for (int j = 0; j < 4; ++j) den += __expf(lg[j] + bg[j] - gmx);
            const float gw = 1.0f / den;
            float ev[4];
#pragma unroll
            for (int e = 0; e < 4; ++e) ev[e] = (gs == 0 ? lg[4 + e] : gs == 1 ? lg[8 + e] : gs == 2 ? lg[12 + e] : lg[16 + e]) + be[gs * 4 + e];
            int i0 = 0; float m0 = ev[0];
#pragma unroll
            for (int e = 1; e < 4; ++e) if (ev[e] > m0) { m0 = ev[e]; i0 = e; }
            int i1 = 0; float m1 = -__builtin_inff();
#pragma unroll
            for (int e = 0; e < 4; ++e) if (e != i0 && ev[e] > m1) { m1 = ev[e]; i1 = e; }
            const float w0 = gw / (1.0f + __expf(m1 - m0)), w1 = gw - w0; const int e0 = gs * 4 + i0, e1 = gs * 4 + i1;
            if (F.lane == 0) { route_e[r] = e0 | (e1 << 8); route_w[r] = (f32x2){w0, w1}; atomicAdd((int*)&cntl[e0], 1); atomicAdd((int*)&cntl[e1], 1); }
        }
        __syncthreads();
        if (F.tid < 16) cnt[it * 16 + F.tid] = cntl[F.tid];
        __syncthreads();
    }
}
__device__ __forceinline__ void p_scatter(const Frame& F, const Params& P, const bf16* H, bf16* Hs) {
    unsigned char* ws = P.ws;
    LAS int* part = (LAS int*)F.lds;
    LAS int* tot = part + 512; LAS int* pre = tot + 16; LAS int* start = pre + 16  ; LAS int* ae = start + 32  ; LAS int* apos = ae + 256  ;
    const int* cnt = (const int*)(ws + WS_CNT); const int* route_e = (const int*)(ws + WS_ROUTE_E); int* pos = (int*)(ws + WS_POS); int* tile_e = (int*)(ws + WS_TILE);
    for (int it = F.vcu; it < 256; it += F.G) {
        { const int e = F.tid & 15, pt = F.tid >> 4; int s = 0;
#pragma unroll
            for (int c = 0; c < 8; ++c) s += cnt[(pt * 8 + c) * 16 + e];
            part[pt * 16 + e] = s; }
        __syncthreads();
        if (F.tid < 16) { const int e = F.tid; int s = 0, p = 0;
            for (int q = 0; q < 32; ++q) { const int v = part[q * 16 + e]; s += v; if (q < (it >> 3)) p += v; }
            for (int c = (it >> 3) * 8; c < it; ++c) p += cnt[c * 16 + e];
            tot[e] = s; pre[e] = p; }
        __syncthreads();
        if (F.tid == 0) { int s = 0; for (int e = 0; e < 16; ++e) { start[e] = s; s += (tot[e] + 255) & ~255; } start[16] = s; }
        if (F.tid < 256) { const int token = it * 128 + (F.tid >> 1); ae[F.tid] = (route_e[token] >> (8 * (F.tid & 1))) & 0xff; }
        __syncthreads();
        if (F.tid < 256) { const int me = ae[F.tid]; int rank = 0; for (int a = 0; a < F.tid; ++a) rank += (ae[a] == me) ? 1 : 0;
            const int p = start[me] + pre[me] + rank; apos[F.tid] = p; pos[(it * 128 + (F.tid >> 1)) * 2 + (F.tid & 1)] = p; }
        if (it == 0) { if (F.tid < MAXT) { const int r = F.tid * 256; int e = 15; for (int k = 15; k >= 0; --k) if (r < start[k + 1]) e = k; tile_e[F.tid] = e; } if (F.tid == 0) tile_e[511] = start[16] >> 8; }
        __syncthreads();
        for (int a2 = 0; a2 < 16; ++a2) { const int tl = F.wave * 16 + a2; const bf16* src = H + (size_t)(it * 128 + tl) * D;
            const v4u v0 = *(const v4u*)(src + 8 * F.lane), v1 = *(const v4u*)(src + 512 + 8 * F.lane);
#pragma unroll
            for (int s = 0; s < 2; ++s) { bf16* dst = Hs + (size_t)apos[tl * 2 + s] * D; *(v4u*)(dst + 8 * F.lane) = v0; *(v4u*)(dst + 512 + 8 * F.lane) = v1; } }
        __syncthreads();
    }
}
__device__ __forceinline__ void p_combine_ln(const Frame& F, const Params& P, int layer, const float* xin, const bf16* Ys, float* xout, bf16* H  ) {
    unsigned char* ws = P.ws;
    const int gw = F.vcu * NWAVES + F.wave, NGW = F.G * NWAVES;
    const float* lng = P.in[I_LNFG] + layer * D; const float* lnb = P.in[I_LNFB] + layer * D;
    const int* pos = (const int*)(ws + WS_POS); const f32x2* route_w = (const f32x2*)(ws + WS_ROUTE_W);
    for (int ch = gw; ch < M / 16; ch += NGW) {
        const int r0 = ch * 16, b = r0 / T; const float* cb = (const float*)(ws + WS_COND) + ((size_t)layer * 16 + b) * 6144; const float* cbn = (const float*)(ws + WS_COND) + ((size_t)(layer + 1) * 16 + b) * 6144;
        for (int i = 0; i < 16; ++i) { const int r = r0 + i; const int p0 = pos[2 * r], p1 = pos[2 * r + 1]; const f32x2 rw = route_w[r]; RowVec t;
#pragma unroll
            for (int j = 0; j < 4; ++j) { const int col = 4 * F.lane + 256 * j; const f32x4 xv = *(const f32x4*)(xin + (size_t)r * D + col);
                const v2u ya = *(const v2u*)(Ys + (size_t)p0 * D + col), yb = *(const v2u*)(Ys + (size_t)p1 * D + col);
                const f32x4 yv = (f32x4){bflo(ya.x), bfhi(ya.x), bflo(ya.y), bfhi(ya.y)} * rw[0] + (f32x4){bflo(yb.x), bfhi(yb.x), bflo(yb.y), bfhi(yb.y)} * rw[1];
                t.v[j] = xv * DN_ALPHA + (*(const f32x4*)(cb + 5120 + col) + 1.0f) * yv; }
            ln_affine(t, lng, lnb, F.lane);
#pragma unroll
            for (int j = 0; j < 4; ++j) { const int col = 4 * F.lane + 256 * j; *(f32x4*)(xout + (size_t)r * D + col) = t.v[j];
                if (H) { const f32x4 hv = t.v[j] * (*(const f32x4*)(cbn + 1024 + col) + 1.0f) + *(const f32x4*)(cbn + col);
                    v2u o2; o2.x = pk2(hv[0], hv[1]); o2.y = pk2(hv[2], hv[3]); *(v2u*)(H + (size_t)r * D + col) = o2; } }
        }
    }
}
__device__ __forceinline__ void p_kmean(const Frame& F, const bf16* K, float* kmean) {
    const int gw = F.vcu * NWAVES + F.wave, NGW = F.G * NWAVES;
    for (int it = gw; it < 1024; it += NGW) { const int b = it >> 6, blk = (it >> 3) & 7, h = it & 7;
        const bf16* kp = K + (size_t)(b * T + blk * 256) * D + h * 128 + 2 * F.lane; float s0 = 0.f, s1 = 0.f;
#pragma unroll 8
        for (int r = 0; r < 256; ++r) { const unsigned w = *(const unsigned*)(kp + (size_t)r * D); s0 += bflo(w); s1 += bfhi(w); }
        *(f32x2*)(kmean + ((size_t)(b * 8 + h) * 8 + blk) * 128 + 2 * F.lane) = (f32x2){s0 * (1.0f / 256.0f), s1 * (1.0f / 256.0f)}; }
}
__device__ __forceinline__ void p_gate(const Frame& F, const bf16* Q, const float* kmean, unsigned char* sel) {
    LAS float* km = (LAS float*)F.lds;
    for (int it = F.vcu; it < 1024; it += F.G) { const int b = it >> 6, qb = (it >> 3) & 7, h = it & 7;
        const int tl = F.tid >> 1, half = F.tid & 1; const size_t row = (size_t)b * T + qb * 256 + tl;
        if (qb < 4) { if (half == 0) sel[row * 8 + h] = (unsigned char)((1u << qb) - 1u); continue; }
        for (int i = F.tid; i < qb * 128; i += 512) km[i] = kmean[((size_t)(b * 8 + h) * 8) * 128 + i];
        __syncthreads();
        float gt[7];
#pragma unroll
        for (int n = 0; n < 7; ++n) gt[n] = 0.f;
        const bf16* qp = Q + row * D + h * 128 + half * 64;
#pragma unroll
        for (int c8 = 0; c8 < 8; ++c8) { const v4u raw = *(const v4u*)(qp + 8 * c8);
            const float qv[8] = {bflo(raw.x), bfhi(raw.x), bflo(raw.y), bfhi(raw.y), bflo(raw.z), bfhi(raw.z), bflo(raw.w), bfhi(raw.w)};
#pragma unroll
            for (int n = 0; n < 7; ++n) if (n < qb) { const LAS f32x4* kk = (const LAS f32x4*)(km + n * 128 + half * 64 + 8 * c8); const f32x4 k0 = kk[0], k1 = kk[1];
                gt[n] += (qv[0] * k0[0] + qv[1] * k0[1]) + (qv[2] * k0[2] + qv[3] * k0[3]) + (qv[4] * k1[0] + qv[5] * k1[1]) + (qv[6] * k1[2] + qv[7] * k1[3]); } }
        unsigned mask = 0u;
#pragma unroll
        for (int n = 0; n < 7; ++n) gt[n] += __shfl_xor(gt[n], 1);
#pragma unroll
        for (int pick = 0; pick < 3; ++pick) { int bi = -1; float bv = -__builtin_inff();
#pragma unroll
            for (int n = 0; n < 7; ++n) if (n < qb && !((mask >> n) & 1u) && gt[n] > bv) { bv = gt[n]; bi = n; }
            if (bi >= 0) mask |= 1u << bi; }
        if (half == 0) sel[row * 8 + h] = (unsigned char)mask;
        __syncthreads();
    }
}
__device__ __forceinline__ att::BlockRef att_ref(int L, int pass, const bf16* Q, const bf16* K, const bf16* V, bf16* O, const unsigned char* sel) {
    const int bh = L >> 2, x = L & 3, qb = pass ? 7 - x : x, b = bh >> 3, h = bh & 7; const size_t base = (size_t)b * T * D + h * 128;
    att::BlockRef r; r.Q = Q + base + (size_t)qb * 256 * D; r.O = O + base + (size_t)qb * 256 * D; r.K = K + base; r.V = V + base; r.Sel = sel + ((size_t)b * T + qb * 256) * 8 + h; r.P0 = qb * 256; return r;
}
__device__ __forceinline__ void p_attention(const Frame& F, const bf16* Q, const bf16* K, const bf16* V, bf16* O, const unsigned char* sel) {
    constexpr int total = 512; int L = F.vcu; if (L >= total) return; int pass = 0;
    att::BlockRef cur = att_ref(L, 0, Q, K, V, O, sel); att::Seam S;
    att::moba_prime(cur, (char*)F.lds, S);
    for (;;) {
        const bool more_pass = pass == 0, more_item = L + F.G < total, last = !more_pass && !more_item;
        int passn = pass + 1, Ln = L; if (!more_pass) { passn = 0; Ln = more_item ? L + F.G : L; }
        const att::BlockRef nxt = last ? cur : att_ref(Ln, passn, Q, K, V, O, sel);
        att::moba_block(cur, nxt, (char*)F.lds, S);
        if (last) break;
        cur = nxt; pass = passn; L = Ln;
    }
}
constexpr int RING_BYTES = 131072, LDSCTL_OFF = RING_BYTES, MISC_OFF = LDSCTL_OFF + 320, LDS_BYTES = 147456;
constexpr int NPHASE = 20;
#if MK_ONE_LAUNCH
#define GRID_BAR() xcd_barrier(bar)
#else
#define GRID_BAR() do { } while (0)
#endif
template <int LAYER>
__device__ __forceinline__ void moe_phases(const Frame& F, const Params& P, XcdBarrier& bar, int lo, int hi, int pbase, const float* xin, const bf16* Ymix, float* xmid, float* xout, bool want_h) {
    unsigned char* ws = P.ws;
    bf16* H = (bf16*)(ws + WS_H); bf16* HS = (bf16*)(ws + WS_BIG); bf16* YS = (bf16*)(ws + WS_BIG); bf16* HID = (bf16*)P.out;
    const int* tile_e = (const int*)(ws + WS_TILE);
#ifdef PH_SEL
#define IN(k) ((k) == PH_SEL && lo <= (k) && (k) < hi)
#else
#define IN(k) (lo <= (k) && (k) < hi)
#endif
#define BOTH(k) (IN(k) && IN((k) + 1))
    if (IN(pbase + 0)) { p_ln_route(F, P, LAYER, xin, Ymix, xmid, H); if (BOTH(pbase + 0)) GRID_BAR(); }
    if (IN(pbase + 1)) { p_scatter(F, P, H, HS); if (BOTH(pbase + 1)) GRID_BAR(); }
    if (IN(pbase + 2)) {
        const int nt = __builtin_amdgcn_readfirstlane(__hip_atomic_load(tile_e + 511, __ATOMIC_RELAXED, __HIP_MEMORY_SCOPE_AGENT));
        pg8::Gemm g{HS, (const bf16*)(ws + WS_WGU) + (size_t)LAYER * NEXP * 1024 * 1024, MSORT, 1024, 1024}; pg8::GroupedOrder S; S.init(tile_e, nt, 4, F.G, (int)blockIdx.x, (size_t)1024 * 1024 * 2);
        pg8::EpiSwiGLU E{HID};
        pg8::gemm_phase<pg8::EpiSwiGLU, pg8::GroupedOrder, true, true>(F.lds, g, S, E);
        if (BOTH(pbase + 2)) GRID_BAR(); }
    if (IN(pbase + 3)) {
        const int nt = __builtin_amdgcn_readfirstlane(__hip_atomic_load(tile_e + 511, __ATOMIC_RELAXED, __HIP_MEMORY_SCOPE_AGENT));
        pg8::Gemm g{HID, (const bf16*)(ws + WS_WD) + (size_t)LAYER * NEXP * 1024 * 512, MSORT, 1024, 512}; pg8::GroupedOrder S; S.init(tile_e, nt, 4, F.G, (int)blockIdx.x, (size_t)1024 * 512 * 2);
        pg8::EpiBf16<0> E{YS, 1024, nullptr, 0, 0, 1.f};
        pg8::gemm_phase<pg8::EpiBf16<0>, pg8::GroupedOrder, true, true>(F.lds, g, S, E);
        if (BOTH(pbase + 3)) GRID_BAR(); }
    if (IN(pbase + 4)) { p_combine_ln(F, P, LAYER, xmid, YS, xout, want_h ? H : nullptr); if (BOTH(pbase + 4)) GRID_BAR(); }
#undef IN
#undef BOTH
}
__global__ void __launch_bounds__(NWAVES * 64, 2) fwd_kernel(Params P) {
    extern __shared__ __attribute__((aligned(16))) unsigned char lds_raw[];
    Frame F; F.lds = (LAS unsigned char*)lds_raw;
    F.tid = threadIdx.x; F.lane = F.tid & 63; F.wave = __builtin_amdgcn_readfirstlane(F.tid >> 6);
    F.G = gridDim.x; { const int bx = blockIdx.x; F.vcu = (F.G % 8 == 0) ? (bx % 8) * (F.G / 8) + bx / 8 : bx; }
    unsigned char* ws = P.ws;
    volatile LAS unsigned* MISC = (volatile LAS unsigned*)(F.lds + MISC_OFF);
    for (int u = F.tid; u < (LDS_BYTES - LDSCTL_OFF) / 4; u += NWAVES * 64) ((LAS unsigned*)(F.lds + LDSCTL_OFF))[u] = 0u;
    __syncthreads();
    XcdBarrier bar; bar.bar = (unsigned*)(ws + WS_CTL) + CW_BAR; bar.x = 0; bar.st = nullptr;
#if MK_ONE_LAUNCH
    bar = xcd_barrier_post((unsigned*)(ws + WS_CTL) + CW_BAR, MISC + 8);
#endif
    const int lo = P.ph_lo, hi = P.ph_hi;
#ifdef PH_SEL
#define IN(k) ((k) == PH_SEL && lo <= (k) && (k) < hi)
#else
#define IN(k) (lo <= (k) && (k) < hi)
#endif
#define BOTH(k) (IN(k) && IN((k) + 1))
    float* cond = (float*)(ws + WS_COND); float* XA = (float*)(ws + WS_XA); bf16* H = (bf16*)(ws + WS_H);
    unsigned char* big = ws + WS_BIG;
    if (IN(0)) { p0_cond(F, P.in[I_C], P.in[I_ADAW], P.in[I_ADAB], cond); p0_weights(F, P); if (BOTH(0)) GRID_BAR(); }
    if (IN(1)) { p_modulate(F, P.in[I_X], cond, 0, H); if (BOTH(1)) GRID_BAR(); }
    if (IN(2)) { bf16* U = (bf16*)big; bf16* V = (bf16*)(big + 32 * MiB); bf16* Gb = (bf16*)(big + 64 * MiB);
        pg8::Gemm g{H, (const bf16*)(ws + WS_WIN), M, 2048, 1024}; pg8::StaticOrder S; S.init(M, 2048, F.G, (int)blockIdx.x);
        pg8::EpiIn E{U, V, Gb};
        pg8::gemm_phase<pg8::EpiIn, pg8::StaticOrder, true, true>(F.lds, g, S, E);
        if (BOTH(2)) GRID_BAR(); }
    if (IN(3)) { const bf16* U = (const bf16*)big; const bf16* V = (const bf16*)(big + 32 * MiB); const bf16* Gb = (const bf16*)(big + 64 * MiB); bf16* YC = (bf16*)(big + 96 * MiB);
        for (int it = F.vcu; it < 2048; it += F.G) {
#ifndef NO_SGU
            if (it < 1024) p_sgu_item(F, P, it, U, V, YC);
#endif
#ifndef NO_CONV
            if (it >= 1024) p_conv_item(F, P, it - 1024, Gb, YC);
#endif
        }
        if (BOTH(3)) GRID_BAR(); }
    if (IN(4)) { const bf16* YC = (const bf16*)(big + 96 * MiB); bf16* YM = (bf16*)big;
        pg8::Gemm g{YC, (const bf16*)(ws + WS_WOUT), M, 1024, 1024}; pg8::StaticOrder S; S.init(M, 1024, F.G, (int)blockIdx.x);
        pg8::EpiBf16<0> E{YM, 1024, nullptr, 0, 0, 1.f};
        pg8::gemm_phase<pg8::EpiBf16<0>, pg8::StaticOrder, true, true>(F.lds, g, S, E);
        if (BOTH(4)) GRID_BAR(); }
    moe_phases<0>(F, P, bar, lo, hi, 5, P.in[I_X], (const bf16*)big, XA, P.out, true);
    bf16* Qb = (bf16*)big; bf16* Kb = (bf16*)(big + 64 * MiB); bf16* Vb = (bf16*)(big + 128 * MiB);
    if (IN(10)) { pg8::Gemm g{H, (const bf16*)(ws + WS_WQKV), M, 3072, 1024}; pg8::StaticOrder S; S.init(M, 3072, F.G, (int)blockIdx.x);
        pg8::EpiBf16<0> E{Qb, 1024, nullptr, 1024, (size_t)M * D, 1.f};
        pg8::gemm_phase<pg8::EpiBf16<0>, pg8::StaticOrder, true, true>(F.lds, g, S, E);
        if (BOTH(10)) GRID_BAR(); }
    if (IN(11)) { p_kmean(F, Kb, (float*)(ws + WS_KMEAN)); if (BOTH(11)) GRID_BAR(); }
    if (IN(12)) { p_gate(F, Qb, (const float*)(ws + WS_KMEAN), ws + WS_SEL); if (BOTH(12)) GRID_BAR(); }
    if (IN(13)) { p_attention(F, Qb, Kb, Vb, Qb, ws + WS_SEL); if (BOTH(13)) GRID_BAR(); }
    if (IN(14)) { bf16* YM = (bf16*)(big + 64 * MiB);
        pg8::Gemm g{Qb, (const bf16*)(ws + WS_WO2), M, 1024, 1024}; pg8::StaticOrder S; S.init(M, 1024, F.G, (int)blockIdx.x);
        pg8::EpiBf16<0> E{YM, 1024, nullptr, 0, 0, 1.f};
        pg8::gemm_phase<pg8::EpiBf16<0>, pg8::StaticOrder, true, true>(F.lds, g, S, E);
        if (BOTH(14)) GRID_BAR(); }
    moe_phases<1>(F, P, bar, lo, hi, 15, P.out, (const bf16*)(big + 64 * MiB), XA, P.out, false);
#undef IN
#undef BOTH
}

extern "C" void kernel_launch(void* const* d_in, const int* in_sizes, int n_in, void* d_out, int out_size, void* d_ws, size_t ws_size, hipStream_t stream) {
    static int grid = 0;
    if (grid == 0) {
        if (n_in != 27 || in_sizes[0] != M * D || out_size != M * D || ws_size < WS_END) { fprintf(stderr, "kernel_launch: unexpected shapes (n_in %d, in0 %d, out %d, ws %zu); nothing launched\n", n_in, n_in > 0 ? in_sizes[0] : -1, out_size, ws_size); grid = -1; return; }
        int dev = 0, cus = 0, per_cu = 0;
        if (hipGetDevice(&dev) != hipSuccess || hipDeviceGetAttribute(&cus, hipDeviceAttributeMultiprocessorCount, dev) != hipSuccess) { grid = -1; return; }
        if (hipFuncSetAttribute((const void*)fwd_kernel, hipFuncAttributeMaxDynamicSharedMemorySize, LDS_BYTES) != hipSuccess) { fprintf(stderr, "kernel_launch: hipFuncSetAttribute failed\n"); grid = -1; return; }
        if (hipOccupancyMaxActiveBlocksPerMultiprocessor(&per_cu, (const void*)fwd_kernel, NWAVES * 64, LDS_BYTES) != hipSuccess || per_cu < 1) fprintf(stderr, "kernel_launch: occupancy query reports %d workgroups per CU\n", per_cu);
        (void)hipGetLastError();
        grid = cus;
    }
    if (grid < 0) return;
    if (hipMemsetAsync((char*)d_ws + WS_CTL, 0, CTL_ZERO_BYTES, stream) != hipSuccess) return;
    Params p{};
    for (int i = 0; i < 27; ++i) p.in[i] = (const float*)d_in[i];
    p.out = (float*)d_out; p.ws = (unsigned char*)d_ws;
#if MK_ONE_LAUNCH
    p.ph_lo = 0; p.ph_hi = NPHASE; p.li = 0;
    hipLaunchKernelGGL(fwd_kernel, dim3(grid), dim3(NWAVES * 64), LDS_BYTES, stream, p);
#else
    for (int k = 0; k < NPHASE; ++k) { p.ph_lo = k; p.ph_hi = k + 1; p.li = k; hipLaunchKernelGGL(fwd_kernel, dim3(grid), dim3(NWAVES * 64), LDS_BYTES, stream, p); }
#endif
}
```

```cpp
#include <hip/hip_runtime.h>
#include <cstdio>
#include <cstdint>
#ifndef MK_ONE_LAUNCH
#define MK_ONE_LAUNCH 1
#endif
namespace pg8 {
#define PG8_LAS __attribute__((address_space(3)))
typedef unsigned short bf16_t;
typedef short bf16x8 __attribute__((ext_vector_type(8)));
typedef float f32x4 __attribute__((ext_vector_type(4)));
typedef unsigned u32x4 __attribute__((ext_vector_type(4)));
typedef int i32x4 __attribute__((ext_vector_type(4)));
typedef int i32x8 __attribute__((ext_vector_type(8)));
constexpr int BM = 256, BK = 64, HALF = 128, HTB = HALF * BK * 2  , STAGE_BYTES = 8 * HTB, NXCD = 8, WGM = 8;

__host__ __device__ __forceinline__ int lds_byte(int r, int c) { const int st = (r >> 4) * 2 + (c >> 5), rr = r & 15, cc = c & 31, ob = rr * 64 + cc * 2; return st * 1024 + (ob ^ (((ob >> 9) & 1) << 5)); }
__host__ __device__ __forceinline__ void stage_rc(int b, int& R, int& C) { const int st = b / 1024, sb = b % 1024, swz = sb ^ (((sb >> 9) & 1) << 5); R = (st >> 1) * 16 + swz / 64; C = (st & 1) * 32 + (swz % 64) / 2; }
__host__ __device__ __forceinline__ int perm32(int rho) { const int n = rho >> 4, i = rho & 15; return 8 * (i >> 2) + 4 * n + (i & 3); }

struct Unit { int pm, pn; };
struct Gemm { const bf16_t* A; const bf16_t* Bt; int M, N, K; };

struct StaticOrder {
    static constexpr bool GATHER = false;
    __device__ __forceinline__ int rowof(const Unit&, int, int) const { return 0; }
    int nM, nN, nwg, G, c;
    __host__ __device__ void init(int M, int N, int G_, int c_) { nM = M / BM; nN = N / BM; nwg = nM * nN; G = G_; c = c_; }
    __host__ __device__ bool next(int i, Unit& u) const {
        const long L = (long)i * G + c; if (L >= nwg) return false;
        int wgid = (int)L; { const int q = nwg / NXCD, r = nwg % NXCD, xcd = wgid % NXCD, off = wgid / NXCD; wgid = (xcd < r ? xcd * (q + 1) : r * (q + 1) + (xcd - r) * q) + off; }
        const int nig = WGM * nN, gid = wgid / nig, fm = gid * WGM, gsz = (nM - fm) < WGM ? (nM - fm) : WGM;
        u.pm = fm + ((wgid % nig) % gsz); u.pn = (wgid % nig) / gsz; return true;
    }
    __device__ __forceinline__ void a_ready(const Unit&) const {}
    __device__ __forceinline__ const char* bptr(const Gemm& g, const Unit& u, size_t tstep) const { return (const char*)g.Bt + (size_t)u.pn * tstep; }
    __device__ __forceinline__ void done(const Unit&) const {}
};

__device__ __forceinline__ unsigned cvt_pk_bf16(float lo, float hi) { unsigned r; asm volatile("v_cvt_pk_bf16_f32 %0, %1, %2" : "=v"(r) : "v"(lo), "v"(hi)); return r; }
typedef float f32x2 __attribute__((ext_vector_type(2)));
__device__ __forceinline__ f32x2 gelu_pk(f32x2 v) {
    const f32x2 av = __builtin_elementwise_abs(v), d = av * 0.2316418882f + 1.0f;
    f32x2 t; t.x = __builtin_amdgcn_rcpf(d.x); t.y = __builtin_amdgcn_rcpf(d.y);
    f32x2 q = t * 0.5307027145f + (-0.7265760135f); q = q * t + 0.7107068705f; q = q * t + (-0.142248368f); q = q * t + 0.127414796f; q = q * t;
    const f32x2 s = (v * v) * (-0.72134752044f);
    f32x2 e; e.x = __builtin_amdgcn_exp2f(s.x); e.y = __builtin_amdgcn_exp2f(s.y);
    const f32x2 m = v * (q * e), r = v - m;
    f32x2 o; o.x = v.x < 0.f ? m.x : r.x; o.y = v.y < 0.f ? m.y : r.y; return o;
}

template <int ACT  > struct EpiBf16 {
    static constexpr bool PERM = true, AFTER_DRAIN = false; static_assert(ACT == 0 || ACT == 1, "EpiBf16: ACT is 0 (none) or 1 (gelu_pk)");
    bf16_t* O; int ldc; const float* bias; int split_cols; size_t split_stride; float scale0;
    __device__ __forceinline__ void operator()(const f32x4 (&acc)[2][2][4][2], const Unit& u, int wr, int wc, int fr, int fq) const {
        const int row0 = u.pm * BM + wr * 64 + fr; int colt = u.pn * BM; bf16_t* base = O;
        float sc = 1.f; if (split_cols) { const int t = colt / split_cols; base += (size_t)t * split_stride; colt -= t * split_cols; if (t == 0) sc = scale0; }
        const int col0 = colt + wc * 32 + 8 * fq, bcol0 = u.pn * BM + wc * 32 + 8 * fq;
        f32x4 bv[2][2];
#pragma unroll
        for (int bj = 0; bj < 2; ++bj)
#pragma unroll
            for (int n = 0; n < 2; ++n) bv[bj][n] = bias ? *(const f32x4*)(bias + bcol0 + bj * HALF + 4 * n) : (f32x4){0.f, 0.f, 0.f, 0.f};
#pragma unroll
        for (int ai = 0; ai < 2; ++ai)
#pragma unroll
            for (int m = 0; m < 4; ++m) { bf16_t* rowp = base + (size_t)(row0 + ai * HALF + m * 16) * ldc + col0;
#pragma unroll
                for (int bj = 0; bj < 2; ++bj) { f32x4 v0 = acc[ai][bj][m][0] + bv[bj][0], v1 = acc[ai][bj][m][1] + bv[bj][1];
                    if (ACT == 1) { f32x2 a = gelu_pk((f32x2){v0[0], v0[1]}), b = gelu_pk((f32x2){v0[2], v0[3]}), c = gelu_pk((f32x2){v1[0], v1[1]}), d = gelu_pk((f32x2){v1[2], v1[3]});
                        v0 = (f32x4){a.x, a.y, b.x, b.y}; v1 = (f32x4){c.x, c.y, d.x, d.y}; }
                    v0 = v0 * sc; v1 = v1 * sc; u32x4 w; w.x = cvt_pk_bf16(v0[0], v0[1]); w.y = cvt_pk_bf16(v0[2], v0[3]); w.z = cvt_pk_bf16(v1[0], v1[1]); w.w = cvt_pk_bf16(v1[2], v1[3]);
                    *(u32x4*)(rowp + bj * HALF) = w; } }
    }
};
template <class Epi, class Sched, bool ALIGN_EPI = false, bool SP2 = false, bool ELT8 = false>
__device__ __forceinline__ void gemm_phase(PG8_LAS unsigned char* lds, const Gemm g, const Sched& S, const Epi& E) {
    const int tid = threadIdx.x, wid = __builtin_amdgcn_readfirstlane(tid >> 6), lane = tid & 63, wr = wid >> 2, wc = wid & 3, fr = lane & 15, fq = lane >> 4;
    const int K = g.K, rowb = ELT8 ? K : 2 * K  , nt = rowb / (2 * BK);
    constexpr bool GATHER = Sched::GATHER; static_assert(!GATHER || SP2, "gathered A: SP2 loop only");
    unsigned voffA[2], voffB[2]; int gR[2]; unsigned gC2[2];
#pragma unroll
    for (int i = 0; i < 2; ++i) { int R, C; stage_rc(tid * 16 + i * 8192, R, C); const int Rb = Epi::PERM ? ((R & ~31) + perm32(R & 31)) : R;
        voffA[i] = (unsigned)(R * rowb + C * 2); voffB[i] = (unsigned)(Rb * rowb + C * 2); gR[i] = R; gC2[i] = (unsigned)C * 2u; }
    unsigned gc0[2] = {0u, 0u}, gc1[2] = {0u, 0u}, gn0[2] = {0u, 0u}, gn1[2] = {0u, 0u};
#define PG8_GOFF(dst0, dst1, u, ord) do { _Pragma("unroll") for (int _i = 0; _i < 2; ++_i) { dst0[_i] = (unsigned)S.rowof((u), (ord), gR[_i]) * (unsigned)rowb + gC2[_i]; dst1[_i] = (unsigned)S.rowof((u), (ord), HALF + gR[_i]) * (unsigned)rowb + gC2[_i]; } } while (0)
#define PG8_STAGE_A(bufoff, base, h, G0, G1) do { if constexpr (GATHER) { if constexpr ((h) != 0) PG8_STAGE(bufoff, base, G1); else PG8_STAGE(bufoff, base, G0); } else { PG8_STAGE(bufoff, (base) + (h) * hstep, voffA); } } while (0)
    const size_t kstep = (size_t)(BK * 2);
    const size_t hstep = (size_t)HALF * rowb;
    const size_t tstep = 2 * hstep;
    const unsigned ldsw = (unsigned)wid * 1024u;
    const int aoff = lds_byte(wr * 64 + fr, fq * 8), boff = lds_byte(wc * 32 + fr, fq * 8);
#define PG8_SA(b, h) (((b) * 2 + (h)) * HTB)
#define PG8_SB(b, h) ((4 + (b) * 2 + (h)) * HTB)
#define PG8_STAGE(bufoff, gbase, voff) do { _Pragma("unroll") for (int _i = 0; _i < 2; ++_i) \
        __builtin_amdgcn_global_load_lds((const unsigned*)((const char*)(gbase) + (voff)[_i]), (PG8_LAS unsigned*)(lds + (bufoff) + ldsw + _i * 8192), 16, 0, 0); } while (0)
#define PG8_RD16(off) (*(const PG8_LAS i32x4*)(lds + (off)))
#define PG8_LDA(dst, b, h) do { _Pragma("unroll") for (int m = 0; m < 4; ++m) { const i32x4 lo_ = PG8_RD16(PG8_SA(b, h) + aoff + m * 2048), hi_ = PG8_RD16(PG8_SA(b, h) + aoff + m * 2048 + 1024); dst[m] = __builtin_shufflevector(lo_, hi_, 0, 1, 2, 3, 4, 5, 6, 7); } } while (0)
#define PG8_LDB(dst, b, h) do { _Pragma("unroll") for (int n = 0; n < 2; ++n) { const i32x4 lo_ = PG8_RD16(PG8_SB(b, h) + boff + n * 2048), hi_ = PG8_RD16(PG8_SB(b, h) + boff + n * 2048 + 1024); dst[n] = __builtin_shufflevector(lo_, hi_, 0, 1, 2, 3, 4, 5, 6, 7); } } while (0)
#define PG8_MMA(ai, bj, At, Bt) do { __builtin_amdgcn_s_setprio(1); _Pragma("unroll") for (int m = 0; m < 4; ++m) _Pragma("unroll") for (int n = 0; n < 2; ++n) { \
        if constexpr (ELT8) { asm volatile("v_mfma_scale_f32_16x16x128_f8f6f4 %0, %1, %2, %0, %3, %3 op_sel_hi:[0,0,0]" : "+v"(acc[ai][bj][m][n]) : "v"(Bt[n]), "v"(At[m]), "v"(scale1)); }     \
        else { acc[ai][bj][m][n] = __builtin_amdgcn_mfma_f32_16x16x32_bf16(__builtin_bit_cast(bf16x8, __builtin_shufflevector(Bt[n], Bt[n], 0, 1, 2, 3)), __builtin_bit_cast(bf16x8, __builtin_shufflevector(At[m], At[m], 0, 1, 2, 3)), acc[ai][bj][m][n], 0, 0, 0); \
               acc[ai][bj][m][n] = __builtin_amdgcn_mfma_f32_16x16x32_bf16(__builtin_bit_cast(bf16x8, __builtin_shufflevector(Bt[n], Bt[n], 4, 5, 6, 7)), __builtin_bit_cast(bf16x8, __builtin_shufflevector(At[m], At[m], 4, 5, 6, 7)), acc[ai][bj][m][n], 0, 0, 0); } } \
        __builtin_amdgcn_s_setprio(0); } while (0)
#define PG8_WAIT_V(n) asm volatile("s_waitcnt vmcnt(" #n ")" ::: "memory")
#define PG8_WAIT_L(n) asm volatile("s_waitcnt lgkmcnt(" #n ")" ::: "memory")
#define PG8_BAR __builtin_amdgcn_s_barrier()
#define PG8_SCHED __builtin_amdgcn_sched_barrier(0)
    Unit cur, nxt; int ui = 0;
    if (!S.next(0, cur)) return;
    f32x4 acc[2][2][4][2];
#pragma unroll
    for (int a = 0; a < 2; ++a)
#pragma unroll
        for (int b = 0; b < 2; ++b)
#pragma unroll
            for (int m = 0; m < 4; ++m)
#pragma unroll
                for (int n = 0; n < 2; ++n) acc[a][b][m][n] = (f32x4){0.f, 0.f, 0.f, 0.f};
    const int scale1 = 0x7f7f7f7f;
    i32x8 At[4], B0[2], B1[2];
    const char* cA = GATHER ? (const char*)g.A : (const char*)g.A + (size_t)cur.pm * tstep; const char* cB = S.bptr(g, cur, tstep);
    if constexpr (GATHER) PG8_GOFF(gc0, gc1, cur, 0);
    S.a_ready(cur);
    if constexpr (SP2) {
        PG8_STAGE(PG8_SB(0, 0), cB, voffB); PG8_STAGE(PG8_SB(0, 1), cB + hstep, voffB); PG8_STAGE_A(PG8_SA(0, 0), cA, 0, gc0, gc1); PG8_STAGE_A(PG8_SA(0, 1), cA, 1, gc0, gc1);
        if (wr == 1) PG8_BAR;
        PG8_WAIT_V(2); PG8_BAR;
        PG8_STAGE(PG8_SB(1, 0), cB + kstep, voffB); PG8_STAGE_A(PG8_SA(1, 0), cA + kstep, 0, gc0, gc1); PG8_STAGE(PG8_SB(1, 1), cB + hstep + kstep, voffB);
        PG8_WAIT_V(6); PG8_BAR;
    } else {
        PG8_STAGE(PG8_SB(0, 0), cB, voffB); PG8_STAGE(PG8_SA(0, 0), cA, voffA); PG8_STAGE(PG8_SB(0, 1), cB + hstep, voffB); PG8_STAGE(PG8_SA(0, 1), cA + hstep, voffA);
        if (wr == 1) PG8_BAR;
        PG8_WAIT_V(4); PG8_BAR;
        PG8_STAGE(PG8_SB(1, 0), cB + kstep, voffB); PG8_STAGE(PG8_SA(1, 0), cA + kstep, voffA); PG8_STAGE(PG8_SB(1, 1), cB + hstep + kstep, voffB);
        PG8_WAIT_V(6); PG8_BAR;
    }
    for (;;) {
        const bool has_next = S.next(ui + 1, nxt);
        const char* nA = has_next ? (GATHER ? (const char*)g.A : (const char*)g.A + (size_t)nxt.pm * tstep) : cA; const char* nB = has_next ? S.bptr(g, nxt, tstep) : cB;
        if constexpr (GATHER) { if (has_next) PG8_GOFF(gn0, gn1, nxt, ui + 1); else { gn0[0] = gc0[0]; gn0[1] = gc0[1]; gn1[0] = gc1[0]; gn1[1] = gc1[1]; } }
#pragma unroll 1
        for (int t = 0; t < nt; t += 2) {
            const bool last = (t == nt - 2);
            const char* a1 = cA + (size_t)(t + 1) * kstep;
            const char* a2 = last ? nA : cA + (size_t)(t + 2) * kstep; const char* b2 = last ? nB : cB + (size_t)(t + 2) * kstep;
            const char* a3 = a2 + kstep; const char* b3 = b2 + kstep;
            if (last && has_next) S.a_ready(nxt);
            unsigned o20[2] = {0u, 0u}, o21[2] = {0u, 0u};
            if constexpr (GATHER) { o20[0] = last ? gn0[0] : gc0[0]; o20[1] = last ? gn0[1] : gc0[1]; o21[0] = last ? gn1[0] : gc1[0]; o21[1] = last ? gn1[1] : gc1[1]; }
            if constexpr (SP2) {
            PG8_LDB(B0, 0, 0); PG8_LDB(B1, 0, 1); PG8_SCHED; PG8_LDA(At, 0, 0); PG8_STAGE_A(PG8_SA(1, 1), a1, 1, gc0, gc1);
            PG8_WAIT_V(8); PG8_WAIT_L(0); PG8_BAR; PG8_MMA(0, 0, At, B0); PG8_MMA(0, 1, At, B1); PG8_BAR; PG8_SCHED;
            PG8_LDA(At, 0, 1); PG8_STAGE(PG8_SB(0, 0), b2, voffB); PG8_STAGE(PG8_SB(0, 1), b2 + hstep, voffB); PG8_STAGE_A(PG8_SA(0, 0), a2, 0, o20, o21);
            PG8_WAIT_V(8); PG8_WAIT_L(0); PG8_BAR; PG8_MMA(1, 0, At, B0); PG8_MMA(1, 1, At, B1); PG8_BAR; PG8_SCHED;
            PG8_LDB(B0, 1, 0); PG8_LDB(B1, 1, 1); PG8_SCHED; PG8_LDA(At, 1, 0); PG8_STAGE_A(PG8_SA(0, 1), a2, 1, o20, o21);
            PG8_WAIT_V(8); PG8_WAIT_L(0); PG8_BAR; PG8_MMA(0, 0, At, B0); PG8_MMA(0, 1, At, B1); PG8_BAR; PG8_SCHED;
            PG8_LDA(At, 1, 1); PG8_STAGE(PG8_SB(1, 0), b3, voffB); PG8_STAGE(PG8_SB(1, 1), b3 + hstep, voffB); PG8_STAGE_A(PG8_SA(1, 0), a3, 0, o20, o21);
            PG8_WAIT_V(8); PG8_WAIT_L(0); PG8_BAR; PG8_MMA(1, 0, At, B0); PG8_MMA(1, 1, At, B1); PG8_BAR; PG8_SCHED;
            } else {
            PG8_LDB(B0, 0, 0); PG8_SCHED; PG8_LDA(At, 0, 0); PG8_STAGE(PG8_SA(1, 1), a1 + hstep, voffA);
            PG8_WAIT_L(8); PG8_BAR; PG8_WAIT_L(0); PG8_MMA(0, 0, At, B0); PG8_BAR; PG8_SCHED;
            PG8_LDB(B1, 0, 1); PG8_STAGE(PG8_SB(0, 0), b2, voffB);
            PG8_BAR; PG8_WAIT_L(0); PG8_MMA(0, 1, At, B1); PG8_BAR;
            PG8_LDA(At, 0, 1); PG8_STAGE(PG8_SA(0, 0), a2, voffA);
            PG8_BAR; PG8_WAIT_L(0); PG8_MMA(1, 0, At, B0); PG8_BAR; PG8_SCHED;
            PG8_STAGE(PG8_SB(0, 1), b2 + hstep, voffB);
            PG8_WAIT_V(6); PG8_BAR; PG8_MMA(1, 1, At, B1); PG8_BAR;
            PG8_LDB(B0, 1, 0); PG8_SCHED; PG8_LDA(At, 1, 0); PG8_STAGE(PG8_SA(0, 1), a2 + hstep, voffA);
            PG8_WAIT_L(8); PG8_BAR; PG8_WAIT_L(0); PG8_MMA(0, 0, At, B0); PG8_BAR; PG8_SCHED;
            PG8_LDB(B1, 1, 1); PG8_STAGE(PG8_SB(1, 0), b3, voffB);
            PG8_BAR; PG8_WAIT_L(0); PG8_MMA(0, 1, At, B1); PG8_BAR;
            PG8_LDA(At, 1, 1); PG8_STAGE(PG8_SA(1, 0), a3, voffA);
            PG8_BAR; PG8_WAIT_L(0); PG8_MMA(1, 0, At, B0); PG8_BAR; PG8_SCHED;
            PG8_STAGE(PG8_SB(1, 1), b3 + hstep, voffB);
            PG8_WAIT_V(6); PG8_BAR; PG8_MMA(1, 1, At, B1); PG8_BAR;
            }
        }
        if constexpr (ALIGN_EPI) { if (wr == 0) PG8_BAR; }
        if constexpr (ELT8) asm volatile("s_nop 15\n\ts_nop 15" ::: "memory");
        if constexpr (!Epi::AFTER_DRAIN) { E(acc, cur, wr, wc, fr, fq); S.done(cur); }
        if (!has_next) break;
#pragma unroll
        for (int a = 0; a < 2; ++a)
#pragma unroll
            for (int b = 0; b < 2; ++b)
#pragma unroll
                for (int m = 0; m < 4; ++m)
#pragma unroll
                    for (int n = 0; n < 2; ++n) acc[a][b][m][n] = (f32x4){0.f, 0.f, 0.f, 0.f};
        cur = nxt; cA = nA; cB = nB; ++ui;
        if constexpr (GATHER) { gc0[0] = gn0[0]; gc0[1] = gn0[1]; gc1[0] = gn1[0]; gc1[1] = gn1[1]; }
        if constexpr (ALIGN_EPI) { if (wr == 1) PG8_BAR; }
    }
    PG8_WAIT_V(0);
    if constexpr (!ALIGN_EPI) { if (wr == 0) PG8_BAR; }
    PG8_BAR;
    if constexpr (Epi::AFTER_DRAIN) { E.fused(acc, cur, wr, wc, fr, fq, lds, wid, lane); S.done(cur); }
#undef PG8_SA
#undef PG8_SB
#undef PG8_STAGE
#undef PG8_STAGE_A
#undef PG8_GOFF
#undef PG8_LDA
#undef PG8_RD16
#undef PG8_LDB
#undef PG8_MMA
#undef PG8_WAIT_V
#undef PG8_WAIT_L
#undef PG8_BAR
#undef PG8_SCHED
}
}
namespace pg8 {
__device__ __forceinline__ float sigm(float v) { return __builtin_amdgcn_rcpf(1.0f + __builtin_amdgcn_exp2f(-1.4426950408889634f * v)); }
struct EpiIn {
    static constexpr bool PERM = true, AFTER_DRAIN = false;
    bf16_t* U; bf16_t* V; bf16_t* G;
    __device__ __forceinline__ void operator()(const f32x4 (&acc)[2][2][4][2], const Unit& u, int wr, int wc, int fr, int fq) const {
        const int row0 = u.pm * BM + wr * 64 + fr;
        if (u.pn < 4) {
            bf16_t* base = (u.pn < 2) ? U : V; const int col0 = (u.pn & 1) * 256 + wc * 32 + 8 * fq;
#pragma unroll
            for (int ai = 0; ai < 2; ++ai)
#pragma unroll
                for (int m = 0; m < 4; ++m) { bf16_t* rowp = base + (size_t)(row0 + ai * HALF + m * 16) * 512 + col0;
#pragma unroll
                    for (int bj = 0; bj < 2; ++bj) { f32x4 v0 = acc[ai][bj][m][0], v1 = acc[ai][bj][m][1];
                        f32x2 a = gelu_pk((f32x2){v0[0], v0[1]}), b = gelu_pk((f32x2){v0[2], v0[3]}), c = gelu_pk((f32x2){v1[0], v1[1]}), d = gelu_pk((f32x2){v1[2], v1[3]});
                        u32x4 w; w.x = cvt_pk_bf16(a.x, a.y); w.y = cvt_pk_bf16(b.x, b.y); w.z = cvt_pk_bf16(c.x, c.y); w.w = cvt_pk_bf16(d.x, d.y);
                        *(u32x4*)(rowp + bj * HALF) = w; } }
        } else {
            const int col0 = (u.pn - 4) * 128 + wc * 32 + 8 * fq;
#pragma unroll
            for (int ai = 0; ai < 2; ++ai)
#pragma unroll
                for (int m = 0; m < 4; ++m) { bf16_t* rowp = G + (size_t)(row0 + ai * HALF + m * 16) * 512 + col0;
                    const f32x4 a0 = acc[ai][0][m][0], a1 = acc[ai][0][m][1], g0 = acc[ai][1][m][0], g1 = acc[ai][1][m][1];
                    u32x4 w; w.x = cvt_pk_bf16(a0[0] * sigm(g0[0]), a0[1] * sigm(g0[1])); w.y = cvt_pk_bf16(a0[2] * sigm(g0[2]), a0[3] * sigm(g0[3]));
                    w.z = cvt_pk_bf16(a1[0] * sigm(g1[0]), a1[1] * sigm(g1[1])); w.w = cvt_pk_bf16(a1[2] * sigm(g1[2]), a1[3] * sigm(g1[3]));
                    *(u32x4*)rowp = w; }
        }
    }
};
__device__ __forceinline__ unsigned pk_fp8x4(float a, float b, float c, float d);
__device__ __forceinline__ void st8x2_wide(unsigned char* pa, unsigned ax, unsigned ay, unsigned char* pb, unsigned bx, unsigned by, int fq) {
    auto rx = __builtin_amdgcn_permlane16_swap(ax, bx, false, false); auto ry = __builtin_amdgcn_permlane16_swap(ay, by, false, false);
    const u32x4 w = {rx[0], ry[0], rx[1], ry[1]};
    *(u32x4*)((fq & 1) ? pb - 8 : pa) = w;
}
struct EpiQKV {
    static constexpr bool PERM = true, AFTER_DRAIN = false;
    bf16_t* Q; size_t tstride; float* kmean; static constexpr float sc = 0.03125f;
    unsigned char* QK8;
    __device__ __forceinline__ void operator()(const f32x4 (&acc)[2][2][4][2], const Unit& u, int wr, int wc, int fr, int fq) const {
        const int row0 = u.pm * BM + wr * 64 + fr; const int t = u.pn >> 2; bf16_t* base = Q + (size_t)t * tstride; const int col0 = (u.pn & 3) * 256 + wc * 32 + 8 * fq;
#pragma unroll
        for (int ai = 0; ai < 2; ++ai)
#pragma unroll
            for (int m = 0; m < 4; ++m) { bf16_t* rowp = base + (size_t)(row0 + ai * HALF + m * 16) * 1024 + col0; unsigned w8x[2], w8y[2];
#pragma unroll
                for (int bj = 0; bj < 2; ++bj) { const f32x4 v0 = acc[ai][bj][m][0] * sc, v1 = acc[ai][bj][m][1] * sc;
                    if (t == 0) { u32x4 w; w.x = cvt_pk_bf16(v0[0], v0[1]); w.y = cvt_pk_bf16(v0[2], v0[3]); w.z = cvt_pk_bf16(v1[0], v1[1]); w.w = cvt_pk_bf16(v1[2], v1[3]);
                        *(u32x4*)(rowp + bj * HALF) = w; }
                    w8x[bj] = pk_fp8x4(v0[0], v0[1], v0[2], v0[3]); w8y[bj] = pk_fp8x4(v1[0], v1[1], v1[2], v1[3]); }
                { unsigned char* p8 = QK8 + (size_t)t * ((size_t)32 << 20) + (size_t)(row0 + ai * HALF + m * 16) * 1024 + col0; st8x2_wide(p8, w8x[0], w8y[0], p8 + HALF, w8x[1], w8y[1], fq); } }
        if (t == 1) { const int b = u.pm >> 3, blk = u.pm & 7;
#pragma unroll
            for (int bj = 0; bj < 2; ++bj)
#pragma unroll
                for (int n = 0; n < 2; ++n) { f32x4 s = (f32x4){0.f, 0.f, 0.f, 0.f};
#pragma unroll
                    for (int ai = 0; ai < 2; ++ai)
#pragma unroll
                        for (int m = 0; m < 4; ++m) s += acc[ai][bj][m][n];
#pragma unroll
                    for (int j = 0; j < 4; ++j) { float v = s[j]; v += __shfl_xor(v, 1); v += __shfl_xor(v, 2); v += __shfl_xor(v, 4); v += __shfl_xor(v, 8); s[j] = v; }
                    if (fr == 0) { const int kc = (u.pn & 3) * 256 + bj * HALF + wc * 32 + 8 * fq + 4 * n, h = kc >> 7, d = kc & 127; float* kp = kmean + ((size_t)(b * 8 + h) * 8 + blk) * 128 + d;
#pragma unroll
                        for (int j = 0; j < 4; ++j) atomicAdd(kp + j, s[j] * (sc * (1.0f / 256.0f))); } }
        }
    }
};
struct EpiSwiGLU {
    static constexpr bool PERM = true, AFTER_DRAIN = false;
    bf16_t* Hid;
    __device__ __forceinline__ void operator()(const f32x4 (&acc)[2][2][4][2], const Unit& u, int wr, int wc, int fr, int fq) const {
        const int row0 = u.pm * BM + wr * 64 + fr, col0 = u.pn * 128 + wc * 32 + 8 * fq;
#pragma unroll
        for (int ai = 0; ai < 2; ++ai)
#pragma unroll
            for (int m = 0; m < 4; ++m) { bf16_t* rowp = Hid + (size_t)(row0 + ai * HALF + m * 16) * 512 + col0;
                const f32x4 g0 = acc[ai][0][m][0], g1 = acc[ai][0][m][1], u0 = acc[ai][1][m][0], u1 = acc[ai][1][m][1];
                u32x4 w; w.x = cvt_pk_bf16(g0[0] * sigm(g0[0]) * u0[0], g0[1] * sigm(g0[1]) * u0[1]); w.y = cvt_pk_bf16(g0[2] * sigm(g0[2]) * u0[2], g0[3] * sigm(g0[3]) * u0[3]);
                w.z = cvt_pk_bf16(g1[0] * sigm(g1[0]) * u1[0], g1[1] * sigm(g1[1]) * u1[1]); w.w = cvt_pk_bf16(g1[2] * sigm(g1[2]) * u1[2], g1[3] * sigm(g1[3]) * u1[3]);
                *(u32x4*)rowp = w; }
    }
};
constexpr float W8SCALE = 32.0f, W8INV = 1.0f / 32.0f;
__device__ __forceinline__ unsigned pk_fp8x4(float a, float b, float c, float d) { int w = __builtin_amdgcn_cvt_pk_fp8_f32(a, b, 0, false); w = __builtin_amdgcn_cvt_pk_fp8_f32(c, d, w, true); return (unsigned)w; }
struct EpiSwiGLU8 {
    static constexpr bool PERM = true, AFTER_DRAIN = false;
    unsigned char* Hid;
    __device__ __forceinline__ void operator()(const f32x4 (&acc)[2][2][4][2], const Unit& u, int wr, int wc, int fr, int fq) const {
        const int row0 = u.pm * BM + wr * 64 + fr, col0 = u.pn * 128 + wc * 32 + 8 * fq;
#pragma unroll
        for (int ai = 0; ai < 2; ++ai)
#pragma unroll
            for (int m2 = 0; m2 < 4; m2 += 2) { unsigned wx[2], wy[2];
#pragma unroll
                for (int mm = 0; mm < 2; ++mm) { const int m = m2 + mm;
                    const f32x4 g0 = acc[ai][0][m][0] * W8INV, g1 = acc[ai][0][m][1] * W8INV, u0 = acc[ai][1][m][0] * W8INV, u1 = acc[ai][1][m][1] * W8INV;
                    wx[mm] = pk_fp8x4(g0[0] * sigm(g0[0]) * u0[0], g0[1] * sigm(g0[1]) * u0[1], g0[2] * sigm(g0[2]) * u0[2], g0[3] * sigm(g0[3]) * u0[3]);
                    wy[mm] = pk_fp8x4(g1[0] * sigm(g1[0]) * u1[0], g1[1] * sigm(g1[1]) * u1[1], g1[2] * sigm(g1[2]) * u1[2], g1[3] * sigm(g1[3]) * u1[3]); }
                unsigned char* rowp = Hid + (size_t)(row0 + ai * HALF + m2 * 16) * 512 + col0;
                st8x2_wide(rowp, wx[0], wy[0], rowp + 16 * 512, wx[1], wy[1], fq); }
    }
};
struct EpiYs8 {
    static constexpr bool PERM = true, AFTER_DRAIN = false;
    bf16_t* O; float sc;
    __device__ __forceinline__ void operator()(const f32x4 (&acc)[2][2][4][2], const Unit& u, int wr, int wc, int fr, int fq) const {
        const int row0 = u.pm * BM + wr * 64 + fr, col0 = u.pn * BM + wc * 32 + 8 * fq;
#pragma unroll
        for (int ai = 0; ai < 2; ++ai)
#pragma unroll
            for (int m = 0; m < 4; ++m) { bf16_t* rowp = O + (size_t)(row0 + ai * HALF + m * 16) * 1024 + col0;
#pragma unroll
                for (int bj = 0; bj < 2; ++bj) { const f32x4 v0 = acc[ai][bj][m][0] * sc, v1 = acc[ai][bj][m][1] * sc;
                    u32x4 w; w.x = cvt_pk_bf16(v0[0], v0[1]); w.y = cvt_pk_bf16(v0[2], v0[3]); w.z = cvt_pk_bf16(v1[0], v1[1]); w.w = cvt_pk_bf16(v1[2], v1[3]);
                    *(u32x4*)(rowp + bj * HALF) = w; } }
    }
};
struct EpiYsF8 {
    static constexpr bool PERM = true, AFTER_DRAIN = false;
    unsigned char* O; float sc;
    __device__ __forceinline__ void operator()(const f32x4 (&acc)[2][2][4][2], const Unit& u, int wr, int wc, int fr, int fq) const {
        const int row0 = u.pm * BM + wr * 64 + fr, col0 = u.pn * BM + wc * 32 + 8 * fq; typedef unsigned u32x2 __attribute__((ext_vector_type(2)));
#pragma unroll
        for (int ai = 0; ai < 2; ++ai)
#pragma unroll
            for (int m = 0; m < 4; ++m) { unsigned char* rowp = O + (size_t)(row0 + ai * HALF + m * 16) * 1024 + col0;
                unsigned wx[2], wy[2];
#pragma unroll
                for (int bj = 0; bj < 2; ++bj) { const f32x4 v0 = acc[ai][bj][m][0] * sc, v1 = acc[ai][bj][m][1] * sc; wx[bj] = pk_fp8x4(v0[0], v0[1], v0[2], v0[3]); wy[bj] = pk_fp8x4(v1[0], v1[1], v1[2], v1[3]); }
                st8x2_wide(rowp, wx[0], wy[0], rowp + HALF, wx[1], wy[1], fq); }
    }
};
template <bool GATHER_> struct GroupedOrder {
    static constexpr bool GATHER = GATHER_; const PG8_LAS int* rowlds = nullptr;
    __device__ __forceinline__ int rowof(const Unit&, int ord, int r) const { return rowlds[ord * BM + r]; }
    static constexpr int MAXU = 6;
    __device__ __forceinline__ void stage_rows(const int* inv  , int cap, const PG8_LAS int* start, const PG8_LAS int* tot, PG8_LAS int* dst) { rowlds = dst; Unit u;
        for (int i = 0; i < MAXU && next(i, u); ++i) if (threadIdx.x < BM) { const int e = tile_e[u.pm], off = u.pm * BM - start[e] + (int)threadIdx.x; dst[i * BM + threadIdx.x] = off < tot[e] ? inv[e * cap + off] : 0; }
        __syncthreads(); }
    const PG8_LAS int* tile_e;   int nwg, nN, G, c; size_t estride;
    __device__ __forceinline__ void init(const PG8_LAS int* te, int ntiles, int nN_, int G_, int blk, size_t es) { tile_e = te; nN = nN_; nwg = ntiles * nN_; G = G_; estride = es;
        c = (G_ % 8 == 0) ? (blk % 8) * (G_ / 8) + blk / 8 : blk; }
    __device__ __forceinline__ bool next(int i, Unit& u) const { const long L = (long)i * G + c; if (L >= nwg) return false; u.pm = (int)(L / nN); u.pn = (int)(L % nN); return true; }
    __device__ __forceinline__ void a_ready(const Unit&) const {}
    __device__ __forceinline__ const char* bptr(const Gemm& g, const Unit& u, size_t tstep) const {
        const int e = __builtin_amdgcn_readfirstlane(tile_e[u.pm]); return (const char*)g.Bt + (size_t)e * estride + (size_t)u.pn * tstep; }
    __device__ __forceinline__ void done(const Unit&) const {}
};
}
namespace att {
typedef unsigned short bf16;
constexpr int D = 128, PITCH = 1024;
constexpr float SCALE = 0.08838834764831845f;
constexpr float THR = 0.f;
constexpr int NW = 8, QBLK = 32, KVBLK = 64, QB = NW * QBLK;
constexpr int SHM_V = KVBLK * D * 2, SHM_K = KVBLK * D * 2;
constexpr int LDS_BYTES = 2 * SHM_V + 2 * SHM_K + NW * 64 * 4;
typedef short bf16x8 __attribute__((ext_vector_type(8)));
typedef short s16x4 __attribute__((ext_vector_type(4)));
typedef float f32x16 __attribute__((ext_vector_type(16)));
typedef float f32x4 __attribute__((ext_vector_type(4)));
typedef unsigned u32x4 __attribute__((ext_vector_type(4)));
#define KSWZ(row, colB) ((row) * 256 + ((colB) ^ (((row) & 7) << 4)))
#define SBAR() __builtin_amdgcn_sched_barrier(0)
__device__ __forceinline__ int v_st(int k, int c) { const int kk = (k & ~0xC) | ((k & 4) << 1) | ((k & 8) >> 1); return ((kk >> 3) * 4 + (c >> 5)) * 512 + ((kk & 7) * 32 + (c & 31)) * 2; }
__device__ __forceinline__ int v_rd_base(int lane) { return ((lane & 3) << 3) | (((lane >> 2) & 3) << 6) | (((lane >> 4) & 1) << 5) | (((lane >> 5) & 1) << 8); }
constexpr int v_rd_off(int d0, int ks, int half) { return d0 * 512 + ks * 4096 + half * 2048; }
__device__ __forceinline__ int crow(int r, int hi) { return (r & 3) + 8 * (r >> 2) + 4 * hi; }
__device__ __forceinline__ unsigned cvtpk(float lo, float hi) { unsigned r; asm volatile("v_cvt_pk_bf16_f32 %0, %1, %2" : "=v"(r) : "v"(lo), "v"(hi)); return r; }
__device__ __forceinline__ bf16x8 load8(const bf16* p) { return *reinterpret_cast<const bf16x8*>(p); }
__device__ __forceinline__ void mask_tile(f32x16& p0, f32x16& p1, int dq) {
    const float NEG = -__builtin_inff();
#pragma unroll
    for (int r = 0; r < 16; ++r) {
        const int c = (r & 3) + 8 * (r >> 2);
        if (dq - c < 0) p0[r] = NEG;
        if (dq - c - 32 < 0) p1[r] = NEG;
    }
}
__device__ __forceinline__ void partialSM(f32x16& p0, f32x16& p1, float& m_reg, float& mn, float& alpha, bool keep) {
    float pmax = p0[0]; for (int r = 1; r < 16; ++r) pmax = fmaxf(pmax, p0[r]); for (int r = 0; r < 16; ++r) pmax = fmaxf(pmax, p1[r]);
    pmax = keep ? pmax : -__builtin_inff();
    { auto rr = __builtin_amdgcn_permlane32_swap(__float_as_uint(pmax), __float_as_uint(pmax), false, false);
      pmax = fmaxf(__uint_as_float(rr[0]), __uint_as_float(rr[1])); }
    constexpr float C2 = 1.4426950408889634f * SCALE;
    if (__builtin_expect(__all((pmax - m_reg) * SCALE <= THR), 1)) { mn = m_reg; alpha = 1.f; }
    else { mn = fmaxf(m_reg, pmax); alpha = __builtin_amdgcn_exp2f((m_reg - mn) * C2); m_reg = mn; }
    const float mnL = keep ? 8.0f - mn * C2 : -__builtin_inff();
    { typedef float f2_ __attribute__((ext_vector_type(2))); const f2_ c2 = {C2, C2}, ml = {mnL, mnL};
      for (int r = 0; r < 16; r += 2) { const f2_ a = __builtin_elementwise_fma((f2_){p0[r], p0[r + 1]}, c2, ml), b = __builtin_elementwise_fma((f2_){p1[r], p1[r + 1]}, c2, ml); p0[r] = a[0]; p0[r + 1] = a[1]; p1[r] = b[0]; p1[r + 1] = b[1]; } }
    for (int r = 0; r < 16; ++r) p0[r] = __builtin_amdgcn_exp2f(p0[r]);
}
__device__ __forceinline__ void finishSM(f32x16& p0, f32x16& p1, float alpha, float& l_reg, bf16x8& pa0, bf16x8& pa1, bf16x8& pa2, bf16x8& pa3) {
    for (int r = 0; r < 16; ++r) p1[r] = __builtin_amdgcn_exp2f(p1[r]);
    float ps = 0; for (int r = 0; r < 16; ++r) ps += p0[r]; for (int r = 0; r < 16; ++r) ps += p1[r];
    { auto rr = __builtin_amdgcn_permlane32_swap(__float_as_uint(ps), __float_as_uint(ps), false, false);
      ps = __uint_as_float(rr[0]) + __uint_as_float(rr[1]); }
    l_reg = l_reg * alpha + ps;
#define PK4(P, B_, OUT) do { unsigned a0 = cvtpk(P[B_+0], P[B_+1]), a1 = cvtpk(P[B_+2], P[B_+3]);                          \
        unsigned b0 = cvtpk(P[B_+4], P[B_+5]), b1 = cvtpk(P[B_+6], P[B_+7]);                                             \
        auto r0 = __builtin_amdgcn_permlane32_swap(a0, b0, false, false); auto r1 = __builtin_amdgcn_permlane32_swap(a1, b1, false, false); \
        u32x4 w = {r0[0], r1[0], r0[1], r1[1]}; OUT = *reinterpret_cast<bf16x8*>(&w); } while (0)
    PK4(p0, 0, pa0); PK4(p0, 8, pa1); PK4(p1, 0, pa2); PK4(p1, 8, pa3);
#undef PK4
}
template <int KB>
__device__ __forceinline__ void qkt(f32x16& p0, f32x16& p1, const char* K_lds, int r32, int hi, const bf16x8* qr) {
    p0 = f32x16{}; p1 = f32x16{};
    const char* kb[4];
#pragma unroll
    for (int dd = 0; dd < 4; ++dd) kb[dd] = K_lds + KB * SHM_K + KSWZ(r32, (dd * 16 + hi * 8) * 2);
#pragma unroll
    for (int d0 = 0; d0 < 8; ++d0) { const char* a = kb[d0 & 3] + (d0 >> 2) * 128;
        bf16x8 b0 = *reinterpret_cast<const bf16x8*>(a);
        bf16x8 b1 = *reinterpret_cast<const bf16x8*>(a + 32 * 256);
        p0 = __builtin_amdgcn_mfma_f32_32x32x16_bf16(b0, qr[d0], p0, 0, 0, 0);
        p1 = __builtin_amdgcn_mfma_f32_32x32x16_bf16(b1, qr[d0], p1, 0, 0, 0); }
}
typedef int i32x8_ __attribute__((ext_vector_type(8)));
template <int KB>
__device__ __forceinline__ void qkt8(f32x16& p0, f32x16& p1, const char* K_lds, int r32, int hi, const u32x4* q8) {
    p0 = f32x16{}; p1 = f32x16{};
    const char* kr = K_lds + KB * SHM_K + r32 * 128; const int kx = r32 & 7;
#pragma unroll
    for (int j = 0; j < 2; ++j) { const int c0 = ((4 * j + 2 * hi) ^ kx) << 4, c1 = ((4 * j + 2 * hi + 1) ^ kx) << 4;
        const u32x4 a0 = *(const u32x4*)(kr + c0), a1 = *(const u32x4*)(kr + c1), b0 = *(const u32x4*)(kr + 32 * 128 + c0), b1 = *(const u32x4*)(kr + 32 * 128 + c1);
        const i32x8_ qa = {(int)q8[2 * j][0], (int)q8[2 * j][1], (int)q8[2 * j][2], (int)q8[2 * j][3], (int)q8[2 * j + 1][0], (int)q8[2 * j + 1][1], (int)q8[2 * j + 1][2], (int)q8[2 * j + 1][3]};
        const i32x8_ ka = {(int)a0[0], (int)a0[1], (int)a0[2], (int)a0[3], (int)a1[0], (int)a1[1], (int)a1[2], (int)a1[3]}, kb = {(int)b0[0], (int)b0[1], (int)b0[2], (int)b0[3], (int)b1[0], (int)b1[1], (int)b1[2], (int)b1[3]};
        p0 = __builtin_amdgcn_mfma_scale_f32_32x32x64_f8f6f4(ka, qa, p0, 0, 0, 0, 0x7f7f7f7f, 0, 0x7f7f7f7f);
        p1 = __builtin_amdgcn_mfma_scale_f32_32x32x64_f8f6f4(kb, qa, p1, 0, 0, 0, 0x7f7f7f7f, 0, 0x7f7f7f7f); }
}
template <int VB>
__device__ __forceinline__ void pv_tile(f32x16* o, int vb0, bf16x8 pa0, bf16x8 pa1, bf16x8 pa2, bf16x8 pa3) {
#define TRRD(dst, off) asm volatile("ds_read_b64_tr_b16 %0, %1 offset:%2" : "=&v"(dst) : "v"(vb0), "i"(off) : "memory")
#define PV_D0(d0) do { s16x4 l0, l1, l2, l3, h0, h1, h2, h3; constexpr int b_ = VB * SHM_V + v_rd_off(d0, 0, 0);  \
        TRRD(l0, b_); TRRD(h0, b_ + 2048); TRRD(l1, b_ + 4096); TRRD(h1, b_ + 6144); TRRD(l2, b_ + 8192); TRRD(h2, b_ + 10240); TRRD(l3, b_ + 12288); TRRD(h3, b_ + 14336); \
        asm volatile("s_waitcnt lgkmcnt(0)" ::: "memory"); SBAR();   \
        o[d0] = __builtin_amdgcn_mfma_f32_32x32x16_bf16(pa0, (bf16x8){l0[0], l0[1], l0[2], l0[3], h0[0], h0[1], h0[2], h0[3]}, o[d0], 0, 0, 0);   \
        o[d0] = __builtin_amdgcn_mfma_f32_32x32x16_bf16(pa1, (bf16x8){l1[0], l1[1], l1[2], l1[3], h1[0], h1[1], h1[2], h1[3]}, o[d0], 0, 0, 0);   \
        o[d0] = __builtin_amdgcn_mfma_f32_32x32x16_bf16(pa2, (bf16x8){l2[0], l2[1], l2[2], l2[3], h2[0], h2[1], h2[2], h2[3]}, o[d0], 0, 0, 0);   \
        o[d0] = __builtin_amdgcn_mfma_f32_32x32x16_bf16(pa3, (bf16x8){l3[0], l3[1], l3[2], l3[3], h3[0], h3[1], h3[2], h3[3]}, o[d0], 0, 0, 0); } while (0)
    PV_D0(0); PV_D0(1); PV_D0(2); PV_D0(3);
#undef PV_D0
#undef TRRD
}
typedef int i32x8v __attribute__((ext_vector_type(8)));
__device__ __forceinline__ unsigned pk8(float a, float b, float c, float d) { int w = __builtin_amdgcn_cvt_pk_fp8_f32(a, b, 0, false); w = __builtin_amdgcn_cvt_pk_fp8_f32(c, d, w, true); return (unsigned)w; }
__device__ __forceinline__ void finishSM8(f32x16& p0, f32x16& p1, float alpha, float& l_reg, i32x8v& pa) {
    for (int r = 0; r < 16; ++r) p1[r] = __builtin_amdgcn_exp2f(p1[r]);
    float ps; { typedef float f2_ __attribute__((ext_vector_type(2))); f2_ s2 = {0.f, 0.f};
      for (int r = 0; r < 16; r += 2) { s2 += (f2_){p0[r], p0[r + 1]}; s2 += (f2_){p1[r], p1[r + 1]}; } ps = s2[0] + s2[1]; }
    { auto rr = __builtin_amdgcn_permlane32_swap(__float_as_uint(ps), __float_as_uint(ps), false, false);
      ps = __uint_as_float(rr[0]) + __uint_as_float(rr[1]); }
    l_reg = l_reg * alpha + ps;
#pragma unroll
    for (int j = 0; j < 4; ++j) { const unsigned w0 = pk8(p0[4 * j], p0[4 * j + 1], p0[4 * j + 2], p0[4 * j + 3]), w1 = pk8(p1[4 * j], p1[4 * j + 1], p1[4 * j + 2], p1[4 * j + 3]);
        auto rr = __builtin_amdgcn_permlane32_swap(w0, w1, false, false); pa[j] = (int)rr[0]; pa[4 + j] = (int)rr[1]; }
}
template <int VB>
__device__ __forceinline__ void pv_tile8(f32x16* o, int vb0, i32x8v pa) {
    typedef int v2i_ __attribute__((ext_vector_type(2))); typedef __attribute__((address_space(3))) v2i_ lds_v2i;
#define TR8(off) __builtin_amdgcn_ds_read_tr8_b64_v2i32((lds_v2i*)(unsigned)(vb0 + (off)))
#pragma unroll
    for (int d0 = 0; d0 < 4; ++d0) { constexpr int R0 = 0 * 32, R1 = 16 * 32, R2 = 8 * 32, R3 = 24 * 32; const int b_ = VB * SHM_V + d0 * 2048;
        const v2i_ t0 = TR8(b_ + R0), t1 = TR8(b_ + R1), t2 = TR8(b_ + R2), t3 = TR8(b_ + R3);
        const i32x8v vb = {t0[0], t0[1], t1[0], t1[1], t2[0], t2[1], t3[0], t3[1]};
        o[d0] = __builtin_amdgcn_mfma_scale_f32_32x32x64_f8f6f4(pa, vb, o[d0], 0, 0, 0, 0x77777777, 0, 0x7f7f7f7f); }
#undef TR8
}
struct BlockRef { const bf16* Q;   const unsigned char* Q8; const unsigned char* K8;   const unsigned char* V8;   unsigned char* O;     const float* Kmean; int P0; };
struct Seam { u32x4 q8[4];   u32x4 st_v; u32x4 st_k; };
#define ROW(p, k0, rr) ((p) + (unsigned)(((k0) + (rr)) * PITCH + sc))
#define VMW() asm volatile("s_waitcnt vmcnt(0)" ::: "memory")
#define VMWN(n) asm volatile("s_waitcnt vmcnt(%0)" :: "i"(n) : "memory")
#define SLOAD_H(Kp, Vp, k0) do { S.st_v = *(const u32x4*)((Vp) + (unsigned)(((k0) + krow) * PITCH + kch * 16));              \
                         S.st_k = *(const u32x4*)((Kp) + (unsigned)(((k0) + krow) * PITCH + kch * 16)); } while (0)
#define SWRITE_HK(bf) do { *(u32x4*)(K_lds + (bf) * SHM_K + kw8) = S.st_k; } while (0)
#define SWRITE_HV(bf) do { *(u32x4*)(V_lds + (bf) * SHM_V + vw8) = S.st_v; } while (0)
#define SWRITE_H(bf) do { SWRITE_HV(bf); SWRITE_HK(bf); } while (0)
__device__ __forceinline__ void moba_prime(const BlockRef& cur, char* lds, Seam& S) {
    const int tid = threadIdx.x, wid = __builtin_amdgcn_readfirstlane(tid >> 6), lane = tid & 63, r32 = lane & 31, hi = lane >> 5;
    const int sr = tid >> 4, sc = (tid & 15) * 8, krow = tid >> 3, kch = tid & 7, kw8 = krow * 128 + ((kch ^ (krow & 7)) << 4); char* K_lds = lds + 2 * SHM_V;
#pragma unroll
    for (int i = 0; i < 4; ++i) S.q8[i] = *(const u32x4*)(cur.Q8 + (unsigned)((wid * QBLK + r32) * PITCH + 64 * (i >> 1) + 32 * hi + 16 * (i & 1)));
    SLOAD_H(cur.K8, cur.V8, 0); VMW(); SWRITE_HK(0);
    __syncthreads();
}
__device__ __forceinline__ void moba_block(const BlockRef& cur, const BlockRef& nxt, char* lds, Seam& S) {
    const int tid = threadIdx.x, wid = __builtin_amdgcn_readfirstlane(tid >> 6), lane = tid & 63, r32 = lane & 31, hi = lane >> 5;
    const int NT = cur.P0 / KVBLK + 4;
    const int qlo = cur.P0 + wid * QBLK, qm = qlo + r32 - 4 * hi;
    unsigned selfull = 0xFFu;
    { const int qb = cur.P0 >> 8;
      if (qb >= 4) { float b1 = -__builtin_inff(), b2 = b1, b3 = b1; int i1 = 0, i2 = 0, i3 = 0;
        bf16x8 qg[8];
#pragma unroll
        for (int d0 = 0; d0 < 8; ++d0) qg[d0] = load8(cur.Q + (unsigned)((wid * QBLK + r32) * PITCH + hi * 8) + d0 * 16);
        float* kml = (float*)(lds + LDS_BYTES);
        for (int i = tid; i < qb * 128; i += NW * 64) kml[i] = cur.Kmean[i];
        __syncthreads();
#pragma unroll 1
        for (int n = 0; n < qb; ++n) { float g = 0.f; const float* kmn = kml + n * 128 + 8 * hi;
#pragma unroll
            for (int d0 = 0; d0 < 8; ++d0) { const u32x4 qw = *reinterpret_cast<const u32x4*>(&qg[d0]); const f32x4 k0 = *(const f32x4*)(kmn + 16 * d0), k1 = *(const f32x4*)(kmn + 16 * d0 + 4);
                g += (__uint_as_float(qw.x << 16) * k0[0] + __uint_as_float(qw.x & 0xffff0000u) * k0[1]) + (__uint_as_float(qw.y << 16) * k0[2] + __uint_as_float(qw.y & 0xffff0000u) * k0[3])
                   + (__uint_as_float(qw.z << 16) * k1[0] + __uint_as_float(qw.z & 0xffff0000u) * k1[1]) + (__uint_as_float(qw.w << 16) * k1[2] + __uint_as_float(qw.w & 0xffff0000u) * k1[3]); }
            g += __shfl_xor(g, 32);
            if (g > b1) { b3 = b2; i3 = i2; b2 = b1; i2 = i1; b1 = g; i1 = n; } else if (g > b2) { b3 = b2; i3 = i2; b2 = g; i2 = n; } else if (g > b3) { b3 = g; i3 = n; } }
        const unsigned mask = (1u << i1) | (1u << i2) | (1u << i3);
        selfull = mask | (0xFFu << qb); } }
    char* V_lds = lds; char* K_lds = lds + 2 * SHM_V;
    float* ws = (float*)(lds + 2 * SHM_V + 2 * SHM_K) + wid * 64; float* li_l = ws, * al_l = ws + 32;
    float m_reg = -1e30f, l_reg = 0; f32x16 o[4] = {};
    const int sr = tid >> 4, sc = (tid & 15) * 8, krow = tid >> 3, kch = tid & 7, kw8 = krow * 128 + ((kch ^ (krow & 7)) << 4), vw8 = (kch >> 1) * 2048 + ((krow & ~12) | ((krow & 4) << 1) | ((krow & 8) >> 1)) * 32 + (kch & 1) * 16;
    const int vb0 = (int)(uintptr_t)V_lds + (32 * hi + ((lane & 15) >> 1)) * 32 + 16 * ((lane >> 4) & 1) + 8 * (lane & 1);
    const unsigned char* Kh = cur.K8; const unsigned char* Vh = cur.V8;
#define RESC(a) do { if (__any((a) < 1.f)) { if (hi == 0) al_l[r32] = (a); asm volatile("s_waitcnt lgkmcnt(0)" ::: "memory");              \
                     for (int d_ = 0; d_ < 4; ++d_) for (int r = 0; r < 16; ++r) o[d_][r] *= al_l[crow(r, hi)]; } } while (0)
#define KBASE(t) ((t) * KVBLK)
#define KEEP(t) (((selfull >> (KBASE(t) >> 8)) & 1u) != 0u)
#define MASKT(P0_, P1_, t) do { const int kb_ = KBASE(t); if (kb_ + KVBLK - 1 > qlo) mask_tile(P0_, P1_, qm - kb_); } while (0)
    constexpr int NQL = 4;
#define SEAM_K0() do { VMWN(NQL); SWRITE_HK(0); SBAR(); } while (0)
    f32x16 pA0, pA1, pB0, pB1; float mnA, mnB, alA, alB; i32x8v pa;
    SWRITE_HV(0); SBAR();
    if (NT > 1) { SLOAD_H(Kh, Vh, KBASE(1)); }
    SBAR(); qkt8<0>(pA0, pA1, K_lds, r32, hi, S.q8);
    MASKT(pA0, pA1, 0); partialSM(pA0, pA1, m_reg, mnA, alA, KEEP(0));
    if (NT > 1) { VMW(); SWRITE_H(1); }
    __syncthreads();
#define HALF_STEP(PX0, PX1, mnX, alX, PY0, PY1, alY, t, KB, VB, SB) do {                                                      \
        SBAR(); qkt8<KB>(PX0, PX1, K_lds, r32, hi, S.q8);                                             \
        finishSM8(PY0, PY1, alY, l_reg, pa); SBAR();                                                           \
        if ((t) + 1 < NT) { SLOAD_H(Kh, Vh, KBASE((t) + 1)); SBAR(); }                                               \
        pv_tile8<VB>(o, vb0, pa); MASKT(PX0, PX1, (t)); partialSM(PX0, PX1, m_reg, mnX, alX, KEEP(t));                                        \
        __syncthreads();                                                                                                      \
        if ((t) + 1 < NT) { VMW(); SWRITE_H(SB); }                                                                          \
        RESC(alX); __syncthreads(); } while (0)
    for (int t = 1; t + 1 < NT; t += 2) {
        HALF_STEP(pB0, pB1, mnB, alB, pA0, pA1, alA, t, 1, 0, 0);
        HALF_STEP(pA0, pA1, mnA, alA, pB0, pB1, alB, t + 1, 0, 1, 1);
    }
    const bool even = (NT & 1) == 0;
    if (even) { SBAR(); qkt8<1>(pB0, pB1, K_lds, r32, hi, S.q8); SBAR(); }
    SLOAD_H(nxt.K8, nxt.V8, 0); SBAR();
#pragma unroll
    for (int i = 0; i < 4; ++i) S.q8[i] = *(const u32x4*)(nxt.Q8 + (unsigned)((wid * QBLK + r32) * PITCH + 64 * (i >> 1) + 32 * hi + 16 * (i & 1)));
    SBAR();
    finishSM8(pA0, pA1, alA, l_reg, pa); SBAR();
    pv_tile8<0>(o, vb0, pa);
    if (even) { MASKT(pB0, pB1, NT - 1); partialSM(pB0, pB1, m_reg, mnB, alB, KEEP(NT - 1)); __syncthreads(); RESC(alB);
        finishSM8(pB0, pB1, alB, l_reg, pa); SBAR(); pv_tile8<1>(o, vb0, pa); }
    SBAR(); SEAM_K0();
    if (hi == 0) li_l[r32] = l_reg; asm volatile("s_waitcnt lgkmcnt(0)" ::: "memory");
    float rli[16];
#pragma unroll
    for (int r = 0; r < 16; ++r) rli[r] = __builtin_amdgcn_rcpf(li_l[crow(r, hi)]);
    unsigned char* ost = (unsigned char*)lds + 73728 + wid * 4096;
#pragma unroll
    for (int r = 0; r < 16; ++r) { const float sc16 = rli[r] * (16.0f * 256.0f);     unsigned char* orow = ost + crow(r, hi) * 128 + r32;
#pragma unroll
        for (int d0 = 0; d0 < 4; ++d0) { const float v = o[d0][r] * sc16; orow[d0 * 32] = (unsigned char)__builtin_amdgcn_cvt_pk_fp8_f32(v, v, 0, false); } }
#pragma unroll
    for (int i = 0; i < 4; ++i) { const int ch = lane + 64 * i, row = ch >> 3, c16 = ch & 7;
        const u32x4 d = *(const u32x4*)(ost + row * 128 + c16 * 16);
        *(u32x4*)(cur.O + (unsigned)((wid * QBLK + row) * PITCH + c16 * 16)) = d; }
    __syncthreads();
#undef RESC
#undef KBASE
#undef KEEP
#undef MASKT
#undef SEAM_K0
#undef HALF_STEP
}
#undef ROW
#undef VMW
#undef VMWN
#undef SLOAD_H
#undef SWRITE_HK
#undef SWRITE_HV
#undef SWRITE_H
}
#define GAS __attribute__((address_space(1)))
#define LAS __attribute__((address_space(3)))
typedef unsigned short bf16;
typedef unsigned v4u __attribute__((ext_vector_type(4)));
typedef float f32x4 __attribute__((ext_vector_type(4)));
typedef short bf16x8 __attribute__((ext_vector_type(8)));
typedef GAS unsigned gu32;
typedef GAS unsigned long long gu64;
#define RLX_AGENT __ATOMIC_RELAXED, __HIP_MEMORY_SCOPE_AGENT
#define LDS_WAIT() asm volatile("s_waitcnt lgkmcnt(0)" ::: "memory")
#define VM_WAIT() asm volatile("s_waitcnt vmcnt(0)" ::: "memory")
__device__ __forceinline__ unsigned long long rt() { return __builtin_amdgcn_s_memrealtime(); }
__device__ __forceinline__ unsigned f2bf(float f) { unsigned u = __builtin_bit_cast(unsigned, f); return (u + 0x7fffu + ((u >> 16) & 1u)) >> 16; }
__device__ __forceinline__ unsigned pk2(float lo, float hi) { unsigned r; asm("v_cvt_pk_bf16_f32 %0, %1, %2" : "=v"(r) : "v"(lo), "v"(hi)); return r; }

#define XB_TMO      128
#define XB_XCNT(j)  (256  + 64 * (j))
#define XB_XSUB(j)  (1280 + 64 * (j))
#define XB_XGEN(j)  (2304 + 64 * (j))
#define XB_TOP      3328
#define XB_TOPGEN   3392
#define XCD_BAR_WORDS 3456
#define XB_SPIN_CAP (1u << 18)

__device__ __forceinline__ unsigned xb_ld(unsigned* p)              { return __hip_atomic_load(p, __ATOMIC_RELAXED, __HIP_MEMORY_SCOPE_AGENT); }
__device__ __forceinline__ unsigned xb_add(unsigned* p, unsigned v) { return __hip_atomic_fetch_add(p, v, __ATOMIC_RELAXED, __HIP_MEMORY_SCOPE_AGENT); }
__device__ __forceinline__ unsigned xb_xcc_id() { return (unsigned)__builtin_amdgcn_s_getreg((3 << 11) | 20) & 0xFu; }
#define XB_SPIN(cond, bar) do { unsigned _sp = 0; while (cond) { __builtin_amdgcn_s_sleep(1); \
    if ((++_sp & 255u) == 0u) { if (xb_ld(&(bar)[XB_TMO])) break; if (_sp > XB_SPIN_CAP) { atomicAdd(&(bar)[XB_TMO], 1u); break; } } } } while (0)

struct XcdBarrier {
    unsigned* bar; unsigned x;
    volatile LAS unsigned* st;
};

__device__ __forceinline__ XcdBarrier xcd_barrier_post(unsigned* bar, volatile LAS unsigned* st) {
    XcdBarrier b; b.bar = bar; b.x = xb_xcc_id(); b.st = st;
    if (threadIdx.x == 0) (void)xb_add(&bar[XB_XCNT(b.x)], 1u);
    return b;
}
__device__ __forceinline__ void xcd_barrier_complete(unsigned* bar, unsigned x, unsigned& nloc, unsigned& nx) {
    const unsigned G = gridDim.x * gridDim.y * gridDim.z;
    unsigned sum, cnt, mine, sp = 0u;
    for (;;) {
        sum = 0u; cnt = 0u; mine = 0u;
#pragma unroll
        for (unsigned j = 0; j < 16; ++j) { const unsigned c = xb_ld(&bar[XB_XCNT(j)]); sum += c; cnt += (c > 0u) ? 1u : 0u; mine = (j == x) ? c : mine; }
        if (sum == G) break;
        __builtin_amdgcn_s_sleep(1);
        if ((++sp & 255u) == 0u) { if (xb_ld(&bar[XB_TMO])) break; if (sp > XB_SPIN_CAP) { atomicAdd(&bar[XB_TMO], 1u); break; } }
    }
    nloc = mine > 0u ? mine : 1u; nx = cnt > 0u ? cnt : 1u;
}

__device__ __forceinline__ void xcd_barrier(const XcdBarrier& b) {
    asm volatile("s_waitcnt vmcnt(0)" ::: "memory");
    __syncthreads();
    if (threadIdx.x == 0) {
        unsigned* bar = b.bar;
        __builtin_amdgcn_s_waitcnt(0);
        unsigned nloc = b.st[0], nx = b.st[1];
        if (nloc == 0u) { xcd_barrier_complete(bar, b.x, nloc, nx); b.st[0] = nloc; b.st[1] = nx; }
        const unsigned old = xb_add(&bar[XB_XSUB(b.x)], 1u);
        const unsigned gen = old / nloc;
        if (old + 1u == (gen + 1u) * nloc) {
            __builtin_amdgcn_fence(__ATOMIC_RELEASE, "agent");
            asm volatile("s_waitcnt vmcnt(0)" ::: "memory");
            const unsigned og = xb_add(&bar[XB_TOP], 1u);
            const unsigned tg = og / nx;
            if (og + 1u == (tg + 1u) * nx) xb_add(&bar[XB_TOPGEN], 1u);
            else XB_SPIN(xb_ld(&bar[XB_TOPGEN]) == tg, bar);
            __builtin_amdgcn_fence(__ATOMIC_ACQUIRE, "agent");
            xb_add(&bar[XB_XGEN(b.x)], 1u);
            asm volatile("s_waitcnt vmcnt(0)" ::: "memory");
        } else {
            XB_SPIN(xb_ld(&bar[XB_XGEN(b.x)]) == gen, bar);
            __builtin_amdgcn_fence(__ATOMIC_ACQUIRE, "agent");
            asm volatile("s_waitcnt vmcnt(0)" ::: "memory");
        }
    }
    __syncthreads();
}
__device__ __forceinline__ void group4_barrier(unsigned* bar, unsigned* gword, unsigned* xmap4) {
    asm volatile("s_waitcnt vmcnt(0)" ::: "memory");
    __syncthreads();
    if (threadIdx.x == 0) {
        const unsigned x0 = xb_ld(xmap4), x1 = xb_ld(xmap4 + 1), x2 = xb_ld(xmap4 + 2), x3 = xb_ld(xmap4 + 3);
        if (!(x0 != 0u && x0 == x1 && x1 == x2 && x2 == x3)) { __builtin_amdgcn_fence(__ATOMIC_RELEASE, "agent"); asm volatile("s_waitcnt vmcnt(0)" ::: "memory"); }
        (void)xb_add(gword, 1u);
        XB_SPIN(xb_ld(gword) < 4u, bar);
        __builtin_amdgcn_fence(__ATOMIC_ACQUIRE, "agent");
        asm volatile("s_waitcnt vmcnt(0)" ::: "memory");
    }
    __syncthreads();
}
template <class Fn> __device__ __forceinline__ void local_barrier_ov(unsigned* bar, unsigned* word, unsigned n, Fn fn) {
    asm volatile("s_waitcnt vmcnt(0)" ::: "memory");
    __syncthreads();
    if (threadIdx.x == 0) {
        (void)xb_add(word, 1u);
        XB_SPIN(xb_ld(word) < n, bar);
        __builtin_amdgcn_fence(__ATOMIC_ACQUIRE, "agent");
        asm volatile("s_waitcnt vmcnt(0)" ::: "memory");
    } else if (threadIdx.x >= 64) { fn(); }
    __syncthreads();
}
template <class Fn> __device__ __forceinline__ void xcd_barrier_ov(const XcdBarrier& b, Fn fn) {
    asm volatile("s_waitcnt vmcnt(0)" ::: "memory");
    __syncthreads();
    if (threadIdx.x == 0) {
        unsigned* bar = b.bar;
        __builtin_amdgcn_s_waitcnt(0);
        unsigned nloc = b.st[0], nx = b.st[1];
        if (nloc == 0u) { xcd_barrier_complete(bar, b.x, nloc, nx); b.st[0] = nloc; b.st[1] = nx; }
        const unsigned old = xb_add(&bar[XB_XSUB(b.x)], 1u);
        const unsigned gen = old / nloc;
        if (old + 1u == (gen + 1u) * nloc) {
            __builtin_amdgcn_fence(__ATOMIC_RELEASE, "agent");
            asm volatile("s_waitcnt vmcnt(0)" ::: "memory");
            const unsigned og = xb_add(&bar[XB_TOP], 1u);
            const unsigned tg = og / nx;
            if (og + 1u == (tg + 1u) * nx) xb_add(&bar[XB_TOPGEN], 1u);
            else XB_SPIN(xb_ld(&bar[XB_TOPGEN]) == tg, bar);
            __builtin_amdgcn_fence(__ATOMIC_ACQUIRE, "agent");
            xb_add(&bar[XB_XGEN(b.x)], 1u);
            asm volatile("s_waitcnt vmcnt(0)" ::: "memory");
        } else {
            XB_SPIN(xb_ld(&bar[XB_XGEN(b.x)]) == gen, bar);
            __builtin_amdgcn_fence(__ATOMIC_ACQUIRE, "agent");
            asm volatile("s_waitcnt vmcnt(0)" ::: "memory");
        }
    } else if (threadIdx.x >= 64) { fn(); }
    __syncthreads();
}
constexpr int NB = 16, T = 2048, D = 1024, M = NB * T;
constexpr int NEXP = 16, DEXP = 512;
constexpr int MAXT = 272, MSORT = MAXT * 256;
constexpr float LN_EPS = 1e-5f, DN_ALPHA = 1.4142135623730951f;
constexpr int NWAVES = 8;
constexpr size_t MiB = 1u << 20;
constexpr size_t WS_CTL = 0, CTL_ZERO_BYTES = 1 * MiB;
constexpr size_t WS_COND = 1 * MiB;
constexpr size_t WS_KMEAN = 512 * 1024;
constexpr size_t WS_ROUTE_E = 3 * MiB;
constexpr size_t WS_ROUTE_W = WS_ROUTE_E + 128 * 1024;
constexpr size_t WS_POS = WS_ROUTE_W + 256 * 1024;
constexpr size_t WS_CNT = WS_POS + 256 * 1024;
constexpr size_t WS_TILE = WS_CNT + 16 * 1024;
constexpr size_t WS_SEL = 4 * MiB;
constexpr size_t WS_INV = 5 * MiB;
constexpr size_t WS_WIN = 8 * MiB, WS_WOUT = 12 * MiB, WS_WQKV = 14 * MiB, WS_WO2 = 20 * MiB;
constexpr size_t WS_WGU = 22 * MiB;
constexpr size_t WS_WD = 86 * MiB;
constexpr size_t WS_XA = 118 * MiB;
constexpr size_t WS_H8 = 118 * MiB + 128 * MiB - 32 * MiB;
constexpr size_t WS_H = 246 * MiB;
constexpr size_t WS_BIG = 310 * MiB;
constexpr size_t WS_END = 502 * MiB;
constexpr int CW_BAR = 4096;
constexpr int CW_LBAR = 49152;
constexpr int CW_XMAP = 24576;
constexpr int CW_GBAR = 32768;
constexpr int CW_MOE = 16384;
constexpr int TAB_START = 512, TAB_TOT = 544, INV_CAP = 32768;

typedef unsigned v2u __attribute__((ext_vector_type(2)));
typedef float f32x2 __attribute__((ext_vector_type(2)));
__device__ __forceinline__ float bflo(unsigned w) { return __builtin_bit_cast(float, w << 16); }
__device__ __forceinline__ float bfhi(unsigned w) { return __builtin_bit_cast(float, w & 0xffff0000u); }
__device__ __forceinline__ float dpp_add(float v, float src_holder, int ctrl_unused) { return v; }
#define WS_DPP(v, ctrl, rmask) (v) += __builtin_bit_cast(float, __builtin_amdgcn_update_dpp(0, __builtin_bit_cast(int, (v)), (ctrl), (rmask), 0xF, true))
__device__ __forceinline__ float wave_sum(float v) {
    WS_DPP(v, 0xB1, 0xF);
    WS_DPP(v, 0x4E, 0xF);
    WS_DPP(v, 0x141, 0xF);
    WS_DPP(v, 0x140, 0xF);
    WS_DPP(v, 0x142, 0xA);
    WS_DPP(v, 0x143, 0xC);
    return __builtin_bit_cast(float, __builtin_amdgcn_readlane(__builtin_bit_cast(int, v), 63));
}

#define DPPF(v, ctrl) __builtin_bit_cast(float, __builtin_amdgcn_update_dpp(0, __builtin_bit_cast(int, (v)), (ctrl), 0xF, 0xF, true))
__device__ __forceinline__ float xrow_sum(float r) {
    { float x = r, y = r; asm volatile("s_nop 1\n\tv_permlane16_swap_b32 %0, %1" : "+v"(x), "+v"(y)); r = x + y; }
    { float x = r, y = r; asm volatile("s_nop 1\n\tv_permlane32_swap_b32 %0, %1" : "+v"(x), "+v"(y)); r = x + y; }
    return r;
}
__device__ __forceinline__ void wave_sum4(float a, float b, float c, float d, float& s0, float& s1, float& s2, float& s3, int lane) {
    const bool odd = (lane & 1) != 0, hi2 = (lane & 2) != 0;
    const float rab = (odd ? b : a) + DPPF(odd ? a : b, 0xB1);
    const float rcd = (odd ? d : c) + DPPF(odd ? c : d, 0xB1);
    float r = (hi2 ? rcd : rab) + DPPF(hi2 ? rab : rcd, 0x4E);
    r += DPPF(r, 0x124); r += DPPF(r, 0x128);
    r = xrow_sum(r);
    s0 = __builtin_bit_cast(float, __builtin_amdgcn_readlane(__builtin_bit_cast(int, r), 0)); s1 = __builtin_bit_cast(float, __builtin_amdgcn_readlane(__builtin_bit_cast(int, r), 1));
    s2 = __builtin_bit_cast(float, __builtin_amdgcn_readlane(__builtin_bit_cast(int, r), 2)); s3 = __builtin_bit_cast(float, __builtin_amdgcn_readlane(__builtin_bit_cast(int, r), 3));
}

#define DPPX1(v) ((unsigned)__builtin_amdgcn_update_dpp(0, (int)(v), 0xB1, 0xF, 0xF, true))
template <class T> __device__ __forceinline__ T* pair_addr(T* pa, T* pb, int lane) { return (lane & 1) ? pb - 8 : pa; }
__device__ __forceinline__ void pair_split(v4u ld, int lane, v2u& a, v2u& b) {
    const bool odd = (lane & 1) != 0; const unsigned nx = DPPX1(odd ? ld.x : ld.z), ny = DPPX1(odd ? ld.y : ld.w);
    a = odd ? (v2u){nx, ny} : (v2u){ld.x, ld.y}; b = odd ? (v2u){ld.z, ld.w} : (v2u){nx, ny}; }
__device__ __forceinline__ v4u pair_join(v2u a, v2u b, int lane) {
    const bool odd = (lane & 1) != 0; const unsigned nx = DPPX1(odd ? a.x : b.x), ny = DPPX1(odd ? a.y : b.y);
    return odd ? (v4u){nx, ny, b.x, b.y} : (v4u){a.x, a.y, nx, ny}; }
struct Params { const float* in[27]; float* out; unsigned char* ws; int ph_lo, ph_hi, li, pad; };
enum { I_X = 0, I_C, I_ADAW, I_ADAB, I_LNMG, I_LNMB, I_LNFG, I_LNFB, I_WIN, I_SLNG, I_SLNB, I_WS, I_BS, I_WDW, I_BDW, I_CLNG, I_CLNB, I_WOUT, I_WQKV, I_WO2,
       I_WGRP, I_BGRP, I_WER, I_BER, I_WGATE, I_WUP, I_WDOWN };
struct Frame {
    LAS unsigned char* lds;
    int tid, lane, wave, vcu, G;
};

__device__ __forceinline__ void p0_cond(const Frame& F, const float* c, const float* ada_w, const float* ada_b, float* cond) {
    LAS float* sc = (LAS float*)F.lds;
    LAS float* red = (LAS float*)(F.lds + 65536);
    bool loaded = false;
    for (int it = blockIdx.x; it < 192; it += F.G) {
        if (!loaded) { for (int i = F.tid; i < 16384; i += 512) { const int b = i >> 10, k = i & 1023; const float v = c[i]; sc[k * 16 + b] = v / (1.0f + __expf(-v)); } __syncthreads(); loaded = true; }
        const int L = it / 96, j0 = (it % 96) * 64, col = F.tid & 63, ks = F.tid >> 6;
        float acc[16];
#pragma unroll
        for (int b = 0; b < 16; ++b) acc[b] = 0.f;
        const float* w = ada_w + (size_t)L * 1024 * 6144 + (size_t)(ks * 128) * 6144 + j0 + col;
        for (int kb = 0; kb < 128; kb += 32) { float wv[32];
#pragma unroll
            for (int k = 0; k < 32; ++k) wv[k] = __builtin_nontemporal_load(w + (size_t)(kb + k) * 6144);
#pragma unroll
            for (int k = 0; k < 32; ++k) { const LAS f32x4* s4 = (const LAS f32x4*)(sc + (ks * 128 + kb + k) * 16);
#pragma unroll
                for (int q = 0; q < 4; ++q) { const f32x4 s = s4[q]; acc[4 * q + 0] += s[0] * wv[k]; acc[4 * q + 1] += s[1] * wv[k]; acc[4 * q + 2] += s[2] * wv[k]; acc[4 * q + 3] += s[3] * wv[k]; } } }
#pragma unroll
        for (int b = 0; b < 16; ++b) red[(ks * 16 + b) * 64 + col] = acc[b];
        __syncthreads();
        for (int o = F.tid; o < 1024; o += 512) { const int b = o >> 6, cc = o & 63; float s = ada_b[L * 6144 + j0 + cc];
#pragma unroll
            for (int k2 = 0; k2 < 8; ++k2) s += red[(k2 * 16 + b) * 64 + cc];
            cond[(size_t)(L * 16 + b) * 6144 + j0 + cc] = s; }
        __syncthreads();
    }
}
__device__ __forceinline__ void transpose_item(const float* W, int srcN, bf16* WT, int dstK, int k0, int n0, int drow0, LAS float* scr, int lane) {
    { const int kr = lane >> 3, n4 = (lane & 7) * 4; f32x4 v[8];
#pragma unroll
        for (int i = 0; i < 8; ++i) v[i] = __builtin_nontemporal_load((const f32x4*)(W + (size_t)(k0 + kr + 8 * i) * srcN + n0 + n4));
#pragma unroll
        for (int i = 0; i < 8; ++i) { LAS float* d = scr + (kr + 8 * i) * 33 + n4; d[0] = v[i][0]; d[1] = v[i][1]; d[2] = v[i][2]; d[3] = v[i][3]; } }
    LDS_WAIT(); asm volatile("" ::: "memory");
    const int c = lane & 7;
#pragma unroll
    for (int j = 0; j < 4; ++j) { const int n = (lane >> 3) + 8 * j; const LAS float* s = scr + (8 * c) * 33 + n;
        v4u o; o.x = pk2(s[0 * 33], s[1 * 33]); o.y = pk2(s[2 * 33], s[3 * 33]); o.z = pk2(s[4 * 33], s[5 * 33]); o.w = pk2(s[6 * 33], s[7 * 33]);
        *(GAS v4u*)(WT + (size_t)(drow0 + n) * dstK + k0 + 8 * c) = o; }
    LDS_WAIT(); asm volatile("" ::: "memory");
}
__device__ __forceinline__ void transpose_item_fp8(const float* W, int srcN, unsigned char* WT, int dstK, int k0, int n0, int drow0, LAS float* scr, int lane) {
    { const int kr = lane >> 3, n4 = (lane & 7) * 4; f32x4 v[8];
#pragma unroll
        for (int i = 0; i < 8; ++i) v[i] = __builtin_nontemporal_load((const f32x4*)(W + (size_t)(k0 + kr + 8 * i) * srcN + n0 + n4));
#pragma unroll
        for (int i = 0; i < 8; ++i) { LAS float* d = scr + (kr + 8 * i) * 33 + n4; d[0] = v[i][0] * 32.0f; d[1] = v[i][1] * 32.0f; d[2] = v[i][2] * 32.0f; d[3] = v[i][3] * 32.0f; } }
    LDS_WAIT(); asm volatile("" ::: "memory");
    const int c = lane & 3;
#pragma unroll
    for (int j = 0; j < 2; ++j) { const int n = (lane >> 2) + 16 * j; const LAS float* s = scr + (16 * c) * 33 + n;
        v4u o; o.x = pg8::pk_fp8x4(s[0 * 33], s[1 * 33], s[2 * 33], s[3 * 33]); o.y = pg8::pk_fp8x4(s[4 * 33], s[5 * 33], s[6 * 33], s[7 * 33]);
        o.z = pg8::pk_fp8x4(s[8 * 33], s[9 * 33], s[10 * 33], s[11 * 33]); o.w = pg8::pk_fp8x4(s[12 * 33], s[13 * 33], s[14 * 33], s[15 * 33]);
        *(GAS v4u*)(WT + (size_t)(drow0 + n) * dstK + k0 + 16 * c) = o; }
    LDS_WAIT(); asm volatile("" ::: "memory");
}
constexpr int CV_S0 = 1024, CV_S1 = CV_S0 + 512, CV_S2 = CV_S1 + 1536, CV_S3 = CV_S2 + 512, CV_S4 = CV_S3 + 8192, CV_S5 = CV_S4 + 8192, CV_S6 = CV_S5 + 8192;
__device__ __forceinline__ void convert_item(const Params& P, int it, LAS float* scr, int lane) {
    unsigned char* ws = P.ws;
    if (it < CV_S0) { const int r = it, kb = r >> 6, nb = r & 63, n0 = nb * 32;
        const int drow = n0 < 1024 ? n0 : (n0 < 1536 ? (4 + ((n0 - 1024) >> 7)) * 256 + ((n0 - 1024) & 127) : (4 + ((n0 - 1536) >> 7)) * 256 + 128 + ((n0 - 1536) & 127));
        transpose_item(P.in[I_WIN], 2048, (bf16*)(ws + WS_WIN), 1024, kb * 64, n0, drow, scr, lane); }
    else if (it < CV_S1) { const int r = it - CV_S0, kb = r >> 5, nb = r & 31; transpose_item(P.in[I_WOUT], 1024, (bf16*)(ws + WS_WOUT), 1024, kb * 64, nb * 32, nb * 32, scr, lane); }
    else if (it < CV_S2) { const int r = it - CV_S1, kb = r / 96, nb = r % 96; transpose_item_fp8(P.in[I_WQKV], 3072, ws + WS_WQKV, 1024, kb * 64, nb * 32, nb * 32, scr, lane); }
    else if (it < CV_S3) { const int r = it - CV_S2, kb = r >> 5, nb = r & 31; transpose_item_fp8(P.in[I_WO2], 1024, ws + WS_WO2, 1024, kb * 64, nb * 32, nb * 32, scr, lane); }
    else if (it < CV_S5) { const bool up = it >= CV_S4; const int r = it - (up ? CV_S4 : CV_S3), le = r >> 8, q = r & 255, kb = q >> 4, nb = q & 15, n0 = nb * 32;
        const int drow = (n0 >> 7) * 256 + (up ? 128 : 0) + (n0 & 127);
        transpose_item_fp8(P.in[up ? I_WUP : I_WGATE] + (size_t)le * 1024 * 512, 512, ws + WS_WGU + (size_t)le * 1024 * 1024, 1024, kb * 64, n0, drow, scr, lane); }
    else { const int r = it - CV_S5, le = r >> 8, q = r & 255, kb = q >> 5, nb = q & 31;
        transpose_item_fp8(P.in[I_WDOWN] + (size_t)le * 512 * 1024, 1024, ws + WS_WD + (size_t)le * 1024 * 512, 512, kb * 64, nb * 32, nb * 32, scr, lane); }
}
__device__ __forceinline__ void p0_weights(const Frame& F, const Params& P) {
    LAS float* scr = (LAS float*)(F.lds + F.wave * 16384);
    const int gw = F.vcu * NWAVES + F.wave, NGW = F.G * NWAVES;
    constexpr int NP0 = CV_S3 + 3 * 4096;
    for (int j = gw; j < NP0; j += NGW) { const int it = j < CV_S3 ? j : (j < CV_S3 + 4096 ? j : (j < CV_S3 + 8192 ? CV_S4 + (j - CV_S3 - 4096) : CV_S5 + (j - CV_S3 - 8192)));
        convert_item(P, it, scr, F.lane); }
}
__device__ __forceinline__ void bg_convert(const Frame& F, const Params& P, int rank, int ns, int j0, int j1) {
    LAS float* scr = (LAS float*)(F.lds + F.wave * 16384);
    for (int j = j0 + rank * NWAVES + F.wave; j < j1; j += ns * NWAVES) { const int it = j < 4096 ? CV_S3 + 4096 + j : (j < 8192 ? CV_S4 + 4096 + (j - 4096) : CV_S5 + 4096 + (j - 8192));
        convert_item(P, it, scr, F.lane); }
}
__device__ __forceinline__ void p_modulate(const Frame& F, const float* x, const float* cond_l  , int sh_off, bf16* H) {
    const int gw = F.vcu * NWAVES + F.wave, NGW = F.G * NWAVES;
    for (int ch = gw; ch < M / 16; ch += NGW) {
        const int r0 = ch * 16, b = r0 / T; const float* cb = cond_l + (size_t)b * 6144 + sh_off;
        f32x4 sh[4], sc[4];
#pragma unroll
        for (int j = 0; j < 4; ++j) { sh[j] = *(const f32x4*)(cb + 4 * F.lane + 256 * j); sc[j] = *(const f32x4*)(cb + 1024 + 4 * F.lane + 256 * j) + 1.0f; }
#pragma unroll 4
        for (int i = 0; i < 16; ++i) { const float* xr = x + (size_t)(r0 + i) * D + 4 * F.lane; bf16* hr = H + (size_t)(r0 + i) * D + 4 * F.lane;
#pragma unroll
            for (int j = 0; j < 4; j += 2) { v2u o[2];
#pragma unroll
                for (int k = 0; k < 2; ++k) { const f32x4 v = __builtin_nontemporal_load((const f32x4*)(xr + 256 * (j + k))) * sc[j + k] + sh[j + k]; o[k].x = pk2(v[0], v[1]); o[k].y = pk2(v[2], v[3]); }
                const bool odd = (F.lane & 1) != 0; const unsigned sx = odd ? o[0].x : o[1].x, sy = odd ? o[0].y : o[1].y;
                const unsigned nx = (unsigned)__builtin_amdgcn_update_dpp(0, (int)sx, 0xB1, 0xF, 0xF, true), ny = (unsigned)__builtin_amdgcn_update_dpp(0, (int)sy, 0xB1, 0xF, 0xF, true);
                const v4u w = odd ? (v4u){nx, ny, o[1].x, o[1].y} : (v4u){o[0].x, o[0].y, nx, ny};
                *(v4u*)(hr + 256 * (j + (odd ? 1 : 0)) - (odd ? 4 : 0)) = w; } }
    }
}
__device__ __forceinline__ void p_sgu_item(const Frame& F, const Params& P, int bc, const bf16* U, const bf16* V, bf16* YC) {
    const int r0 = bc * 128;
    LAS bf16* Vt = (LAS bf16*)F.lds;
    LAS bf16* Wl = (LAS bf16*)(F.lds + 34816);
    const float* lng = P.in[I_SLNG]; const float* lnb = P.in[I_SLNB];
    const int fr = F.lane & 15, fq = F.lane >> 4, w16 = F.wave * 16;
    v4u raw[16];
#pragma unroll
    for (int i = 0; i < 16; ++i) raw[i] = __builtin_nontemporal_load((const v4u*)(V + (size_t)(r0 + w16 + i) * 512 + 8 * F.lane));
    const f32x4 g0 = *(const f32x4*)(lng + 8 * F.lane), g1 = *(const f32x4*)(lng + 8 * F.lane + 4), b0 = *(const f32x4*)(lnb + 8 * F.lane), b1 = *(const f32x4*)(lnb + 8 * F.lane + 4);
#pragma unroll
    for (int i = 0; i < 16; ++i) { const v4u rw = raw[i];
        const float v[8] = {bflo(rw.x), bfhi(rw.x), bflo(rw.y), bfhi(rw.y), bflo(rw.z), bfhi(rw.z), bflo(rw.w), bfhi(rw.w)};
        float s = 0.f;
#pragma unroll
        for (int j = 0; j < 8; ++j) s += v[j];
        const float mu = wave_sum(s) * (1.0f / 512.0f); float s2 = 0.f;
#pragma unroll
        for (int j = 0; j < 8; ++j) { const float d = v[j] - mu; s2 += d * d; }
        const float rs = 1.0f / sqrtf(wave_sum(s2) * (1.0f / 512.0f) + LN_EPS);
        v4u nw; nw.x = pk2((v[0] - mu) * rs * g0[0] + b0[0], (v[1] - mu) * rs * g0[1] + b0[1]); nw.y = pk2((v[2] - mu) * rs * g0[2] + b0[2], (v[3] - mu) * rs * g0[3] + b0[3]);
        nw.z = pk2((v[4] - mu) * rs * g1[0] + b1[0], (v[5] - mu) * rs * g1[1] + b1[1]); nw.w = pk2((v[6] - mu) * rs * g1[2] + b1[2], (v[7] - mu) * rs * g1[3] + b1[3]); raw[i] = nw; }
    f32x4 w[8];
#pragma unroll
    for (int k = 0; k < 8; ++k) w[k] = *(const f32x4*)(P.in[I_WS] + (size_t)(F.tid + 512 * k) * 4);
    for (int g = 0; g < 4; ++g) {
        if (fq == g) { const int d0 = 8 * fr;
#define SGU_W(rw, jp) ((jp) == 0 ? (rw).x : (jp) == 1 ? (rw).y : (jp) == 2 ? (rw).z : (rw).w)
#pragma unroll
            for (int i4 = 0; i4 < 16; i4 += 4)
#pragma unroll
                for (int jp = 0; jp < 4; ++jp) { const unsigned w0 = SGU_W(raw[i4], jp), w1 = SGU_W(raw[i4 + 1], jp), w2 = SGU_W(raw[i4 + 2], jp), w3 = SGU_W(raw[i4 + 3], jp);
                    v2u lo, hi; lo.x = __builtin_amdgcn_perm(w1, w0, 0x05040100u); lo.y = __builtin_amdgcn_perm(w3, w2, 0x05040100u); hi.x = __builtin_amdgcn_perm(w1, w0, 0x07060302u); hi.y = __builtin_amdgcn_perm(w3, w2, 0x07060302u);
                    *(LAS v2u*)(Vt + (d0 + 2 * jp) * 136 + w16 + i4) = lo; *(LAS v2u*)(Vt + (d0 + 2 * jp + 1) * 136 + w16 + i4) = hi; }
#undef SGU_W
        }
        {
#pragma unroll
            for (int k = 0; k < 8; ++k) { const int i = F.tid + 512 * k, p = i >> 5, q4 = (i & 31) * 4;
                v2u o; o.x = pk2(q4 + 0 <= p ? w[k][0] : 0.f, q4 + 1 <= p ? w[k][1] : 0.f); o.y = pk2(q4 + 2 <= p ? w[k][2] : 0.f, q4 + 3 <= p ? w[k][3] : 0.f);
                *(LAS v2u*)(Wl + p * 136 + q4) = o; }
            if (g < 3) { const float* wsn = P.in[I_WS] + (size_t)(g + 1) * 128 * 128;
#pragma unroll
                for (int k = 0; k < 8; ++k) w[k] = *(const f32x4*)(wsn + (size_t)(F.tid + 512 * k) * 4); } }
        const int row = r0 + w16 + fr; const float bs = P.in[I_BS][g * 128 + w16 + fr];
        v2u uu[8];
#pragma unroll
        for (int nt = 0; nt < 8; nt += 2) { const v4u ld = __builtin_nontemporal_load((const v4u*)(U + (size_t)row * 512 + 128 * g + 16 * (nt + (fq & 1)) + 4 * (fq & ~1)));
            auto rx = __builtin_amdgcn_permlane16_swap(ld.x, ld.z, false, false); auto ry = __builtin_amdgcn_permlane16_swap(ld.y, ld.w, false, false);
            uu[nt] = (v2u){rx[0], ry[0]}; uu[nt + 1] = (v2u){rx[1], ry[1]}; }
        __syncthreads();
        f32x4 acc[8];
#pragma unroll
        for (int nt = 0; nt < 8; ++nt) acc[nt] = (f32x4){0.f, 0.f, 0.f, 0.f};
#pragma unroll
        for (int ks = 0; ks < 4; ++ks) { if (32 * ks <= w16 + 15) {
            const bf16x8 wf = *(const LAS bf16x8*)(Wl + (w16 + fr) * 136 + 32 * ks + 8 * fq);
#pragma unroll
            for (int nt = 0; nt < 8; ++nt) { const bf16x8 vf = *(const LAS bf16x8*)(Vt + (16 * nt + fr) * 136 + 32 * ks + 8 * fq);
                acc[nt] = __builtin_amdgcn_mfma_f32_16x16x32_bf16(vf, wf, acc[nt], 0, 0, 0); } } }
#pragma unroll
        for (int nt = 0; nt < 8; nt += 2) { v2u o[2];
#pragma unroll
            for (int k = 0; k < 2; ++k) { o[k].x = pk2(bflo(uu[nt + k].x) * (acc[nt + k][0] + bs), bfhi(uu[nt + k].x) * (acc[nt + k][1] + bs)); o[k].y = pk2(bflo(uu[nt + k].y) * (acc[nt + k][2] + bs), bfhi(uu[nt + k].y) * (acc[nt + k][3] + bs)); }
            auto rx = __builtin_amdgcn_permlane16_swap(o[0].x, o[1].x, false, false); auto ry = __builtin_amdgcn_permlane16_swap(o[0].y, o[1].y, false, false);
            *(v4u*)(YC + (size_t)row * D + 128 * g + 16 * (nt + (fq & 1)) + 4 * (fq & ~1)) = (v4u){rx[0], ry[0], rx[1], ry[1]}; }
        __syncthreads();
    }
}
__device__ __forceinline__ void conv_load(const Frame& F, int ci, const bf16* Gb, v4u (&v)[8]) {
    const int R0 = ci * 32, b = R0 / T, t0 = R0 % T;
#pragma unroll
    for (int k = 0; k < 8; ++k) { const int i = F.tid + 512 * k, r = i >> 6, cc = i & 63, t = t0 - 30 + r; const int tc = t < 0 ? 0 : (r > 61 ? t0 : t);
        v[k] = *(const v4u*)(Gb + (size_t)(b * T + tc) * 512 + cc * 8); if (t < 0) v[k] = (v4u){0u, 0u, 0u, 0u}; }
}
struct ConvConst { f32x2 w2[31]; f32x2 bd; f32x4 g0, g1, b0, b1; };
__device__ __forceinline__ void conv_const(const Frame& F, const Params& P, ConvConst& C) { const int cp = F.tid & 255; const float* wdw = P.in[I_WDW];
#pragma unroll
    for (int k = 0; k < 31; ++k) C.w2[k] = *(const f32x2*)(wdw + k * 512 + 2 * cp);
    C.bd = *(const f32x2*)(P.in[I_BDW] + 2 * cp); const float* lng = P.in[I_CLNG]; const float* lnb = P.in[I_CLNB];
    C.g0 = *(const f32x4*)(lng + 8 * F.lane); C.g1 = *(const f32x4*)(lng + 8 * F.lane + 4); C.b0 = *(const f32x4*)(lnb + 8 * F.lane); C.b1 = *(const f32x4*)(lnb + 8 * F.lane + 4); }
__device__ __forceinline__ void p_conv_item(const Frame& F, const Params& P, int ci, int ci_next, const bf16* Gb, bf16* YC, v4u (&v)[8], const ConvConst& C) {
    const int R0 = ci * 32;
    LAS bf16* Gin = (LAS bf16*)F.lds;
    LAS float* Yc = (LAS float*)(F.lds + 63488);
#pragma unroll
    for (int k = 0; k < 8; ++k) { const int i = F.tid + 512 * k, r = i >> 6, cc = i & 63; if (i < 62 * 64) *(LAS v4u*)(Gin + r * 512 + cc * 8) = v[k]; }
    if (ci_next >= 0) conv_load(F, ci_next, Gb, v);
    __syncthreads();
    { const int cp = F.tid & 255, th = F.tid >> 8;
        const f32x2 bd = C.bd;
#pragma unroll 1
        for (int blk = 0; blk < 2; ++blk) { const int o0 = 16 * th + 8 * blk; f32x2 a2[8];
#pragma unroll
            for (int o = 0; o < 8; ++o) a2[o] = bd;
#pragma unroll
            for (int i = 0; i < 38; ++i) { const unsigned pr = *(const LAS unsigned*)(Gin + (o0 + i) * 512 + 2 * cp); const f32x2 vv = (f32x2){bflo(pr), bfhi(pr)};
#pragma unroll
                for (int o = 0; o < 8; ++o) { const int k = i - o; if (k >= 0 && k < 31) a2[o] = __builtin_elementwise_fma(C.w2[k], vv, a2[o]); } }
#pragma unroll
            for (int o = 0; o < 8; ++o) *(LAS f32x2*)(Yc + (o0 + o) * 512 + 2 * cp) = a2[o]; }
    }
    __syncthreads();
    { const f32x4 g0 = C.g0, g1 = C.g1, b0 = C.b0, b1 = C.b1;
        f32x4 y[4][2]; float s[4], q[4];
#pragma unroll
        for (int i = 0; i < 4; ++i) { const int r = F.wave * 4 + i; y[i][0] = *(const LAS f32x4*)(Yc + r * 512 + 8 * F.lane); y[i][1] = *(const LAS f32x4*)(Yc + r * 512 + 8 * F.lane + 4); }
#pragma unroll
        for (int i = 0; i < 4; ++i) { const f32x4 a = y[i][0], b = y[i][1]; s[i] = ((a[0] + a[1]) + (a[2] + a[3])) + ((b[0] + b[1]) + (b[2] + b[3]));
            q[i] = ((a[0] * a[0] + a[1] * a[1]) + (a[2] * a[2] + a[3] * a[3])) + ((b[0] * b[0] + b[1] * b[1]) + (b[2] * b[2] + b[3] * b[3])); }
        wave_sum4(s[0], s[1], s[2], s[3], s[0], s[1], s[2], s[3], F.lane); wave_sum4(q[0], q[1], q[2], q[3], q[0], q[1], q[2], q[3], F.lane);
#pragma unroll
        for (int i = 0; i < 4; ++i) { const int r = F.wave * 4 + i; const float mean = s[i] * (1.0f / 512.0f), rstd = 1.0f / sqrtf(fmaxf(q[i] * (1.0f / 512.0f) - mean * mean, 0.f) + LN_EPS);
            float v8[8] = {y[i][0][0], y[i][0][1], y[i][0][2], y[i][0][3], y[i][1][0], y[i][1][1], y[i][1][2], y[i][1][3]};
#pragma unroll
            for (int j = 0; j < 8; ++j) { const float z = (v8[j] - mean) * rstd * (j < 4 ? g0[j & 3] : g1[j & 3]) + (j < 4 ? b0[j & 3] : b1[j & 3]); v8[j] = z * __builtin_amdgcn_rcpf(1.0f + __expf(-z)); }
            v4u o; o.x = pk2(v8[0], v8[1]); o.y = pk2(v8[2], v8[3]); o.z = pk2(v8[4], v8[5]); o.w = pk2(v8[6], v8[7]);
            *(v4u*)(YC + (size_t)(R0 + r) * D + 512 + 8 * F.lane) = o; }
    }
    __syncthreads();
}
#define COL8(q) (512 * ((q) >> 1) + 8 * F.lane + 4 * ((q) & 1))
struct RowVec { f32x4 v[4]; };
__device__ __forceinline__ f32x4 up4(v2u w) { return (f32x4){bflo(w.x), bfhi(w.x), bflo(w.y), bfhi(w.y)}; }
__device__ __forceinline__ f32x4 up4f8(unsigned w) { const f32x2 lo = __builtin_amdgcn_cvt_pk_f32_fp8((int)w, false), hi = __builtin_amdgcn_cvt_pk_f32_fp8((int)w, true); return (f32x4){lo[0], lo[1], hi[0], hi[1]}; }
__device__ __forceinline__ void ln_stats(RowVec& t, float& rstd) {
    float s = 0.f;
#pragma unroll
    for (int j = 0; j < 4; ++j) s += (t.v[j][0] + t.v[j][1]) + (t.v[j][2] + t.v[j][3]);
    const float mean = wave_sum(s) * (1.0f / D); float s2 = 0.f;
#pragma unroll
    for (int j = 0; j < 4; ++j) { t.v[j] = t.v[j] - mean; s2 += (t.v[j][0] * t.v[j][0] + t.v[j][1] * t.v[j][1]) + (t.v[j][2] * t.v[j][2] + t.v[j][3] * t.v[j][3]); }
    rstd = 1.0f / sqrtf(wave_sum(s2) * (1.0f / D) + LN_EPS);
}
struct ModVecs { f32x4 A[4], B[4], G[4], C[4], Dv[4]; };
__device__ __forceinline__ void mod_vecs(const Frame& F, ModVecs& mv, const float* cin, int sh_in, int g_off, const float* lng, const float* lnb, const float* cout, int sh_out) {
#pragma unroll
    for (int q = 0; q < 4; ++q) { const int col = COL8(q);
        const f32x4 sh = *(const f32x4*)(cin + sh_in + col), sc1 = *(const f32x4*)(cin + sh_in + 1024 + col) + 1.0f;
        f32x4 a; a[0] = DN_ALPHA / sc1[0]; a[1] = DN_ALPHA / sc1[1]; a[2] = DN_ALPHA / sc1[2]; a[3] = DN_ALPHA / sc1[3];
        mv.A[q] = a; mv.B[q] = -sh * a; mv.G[q] = *(const f32x4*)(cin + g_off + col) + 1.0f;
        const f32x4 g = *(const f32x4*)(lng + col), b = *(const f32x4*)(lnb + col);
        if (cout) { const f32x4 so = *(const f32x4*)(cout + sh_out + 1024 + col) + 1.0f; mv.C[q] = g * so; mv.Dv[q] = b * so + *(const f32x4*)(cout + sh_out + col); }
        else { mv.C[q] = g; mv.Dv[q] = b; } }
}
__device__ __forceinline__ int slot8(int c) { return (((c >> 9) << 1) | ((c >> 2) & 1)) * 256 + ((c & 511) >> 3) * 4 + (c & 3); }
__device__ __forceinline__ void moe_table(const Frame& F, unsigned* gcnt, LAS int* tl) {
    if (F.tid < 16) tl[F.tid] = (int)((__hip_atomic_load((unsigned long long*)(gcnt + 64 * (F.tid >> 2)), __ATOMIC_RELAXED, __HIP_MEMORY_SCOPE_AGENT) >> (16 * (F.tid & 3))) & 0xffffu);
    __syncthreads();
    if (F.tid == 0) { int s = 0; for (int e = 0; e < 16; ++e) { tl[16 + e] = s; s += (tl[e] + 255) & ~255; } tl[32] = s; }
    __syncthreads();
    if (F.tid < MAXT) { const int r = F.tid * 256; int e = 15; for (int k = 15; k >= 0; --k) if (r < tl[16 + k + 1]) e = k; tl[64 + F.tid] = e; }
    __syncthreads();
}
__device__ __forceinline__ void p9_fill_start(unsigned* gcnt, LAS int* dst, int t) {
    if ((unsigned)t < 64u) { const int e = t & 15;
        const int tot = (int)((__hip_atomic_load((unsigned long long*)(gcnt + 64 * (e >> 2)), __ATOMIC_RELAXED, __HIP_MEMORY_SCOPE_AGENT) >> (16 * (e & 3))) & 0xffffu), pad = (tot + 255) & ~255;
        int s = pad;
#pragma unroll
        for (int d = 1; d < 16; d <<= 1) { const int v = __shfl_up(s, d, 16); if (e >= d) s += v; }
        if (t < 16) dst[e] = s - pad; }
}
__device__ __forceinline__ void p5_fill_w(const Frame& F, const Params& P, int layer, int t, int nthr) {
    LAS float* Wr = (LAS float*)F.lds;
    const float* wg = P.in[I_WGRP] + (size_t)layer * D * 4; const float* we = P.in[I_WER] + (size_t)layer * 4 * D * 4;
    for (int d = t; d < D; d += nthr) { const f32x4 a = *(const f32x4*)(wg + d * 4); const int s = slot8(d);
#pragma unroll
        for (int o = 0; o < 4; ++o) Wr[o * D + s] = a[o];
#pragma unroll
        for (int g = 0; g < 4; ++g) { const f32x4 e = *(const f32x4*)(we + ((size_t)g * D + d) * 4);
#pragma unroll
            for (int o = 0; o < 4; ++o) Wr[(4 + 4 * g + o) * D + s] = e[o]; } }
    LAS float* bg = (LAS float*)(F.lds + 81920 + 64); LAS float* be = bg + 4;
    if (t < 4) bg[t] = P.in[I_BGRP][layer * 4 + t]; if (t >= 64 && t < 80) be[t - 64] = P.in[I_BER][layer * 16 + t - 64];
}
__device__ __forceinline__ void p5_fill_mv(const Frame& F, const Params& P, int layer, int it, int t) {
    LAS int* cntl = (LAS int*)(F.lds + 81920); LAS float* MV = (LAS float*)(F.lds + 82944);
    const float* cond_l = (const float*)(P.ws + WS_COND) + (size_t)layer * 16 * 6144; const float* lng = P.in[I_LNMG] + layer * D; const float* lnb = P.in[I_LNMB] + layer * D;
    const int b = (it * 128) / T; const float* cb = cond_l + (size_t)b * 6144;
        if (t < 16) cntl[t] = 0;
        if (t < 256) { const int col = 4 * t, s = slot8(col); const f32x4 sh = *(const f32x4*)(cb + col), sc1 = *(const f32x4*)(cb + 1024 + col) + 1.0f;
            f32x4 a; a[0] = DN_ALPHA / sc1[0]; a[1] = DN_ALPHA / sc1[1]; a[2] = DN_ALPHA / sc1[2]; a[3] = DN_ALPHA / sc1[3];
            const f32x4 g = *(const f32x4*)(lng + col), bb = *(const f32x4*)(lnb + col), so = *(const f32x4*)(cb + 4096 + col) + 1.0f;
            *(LAS f32x4*)(MV + s) = a; *(LAS f32x4*)(MV + 1024 + s) = -sh * a; *(LAS f32x4*)(MV + 2048 + s) = *(const f32x4*)(cb + 2048 + col) + 1.0f;
            *(LAS f32x4*)(MV + 3072 + s) = g * so; *(LAS f32x4*)(MV + 4096 + s) = bb * so + *(const f32x4*)(cb + 3072 + col); }
}
struct RowRaw { v4u h[2]; v4u y[2]; };
template <bool Y8> __device__ __forceinline__ void p_ln_route(const Frame& F, const Params& P, int layer, const void* Yv, bf16* H, bf16* Hout, unsigned char* H8, bool pre) {
    const bf16* Y = (const bf16*)Yv; const unsigned char* Yb = (const unsigned char*)Yv;
    unsigned char* ws = P.ws;
    LAS float* Wr = (LAS float*)F.lds;
    LAS int* cntl = (LAS int*)(F.lds + 81920);
    LAS float* MV = (LAS float*)(F.lds + 82944);
    if (!pre) p5_fill_w(F, P, layer, F.tid, 512);
    LAS float* bg = (LAS float*)(F.lds + 81920 + 64); LAS float* be = bg + 4;
    const float* cond_l = (const float*)(ws + WS_COND) + (size_t)layer * 16 * 6144;
    const float* lng = P.in[I_LNMG] + layer * D; const float* lnb = P.in[I_LNMB] + layer * D;
    int* route_e = (int*)(ws + WS_ROUTE_E); f32x2* route_w = (f32x2*)(ws + WS_ROUTE_W);
    LAS int* ael = (LAS int*)(F.lds + 103424)  ; LAS int* basel = ael + 256  ; LAS int* totl = basel + 16  ; LAS int* startl = totl + 16  ; LAS int* lastf = startl + 32;
    unsigned* gcnt = (unsigned*)(ws + WS_CTL) + CW_MOE + layer * 2048;
    int* pos = (int*)(ws + WS_POS); int* inv = (int*)(ws + WS_INV); int* tab = (int*)(ws + WS_TILE);
    for (int it = F.vcu; it < 256; it += F.G) {
        const int rbase = it * 128 + F.wave * 16, b = rbase / T; const float* cb = cond_l + (size_t)b * 6144;
        RowRaw rb[4];
#define LD_ROW(dst, r) do { _Pragma("unroll") for (int j = 0; j < 2; ++j) { (dst).h[j] = __builtin_nontemporal_load((const v4u*)(H + (size_t)(r) * D + 8 * F.lane + 512 * j)); if constexpr (Y8) { if (j == 0) (dst).y[0] = __builtin_nontemporal_load((const v4u*)pair_addr(Yb + (size_t)(r) * D + 8 * F.lane, Yb + (size_t)(r) * D + 8 * F.lane + 512, F.lane));   } else (dst).y[j] = __builtin_nontemporal_load((const v4u*)(Y + (size_t)(r) * D + 8 * F.lane + 512 * j)); } } while (0)
        if (!(pre && it == F.vcu)) p5_fill_mv(F, P, layer, it, F.tid);
        __syncthreads();
#define P5_PAIR(bA, bB, ii, REA_, WA0_, WA1_, REB_, WB0_, WB1_) do { const int r = rbase + (ii); RowVec tA, tB; float rsA, rsB; \
            v2u ya0_ = {0u, 0u}, ya1_ = {0u, 0u}, yb0_ = {0u, 0u}, yb1_ = {0u, 0u}; if constexpr (Y8) { pair_split((bA).y[0], F.lane, ya0_, ya1_); pair_split((bB).y[0], F.lane, yb0_, yb1_); } \
            _Pragma("unroll") for (int q = 0; q < 4; ++q) { const int s = 256 * q + 4 * F.lane; const f32x4 mA = *(const LAS f32x4*)(MV + s), mB = *(const LAS f32x4*)(MV + 1024 + s), mG = *(const LAS f32x4*)(MV + 2048 + s); \
                { const v4u hw = (bA).h[q >> 1], yw = (bA).y[q >> 1]; const v2u h2 = (q & 1) ? (v2u){hw.z, hw.w} : (v2u){hw.x, hw.y}, y2 = (q & 1) ? (v2u){yw.z, yw.w} : (v2u){yw.x, yw.y}; f32x4 yv; if constexpr (Y8) yv = up4f8((q >> 1) ? ((q & 1) ? ya1_.y : ya1_.x) : ((q & 1) ? ya0_.y : ya0_.x)) * 0.015625f; else yv = up4(y2); tA.v[q] = up4(h2) * mA + mB + mG * yv; } \
                { const v4u hw = (bB).h[q >> 1], yw = (bB).y[q >> 1]; const v2u h2 = (q & 1) ? (v2u){hw.z, hw.w} : (v2u){hw.x, hw.y}, y2 = (q & 1) ? (v2u){yw.z, yw.w} : (v2u){yw.x, yw.y}; f32x4 yv; if constexpr (Y8) yv = up4f8((q >> 1) ? ((q & 1) ? yb1_.y : yb1_.x) : ((q & 1) ? yb0_.y : yb0_.x)) * 0.015625f; else yv = up4(y2); tB.v[q] = up4(h2) * mA + mB + mG * yv; } } \
            float sA_ = 0.f, qA_ = 0.f, sB_ = 0.f, qB_ = 0.f; \
            _Pragma("unroll") for (int q = 0; q < 4; ++q) { const f32x4 xa = tA.v[q], xb = tB.v[q]; sA_ += (xa[0] + xa[1]) + (xa[2] + xa[3]); qA_ += (xa[0] * xa[0] + xa[1] * xa[1]) + (xa[2] * xa[2] + xa[3] * xa[3]); \
                sB_ += (xb[0] + xb[1]) + (xb[2] + xb[3]); qB_ += (xb[0] * xb[0] + xb[1] * xb[1]) + (xb[2] * xb[2] + xb[3] * xb[3]); } \
            float tsA, tqA, tsB, tqB; wave_sum4(sA_, qA_, sB_, qB_, tsA, tqA, tsB, tqB, F.lane);     \
            const float mnA = tsA * (1.0f / D), mnB = tsB * (1.0f / D); rsA = __builtin_amdgcn_rsqf(fmaxf(tqA * (1.0f / D) - mnA * mnA, 0.f) + LN_EPS); rsB = __builtin_amdgcn_rsqf(fmaxf(tqB * (1.0f / D) - mnB * mnB, 0.f) + LN_EPS); \
            f32x4 aA[4] = {}, aB[4] = {}; unsigned owA[8], o8A[4], owB[8], o8B[4];     \
            _Pragma("unroll") for (int q = 0; q < 4; ++q) { const int s = 256 * q + 4 * F.lane; const f32x4 mC = *(const LAS f32x4*)(MV + 3072 + s), mD = *(const LAS f32x4*)(MV + 4096 + s); \
                const f32x4 hA = (tA.v[q] - mnA) * rsA * mC + mD, hB = (tB.v[q] - mnB) * rsB * mC + mD; tA.v[q] = hA; tB.v[q] = hB; \
                owA[2 * q] = pk2(hA[0], hA[1]); owA[2 * q + 1] = pk2(hA[2], hA[3]); o8A[q] = pg8::pk_fp8x4(hA[0], hA[1], hA[2], hA[3]); \
                owB[2 * q] = pk2(hB[0], hB[1]); owB[2 * q + 1] = pk2(hB[2], hB[3]); o8B[q] = pg8::pk_fp8x4(hB[0], hB[1], hB[2], hB[3]); \
                _Pragma("unroll") for (int o = 0; o < 4; ++o) { const f32x4 w = *(const LAS f32x4*)(Wr + o * D + s); \
                    aA[o] = __builtin_elementwise_fma(hA, w, aA[o]); aB[o] = __builtin_elementwise_fma(hB, w, aB[o]); } } \
            *(v4u*)(Hout + (size_t)r * D + 8 * F.lane) = (v4u){owA[0], owA[1], owA[2], owA[3]}; *(v4u*)(Hout + (size_t)r * D + 8 * F.lane + 512) = (v4u){owA[4], owA[5], owA[6], owA[7]}; \
            *(v4u*)(Hout + (size_t)(r + 1) * D + 8 * F.lane) = (v4u){owB[0], owB[1], owB[2], owB[3]}; *(v4u*)(Hout + (size_t)(r + 1) * D + 8 * F.lane + 512) = (v4u){owB[4], owB[5], owB[6], owB[7]}; \
            *(v4u*)pair_addr(H8 + (size_t)r * D + 8 * F.lane, H8 + (size_t)r * D + 8 * F.lane + 512, F.lane) = pair_join((v2u){o8A[0], o8A[1]}, (v2u){o8A[2], o8A[3]}, F.lane); \
            *(v4u*)pair_addr(H8 + (size_t)(r + 1) * D + 8 * F.lane, H8 + (size_t)(r + 1) * D + 8 * F.lane + 512, F.lane) = pair_join((v2u){o8B[0], o8B[1]}, (v2u){o8B[2], o8B[3]}, F.lane); \
            __builtin_amdgcn_sched_barrier(0); \
            float lA[4], lB[4]; _Pragma("unroll") for (int o = 0; o < 4; ++o) { lA[o] = (aA[o][0] + aA[o][1]) + (aA[o][2] + aA[o][3]); lB[o] = (aB[o][0] + aB[o][1]) + (aB[o][2] + aB[o][3]); } \
            wave_sum4(lA[0], lA[1], lA[2], lA[3], lA[0], lA[1], lA[2], lA[3], F.lane); wave_sum4(lB[0], lB[1], lB[2], lB[3], lB[0], lB[1], lB[2], lB[3], F.lane); \
            _Pragma("unroll") for (int o = 0; o < 4; ++o) { lA[o] += bg[o]; lB[o] += bg[o]; } \
            int gA = 0, gB = 0; float mxA = lA[0], mxB = lB[0]; \
            _Pragma("unroll") for (int j = 1; j < 4; ++j) { if (lA[j] > mxA) { mxA = lA[j]; gA = j; } if (lB[j] > mxB) { mxB = lB[j]; gB = j; } } \
            gA = __builtin_amdgcn_readfirstlane(gA); gB = __builtin_amdgcn_readfirstlane(gB); \
            float dA = 0.f, dB = 0.f; \
            _Pragma("unroll") for (int j = 0; j < 4; ++j) { dA += __expf(lA[j] - mxA); dB += __expf(lB[j] - mxB); } \
            const float gwA = __builtin_amdgcn_rcpf(dA), gwB = __builtin_amdgcn_rcpf(dB); \
            f32x4 cA[4] = {}, cB[4] = {}; const LAS float* WeA = Wr + (4 + 4 * gA) * D; const LAS float* WeB = Wr + (4 + 4 * gB) * D; \
            _Pragma("unroll") for (int q = 0; q < 4; ++q) { const int s = 256 * q + 4 * F.lane; const f32x4 hA = tA.v[q], hB = tB.v[q]; \
                _Pragma("unroll") for (int o = 0; o < 4; ++o) { const f32x4 wA = *(const LAS f32x4*)(WeA + o * D + s), wB = *(const LAS f32x4*)(WeB + o * D + s); \
                    cA[o] = __builtin_elementwise_fma(hA, wA, cA[o]); cB[o] = __builtin_elementwise_fma(hB, wB, cB[o]); } } \
            __builtin_amdgcn_sched_barrier(0); \
            float eA[4], eB[4]; _Pragma("unroll") for (int o = 0; o < 4; ++o) { eA[o] = (cA[o][0] + cA[o][1]) + (cA[o][2] + cA[o][3]); eB[o] = (cB[o][0] + cB[o][1]) + (cB[o][2] + cB[o][3]); } \
            wave_sum4(eA[0], eA[1], eA[2], eA[3], eA[0], eA[1], eA[2], eA[3], F.lane); wave_sum4(eB[0], eB[1], eB[2], eB[3], eB[0], eB[1], eB[2], eB[3], F.lane); \
            _Pragma("unroll") for (int o = 0; o < 4; ++o) { eA[o] += be[gA * 4 + o]; eB[o] += be[gB * 4 + o]; } \
            { int i0 = 0; float m0 = eA[0]; _Pragma("unroll") for (int e2 = 1; e2 < 4; ++e2) if (eA[e2] > m0) { m0 = eA[e2]; i0 = e2; } \
              int i1 = 0; float m1 = -__builtin_inff(); _Pragma("unroll") for (int e2 = 0; e2 < 4; ++e2) if (e2 != i0 && eA[e2] > m1) { m1 = eA[e2]; i1 = e2; } \
              WA0_ = gwA * __builtin_amdgcn_rcpf(1.0f + __expf(m1 - m0)); WA1_ = gwA - WA0_; REA_ = (gA * 4 + i0) | ((gA * 4 + i1) << 8); } \
            { int i0 = 0; float m0 = eB[0]; _Pragma("unroll") for (int e2 = 1; e2 < 4; ++e2) if (eB[e2] > m0) { m0 = eB[e2]; i0 = e2; } \
              int i1 = 0; float m1 = -__builtin_inff(); _Pragma("unroll") for (int e2 = 0; e2 < 4; ++e2) if (e2 != i0 && eB[e2] > m1) { m1 = eB[e2]; i1 = e2; } \
              WB0_ = gwB * __builtin_amdgcn_rcpf(1.0f + __expf(m1 - m0)); WB1_ = gwB - WB0_; REB_ = (gB * 4 + i0) | ((gB * 4 + i1) << 8); } } while (0)
        for (int i = 0; i < 16; i += 4) { asm volatile("" ::: "memory"); LD_ROW(rb[0], rbase + i); LD_ROW(rb[1], rbase + i + 1); LD_ROW(rb[2], rbase + i + 2); LD_ROW(rb[3], rbase + i + 3);
            int re0, re1, re2, re3; float wa0, wa1, wa2, wa3, wb0, wb1, wb2, wb3;
            P5_PAIR(rb[0], rb[1], i, re0, wa0, wb0, re1, wa1, wb1); __builtin_amdgcn_sched_barrier(0); P5_PAIR(rb[2], rb[3], i + 2, re2, wa2, wb2, re3, wa3, wb3);
            if (F.lane == 0) { const int r = rbase + i; *(v4u*)(route_e + r) = (v4u){(unsigned)re0, (unsigned)re1, (unsigned)re2, (unsigned)re3};
                { LAS int* ap = ael + 2 * (F.wave * 16 + i); ap[0] = re0 & 0xff; ap[1] = re0 >> 8; ap[2] = re1 & 0xff; ap[3] = re1 >> 8; ap[4] = re2 & 0xff; ap[5] = re2 >> 8; ap[6] = re3 & 0xff; ap[7] = re3 >> 8; }
                *(f32x4*)(route_w + r) = (f32x4){wa0, wb0, wa1, wb1}; *(f32x4*)(route_w + r + 2) = (f32x4){wa2, wb2, wa3, wb3};
                __hip_atomic_fetch_add(&cntl[re0 & 0xff], 1, __ATOMIC_RELAXED, __HIP_MEMORY_SCOPE_WORKGROUP); __hip_atomic_fetch_add(&cntl[re0 >> 8], 1, __ATOMIC_RELAXED, __HIP_MEMORY_SCOPE_WORKGROUP);
                __hip_atomic_fetch_add(&cntl[re1 & 0xff], 1, __ATOMIC_RELAXED, __HIP_MEMORY_SCOPE_WORKGROUP); __hip_atomic_fetch_add(&cntl[re1 >> 8], 1, __ATOMIC_RELAXED, __HIP_MEMORY_SCOPE_WORKGROUP);
                __hip_atomic_fetch_add(&cntl[re2 & 0xff], 1, __ATOMIC_RELAXED, __HIP_MEMORY_SCOPE_WORKGROUP); __hip_atomic_fetch_add(&cntl[re2 >> 8], 1, __ATOMIC_RELAXED, __HIP_MEMORY_SCOPE_WORKGROUP);
                __hip_atomic_fetch_add(&cntl[re3 & 0xff], 1, __ATOMIC_RELAXED, __HIP_MEMORY_SCOPE_WORKGROUP); __hip_atomic_fetch_add(&cntl[re3 >> 8], 1, __ATOMIC_RELAXED, __HIP_MEMORY_SCOPE_WORKGROUP); } }
#undef P5_PAIR
#undef LD_ROW
        __syncthreads();
        if (F.tid < 4) { const unsigned long long c = (unsigned long long)(unsigned)cntl[4 * F.tid] | ((unsigned long long)(unsigned)cntl[4 * F.tid + 1] << 16) | ((unsigned long long)(unsigned)cntl[4 * F.tid + 2] << 32) | ((unsigned long long)(unsigned)cntl[4 * F.tid + 3] << 48);
            const unsigned long long o = __hip_atomic_fetch_add((unsigned long long*)(gcnt + 64 * F.tid), c, __ATOMIC_RELAXED, __HIP_MEMORY_SCOPE_AGENT);
            basel[4 * F.tid] = (int)(o & 0xffffu); basel[4 * F.tid + 1] = (int)((o >> 16) & 0xffffu); basel[4 * F.tid + 2] = (int)((o >> 32) & 0xffffu); basel[4 * F.tid + 3] = (int)(o >> 48); }
        __syncthreads();
        { LAS int* wc = lastf + 16;
          int me = 0, rin = 0;
          if (F.tid < 256) { me = ael[F.tid]; int wcount = 0;
#pragma unroll 1
              for (int e = 0; e < 16; ++e) { const unsigned long long m = __ballot(me == e); const int below = (int)__builtin_amdgcn_mbcnt_hi((unsigned)(m >> 32), __builtin_amdgcn_mbcnt_lo((unsigned)m, 0u));
                  if (me == e) rin = below; if (F.lane == e) wcount = __popcll(m); }
              if (F.lane < 16) wc[F.wave * 16 + F.lane] = wcount; }
          __syncthreads();
          if (F.tid < 256) { int rank = rin; for (int w = 0; w < 3; ++w) if (w < F.wave) rank += wc[w * 16 + me];
              const int off = basel[me] + rank, token = it * 128 + (F.tid >> 1); pos[token * 2 + (F.tid & 1)] = off; inv[me * INV_CAP + off] = token; } }
        __syncthreads();
    }
}
__device__ __forceinline__ void p_positions(const Frame& F, const Params& P) {
    unsigned char* ws = P.ws;
    LAS int* part = (LAS int*)F.lds;
    LAS int* tot = part + 512; LAS int* pre = tot + 16; LAS int* start = pre + 16  ; LAS int* ae = start + 32  ; LAS int* inpart = ae + 256  ;
    const int* cnt = (const int*)(ws + WS_CNT); const int* route_e = (const int*)(ws + WS_ROUTE_E); int* pos = (int*)(ws + WS_POS); int* tile_e = (int*)(ws + WS_TILE); int* inv = (int*)(ws + WS_INV);
    for (int it = F.vcu; it < 256; it += F.G) {
        { const int e = F.tid & 15, pt = F.tid >> 4; int s = 0, pp = 0;
#pragma unroll
            for (int c = 0; c < 8; ++c) { const int v = cnt[(pt * 8 + c) * 16 + e]; s += v; if (pt * 8 + c < it) pp += v; }
            part[pt * 16 + e] = s; if (pt == (it >> 3)) inpart[e] = pp; }
        __syncthreads();
        if (F.tid < 16) { const int e = F.tid; int s = 0, p = 0;
            for (int q = 0; q < 32; ++q) { const int v = part[q * 16 + e]; s += v; if (q < (it >> 3)) p += v; }
            tot[e] = s; pre[e] = p + inpart[e]; }
        __syncthreads();
        if (F.tid == 0) { int s = 0; for (int e = 0; e < 16; ++e) { start[e] = s; s += (tot[e] + 255) & ~255; } start[16] = s; }
        if (F.tid < 256) { const int token = it * 128 + (F.tid >> 1); ae[F.tid] = (route_e[token] >> (8 * (F.tid & 1))) & 0xff; }
        __syncthreads();
        if (F.tid < 256) { const int me = ae[F.tid]; int rank = 0; for (int a = 0; a < F.tid; ++a) rank += (ae[a] == me) ? 1 : 0;
            const int p = start[me] + pre[me] + rank, token = it * 128 + (F.tid >> 1); pos[token * 2 + (F.tid & 1)] = p; inv[p] = token; }
        if (it < 16) { const int e = it; for (int p = start[e] + tot[e] + F.tid; p < start[e + 1]; p += 512) inv[p] = 0; }
        if (it == 0) { if (F.tid < MAXT) { const int r = F.tid * 256; int e = 15; for (int k = 15; k >= 0; --k) if (r < start[k + 1]) e = k; tile_e[F.tid] = e; } if (F.tid == 0) tile_e[511] = start[16] >> 8; }
        __syncthreads();
    }
}
struct Raw3 { v4u h[2]; v4u yar, ybr;   f32x2 rw; };
template <bool FINAL> __device__ __forceinline__ void p9_fill_mv(const Frame& F, const Params& P, int layer, int it, int t) {
    unsigned char* ws = P.ws; LAS float* MV = (LAS float*)F.lds;
    const float* lng = P.in[I_LNFG] + layer * D; const float* lnb = P.in[I_LNFB] + layer * D;
    const int b = (it * 128) / T; const float* cb = (const float*)(ws + WS_COND) + ((size_t)layer * 16 + b) * 6144; const float* cbn = FINAL ? nullptr : (const float*)(ws + WS_COND) + ((size_t)(layer + 1) * 16 + b) * 6144;
        if (t < 256) { const int col = 4 * t, s = slot8(col); const f32x4 sh = *(const f32x4*)(cb + 3072 + col), sc1 = *(const f32x4*)(cb + 4096 + col) + 1.0f;
            f32x4 a; a[0] = DN_ALPHA / sc1[0]; a[1] = DN_ALPHA / sc1[1]; a[2] = DN_ALPHA / sc1[2]; a[3] = DN_ALPHA / sc1[3];
            const f32x4 g = *(const f32x4*)(lng + col), bb = *(const f32x4*)(lnb + col);
            *(LAS f32x4*)(MV + s) = a; *(LAS f32x4*)(MV + 1024 + s) = -sh * a; *(LAS f32x4*)(MV + 2048 + s) = *(const f32x4*)(cb + 5120 + col) + 1.0f;
            if (cbn) { const f32x4 so = *(const f32x4*)(cbn + 1024 + col) + 1.0f; *(LAS f32x4*)(MV + 3072 + s) = g * so; *(LAS f32x4*)(MV + 4096 + s) = bb * so + *(const f32x4*)(cbn + col); }
            else { *(LAS f32x4*)(MV + 3072 + s) = g; *(LAS f32x4*)(MV + 4096 + s) = bb; } }
}
template <bool FINAL> __device__ __forceinline__ void p_combine_ln(const Frame& F, const Params& P, int layer, const unsigned char* Ys, bf16* H, bf16* Hout, unsigned char* H8, float* out  , bool pre) {
    unsigned char* ws = P.ws;
    LAS float* MV = (LAS float*)F.lds;
    const float* lng = P.in[I_LNFG] + layer * D; const float* lnb = P.in[I_LNFB] + layer * D;
    const int* pos = (const int*)(ws + WS_POS); const f32x2* route_w = (const f32x2*)(ws + WS_ROUTE_W);
    for (int it = F.vcu; it < 256; it += F.G) {
        const int r0 = it * 128 + F.wave * 16, b = r0 / T; const float* cb = (const float*)(ws + WS_COND) + ((size_t)layer * 16 + b) * 6144; const float* cbn = FINAL ? nullptr : (const float*)(ws + WS_COND) + ((size_t)(layer + 1) * 16 + b) * 6144;
        const int pv = pos[2 * r0 + (F.lane & 31)] + ((const LAS int*)(F.lds + 20480))[(((const int*)(ws + WS_ROUTE_E))[r0 + ((F.lane & 31) >> 1)] >> (8 * (F.lane & 1))) & 0xff];
        const f32x2 rwv = route_w[r0 + (F.lane & 15)];
#define ROWP(i_, p0_, p1_, rw_) const int p0_ = __shfl(pv, 2 * (i_)), p1_ = __shfl(pv, 2 * (i_) + 1); const f32x2 rw_ = (f32x2){__shfl(rwv[0], (i_)) * 0.0625f, __shfl(rwv[1], (i_)) * 0.0625f}
#define LD_ROW3(dst, r, p0_, p1_, rw_) do { (dst).rw = (rw_); _Pragma("unroll") for (int j = 0; j < 2; ++j) { const int col = 8 * F.lane + 512 * j; (dst).h[j] = __builtin_nontemporal_load((const v4u*)(H + (size_t)(r) * D + col)); } \
            (dst).yar = __builtin_nontemporal_load((const v4u*)pair_addr(Ys + (size_t)(p0_) * D + 8 * F.lane, Ys + (size_t)(p0_) * D + 8 * F.lane + 512, F.lane)); (dst).ybr = __builtin_nontemporal_load((const v4u*)pair_addr(Ys + (size_t)(p1_) * D + 8 * F.lane, Ys + (size_t)(p1_) * D + 8 * F.lane + 512, F.lane)); } while (0)
        Raw3 rb[4];
        if (!(pre && it == F.vcu)) p9_fill_mv<FINAL>(F, P, layer, it, F.tid);
        if (!pre && it == F.vcu) p9_fill_start((unsigned*)(ws + WS_CTL) + CW_MOE + layer * 2048, (LAS int*)(F.lds + 20480), F.tid);
        __syncthreads();
#define P9_T(buf, t) { v2u ya_[2], yb_[2]; pair_split((buf).yar, F.lane, ya_[0], ya_[1]); pair_split((buf).ybr, F.lane, yb_[0], yb_[1]); _Pragma("unroll") for (int q = 0; q < 4; ++q) { const v4u hw = (buf).h[q >> 1]; const v2u aw_ = ya_[q >> 1], bw_ = yb_[q >> 1]; \
                const v2u h2 = (q & 1) ? (v2u){hw.z, hw.w} : (v2u){hw.x, hw.y}; const unsigned a1 = (q & 1) ? aw_.y : aw_.x, b1 = (q & 1) ? bw_.y : bw_.x; \
                const int s = 256 * q + 4 * F.lane; t.v[q] = up4(h2) * *(const LAS f32x4*)(MV + s) + *(const LAS f32x4*)(MV + 1024 + s) + *(const LAS f32x4*)(MV + 2048 + s) * (up4f8(a1) * (buf).rw[0] + up4f8(b1) * (buf).rw[1]); } }
#define P9_OUT(t, r, mn, rstd) do { \
            if constexpr (FINAL) { _Pragma("unroll") for (int q = 0; q < 4; ++q) { const int s = 256 * q + 4 * F.lane; *(f32x4*)(out + (size_t)(r) * D + COL8(q)) = (t.v[q] - mn) * rstd * *(const LAS f32x4*)(MV + 3072 + s) + *(const LAS f32x4*)(MV + 4096 + s); } } \
            else { unsigned ow[8], o8[4]; _Pragma("unroll") for (int q = 0; q < 4; ++q) { const int s = 256 * q + 4 * F.lane; const f32x4 o = (t.v[q] - mn) * rstd * *(const LAS f32x4*)(MV + 3072 + s) + *(const LAS f32x4*)(MV + 4096 + s); ow[2 * q] = pk2(o[0], o[1]); ow[2 * q + 1] = pk2(o[2], o[3]); o8[q] = pg8::pk_fp8x4(o[0], o[1], o[2], o[3]); } \
                *(v4u*)pair_addr(H8 + (size_t)(r) * D + 8 * F.lane, H8 + (size_t)(r) * D + 8 * F.lane + 512, F.lane) = pair_join((v2u){o8[0], o8[1]}, (v2u){o8[2], o8[3]}, F.lane);     \
                *(v4u*)(Hout + (size_t)(r) * D + 8 * F.lane) = (v4u){ow[0], ow[1], ow[2], ow[3]}; *(v4u*)(Hout + (size_t)(r) * D + 8 * F.lane + 512) = (v4u){ow[4], ow[5], ow[6], ow[7]}; } } while (0)
#define P9_PAIR(bA, bB, ii) do { RowVec tA, tB; P9_T(bA, tA) P9_T(bB, tB) \
            float sA_ = 0.f, qA_ = 0.f, sB_ = 0.f, qB_ = 0.f; \
            _Pragma("unroll") for (int q = 0; q < 4; ++q) { const f32x4 xa = tA.v[q], xb = tB.v[q]; sA_ += (xa[0] + xa[1]) + (xa[2] + xa[3]); qA_ += (xa[0] * xa[0] + xa[1] * xa[1]) + (xa[2] * xa[2] + xa[3] * xa[3]); \
                sB_ += (xb[0] + xb[1]) + (xb[2] + xb[3]); qB_ += (xb[0] * xb[0] + xb[1] * xb[1]) + (xb[2] * xb[2] + xb[3] * xb[3]); } \
            float tsA, tqA, tsB, tqB; wave_sum4(sA_, qA_, sB_, qB_, tsA, tqA, tsB, tqB, F.lane); \
            const float mnA = tsA * (1.0f / D), mnB = tsB * (1.0f / D); const float rsA = 1.0f / sqrtf(fmaxf(tqA * (1.0f / D) - mnA * mnA, 0.f) + LN_EPS), rsB = 1.0f / sqrtf(fmaxf(tqB * (1.0f / D) - mnB * mnB, 0.f) + LN_EPS); \
            P9_OUT(tA, r0 + (ii), mnA, rsA); P9_OUT(tB, r0 + (ii) + 1, mnB, rsB); } while (0)
        for (int i = 0; i < 16; i += 4) {
            { ROWP(i, a0, a1, aw); LD_ROW3(rb[0], r0 + i, a0, a1, aw); } { ROWP(i + 1, a0, a1, aw); LD_ROW3(rb[1], r0 + i + 1, a0, a1, aw); }
            { ROWP(i + 2, a0, a1, aw); LD_ROW3(rb[2], r0 + i + 2, a0, a1, aw); } { ROWP(i + 3, a0, a1, aw); LD_ROW3(rb[3], r0 + i + 3, a0, a1, aw); }
            P9_PAIR(rb[0], rb[1], i); __builtin_amdgcn_sched_barrier(0); P9_PAIR(rb[2], rb[3], i + 2); __builtin_amdgcn_sched_barrier(0); }
#undef P9_PAIR
#undef P9_OUT
#undef P9_T
#undef LD_ROW3
#undef ROWP
        __syncthreads();
    }
}
__device__ __forceinline__ void p_kmean(const Frame& F, const bf16* K, float* kmean) {
    const int gw = F.vcu * NWAVES + F.wave, NGW = F.G * NWAVES;
    for (int it = gw; it < 1024; it += NGW) { const int b = it >> 6, blk = (it >> 3) & 7, h = it & 7;
        const bf16* kp = K + (size_t)(b * T + blk * 256) * D + h * 128 + 2 * F.lane; float s0 = 0.f, s1 = 0.f;
#pragma unroll 8
        for (int r = 0; r < 256; ++r) { const unsigned w = *(const unsigned*)(kp + (size_t)r * D); s0 += bflo(w); s1 += bfhi(w); }
        *(f32x2*)(kmean + ((size_t)(b * 8 + h) * 8 + blk) * 128 + 2 * F.lane) = (f32x2){s0 * (1.0f / 256.0f), s1 * (1.0f / 256.0f)}; }
}
__device__ __forceinline__ void p_gate(const Frame& F, const bf16* Q, const float* kmean, unsigned char* sel) {
    LAS float* km = (LAS float*)F.lds;
    for (int it = F.vcu; it < 1024; it += F.G) { const int b = it >> 6, qb = (it >> 3) & 7, h = it & 7;
        const int tl = F.tid >> 1, half = F.tid & 1; const size_t row = (size_t)b * T + qb * 256 + tl;
        if (qb < 4) { if (half == 0) sel[row * 8 + h] = (unsigned char)((1u << qb) - 1u); continue; }
        for (int i = F.tid; i < qb * 128; i += 512) km[i] = kmean[((size_t)(b * 8 + h) * 8) * 128 + i];
        __syncthreads();
        float gt[7];
#pragma unroll
        for (int n = 0; n < 7; ++n) gt[n] = 0.f;
        const bf16* qp = Q + row * D + h * 128 + half * 64;
#pragma unroll
        for (int c8 = 0; c8 < 8; ++c8) { const v4u raw = *(const v4u*)(qp + 8 * c8);
            const float qv[8] = {bflo(raw.x), bfhi(raw.x), bflo(raw.y), bfhi(raw.y), bflo(raw.z), bfhi(raw.z), bflo(raw.w), bfhi(raw.w)};
#pragma unroll
            for (int n = 0; n < 7; ++n) if (n < qb) { const LAS f32x4* kk = (const LAS f32x4*)(km + n * 128 + half * 64 + 8 * c8); const f32x4 k0 = kk[0], k1 = kk[1];
                gt[n] += (qv[0] * k0[0] + qv[1] * k0[1]) + (qv[2] * k0[2] + qv[3] * k0[3]) + (qv[4] * k1[0] + qv[5] * k1[1]) + (qv[6] * k1[2] + qv[7] * k1[3]); } }
        unsigned mask = 0u;
#pragma unroll
        for (int n = 0; n < 7; ++n) gt[n] += __shfl_xor(gt[n], 1);
#pragma unroll
        for (int pick = 0; pick < 3; ++pick) { int bi = -1; float bv = -__builtin_inff();
#pragma unroll
            for (int n = 0; n < 7; ++n) if (n < qb && !((mask >> n) & 1u) && gt[n] > bv) { bv = gt[n]; bi = n; }
            if (bi >= 0) mask |= 1u << bi; }
        if (half == 0) sel[row * 8 + h] = (unsigned char)mask;
        __syncthreads();
    }
}
__device__ __forceinline__ att::BlockRef att_ref(int L, int pass, const bf16* Q, const unsigned char* Q8, const unsigned char* K8, const unsigned char* V8, unsigned char* O, const float* kmean, bool lmap) {
    const int v_ = L & 255, bh = lmap ? ((2 * (v_ >> 5) + (L >> 8)) * 8 + ((v_ >> 2) & 7)) : (L >> 2), x = L & 3, qb = pass ? 7 - x : x, b = bh >> 3, h = bh & 7; const size_t base = (size_t)b * T * D + h * 128;
    att::BlockRef r; r.Q = Q + base + (size_t)qb * 256 * D; r.Q8 = Q8 + base + (size_t)qb * 256 * D; r.O = O + base + (size_t)qb * 256 * D; r.K8 = K8 + base; r.V8 = V8 + base; r.Kmean = kmean + (size_t)bh * 8 * 128; r.P0 = qb * 256; return r;
}
__device__ __forceinline__ void p_attention(const Frame& F, const bf16* Q, const unsigned char* Q8, const unsigned char* K8, const unsigned char* V8, unsigned char* O, const float* sel, bool lmap) {
    constexpr int total = 512; int L = F.vcu; if (L >= total) return; int pass = 0;
    att::BlockRef cur = att_ref(L, 0, Q, Q8, K8, V8, O, sel, lmap); att::Seam S;
    att::moba_prime(cur, (char*)F.lds, S);
    for (;;) {
        const bool more_pass = pass == 0, more_item = L + F.G < total, last = !more_pass && !more_item;
        int passn = pass + 1, Ln = L; if (!more_pass) { passn = 0; Ln = more_item ? L + F.G : L; }
        const att::BlockRef nxt = last ? cur : att_ref(Ln, passn, Q, Q8, K8, V8, O, sel, lmap);
        att::moba_block(cur, nxt, (char*)F.lds, S);
        if (last) break;
        cur = nxt; pass = passn; L = Ln;
    }
}
constexpr int RING_BYTES = 131072, LDSCTL_OFF = RING_BYTES, MISC_OFF = LDSCTL_OFF + 320, LDS_BYTES = 147456;
constexpr int NPHASE = 20;
#ifndef NO_SGU
#define SGU_CALL p_sgu_item(F, P, it, U, V, YC);
#else
#define SGU_CALL
#endif
#ifndef NO_CONV
#define CONV_CALL p_conv_item(F, P, ci, (ci + cstep < cend) ? ci + cstep : -1, Gb, YC, cv, cc);
#else
#define CONV_CALL
#endif
#ifndef PROBE_DUP
#define PROBE_DUP 0u
#endif
#define DUP(k) (((PROBE_DUP) >> (k)) & 1u)
#define RUN(k, ...) do { __VA_ARGS__ if (DUP(k)) { __VA_ARGS__ } } while (0)
#if MK_ONE_LAUNCH
#define GRID_BAR() xcd_barrier(bar)
#define GRID_BAR_OV(...) xcd_barrier_ov(bar, [&]() { __VA_ARGS__ })
#define SEAM_BAR_OV(s, ...) do { if (local_ok) local_barrier_ov(bar.bar, (unsigned*)(ws + WS_CTL) + CW_LBAR + (s) * 512 + (F.vcu >> 5) * 64, 32u, [&]() { __VA_ARGS__ }); else xcd_barrier_ov(bar, [&]() { __VA_ARGS__ }); } while (0)
#define SEAM_BAR(s) SEAM_BAR_OV(s, )
#else
#define GRID_BAR() do { } while (0)
#define GRID_BAR_OV(...) do { } while (0)
#define SEAM_BAR_OV(s, ...) do { } while (0)
#define SEAM_BAR(s) do { } while (0)
#endif
template <int LAYER, int pbase>
__device__ __forceinline__ void moe_phases(const Frame& F, const Params& P, XcdBarrier& bar, int lo, int hi, const bf16* Ymix, float* out_final) {
    unsigned char* ws = P.ws;
    bf16* H = (bf16*)(ws + WS_H); unsigned char* YS = ws + WS_BIG;   unsigned char* HID = (unsigned char*)P.out; unsigned char* H8 = ws + WS_H8;
    LAS int* tl = (LAS int*)(F.lds + LDSCTL_OFF + 8192);
    unsigned* gcnt = (unsigned*)(ws + WS_CTL) + CW_MOE + LAYER * 2048;
#ifdef PH_SEL
#define IN(k) ((k) == PH_SEL && lo <= (k) && (k) < hi)
#else
#define IN(k) (lo <= (k) && (k) < hi)
#endif
#define BOTH(k) (IN(k) && IN((k) + 1))
    if (IN(pbase + 0)) { p_ln_route<LAYER == 1>(F, P, LAYER, Ymix, H, H, H8, MK_ONE_LAUNCH && IN(pbase - 1)); if (BOTH(pbase + 0)) GRID_BAR(); }
    if (IN(pbase + 2)) {
        moe_table(F, gcnt, tl); const int nt = __builtin_amdgcn_readfirstlane(tl[32]) >> 8;
        pg8::Gemm g{(const bf16*)H8, (const bf16*)(ws + WS_WGU + (size_t)LAYER * NEXP * 1024 * 1024), MSORT, 1024, 1024}; pg8::GroupedOrder<true> S; S.init(tl + 64, nt, 4, F.G, (int)blockIdx.x, (size_t)1024 * 1024); S.stage_rows((const int*)(ws + WS_INV), INV_CAP, tl + 16, tl, (LAS int*)(F.lds + LDSCTL_OFF + 1024));
        pg8::EpiSwiGLU8 E{HID};
        RUN(pbase + 2, pg8::gemm_phase<pg8::EpiSwiGLU8, pg8::GroupedOrder<true>, true, true, true>(F.lds, g, S, E););
        if (LAYER == 0) { const int nfull = S.nwg % F.G; if (nfull == 0) bg_convert(F, P, S.c, F.G, 0, 8192); else if (S.c >= nfull) bg_convert(F, P, S.c - nfull, F.G - nfull, 0, 8192); }
        if (BOTH(pbase + 2)) { if (MK_ONE_LAUNCH && (F.G & 3) == 0) group4_barrier(bar.bar, (unsigned*)(ws + WS_CTL) + CW_GBAR + LAYER * 4096 + (F.vcu >> 2) * 64, (unsigned*)(ws + WS_CTL) + CW_XMAP + (F.vcu & ~3)); else GRID_BAR(); } }
    if (IN(pbase + 3)) {
        if (!(MK_ONE_LAUNCH && IN(pbase + 2))) moe_table(F, gcnt, tl);
        const int nt = __builtin_amdgcn_readfirstlane(tl[32]) >> 8;
        pg8::Gemm g{(const bf16*)HID, (const bf16*)(ws + WS_WD + (size_t)LAYER * NEXP * 1024 * 512), MSORT, 1024, 512}; pg8::GroupedOrder<false> S; S.init(tl + 64, nt, 4, F.G, (int)blockIdx.x, (size_t)1024 * 512);
        pg8::EpiYsF8 E{YS, pg8::W8INV * 16.0f};
        RUN(pbase + 3, pg8::gemm_phase<pg8::EpiYsF8, pg8::GroupedOrder<false>, true, true, true>(F.lds, g, S, E););
        if (LAYER == 0) { const int nfull = S.nwg % F.G; if (nfull == 0) bg_convert(F, P, S.c, F.G, 8192, 12288); else if (S.c >= nfull) bg_convert(F, P, S.c - nfull, F.G - nfull, 8192, 12288); }
        if (BOTH(pbase + 3)) GRID_BAR_OV(p9_fill_mv<LAYER == 1>(F, P, LAYER, F.vcu, F.tid - 64); p9_fill_start(gcnt, (LAS int*)(F.lds + 20480), F.tid - 320););     }
    if (IN(pbase + 4)) { p_combine_ln<LAYER == 1>(F, P, LAYER, YS, H, H, H8, out_final, MK_ONE_LAUNCH && IN(pbase + 3)); if (BOTH(pbase + 4)) GRID_BAR(); }
#undef IN
#undef BOTH
}
__global__ void __launch_bounds__(NWAVES * 64, 2) fwd_kernel(Params P) {
    extern __shared__ __attribute__((aligned(16))) unsigned char lds_raw[];
    Frame F; F.lds = (LAS unsigned char*)lds_raw;
    F.tid = threadIdx.x; F.lane = F.tid & 63; F.wave = __builtin_amdgcn_readfirstlane(F.tid >> 6);
    F.G = gridDim.x; { const int bx = blockIdx.x; F.vcu = (F.G % 8 == 0) ? (bx % 8) * (F.G / 8) + bx / 8 : bx; }
    unsigned char* ws = P.ws;
    volatile LAS unsigned* MISC = (volatile LAS unsigned*)(F.lds + MISC_OFF);
    for (int u = F.tid; u < (LDS_BYTES - LDSCTL_OFF) / 4; u += NWAVES * 64) ((LAS unsigned*)(F.lds + LDSCTL_OFF))[u] = 0u;
    __syncthreads();
    XcdBarrier bar; bar.bar = (unsigned*)(ws + WS_CTL) + CW_BAR; bar.x = 0; bar.st = nullptr;
#if MK_ONE_LAUNCH
    bar = xcd_barrier_post((unsigned*)(ws + WS_CTL) + CW_BAR, MISC + 8);
    if (F.tid == 0) __hip_atomic_store((unsigned*)(ws + WS_CTL) + CW_XMAP + F.vcu, xb_xcc_id() + 1u, __ATOMIC_RELAXED, __HIP_MEMORY_SCOPE_AGENT);
#endif
    const int lo = P.ph_lo, hi = P.ph_hi;
#ifdef PH_SEL
#define IN(k) ((k) == PH_SEL && lo <= (k) && (k) < hi)
#else
#define IN(k) (lo <= (k) && (k) < hi)
#endif
#define BOTH(k) (IN(k) && IN((k) + 1))
    float* cond = (float*)(ws + WS_COND); bf16* H = (bf16*)(ws + WS_H);
    unsigned char* big = ws + WS_BIG;
    if (IN(0)) { RUN(0, p0_cond(F, P.in[I_C], P.in[I_ADAW], P.in[I_ADAB], cond); p0_weights(F, P); __syncthreads();); if (BOTH(0)) GRID_BAR(); }
    bool local_ok = false;
#if MK_ONE_LAUNCH
    if (lo == 0 && hi >= 20 && F.G == 256) { if (F.tid == 0) MISC[16] = 1u; __syncthreads();
        if (F.tid < 256) { unsigned* xm = (unsigned*)(ws + WS_CTL) + CW_XMAP; const unsigned a = xb_ld(xm + F.tid), b = xb_ld(xm + (F.tid & ~31)); if (a == 0u || a != b) MISC[16] = 0u; }
        __syncthreads(); local_ok = __builtin_amdgcn_readfirstlane((int)MISC[16]) != 0; }
#endif
    if (IN(1)) { RUN(1, p_modulate(F, P.in[I_X], cond, 0, H);); if (BOTH(1)) SEAM_BAR(0); }
    if (IN(2)) { bf16* U = (bf16*)big; bf16* V = (bf16*)(big + 32 * MiB); bf16* Gb = (bf16*)(big + 64 * MiB);
        pg8::Gemm g{H, (const bf16*)(ws + WS_WIN), M, 2048, 1024}; pg8::StaticOrder S; S.init(M, 2048, F.G, (int)blockIdx.x);
        pg8::EpiIn E{U, V, Gb};
        RUN(2, pg8::gemm_phase<pg8::EpiIn, pg8::StaticOrder, true, true>(F.lds, g, S, E););
        if (BOTH(2)) SEAM_BAR(1); }
    if (IN(3)) { const bf16* U = (const bf16*)big; const bf16* V = (const bf16*)(big + 32 * MiB); const bf16* Gb = (const bf16*)(big + 64 * MiB); bf16* YC = (bf16*)(big + 96 * MiB);
        RUN(20, for (int it = F.vcu; it < 256; it += F.G) { SGU_CALL }); RUN(21, { v4u cv[8]; ConvConst cc; conv_const(F, P, cc); const int cstep = local_ok ? 1 : F.G, c0 = local_ok ? 4 * F.vcu : F.vcu, cend = local_ok ? 4 * F.vcu + 4 : 1024;
            if (c0 < cend) conv_load(F, c0, Gb, cv); for (int ci = c0; ci < cend; ci += cstep) { CONV_CALL } });
        if (BOTH(3)) SEAM_BAR(2); }
    if (IN(4)) { const bf16* YC = (const bf16*)(big + 96 * MiB); bf16* YM = (bf16*)(ws + WS_XA);
        pg8::Gemm g{YC, (const bf16*)(ws + WS_WOUT), M, 1024, 1024}; pg8::StaticOrder S; S.init(M, 1024, F.G, (int)blockIdx.x);
        pg8::EpiBf16<0> E{YM, 1024, nullptr, 0, 0, 1.f};
        RUN(4, pg8::gemm_phase<pg8::EpiBf16<0>, pg8::StaticOrder, true, true>(F.lds, g, S, E););
        if (BOTH(4)) SEAM_BAR_OV(3, p5_fill_w(F, P, 0, F.tid - 64, 448); p5_fill_mv(F, P, 0, F.vcu, F.tid - 64);); }
    moe_phases<0, 5>(F, P, bar, lo, hi, (const bf16*)(ws + WS_XA), nullptr);
    bf16* Qb = (bf16*)big; unsigned char* Q8b = big + 64 * MiB; unsigned char* K8b = big + 96 * MiB; unsigned char* V8b = big + 128 * MiB;
    if (IN(10)) { pg8::Gemm g{(const bf16*)(ws + WS_H8), (const bf16*)(ws + WS_WQKV), M, 3072, 1024};
        pg8::StaticOrder S; S.init(M, 3072, F.G, (int)blockIdx.x);
        pg8::EpiQKV E{Qb, (size_t)M * D, (float*)(ws + WS_KMEAN), Q8b};
        RUN(10, pg8::gemm_phase<pg8::EpiQKV, pg8::StaticOrder, true, true, true>(F.lds, g, S, E););
        if (BOTH(10)) SEAM_BAR(4); }
    if (IN(13)) { RUN(13, p_attention(F, Qb, Q8b, K8b, V8b, ws + WS_XA  , (const float*)(ws + WS_KMEAN), local_ok);); if (BOTH(13)) SEAM_BAR(5); }
    if (IN(14)) { bf16* YM = (bf16*)(ws + WS_XA + 32 * MiB);
        pg8::Gemm g{(const bf16*)(ws + WS_XA), (const bf16*)(ws + WS_WO2), M, 1024, 1024}; pg8::StaticOrder S; S.init(M, 1024, F.G, (int)blockIdx.x);
        pg8::EpiYsF8 E{(unsigned char*)YM, pg8::W8INV * (1.0f / 16.0f) * 64.0f};
        RUN(14, pg8::gemm_phase<pg8::EpiYsF8, pg8::StaticOrder, true, true, true>(F.lds, g, S, E););
        if (BOTH(14)) SEAM_BAR_OV(6, p5_fill_w(F, P, 1, F.tid - 64, 448); p5_fill_mv(F, P, 1, F.vcu, F.tid - 64);); }
    moe_phases<1, 15>(F, P, bar, lo, hi, (const bf16*)(ws + WS_XA + 32 * MiB), P.out);
#undef IN
#undef BOTH
}

extern "C" void kernel_launch(void* const* d_in, const int* in_sizes, int n_in, void* d_out, int out_size, void* d_ws, size_t ws_size, hipStream_t stream) {
    static int grid = 0;
    if (grid == 0) {
        if (n_in != 27 || in_sizes[0] != M * D || out_size != M * D || ws_size < WS_END) { fprintf(stderr, "kernel_launch: unexpected shapes (n_in %d, in0 %d, out %d, ws %zu); nothing launched\n", n_in, n_in > 0 ? in_sizes[0] : -1, out_size, ws_size); grid = -1; return; }
        int dev = 0, cus = 0, per_cu = 0;
        if (hipGetDevice(&dev) != hipSuccess || hipDeviceGetAttribute(&cus, hipDeviceAttributeMultiprocessorCount, dev) != hipSuccess) { grid = -1; return; }
        if (hipFuncSetAttribute((const void*)fwd_kernel, hipFuncAttributeMaxDynamicSharedMemorySize, LDS_BYTES) != hipSuccess) { fprintf(stderr, "kernel_launch: hipFuncSetAttribute failed\n"); grid = -1; return; }
        if (hipOccupancyMaxActiveBlocksPerMultiprocessor(&per_cu, (const void*)fwd_kernel, NWAVES * 64, LDS_BYTES) != hipSuccess || per_cu < 1) fprintf(stderr, "kernel_launch: occupancy query reports %d workgroups per CU\n", per_cu);
        (void)hipGetLastError();
        grid = cus;
    }
    if (grid < 0) return;
    if (hipMemsetAsync((char*)d_ws + WS_CTL, 0, CTL_ZERO_BYTES, stream) != hipSuccess) return;
    Params p{};
    for (int i = 0; i < 27; ++i) p.in[i] = (const float*)d_in[i];
    p.out = (float*)d_out; p.ws = (unsigned char*)d_ws;
#if MK_ONE_LAUNCH
    p.ph_lo = 0; p.ph_hi = NPHASE; p.li = 0;
    hipLaunchKernelGGL(fwd_kernel, dim3(grid), dim3(NWAVES * 64), LDS_BYTES, stream, p);
#else
    for (int k = 0; k < NPHASE; ++k) { p.ph_lo = k; p.ph_hi = k + 1; p.li = k; hipLaunchKernelGGL(fwd_kernel, dim3(grid), dim3(NWAVES * 64), LDS_BYTES, stream, p); }
#endif
}
```

```cpp
#include <hip/hip_runtime.h>
#include <cstdio>
#include <cstdint>
#ifndef MK_ONE_LAUNCH
#define MK_ONE_LAUNCH 1
#endif
namespace pg8 {
#define PG8_LAS __attribute__((address_space(3)))
typedef unsigned short bf16_t;
typedef short bf16x8 __attribute__((ext_vector_type(8)));
typedef float f32x4 __attribute__((ext_vector_type(4)));
typedef unsigned u32x4 __attribute__((ext_vector_type(4)));
typedef int i32x4 __attribute__((ext_vector_type(4)));
typedef int i32x8 __attribute__((ext_vector_type(8)));
constexpr int BM = 256, BK = 64, HALF = 128, HTB = HALF * BK * 2  , STAGE_BYTES = 8 * HTB, NXCD = 8, WGM = 8;

__host__ __device__ __forceinline__ int lds_byte(int r, int c) { const int st = (r >> 4) * 2 + (c >> 5), rr = r & 15, cc = c & 31, ob = rr * 64 + cc * 2; return st * 1024 + (ob ^ (((ob >> 9) & 1) << 5)); }
__host__ __device__ __forceinline__ void stage_rc(int b, int& R, int& C) { const int st = b / 1024, sb = b % 1024, swz = sb ^ (((sb >> 9) & 1) << 5); R = (st >> 1) * 16 + swz / 64; C = (st & 1) * 32 + (swz % 64) / 2; }
__host__ __device__ __forceinline__ int perm32(int rho) { const int n = rho >> 4, i = rho & 15; return 8 * (i >> 2) + 4 * n + (i & 3); }

struct Unit { int pm, pn; };
struct Gemm { const bf16_t* A; const bf16_t* Bt; int M, N, K; };

struct StaticOrder {
    static constexpr bool GATHER = false;
    __device__ __forceinline__ int rowof(const Unit&, int, int) const { return 0; }
    int nM, nN, nwg, G, c;
    __host__ __device__ void init(int M, int N, int G_, int c_) { nM = M / BM; nN = N / BM; nwg = nM * nN; G = G_; c = c_; }
    __host__ __device__ bool next(int i, Unit& u) const {
        const long L = (long)i * G + c; if (L >= nwg) return false;
        int wgid = (int)L; { const int q = nwg / NXCD, r = nwg % NXCD, xcd = wgid % NXCD, off = wgid / NXCD; wgid = (xcd < r ? xcd * (q + 1) : r * (q + 1) + (xcd - r) * q) + off; }
        const int nig = WGM * nN, gid = wgid / nig, fm = gid * WGM, gsz = (nM - fm) < WGM ? (nM - fm) : WGM;
        u.pm = fm + ((wgid % nig) % gsz); u.pn = (wgid % nig) / gsz; return true;
    }
    __device__ __forceinline__ void a_ready(const Unit&) const {}
    __device__ __forceinline__ const char* bptr(const Gemm& g, const Unit& u, size_t tstep) const { return (const char*)g.Bt + (size_t)u.pn * tstep; }
    __device__ __forceinline__ void done(const Unit&) const {}
};

__device__ __forceinline__ unsigned cvt_pk_bf16(float lo, float hi) { unsigned r; asm volatile("v_cvt_pk_bf16_f32 %0, %1, %2" : "=v"(r) : "v"(lo), "v"(hi)); return r; }
typedef float f32x2 __attribute__((ext_vector_type(2)));
__device__ __forceinline__ f32x2 gelu_pk(f32x2 v) {
    const f32x2 av = __builtin_elementwise_abs(v), d = av * 0.2316418882f + 1.0f;
    f32x2 t; t.x = __builtin_amdgcn_rcpf(d.x); t.y = __builtin_amdgcn_rcpf(d.y);
    f32x2 q = t * 0.5307027145f + (-0.7265760135f); q = q * t + 0.7107068705f; q = q * t + (-0.142248368f); q = q * t + 0.127414796f; q = q * t;
    const f32x2 s = (v * v) * (-0.72134752044f);
    f32x2 e; e.x = __builtin_amdgcn_exp2f(s.x); e.y = __builtin_amdgcn_exp2f(s.y);
    const f32x2 m = v * (q * e), r = v - m;
    f32x2 o; o.x = v.x < 0.f ? m.x : r.x; o.y = v.y < 0.f ? m.y : r.y; return o;
}

template <int ACT  > struct EpiBf16 {
    static constexpr bool PERM = true, AFTER_DRAIN = false; static_assert(ACT == 0 || ACT == 1, "EpiBf16: ACT is 0 (none) or 1 (gelu_pk)");
    bf16_t* O; int ldc; const float* bias; int split_cols; size_t split_stride; float scale0;
    __device__ __forceinline__ void operator()(const f32x4 (&acc)[2][2][4][2], const Unit& u, int wr, int wc, int fr, int fq) const {
        const int row0 = u.pm * BM + wr * 64 + fr; int colt = u.pn * BM; bf16_t* base = O;
        float sc = 1.f; if (split_cols) { const int t = colt / split_cols; base += (size_t)t * split_stride; colt -= t * split_cols; if (t == 0) sc = scale0; }
        const int col0 = colt + wc * 32 + 8 * fq, bcol0 = u.pn * BM + wc * 32 + 8 * fq;
        f32x4 bv[2][2];
#pragma unroll
        for (int bj = 0; bj < 2; ++bj)
#pragma unroll
            for (int n = 0; n < 2; ++n) bv[bj][n] = bias ? *(const f32x4*)(bias + bcol0 + bj * HALF + 4 * n) : (f32x4){0.f, 0.f, 0.f, 0.f};
#pragma unroll
        for (int ai = 0; ai < 2; ++ai)
#pragma unroll
            for (int m = 0; m < 4; ++m) { bf16_t* rowp = base + (size_t)(row0 + ai * HALF + m * 16) * ldc + col0;
#pragma unroll
                for (int bj = 0; bj < 2; ++bj) { f32x4 v0 = acc[ai][bj][m][0] + bv[bj][0], v1 = acc[ai][bj][m][1] + bv[bj][1];
                    if (ACT == 1) { f32x2 a = gelu_pk((f32x2){v0[0], v0[1]}), b = gelu_pk((f32x2){v0[2], v0[3]}), c = gelu_pk((f32x2){v1[0], v1[1]}), d = gelu_pk((f32x2){v1[2], v1[3]});
                        v0 = (f32x4){a.x, a.y, b.x, b.y}; v1 = (f32x4){c.x, c.y, d.x, d.y}; }
                    v0 = v0 * sc; v1 = v1 * sc; u32x4 w; w.x = cvt_pk_bf16(v0[0], v0[1]); w.y = cvt_pk_bf16(v0[2], v0[3]); w.z = cvt_pk_bf16(v1[0], v1[1]); w.w = cvt_pk_bf16(v1[2], v1[3]);
                    *(u32x4*)(rowp + bj * HALF) = w; } }
    }
};
template <class Epi, class Sched, bool ALIGN_EPI = false, bool SP2 = false, bool ELT8 = false>
__device__ __forceinline__ void gemm_phase(PG8_LAS unsigned char* lds, const Gemm g, const Sched& S, const Epi& E) {
    const int tid = threadIdx.x, wid = __builtin_amdgcn_readfirstlane(tid >> 6), lane = tid & 63, wr = wid >> 2, wc = wid & 3, fr = lane & 15, fq = lane >> 4;
    const int K = g.K, rowb = ELT8 ? K : 2 * K  , nt = rowb / (2 * BK);
    constexpr bool GATHER = Sched::GATHER; static_assert(!GATHER || SP2, "gathered A: SP2 loop only");
    unsigned voffA[2], voffB[2]; int gR[2]; unsigned gC2[2];
#pragma unroll
    for (int i = 0; i < 2; ++i) { int R, C; stage_rc(tid * 16 + i * 8192, R, C); const int Rb = Epi::PERM ? ((R & ~31) + perm32(R & 31)) : R;
        voffA[i] = (unsigned)(R * rowb + C * 2); voffB[i] = (unsigned)(Rb * rowb + C * 2); gR[i] = R; gC2[i] = (unsigned)C * 2u; }
    unsigned gc0[2] = {0u, 0u}, gc1[2] = {0u, 0u}, gn0[2] = {0u, 0u}, gn1[2] = {0u, 0u};
#define PG8_GOFF(dst0, dst1, u, ord) do { _Pragma("unroll") for (int _i = 0; _i < 2; ++_i) { dst0[_i] = (unsigned)S.rowof((u), (ord), gR[_i]) * (unsigned)rowb + gC2[_i]; dst1[_i] = (unsigned)S.rowof((u), (ord), HALF + gR[_i]) * (unsigned)rowb + gC2[_i]; } } while (0)
#define PG8_STAGE_A(bufoff, base, h, G0, G1) do { if constexpr (GATHER) { if constexpr ((h) != 0) PG8_STAGE(bufoff, base, G1); else PG8_STAGE(bufoff, base, G0); } else { PG8_STAGE(bufoff, (base) + (h) * hstep, voffA); } } while (0)
    const size_t kstep = (size_t)(BK * 2);
    const size_t hstep = (size_t)HALF * rowb;
    const size_t tstep = 2 * hstep;
    const unsigned ldsw = (unsigned)wid * 1024u;
    const int aoff = lds_byte(wr * 64 + fr, fq * 8), boff = lds_byte(wc * 32 + fr, fq * 8);
#define PG8_SA(b, h) (((b) * 2 + (h)) * HTB)
#define PG8_SB(b, h) ((4 + (b) * 2 + (h)) * HTB)
#define PG8_STAGE(bufoff, gbase, voff) do { _Pragma("unroll") for (int _i = 0; _i < 2; ++_i) \
        __builtin_amdgcn_global_load_lds((const unsigned*)((const char*)(gbase) + (voff)[_i]), (PG8_LAS unsigned*)(lds + (bufoff) + ldsw + _i * 8192), 16, 0, 0); } while (0)
#define PG8_RD16(off) (*(const PG8_LAS i32x4*)(lds + (off)))
#define PG8_LDA(dst, b, h) do { _Pragma("unroll") for (int m = 0; m < 4; ++m) { const i32x4 lo_ = PG8_RD16(PG8_SA(b, h) + aoff + m * 2048), hi_ = PG8_RD16(PG8_SA(b, h) + aoff + m * 2048 + 1024); dst[m] = __builtin_shufflevector(lo_, hi_, 0, 1, 2, 3, 4, 5, 6, 7); } } while (0)
#define PG8_LDB(dst, b, h) do { _Pragma("unroll") for (int n = 0; n < 2; ++n) { const i32x4 lo_ = PG8_RD16(PG8_SB(b, h) + boff + n * 2048), hi_ = PG8_RD16(PG8_SB(b, h) + boff + n * 2048 + 1024); dst[n] = __builtin_shufflevector(lo_, hi_, 0, 1, 2, 3, 4, 5, 6, 7); } } while (0)
#define PG8_MMA(ai, bj, At, Bt) do { __builtin_amdgcn_s_setprio(1); _Pragma("unroll") for (int m = 0; m < 4; ++m) _Pragma("unroll") for (int n = 0; n < 2; ++n) { \
        if constexpr (ELT8) { asm volatile("v_mfma_scale_f32_16x16x128_f8f6f4 %0, %1, %2, %0, %3, %3 op_sel_hi:[0,0,0]" : "+v"(acc[ai][bj][m][n]) : "v"(Bt[n]), "v"(At[m]), "v"(scale1)); }     \
        else { acc[ai][bj][m][n] = __builtin_amdgcn_mfma_f32_16x16x32_bf16(__builtin_bit_cast(bf16x8, __builtin_shufflevector(Bt[n], Bt[n], 0, 1, 2, 3)), __builtin_bit_cast(bf16x8, __builtin_shufflevector(At[m], At[m], 0, 1, 2, 3)), acc[ai][bj][m][n], 0, 0, 0); \
               acc[ai][bj][m][n] = __builtin_amdgcn_mfma_f32_16x16x32_bf16(__builtin_bit_cast(bf16x8, __builtin_shufflevector(Bt[n], Bt[n], 4, 5, 6, 7)), __builtin_bit_cast(bf16x8, __builtin_shufflevector(At[m], At[m], 4, 5, 6, 7)), acc[ai][bj][m][n], 0, 0, 0); } } \
        __builtin_amdgcn_s_setprio(0); } while (0)
#define PG8_WAIT_V(n) asm volatile("s_waitcnt vmcnt(" #n ")" ::: "memory")
#define PG8_WAIT_L(n) asm volatile("s_waitcnt lgkmcnt(" #n ")" ::: "memory")
#define PG8_BAR __builtin_amdgcn_s_barrier()
#define PG8_SCHED __builtin_amdgcn_sched_barrier(0)
    Unit cur, nxt; int ui = 0;
    if (!S.next(0, cur)) return;
    f32x4 acc[2][2][4][2];
#pragma unroll
    for (int a = 0; a < 2; ++a)
#pragma unroll
        for (int b = 0; b < 2; ++b)
#pragma unroll
            for (int m = 0; m < 4; ++m)
#pragma unroll
                for (int n = 0; n < 2; ++n) acc[a][b][m][n] = (f32x4){0.f, 0.f, 0.f, 0.f};
    const int scale1 = 0x7f7f7f7f;
    i32x8 At[4], B0[2], B1[2];
    const char* cA = GATHER ? (const char*)g.A : (const char*)g.A + (size_t)cur.pm * tstep; const char* cB = S.bptr(g, cur, tstep);
    if constexpr (GATHER) PG8_GOFF(gc0, gc1, cur, 0);
    S.a_ready(cur);
    if constexpr (SP2) {
        PG8_STAGE(PG8_SB(0, 0), cB, voffB); PG8_STAGE(PG8_SB(0, 1), cB + hstep, voffB); PG8_STAGE_A(PG8_SA(0, 0), cA, 0, gc0, gc1); PG8_STAGE_A(PG8_SA(0, 1), cA, 1, gc0, gc1);
        if (wr == 1) PG8_BAR;
        PG8_WAIT_V(2); PG8_BAR;
        PG8_STAGE(PG8_SB(1, 0), cB + kstep, voffB); PG8_STAGE_A(PG8_SA(1, 0), cA + kstep, 0, gc0, gc1); PG8_STAGE(PG8_SB(1, 1), cB + hstep + kstep, voffB);
        PG8_WAIT_V(6); PG8_BAR;
    } else {
        PG8_STAGE(PG8_SB(0, 0), cB, voffB); PG8_STAGE(PG8_SA(0, 0), cA, voffA); PG8_STAGE(PG8_SB(0, 1), cB + hstep, voffB); PG8_STAGE(PG8_SA(0, 1), cA + hstep, voffA);
        if (wr == 1) PG8_BAR;
        PG8_WAIT_V(4); PG8_BAR;
        PG8_STAGE(PG8_SB(1, 0), cB + kstep, voffB); PG8_STAGE(PG8_SA(1, 0), cA + kstep, voffA); PG8_STAGE(PG8_SB(1, 1), cB + hstep + kstep, voffB);
        PG8_WAIT_V(6); PG8_BAR;
    }
    for (;;) {
        const bool has_next = S.next(ui + 1, nxt);
        const char* nA = has_next ? (GATHER ? (const char*)g.A : (const char*)g.A + (size_t)nxt.pm * tstep) : cA; const char* nB = has_next ? S.bptr(g, nxt, tstep) : cB;
        if constexpr (GATHER) { if (has_next) PG8_GOFF(gn0, gn1, nxt, ui + 1); else { gn0[0] = gc0[0]; gn0[1] = gc0[1]; gn1[0] = gc1[0]; gn1[1] = gc1[1]; } }
#pragma unroll 1
        for (int t = 0; t < nt; t += 2) {
            const bool last = (t == nt - 2);
            const char* a1 = cA + (size_t)(t + 1) * kstep;
            const char* a2 = last ? nA : cA + (size_t)(t + 2) * kstep; const char* b2 = last ? nB : cB + (size_t)(t + 2) * kstep;
            const char* a3 = a2 + kstep; const char* b3 = b2 + kstep;
            if (last && has_next) S.a_ready(nxt);
            unsigned o20[2] = {0u, 0u}, o21[2] = {0u, 0u};
            if constexpr (GATHER) { o20[0] = last ? gn0[0] : gc0[0]; o20[1] = last ? gn0[1] : gc0[1]; o21[0] = last ? gn1[0] : gc1[0]; o21[1] = last ? gn1[1] : gc1[1]; }
            if constexpr (SP2) {
            PG8_LDB(B0, 0, 0); PG8_LDB(B1, 0, 1); PG8_SCHED; PG8_LDA(At, 0, 0); PG8_STAGE_A(PG8_SA(1, 1), a1, 1, gc0, gc1);
            PG8_WAIT_V(8); PG8_WAIT_L(0); PG8_BAR; PG8_MMA(0, 0, At, B0); PG8_MMA(0, 1, At, B1); PG8_BAR; PG8_SCHED;
            PG8_LDA(At, 0, 1); PG8_STAGE(PG8_SB(0, 0), b2, voffB); PG8_STAGE(PG8_SB(0, 1), b2 + hstep, voffB); PG8_STAGE_A(PG8_SA(0, 0), a2, 0, o20, o21);
            PG8_WAIT_V(8); PG8_WAIT_L(0); PG8_BAR; PG8_MMA(1, 0, At, B0); PG8_MMA(1, 1, At, B1); PG8_BAR; PG8_SCHED;
            PG8_LDB(B0, 1, 0); PG8_LDB(B1, 1, 1); PG8_SCHED; PG8_LDA(At, 1, 0); PG8_STAGE_A(PG8_SA(0, 1), a2, 1, o20, o21);
            PG8_WAIT_V(8); PG8_WAIT_L(0); PG8_BAR; PG8_MMA(0, 0, At, B0); PG8_MMA(0, 1, At, B1); PG8_BAR; PG8_SCHED;
            PG8_LDA(At, 1, 1); PG8_STAGE(PG8_SB(1, 0), b3, voffB); PG8_STAGE(PG8_SB(1, 1), b3 + hstep, voffB); PG8_STAGE_A(PG8_SA(1, 0), a3, 0, o20, o21);
            PG8_WAIT_V(8); PG8_WAIT_L(0); PG8_BAR; PG8_MMA(1, 0, At, B0); PG8_MMA(1, 1, At, B1); PG8_BAR; PG8_SCHED;
            } else {
            PG8_LDB(B0, 0, 0); PG8_SCHED; PG8_LDA(At, 0, 0); PG8_STAGE(PG8_SA(1, 1), a1 + hstep, voffA);
            PG8_WAIT_L(8); PG8_BAR; PG8_WAIT_L(0); PG8_MMA(0, 0, At, B0); PG8_BAR; PG8_SCHED;
            PG8_LDB(B1, 0, 1); PG8_STAGE(PG8_SB(0, 0), b2, voffB);
            PG8_BAR; PG8_WAIT_L(0); PG8_MMA(0, 1, At, B1); PG8_BAR;
            PG8_LDA(At, 0, 1); PG8_STAGE(PG8_SA(0, 0), a2, voffA);
            PG8_BAR; PG8_WAIT_L(0); PG8_MMA(1, 0, At, B0); PG8_BAR; PG8_SCHED;
            PG8_STAGE(PG8_SB(0, 1), b2 + hstep, voffB);
            PG8_WAIT_V(6); PG8_BAR; PG8_MMA(1, 1, At, B1); PG8_BAR;
            PG8_LDB(B0, 1, 0); PG8_SCHED; PG8_LDA(At, 1, 0); PG8_STAGE(PG8_SA(0, 1), a2 + hstep, voffA);
            PG8_WAIT_L(8); PG8_BAR; PG8_WAIT_L(0); PG8_MMA(0, 0, At, B0); PG8_BAR; PG8_SCHED;
            PG8_LDB(B1, 1, 1); PG8_STAGE(PG8_SB(1, 0), b3, voffB);
            PG8_BAR; PG8_WAIT_L(0); PG8_MMA(0, 1, At, B1); PG8_BAR;
            PG8_LDA(At, 1, 1); PG8_STAGE(PG8_SA(1, 0), a3, voffA);
            PG8_BAR; PG8_WAIT_L(0); PG8_MMA(1, 0, At, B0); PG8_BAR; PG8_SCHED;
            PG8_STAGE(PG8_SB(1, 1), b3 + hstep, voffB);
            PG8_WAIT_V(6); PG8_BAR; PG8_MMA(1, 1, At, B1); PG8_BAR;
            }
        }
        if constexpr (ALIGN_EPI) { if (wr == 0) PG8_BAR; }
        if constexpr (ELT8) asm volatile("s_nop 15\n\ts_nop 15" ::: "memory");
        if constexpr (!Epi::AFTER_DRAIN) { E(acc, cur, wr, wc, fr, fq); S.done(cur); }
        if (!has_next) break;
#pragma unroll
        for (int a = 0; a < 2; ++a)
#pragma unroll
            for (int b = 0; b < 2; ++b)
#pragma unroll
                for (int m = 0; m < 4; ++m)
#pragma unroll
                    for (int n = 0; n < 2; ++n) acc[a][b][m][n] = (f32x4){0.f, 0.f, 0.f, 0.f};
        cur = nxt; cA = nA; cB = nB; ++ui;
        if constexpr (GATHER) { gc0[0] = gn0[0]; gc0[1] = gn0[1]; gc1[0] = gn1[0]; gc1[1] = gn1[1]; }
        if constexpr (ALIGN_EPI) { if (wr == 1) PG8_BAR; }
    }
    PG8_WAIT_V(0);
    if constexpr (!ALIGN_EPI) { if (wr == 0) PG8_BAR; }
    PG8_BAR;
    if constexpr (Epi::AFTER_DRAIN) { E.fused(acc, cur, wr, wc, fr, fq, lds, wid, lane); S.done(cur); }
#undef PG8_SA
#undef PG8_SB
#undef PG8_STAGE
#undef PG8_STAGE_A
#undef PG8_GOFF
#undef PG8_LDA
#undef PG8_RD16
#undef PG8_LDB
#undef PG8_MMA
#undef PG8_WAIT_V
#undef PG8_WAIT_L
#undef PG8_BAR
#undef PG8_SCHED
}
}
namespace pg8 {
__device__ __forceinline__ float sigm(float v) { return __builtin_amdgcn_rcpf(1.0f + __builtin_amdgcn_exp2f(-1.4426950408889634f * v)); }
struct EpiIn {
    static constexpr bool PERM = true, AFTER_DRAIN = false;
    bf16_t* U; bf16_t* V; bf16_t* G;
    __device__ __forceinline__ void operator()(const f32x4 (&acc)[2][2][4][2], const Unit& u, int wr, int wc, int fr, int fq) const {
        const int row0 = u.pm * BM + wr * 64 + fr;
        if (u.pn < 4) {
            bf16_t* base = (u.pn < 2) ? U : V; const int col0 = (u.pn & 1) * 256 + wc * 32 + 8 * fq;
#pragma unroll
            for (int ai = 0; ai < 2; ++ai)
#pragma unroll
                for (int m = 0; m < 4; ++m) { bf16_t* rowp = base + (size_t)(row0 + ai * HALF + m * 16) * 512 + col0;
#pragma unroll
                    for (int bj = 0; bj < 2; ++bj) { f32x4 v0 = acc[ai][bj][m][0], v1 = acc[ai][bj][m][1];
                        f32x2 a = gelu_pk((f32x2){v0[0], v0[1]}), b = gelu_pk((f32x2){v0[2], v0[3]}), c = gelu_pk((f32x2){v1[0], v1[1]}), d = gelu_pk((f32x2){v1[2], v1[3]});
                        u32x4 w; w.x = cvt_pk_bf16(a.x, a.y); w.y = cvt_pk_bf16(b.x, b.y); w.z = cvt_pk_bf16(c.x, c.y); w.w = cvt_pk_bf16(d.x, d.y);
                        *(u32x4*)(rowp + bj * HALF) = w; } }
        } else {
            const int col0 = (u.pn - 4) * 128 + wc * 32 + 8 * fq;
#pragma unroll
            for (int ai = 0; ai < 2; ++ai)
#pragma unroll
                for (int m = 0; m < 4; ++m) { bf16_t* rowp = G + (size_t)(row0 + ai * HALF + m * 16) * 512 + col0;
                    const f32x4 a0 = acc[ai][0][m][0], a1 = acc[ai][0][m][1], g0 = acc[ai][1][m][0], g1 = acc[ai][1][m][1];
                    u32x4 w; w.x = cvt_pk_bf16(a0[0] * sigm(g0[0]), a0[1] * sigm(g0[1])); w.y = cvt_pk_bf16(a0[2] * sigm(g0[2]), a0[3] * sigm(g0[3]));
                    w.z = cvt_pk_bf16(a1[0] * sigm(g1[0]), a1[1] * sigm(g1[1])); w.w = cvt_pk_bf16(a1[2] * sigm(g1[2]), a1[3] * sigm(g1[3]));
                    *(u32x4*)rowp = w; }
        }
    }
};
__device__ __forceinline__ unsigned pk_fp8x4(float a, float b, float c, float d);
__device__ __forceinline__ void st8x2_wide(unsigned char* pa, unsigned ax, unsigned ay, unsigned char* pb, unsigned bx, unsigned by, int fq) {
    auto rx = __builtin_amdgcn_permlane16_swap(ax, bx, false, false); auto ry = __builtin_amdgcn_permlane16_swap(ay, by, false, false);
    const u32x4 w = {rx[0], ry[0], rx[1], ry[1]};
    *(u32x4*)((fq & 1) ? pb - 8 : pa) = w;
}
struct EpiQKV {
    static constexpr bool PERM = true, AFTER_DRAIN = false;
    bf16_t* Q; size_t tstride; float* kmean; static constexpr float sc = 0.03125f;
    unsigned char* QK8;
    __device__ __forceinline__ void operator()(const f32x4 (&acc)[2][2][4][2], const Unit& u, int wr, int wc, int fr, int fq) const {
        const int row0 = u.pm * BM + wr * 64 + fr; const int t = u.pn >> 2; bf16_t* base = Q + (size_t)t * tstride; const int col0 = (u.pn & 3) * 256 + wc * 32 + 8 * fq;
#pragma unroll
        for (int ai = 0; ai < 2; ++ai)
#pragma unroll
            for (int m = 0; m < 4; ++m) { bf16_t* rowp = base + (size_t)(row0 + ai * HALF + m * 16) * 1024 + col0; unsigned w8x[2], w8y[2];
#pragma unroll
                for (int bj = 0; bj < 2; ++bj) { const f32x4 v0 = acc[ai][bj][m][0] * sc, v1 = acc[ai][bj][m][1] * sc;
                    if (t == 0) { u32x4 w; w.x = cvt_pk_bf16(v0[0], v0[1]); w.y = cvt_pk_bf16(v0[2], v0[3]); w.z = cvt_pk_bf16(v1[0], v1[1]); w.w = cvt_pk_bf16(v1[2], v1[3]);
                        *(u32x4*)(rowp + bj * HALF) = w; }
                    w8x[bj] = pk_fp8x4(v0[0], v0[1], v0[2], v0[3]); w8y[bj] = pk_fp8x4(v1[0], v1[1], v1[2], v1[3]); }
                { unsigned char* p8 = QK8 + (size_t)t * ((size_t)32 << 20) + (size_t)(row0 + ai * HALF + m * 16) * 1024 + col0; st8x2_wide(p8, w8x[0], w8y[0], p8 + HALF, w8x[1], w8y[1], fq); } }
        if (t == 1) { const int b = u.pm >> 3, blk = u.pm & 7;
#pragma unroll
            for (int bj = 0; bj < 2; ++bj)
#pragma unroll
                for (int n = 0; n < 2; ++n) { f32x4 s = (f32x4){0.f, 0.f, 0.f, 0.f};
#pragma unroll
                    for (int ai = 0; ai < 2; ++ai)
#pragma unroll
                        for (int m = 0; m < 4; ++m) s += acc[ai][bj][m][n];
#pragma unroll
                    for (int j = 0; j < 4; ++j) { float v = s[j]; v += __shfl_xor(v, 1); v += __shfl_xor(v, 2); v += __shfl_xor(v, 4); v += __shfl_xor(v, 8); s[j] = v; }
                    if (fr == 0) { const int kc = (u.pn & 3) * 256 + bj * HALF + wc * 32 + 8 * fq + 4 * n, h = kc >> 7, d = kc & 127; float* kp = kmean + ((size_t)(b * 8 + h) * 8 + blk) * 128 + d;
#pragma unroll
                        for (int j = 0; j < 4; ++j) atomicAdd(kp + j, s[j] * (sc * (1.0f / 256.0f))); } }
        }
    }
};
struct EpiSwiGLU {
    static constexpr bool PERM = true, AFTER_DRAIN = false;
    bf16_t* Hid;
    __device__ __forceinline__ void operator()(const f32x4 (&acc)[2][2][4][2], const Unit& u, int wr, int wc, int fr, int fq) const {
        const int row0 = u.pm * BM + wr * 64 + fr, col0 = u.pn * 128 + wc * 32 + 8 * fq;
#pragma unroll
        for (int ai = 0; ai < 2; ++ai)
#pragma unroll
            for (int m = 0; m < 4; ++m) { bf16_t* rowp = Hid + (size_t)(row0 + ai * HALF + m * 16) * 512 + col0;
                const f32x4 g0 = acc[ai][0][m][0], g1 = acc[ai][0][m][1], u0 = acc[ai][1][m][0], u1 = acc[ai][1][m][1];
                u32x4 w; w.x = cvt_pk_bf16(g0[0] * sigm(g0[0]) * u0[0], g0[1] * sigm(g0[1]) * u0[1]); w.y = cvt_pk_bf16(g0[2] * sigm(g0[2]) * u0[2], g0[3] * sigm(g0[3]) * u0[3]);
                w.z = cvt_pk_bf16(g1[0] * sigm(g1[0]) * u1[0], g1[1] * sigm(g1[1]) * u1[1]); w.w = cvt_pk_bf16(g1[2] * sigm(g1[2]) * u1[2], g1[3] * sigm(g1[3]) * u1[3]);
                *(u32x4*)rowp = w; }
    }
};
constexpr float W8SCALE = 32.0f, W8INV = 1.0f / 32.0f;
__device__ __forceinline__ unsigned pk_fp8x4(float a, float b, float c, float d) { int w = __builtin_amdgcn_cvt_pk_fp8_f32(a, b, 0, false); w = __builtin_amdgcn_cvt_pk_fp8_f32(c, d, w, true); return (unsigned)w; }
struct EpiSwiGLU8 {
    static constexpr bool PERM = true, AFTER_DRAIN = false;
    unsigned char* Hid;
    __device__ __forceinline__ void operator()(const f32x4 (&acc)[2][2][4][2], const Unit& u, int wr, int wc, int fr, int fq) const {
        const int row0 = u.pm * BM + wr * 64 + fr, col0 = u.pn * 128 + wc * 32 + 8 * fq;
#pragma unroll
        for (int ai = 0; ai < 2; ++ai)
#pragma unroll
            for (int m2 = 0; m2 < 4; m2 += 2) { unsigned wx[2], wy[2];
#pragma unroll
                for (int mm = 0; mm < 2; ++mm) { const int m = m2 + mm;
                    const f32x4 g0 = acc[ai][0][m][0] * W8INV, g1 = acc[ai][0][m][1] * W8INV, u0 = acc[ai][1][m][0] * W8INV, u1 = acc[ai][1][m][1] * W8INV;
                    wx[mm] = pk_fp8x4(g0[0] * sigm(g0[0]) * u0[0], g0[1] * sigm(g0[1]) * u0[1], g0[2] * sigm(g0[2]) * u0[2], g0[3] * sigm(g0[3]) * u0[3]);
                    wy[mm] = pk_fp8x4(g1[0] * sigm(g1[0]) * u1[0], g1[1] * sigm(g1[1]) * u1[1], g1[2] * sigm(g1[2]) * u1[2], g1[3] * sigm(g1[3]) * u1[3]); }
                unsigned char* rowp = Hid + (size_t)(row0 + ai * HALF + m2 * 16) * 512 + col0;
                st8x2_wide(rowp, wx[0], wy[0], rowp + 16 * 512, wx[1], wy[1], fq); }
    }
};
struct EpiYs8 {
    static constexpr bool PERM = true, AFTER_DRAIN = false;
    bf16_t* O; float sc;
    __device__ __forceinline__ void operator()(const f32x4 (&acc)[2][2][4][2], const Unit& u, int wr, int wc, int fr, int fq) const {
        const int row0 = u.pm * BM + wr * 64 + fr, col0 = u.pn * BM + wc * 32 + 8 * fq;
#pragma unroll
        for (int ai = 0; ai < 2; ++ai)
#pragma unroll
            for (int m = 0; m < 4; ++m) { bf16_t* rowp = O + (size_t)(row0 + ai * HALF + m * 16) * 1024 + col0;
#pragma unroll
                for (int bj = 0; bj < 2; ++bj) { const f32x4 v0 = acc[ai][bj][m][0] * sc, v1 = acc[ai][bj][m][1] * sc;
                    u32x4 w; w.x = cvt_pk_bf16(v0[0], v0[1]); w.y = cvt_pk_bf16(v0[2], v0[3]); w.z = cvt_pk_bf16(v1[0], v1[1]); w.w = cvt_pk_bf16(v1[2], v1[3]);
                    *(u32x4*)(rowp + bj * HALF) = w; } }
    }
};
struct EpiYsF8 {
    static constexpr bool PERM = true, AFTER_DRAIN = false;
    unsigned char* O; float sc;
    __device__ __forceinline__ void operator()(const f32x4 (&acc)[2][2][4][2], const Unit& u, int wr, int wc, int fr, int fq) const {
        const int row0 = u.pm * BM + wr * 64 + fr, col0 = u.pn * BM + wc * 32 + 8 * fq; typedef unsigned u32x2 __attribute__((ext_vector_type(2)));
#pragma unroll
        for (int ai = 0; ai < 2; ++ai)
#pragma unroll
            for (int m = 0; m < 4; ++m) { unsigned char* rowp = O + (size_t)(row0 + ai * HALF + m * 16) * 1024 + col0;
                unsigned wx[2], wy[2];
#pragma unroll
                for (int bj = 0; bj < 2; ++bj) { const f32x4 v0 = acc[ai][bj][m][0] * sc, v1 = acc[ai][bj][m][1] * sc; wx[bj] = pk_fp8x4(v0[0], v0[1], v0[2], v0[3]); wy[bj] = pk_fp8x4(v1[0], v1[1], v1[2], v1[3]); }
                st8x2_wide(rowp, wx[0], wy[0], rowp + HALF, wx[1], wy[1], fq); }
    }
};
template <bool GATHER_> struct GroupedOrder {
    static constexpr bool GATHER = GATHER_; const PG8_LAS int* rowlds = nullptr;
    __device__ __forceinline__ int rowof(const Unit&, int ord, int r) const { return rowlds[ord * BM + r]; }
    static constexpr int MAXU = 6;
    __device__ __forceinline__ void stage_rows(const int* inv  , int cap, const PG8_LAS int* start, const PG8_LAS int* tot, PG8_LAS int* dst) { rowlds = dst; Unit u;
        for (int i = 0; i < MAXU && next(i, u); ++i) if (threadIdx.x < BM) { const int e = tile_e[u.pm], off = u.pm * BM - start[e] + (int)threadIdx.x; dst[i * BM + threadIdx.x] = off < tot[e] ? inv[e * cap + off] : 0; }
        __syncthreads(); }
    const PG8_LAS int* tile_e;   int nwg, nN, G, c; size_t estride;
    __device__ __forceinline__ void init(const PG8_LAS int* te, int ntiles, int nN_, int G_, int blk, size_t es) { tile_e = te; nN = nN_; nwg = ntiles * nN_; G = G_; estride = es;
        c = (G_ % 8 == 0) ? (blk % 8) * (G_ / 8) + blk / 8 : blk; }
    __device__ __forceinline__ bool next(int i, Unit& u) const { const long L = (long)i * G + c; if (L >= nwg) return false; u.pm = (int)(L / nN); u.pn = (int)(L % nN); return true; }
    __device__ __forceinline__ void a_ready(const Unit&) const {}
    __device__ __forceinline__ const char* bptr(const Gemm& g, const Unit& u, size_t tstep) const {
        const int e = __builtin_amdgcn_readfirstlane(tile_e[u.pm]); return (const char*)g.Bt + (size_t)e * estride + (size_t)u.pn * tstep; }
    __device__ __forceinline__ void done(const Unit&) const {}
};
}
namespace att {
typedef unsigned short bf16;
constexpr int D = 128, PITCH = 1024;
constexpr float SCALE = 0.08838834764831845f;
constexpr float THR = 0.f;
constexpr int NW = 8, QBLK = 32, KVBLK = 64, QB = NW * QBLK;
constexpr int SHM_V = KVBLK * D * 2, SHM_K = KVBLK * D * 2;
constexpr int LDS_BYTES = 2 * SHM_V + 2 * SHM_K + NW * 64 * 4;
typedef short bf16x8 __attribute__((ext_vector_type(8)));
typedef short s16x4 __attribute__((ext_vector_type(4)));
typedef float f32x16 __attribute__((ext_vector_type(16)));
typedef float f32x4 __attribute__((ext_vector_type(4)));
typedef unsigned u32x4 __attribute__((ext_vector_type(4)));
#define KSWZ(row, colB) ((row) * 256 + ((colB) ^ (((row) & 7) << 4)))
#define SBAR() __builtin_amdgcn_sched_barrier(0)
__device__ __forceinline__ int v_st(int k, int c) { const int kk = (k & ~0xC) | ((k & 4) << 1) | ((k & 8) >> 1); return ((kk >> 3) * 4 + (c >> 5)) * 512 + ((kk & 7) * 32 + (c & 31)) * 2; }
__device__ __forceinline__ int v_rd_base(int lane) { return ((lane & 3) << 3) | (((lane >> 2) & 3) << 6) | (((lane >> 4) & 1) << 5) | (((lane >> 5) & 1) << 8); }
constexpr int v_rd_off(int d0, int ks, int half) { return d0 * 512 + ks * 4096 + half * 2048; }
__device__ __forceinline__ int crow(int r, int hi) { return (r & 3) + 8 * (r >> 2) + 4 * hi; }
__device__ __forceinline__ unsigned cvtpk(float lo, float hi) { unsigned r; asm volatile("v_cvt_pk_bf16_f32 %0, %1, %2" : "=v"(r) : "v"(lo), "v"(hi)); return r; }
__device__ __forceinline__ bf16x8 load8(const bf16* p) { return *reinterpret_cast<const bf16x8*>(p); }
__device__ __forceinline__ void mask_tile(f32x16& p0, f32x16& p1, int dq) {
    const float NEG = -__builtin_inff();
#pragma unroll
    for (int r = 0; r < 16; ++r) {
        const int c = (r & 3) + 8 * (r >> 2);
        if (dq - c < 0) p0[r] = NEG;
        if (dq - c - 32 < 0) p1[r] = NEG;
    }
}
__device__ __forceinline__ void partialSM(f32x16& p0, f32x16& p1, float& m_reg, float& mn, float& alpha, bool keep) {
    float pmax = p0[0]; for (int r = 1; r < 16; ++r) pmax = fmaxf(pmax, p0[r]); for (int r = 0; r < 16; ++r) pmax = fmaxf(pmax, p1[r]);
    pmax = keep ? pmax : -__builtin_inff();
    { auto rr = __builtin_amdgcn_permlane32_swap(__float_as_uint(pmax), __float_as_uint(pmax), false, false);
      pmax = fmaxf(__uint_as_float(rr[0]), __uint_as_float(rr[1])); }
    constexpr float C2 = 1.4426950408889634f * SCALE;
    if (__builtin_expect(__all((pmax - m_reg) * SCALE <= THR), 1)) { mn = m_reg; alpha = 1.f; }
    else { mn = fmaxf(m_reg, pmax); alpha = __builtin_amdgcn_exp2f((m_reg - mn) * C2); m_reg = mn; }
    const float mnL = keep ? 8.0f - mn * C2 : -__builtin_inff();
    { typedef float f2_ __attribute__((ext_vector_type(2))); const f2_ c2 = {C2, C2}, ml = {mnL, mnL};
      for (int r = 0; r < 16; r += 2) { const f2_ a = __builtin_elementwise_fma((f2_){p0[r], p0[r + 1]}, c2, ml), b = __builtin_elementwise_fma((f2_){p1[r], p1[r + 1]}, c2, ml); p0[r] = a[0]; p0[r + 1] = a[1]; p1[r] = b[0]; p1[r + 1] = b[1]; } }
    for (int r = 0; r < 16; ++r) p0[r] = __builtin_amdgcn_exp2f(p0[r]);
}
__device__ __forceinline__ void finishSM(f32x16& p0, f32x16& p1, float alpha, float& l_reg, bf16x8& pa0, bf16x8& pa1, bf16x8& pa2, bf16x8& pa3) {
    for (int r = 0; r < 16; ++r) p1[r] = __builtin_amdgcn_exp2f(p1[r]);
    float ps = 0; for (int r = 0; r < 16; ++r) ps += p0[r]; for (int r = 0; r < 16; ++r) ps += p1[r];
    { auto rr = __builtin_amdgcn_permlane32_swap(__float_as_uint(ps), __float_as_uint(ps), false, false);
      ps = __uint_as_float(rr[0]) + __uint_as_float(rr[1]); }
    l_reg = l_reg * alpha + ps;
#define PK4(P, B_, OUT) do { unsigned a0 = cvtpk(P[B_+0], P[B_+1]), a1 = cvtpk(P[B_+2], P[B_+3]);                          \
        unsigned b0 = cvtpk(P[B_+4], P[B_+5]), b1 = cvtpk(P[B_+6], P[B_+7]);                                             \
        auto r0 = __builtin_amdgcn_permlane32_swap(a0, b0, false, false); auto r1 = __builtin_amdgcn_permlane32_swap(a1, b1, false, false); \
        u32x4 w = {r0[0], r1[0], r0[1], r1[1]}; OUT = *reinterpret_cast<bf16x8*>(&w); } while (0)
    PK4(p0, 0, pa0); PK4(p0, 8, pa1); PK4(p1, 0, pa2); PK4(p1, 8, pa3);
#undef PK4
}
template <int KB>
__device__ __forceinline__ void qkt(f32x16& p0, f32x16& p1, const char* K_lds, int r32, int hi, const bf16x8* qr) {
    p0 = f32x16{}; p1 = f32x16{};
    const char* kb[4];
#pragma unroll
    for (int dd = 0; dd < 4; ++dd) kb[dd] = K_lds + KB * SHM_K + KSWZ(r32, (dd * 16 + hi * 8) * 2);
#pragma unroll
    for (int d0 = 0; d0 < 8; ++d0) { const char* a = kb[d0 & 3] + (d0 >> 2) * 128;
        bf16x8 b0 = *reinterpret_cast<const bf16x8*>(a);
        bf16x8 b1 = *reinterpret_cast<const bf16x8*>(a + 32 * 256);
        p0 = __builtin_amdgcn_mfma_f32_32x32x16_bf16(b0, qr[d0], p0, 0, 0, 0);
        p1 = __builtin_amdgcn_mfma_f32_32x32x16_bf16(b1, qr[d0], p1, 0, 0, 0); }
}
typedef int i32x8_ __attribute__((ext_vector_type(8)));
template <int KB>
__device__ __forceinline__ void qkt8(f32x16& p0, f32x16& p1, const char* K_lds, int r32, int hi, const u32x4* q8) {
    p0 = f32x16{}; p1 = f32x16{};
    const char* kr = K_lds + KB * SHM_K + r32 * 128; const int kx = r32 & 7;
#pragma unroll
    for (int j = 0; j < 2; ++j) { const int c0 = ((4 * j + 2 * hi) ^ kx) << 4, c1 = ((4 * j + 2 * hi + 1) ^ kx) << 4;
        const u32x4 a0 = *(const u32x4*)(kr + c0), a1 = *(const u32x4*)(kr + c1), b0 = *(const u32x4*)(kr + 32 * 128 + c0), b1 = *(const u32x4*)(kr + 32 * 128 + c1);
        const i32x8_ qa = {(int)q8[2 * j][0], (int)q8[2 * j][1], (int)q8[2 * j][2], (int)q8[2 * j][3], (int)q8[2 * j + 1][0], (int)q8[2 * j + 1][1], (int)q8[2 * j + 1][2], (int)q8[2 * j + 1][3]};
        const i32x8_ ka = {(int)a0[0], (int)a0[1], (int)a0[2], (int)a0[3], (int)a1[0], (int)a1[1], (int)a1[2], (int)a1[3]}, kb = {(int)b0[0], (int)b0[1], (int)b0[2], (int)b0[3], (int)b1[0], (int)b1[1], (int)b1[2], (int)b1[3]};
        p0 = __builtin_amdgcn_mfma_scale_f32_32x32x64_f8f6f4(ka, qa, p0, 0, 0, 0, 0x7f7f7f7f, 0, 0x7f7f7f7f);
        p1 = __builtin_amdgcn_mfma_scale_f32_32x32x64_f8f6f4(kb, qa, p1, 0, 0, 0, 0x7f7f7f7f, 0, 0x7f7f7f7f); }
}
template <int VB>
__device__ __forceinline__ void pv_tile(f32x16* o, int vb0, bf16x8 pa0, bf16x8 pa1, bf16x8 pa2, bf16x8 pa3) {
#define TRRD(dst, off) asm volatile("ds_read_b64_tr_b16 %0, %1 offset:%2" : "=&v"(dst) : "v"(vb0), "i"(off) : "memory")
#define PV_D0(d0) do { s16x4 l0, l1, l2, l3, h0, h1, h2, h3; constexpr int b_ = VB * SHM_V + v_rd_off(d0, 0, 0);  \
        TRRD(l0, b_); TRRD(h0, b_ + 2048); TRRD(l1, b_ + 4096); TRRD(h1, b_ + 6144); TRRD(l2, b_ + 8192); TRRD(h2, b_ + 10240); TRRD(l3, b_ + 12288); TRRD(h3, b_ + 14336); \
        asm volatile("s_waitcnt lgkmcnt(0)" ::: "memory"); SBAR();   \
        o[d0] = __builtin_amdgcn_mfma_f32_32x32x16_bf16(pa0, (bf16x8){l0[0], l0[1], l0[2], l0[3], h0[0], h0[1], h0[2], h0[3]}, o[d0], 0, 0, 0);   \
        o[d0] = __builtin_amdgcn_mfma_f32_32x32x16_bf16(pa1, (bf16x8){l1[0], l1[1], l1[2], l1[3], h1[0], h1[1], h1[2], h1[3]}, o[d0], 0, 0, 0);   \
        o[d0] = __builtin_amdgcn_mfma_f32_32x32x16_bf16(pa2, (bf16x8){l2[0], l2[1], l2[2], l2[3], h2[0], h2[1], h2[2], h2[3]}, o[d0], 0, 0, 0);   \
        o[d0] = __builtin_amdgcn_mfma_f32_32x32x16_bf16(pa3, (bf16x8){l3[0], l3[1], l3[2], l3[3], h3[0], h3[1], h3[2], h3[3]}, o[d0], 0, 0, 0); } while (0)
    PV_D0(0); PV_D0(1); PV_D0(2); PV_D0(3);
#undef PV_D0
#undef TRRD
}
typedef int i32x8v __attribute__((ext_vector_type(8)));
__device__ __forceinline__ unsigned pk8(float a, float b, float c, float d) { int w = __builtin_amdgcn_cvt_pk_fp8_f32(a, b, 0, false); w = __builtin_amdgcn_cvt_pk_fp8_f32(c, d, w, true); return (unsigned)w; }
__device__ __forceinline__ void finishSM8(f32x16& p0, f32x16& p1, float alpha, float& l_reg, i32x8v& pa) {
    for (int r = 0; r < 16; ++r) p1[r] = __builtin_amdgcn_exp2f(p1[r]);
    float ps; { typedef float f2_ __attribute__((ext_vector_type(2))); f2_ s2 = {0.f, 0.f};
      for (int r = 0; r < 16; r += 2) { s2 += (f2_){p0[r], p0[r + 1]}; s2 += (f2_){p1[r], p1[r + 1]}; } ps = s2[0] + s2[1]; }
    { auto rr = __builtin_amdgcn_permlane32_swap(__float_as_uint(ps), __float_as_uint(ps), false, false);
      ps = __uint_as_float(rr[0]) + __uint_as_float(rr[1]); }
    l_reg = l_reg * alpha + ps;
#pragma unroll
    for (int j = 0; j < 4; ++j) { const unsigned w0 = pk8(p0[4 * j], p0[4 * j + 1], p0[4 * j + 2], p0[4 * j + 3]), w1 = pk8(p1[4 * j], p1[4 * j + 1], p1[4 * j + 2], p1[4 * j + 3]);
        auto rr = __builtin_amdgcn_permlane32_swap(w0, w1, false, false); pa[j] = (int)rr[0]; pa[4 + j] = (int)rr[1]; }
}
template <int VB>
__device__ __forceinline__ void pv_tile8(f32x16* o, int vb0, i32x8v pa) {
    typedef int v2i_ __attribute__((ext_vector_type(2))); typedef __attribute__((address_space(3))) v2i_ lds_v2i;
#define TR8(off) __builtin_amdgcn_ds_read_tr8_b64_v2i32((lds_v2i*)(unsigned)(vb0 + (off)))
#pragma unroll
    for (int d0 = 0; d0 < 4; ++d0) { constexpr int R0 = 0 * 32, R1 = 16 * 32, R2 = 8 * 32, R3 = 24 * 32; const int b_ = VB * SHM_V + d0 * 2048;
        const v2i_ t0 = TR8(b_ + R0), t1 = TR8(b_ + R1), t2 = TR8(b_ + R2), t3 = TR8(b_ + R3);
        const i32x8v vb = {t0[0], t0[1], t1[0], t1[1], t2[0], t2[1], t3[0], t3[1]};
        o[d0] = __builtin_amdgcn_mfma_scale_f32_32x32x64_f8f6f4(pa, vb, o[d0], 0, 0, 0, 0x77777777, 0, 0x7f7f7f7f); }
#undef TR8
}
struct BlockRef { const bf16* Q;   const unsigned char* Q8; const unsigned char* K8;   const unsigned char* V8;   unsigned char* O;     const float* Kmean; int P0; };
struct Seam { u32x4 q8[4];   u32x4 st_v; u32x4 st_k; };
#define ROW(p, k0, rr) ((p) + (unsigned)(((k0) + (rr)) * PITCH + sc))
#define VMW() asm volatile("s_waitcnt vmcnt(0)" ::: "memory")
#define VMWN(n) asm volatile("s_waitcnt vmcnt(%0)" :: "i"(n) : "memory")
#define SLOAD_H(Kp, Vp, k0) do { S.st_v = *(const u32x4*)((Vp) + (unsigned)(((k0) + krow) * PITCH + kch * 16));              \
                         S.st_k = *(const u32x4*)((Kp) + (unsigned)(((k0) + krow) * PITCH + kch * 16)); } while (0)
#define SWRITE_HK(bf) do { *(u32x4*)(K_lds + (bf) * SHM_K + kw8) = S.st_k; } while (0)
#define SWRITE_HV(bf) do { *(u32x4*)(V_lds + (bf) * SHM_V + vw8) = S.st_v; } while (0)
#define SWRITE_H(bf) do { SWRITE_HV(bf); SWRITE_HK(bf); } while (0)
__device__ __forceinline__ void moba_prime(const BlockRef& cur, char* lds, Seam& S) {
    const int tid = threadIdx.x, wid = __builtin_amdgcn_readfirstlane(tid >> 6), lane = tid & 63, r32 = lane & 31, hi = lane >> 5;
    const int sr = tid >> 4, sc = (tid & 15) * 8, krow = tid >> 3, kch = tid & 7, kw8 = krow * 128 + ((kch ^ (krow & 7)) << 4); char* K_lds = lds + 2 * SHM_V;
#pragma unroll
    for (int i = 0; i < 4; ++i) S.q8[i] = *(const u32x4*)(cur.Q8 + (unsigned)((wid * QBLK + r32) * PITCH + 64 * (i >> 1) + 32 * hi + 16 * (i & 1)));
    SLOAD_H(cur.K8, cur.V8, 0); VMW(); SWRITE_HK(0);
    __syncthreads();
}
__device__ __forceinline__ void moba_block(const BlockRef& cur, const BlockRef& nxt, char* lds, Seam& S) {
    const int tid = threadIdx.x, wid = __builtin_amdgcn_readfirstlane(tid >> 6), lane = tid & 63, r32 = lane & 31, hi = lane >> 5;
    const int NT = cur.P0 / KVBLK + 4;
    const int qlo = cur.P0 + wid * QBLK, qm = qlo + r32 - 4 * hi;
    unsigned selfull = 0xFFu;
    { const int qb = cur.P0 >> 8;
      if (qb >= 4) { float b1 = -__builtin_inff(), b2 = b1, b3 = b1; int i1 = 0, i2 = 0, i3 = 0;
        bf16x8 qg[8];
#pragma unroll
        for (int d0 = 0; d0 < 8; ++d0) qg[d0] = load8(cur.Q + (unsigned)((wid * QBLK + r32) * PITCH + hi * 8) + d0 * 16);
        float* kml = (float*)(lds + LDS_BYTES);
        for (int i = tid; i < qb * 128; i += NW * 64) kml[i] = cur.Kmean[i];
        __syncthreads();
#pragma unroll 1
        for (int n = 0; n < qb; ++n) { float g = 0.f; const float* kmn = kml + n * 128 + 8 * hi;
#pragma unroll
            for (int d0 = 0; d0 < 8; ++d0) { const u32x4 qw = *reinterpret_cast<const u32x4*>(&qg[d0]); const f32x4 k0 = *(const f32x4*)(kmn + 16 * d0), k1 = *(const f32x4*)(kmn + 16 * d0 + 4);
                g += (__uint_as_float(qw.x << 16) * k0[0] + __uint_as_float(qw.x & 0xffff0000u) * k0[1]) + (__uint_as_float(qw.y << 16) * k0[2] + __uint_as_float(qw.y & 0xffff0000u) * k0[3])
                   + (__uint_as_float(qw.z << 16) * k1[0] + __uint_as_float(qw.z & 0xffff0000u) * k1[1]) + (__uint_as_float(qw.w << 16) * k1[2] + __uint_as_float(qw.w & 0xffff0000u) * k1[3]); }
            g += __shfl_xor(g, 32);
            if (g > b1) { b3 = b2; i3 = i2; b2 = b1; i2 = i1; b1 = g; i1 = n; } else if (g > b2) { b3 = b2; i3 = i2; b2 = g; i2 = n; } else if (g > b3) { b3 = g; i3 = n; } }
        const unsigned mask = (1u << i1) | (1u << i2) | (1u << i3);
        selfull = mask | (0xFFu << qb); } }
    char* V_lds = lds; char* K_lds = lds + 2 * SHM_V;
    float* ws = (float*)(lds + 2 * SHM_V + 2 * SHM_K) + wid * 64; float* li_l = ws, * al_l = ws + 32;
    float m_reg = -1e30f, l_reg = 0; f32x16 o[4] = {};
    const int sr = tid >> 4, sc = (tid & 15) * 8, krow = tid >> 3, kch = tid & 7, kw8 = krow * 128 + ((kch ^ (krow & 7)) << 4), vw8 = (kch >> 1) * 2048 + ((krow & ~12) | ((krow & 4) << 1) | ((krow & 8) >> 1)) * 32 + (kch & 1) * 16;
    const int vb0 = (int)(uintptr_t)V_lds + (32 * hi + ((lane & 15) >> 1)) * 32 + 16 * ((lane >> 4) & 1) + 8 * (lane & 1);
    const unsigned char* Kh = cur.K8; const unsigned char* Vh = cur.V8;
#define RESC(a) do { if (__any((a) < 1.f)) { if (hi == 0) al_l[r32] = (a); asm volatile("s_waitcnt lgkmcnt(0)" ::: "memory");              \
                     for (int d_ = 0; d_ < 4; ++d_) for (int r = 0; r < 16; ++r) o[d_][r] *= al_l[crow(r, hi)]; } } while (0)
#define KBASE(t) ((t) * KVBLK)
#define KEEP(t) (((selfull >> (KBASE(t) >> 8)) & 1u) != 0u)
#define MASKT(P0_, P1_, t) do { const int kb_ = KBASE(t); if (kb_ + KVBLK - 1 > qlo) mask_tile(P0_, P1_, qm - kb_); } while (0)
    constexpr int NQL = 4;
#define SEAM_K0() do { VMWN(NQL); SWRITE_HK(0); SBAR(); } while (0)
    f32x16 pA0, pA1, pB0, pB1; float mnA, mnB, alA, alB; i32x8v pa;
    SWRITE_HV(0); SBAR();
    if (NT > 1) { SLOAD_H(Kh, Vh, KBASE(1)); }
    SBAR(); qkt8<0>(pA0, pA1, K_lds, r32, hi, S.q8);
    MASKT(pA0, pA1, 0); partialSM(pA0, pA1, m_reg, mnA, alA, KEEP(0));
    if (NT > 1) { VMW(); SWRITE_H(1); }
    __syncthreads();
#define HALF_STEP(PX0, PX1, mnX, alX, PY0, PY1, alY, t, KB, VB, SB) do {                                                      \
        SBAR(); qkt8<KB>(PX0, PX1, K_lds, r32, hi, S.q8);                                             \
        finishSM8(PY0, PY1, alY, l_reg, pa); SBAR();                                                           \
        if ((t) + 1 < NT) { SLOAD_H(Kh, Vh, KBASE((t) + 1)); SBAR(); }                                               \
        pv_tile8<VB>(o, vb0, pa); MASKT(PX0, PX1, (t)); partialSM(PX0, PX1, m_reg, mnX, alX, KEEP(t));                                        \
        __syncthreads();                                                                                                      \
        if ((t) + 1 < NT) { VMW(); SWRITE_H(SB); }                                                                          \
        RESC(alX); __syncthreads(); } while (0)
    for (int t = 1; t + 1 < NT; t += 2) {
        HALF_STEP(pB0, pB1, mnB, alB, pA0, pA1, alA, t, 1, 0, 0);
        HALF_STEP(pA0, pA1, mnA, alA, pB0, pB1, alB, t + 1, 0, 1, 1);
    }
    const bool even = (NT & 1) == 0;
    if (even) { SBAR(); qkt8<1>(pB0, pB1, K_lds, r32, hi, S.q8); SBAR(); }
    SLOAD_H(nxt.K8, nxt.V8, 0); SBAR();
#pragma unroll
    for (int i = 0; i < 4; ++i) S.q8[i] = *(const u32x4*)(nxt.Q8 + (unsigned)((wid * QBLK + r32) * PITCH + 64 * (i >> 1) + 32 * hi + 16 * (i & 1)));
    SBAR();
    finishSM8(pA0, pA1, alA, l_reg, pa); SBAR();
    pv_tile8<0>(o, vb0, pa);
    if (even) { MASKT(pB0, pB1, NT - 1); partialSM(pB0, pB1, m_reg, mnB, alB, KEEP(NT - 1)); __syncthreads(); RESC(alB);
        finishSM8(pB0, pB1, alB, l_reg, pa); SBAR(); pv_tile8<1>(o, vb0, pa); }
    SBAR(); SEAM_K0();
    if (hi == 0) li_l[r32] = l_reg; asm volatile("s_waitcnt lgkmcnt(0)" ::: "memory");
    float rli[16];
#pragma unroll
    for (int r = 0; r < 16; ++r) rli[r] = __builtin_amdgcn_rcpf(li_l[crow(r, hi)]);
    unsigned char* ost = (unsigned char*)lds + 73728 + wid * 4096;
#pragma unroll
    for (int r = 0; r < 16; ++r) { const float sc16 = rli[r] * (16.0f * 256.0f);     unsigned char* orow = ost + crow(r, hi) * 128 + r32;
#pragma unroll
        for (int d0 = 0; d0 < 4; ++d0) { const float v = o[d0][r] * sc16; orow[d0 * 32] = (unsigned char)__builtin_amdgcn_cvt_pk_fp8_f32(v, v, 0, false); } }
#pragma unroll
    for (int i = 0; i < 4; ++i) { const int ch = lane + 64 * i, row = ch >> 3, c16 = ch & 7;
        const u32x4 d = *(const u32x4*)(ost + row * 128 + c16 * 16);
        *(u32x4*)(cur.O + (unsigned)((wid * QBLK + row) * PITCH + c16 * 16)) = d; }
    __syncthreads();
#undef RESC
#undef KBASE
#undef KEEP
#undef MASKT
#undef SEAM_K0
#undef HALF_STEP
}
#undef ROW
#undef VMW
#undef VMWN
#undef SLOAD_H
#undef SWRITE_HK
#undef SWRITE_HV
#undef SWRITE_H
}
#define GAS __attribute__((address_space(1)))
#define LAS __attribute__((address_space(3)))
typedef unsigned short bf16;
typedef unsigned v4u __attribute__((ext_vector_type(4)));
typedef float f32x4 __attribute__((ext_vector_type(4)));
typedef short bf16x8 __attribute__((ext_vector_type(8)));
typedef GAS unsigned gu32;
typedef GAS unsigned long long gu64;
#define RLX_AGENT __ATOMIC_RELAXED, __HIP_MEMORY_SCOPE_AGENT
#define LDS_WAIT() asm volatile("s_waitcnt lgkmcnt(0)" ::: "memory")
#define VM_WAIT() asm volatile("s_waitcnt vmcnt(0)" ::: "memory")
__device__ __forceinline__ unsigned long long rt() { return __builtin_amdgcn_s_memrealtime(); }
__device__ __forceinline__ unsigned f2bf(float f) { unsigned u = __builtin_bit_cast(unsigned, f); return (u + 0x7fffu + ((u >> 16) & 1u)) >> 16; }
__device__ __forceinline__ unsigned pk2(float lo, float hi) { unsigned r; asm("v_cvt_pk_bf16_f32 %0, %1, %2" : "=v"(r) : "v"(lo), "v"(hi)); return r; }

#define XB_TMO      128
#define XB_XCNT(j)  (256  + 64 * (j))
#define XB_XSUB(j)  (1280 + 64 * (j))
#define XB_XGEN(j)  (2304 + 64 * (j))
#define XB_TOP      3328
#define XB_TOPGEN   3392
#define XCD_BAR_WORDS 3456
#define XB_SPIN_CAP (1u << 18)

__device__ __forceinline__ unsigned xb_ld(unsigned* p)              { return __hip_atomic_load(p, __ATOMIC_RELAXED, __HIP_MEMORY_SCOPE_AGENT); }
__device__ __forceinline__ unsigned xb_add(unsigned* p, unsigned v) { return __hip_atomic_fetch_add(p, v, __ATOMIC_RELAXED, __HIP_MEMORY_SCOPE_AGENT); }
__device__ __forceinline__ unsigned xb_xcc_id() { return (unsigned)__builtin_amdgcn_s_getreg((3 << 11) | 20) & 0xFu; }
#define XB_SPIN(cond, bar) do { unsigned _sp = 0; while (cond) { __builtin_amdgcn_s_sleep(1); \
    if ((++_sp & 255u) == 0u) { if (xb_ld(&(bar)[XB_TMO])) break; if (_sp > XB_SPIN_CAP) { atomicAdd(&(bar)[XB_TMO], 1u); break; } } } } while (0)

struct XcdBarrier {
    unsigned* bar; unsigned x;
    volatile LAS unsigned* st;
};

__device__ __forceinline__ XcdBarrier xcd_barrier_post(unsigned* bar, volatile LAS unsigned* st) {
    XcdBarrier b; b.bar = bar; b.x = xb_xcc_id(); b.st = st;
    if (threadIdx.x == 0) (void)xb_add(&bar[XB_XCNT(b.x)], 1u);
    return b;
}
__device__ __forceinline__ void xcd_barrier_complete(unsigned* bar, unsigned x, unsigned& nloc, unsigned& nx) {
    const unsigned G = gridDim.x * gridDim.y * gridDim.z;
    unsigned sum, cnt, mine, sp = 0u;
    for (;;) {
        sum = 0u; cnt = 0u; mine = 0u;
#pragma unroll
        for (unsigned j = 0; j < 16; ++j) { const unsigned c = xb_ld(&bar[XB_XCNT(j)]); sum += c; cnt += (c > 0u) ? 1u : 0u; mine = (j == x) ? c : mine; }
        if (sum == G) break;
        __builtin_amdgcn_s_sleep(1);
        if ((++sp & 255u) == 0u) { if (xb_ld(&bar[XB_TMO])) break; if (sp > XB_SPIN_CAP) { atomicAdd(&bar[XB_TMO], 1u); break; } }
    }
    nloc = mine > 0u ? mine : 1u; nx = cnt > 0u ? cnt : 1u;
}

__device__ __forceinline__ void xcd_barrier(const XcdBarrier& b) {
    asm volatile("s_waitcnt vmcnt(0)" ::: "memory");
    __syncthreads();
    if (threadIdx.x == 0) {
        unsigned* bar = b.bar;
        __builtin_amdgcn_s_waitcnt(0);
        unsigned nloc = b.st[0], nx = b.st[1];
        if (nloc == 0u) { xcd_barrier_complete(bar, b.x, nloc, nx); b.st[0] = nloc; b.st[1] = nx; }
        const unsigned old = xb_add(&bar[XB_XSUB(b.x)], 1u);
        const unsigned gen = old / nloc;
        if (old + 1u == (gen + 1u) * nloc) {
            __builtin_amdgcn_fence(__ATOMIC_RELEASE, "agent");
            asm volatile("s_waitcnt vmcnt(0)" ::: "memory");
            const unsigned og = xb_add(&bar[XB_TOP], 1u);
            const unsigned tg = og / nx;
            if (og + 1u == (tg + 1u) * nx) xb_add(&bar[XB_TOPGEN], 1u);
            else XB_SPIN(xb_ld(&bar[XB_TOPGEN]) == tg, bar);
            __builtin_amdgcn_fence(__ATOMIC_ACQUIRE, "agent");
            xb_add(&bar[XB_XGEN(b.x)], 1u);
            asm volatile("s_waitcnt vmcnt(0)" ::: "memory");
        } else {
            XB_SPIN(xb_ld(&bar[XB_XGEN(b.x)]) == gen, bar);
            __builtin_amdgcn_fence(__ATOMIC_ACQUIRE, "agent");
            asm volatile("s_waitcnt vmcnt(0)" ::: "memory");
        }
    }
    __syncthreads();
}
__device__ __forceinline__ void group4_barrier(unsigned* bar, unsigned* gword, unsigned* xmap4) {
    asm volatile("s_waitcnt vmcnt(0)" ::: "memory");
    __syncthreads();
    if (threadIdx.x == 0) {
        const unsigned x0 = xb_ld(xmap4), x1 = xb_ld(xmap4 + 1), x2 = xb_ld(xmap4 + 2), x3 = xb_ld(xmap4 + 3);
        if (!(x0 != 0u && x0 == x1 && x1 == x2 && x2 == x3)) { __builtin_amdgcn_fence(__ATOMIC_RELEASE, "agent"); asm volatile("s_waitcnt vmcnt(0)" ::: "memory"); }
        (void)xb_add(gword, 1u);
        XB_SPIN(xb_ld(gword) < 4u, bar);
        __builtin_amdgcn_fence(__ATOMIC_ACQUIRE, "agent");
        asm volatile("s_waitcnt vmcnt(0)" ::: "memory");
    }
    __syncthreads();
}
template <class Fn> __device__ __forceinline__ void local_barrier_ov(unsigned* bar, unsigned* word, unsigned n, Fn fn) {
    asm volatile("s_waitcnt vmcnt(0)" ::: "memory");
    __syncthreads();
    if (threadIdx.x == 0) {
        (void)xb_add(word, 1u);
        XB_SPIN(xb_ld(word) < n, bar);
        __builtin_amdgcn_fence(__ATOMIC_ACQUIRE, "agent");
        asm volatile("s_waitcnt vmcnt(0)" ::: "memory");
    } else if (threadIdx.x >= 64) { fn(); }
    __syncthreads();
}
template <class Fn> __device__ __forceinline__ void xcd_barrier_ov(const XcdBarrier& b, Fn fn) {
    asm volatile("s_waitcnt vmcnt(0)" ::: "memory");
    __syncthreads();
    if (threadIdx.x == 0) {
        unsigned* bar = b.bar;
        __builtin_amdgcn_s_waitcnt(0);
        unsigned nloc = b.st[0], nx = b.st[1];
        if (nloc == 0u) { xcd_barrier_complete(bar, b.x, nloc, nx); b.st[0] = nloc; b.st[1] = nx; }
        const unsigned old = xb_add(&bar[XB_XSUB(b.x)], 1u);
        const unsigned gen = old / nloc;
        if (old + 1u == (gen + 1u) * nloc) {
            __builtin_amdgcn_fence(__ATOMIC_RELEASE, "agent");
            asm volatile("s_waitcnt vmcnt(0)" ::: "memory");
            const unsigned og = xb_add(&bar[XB_TOP], 1u);
            const unsigned tg = og / nx;
            if (og + 1u == (tg + 1u) * nx) xb_add(&bar[XB_TOPGEN], 1u);
            else XB_SPIN(xb_ld(&bar[XB_TOPGEN]) == tg, bar);
            __builtin_amdgcn_fence(__ATOMIC_ACQUIRE, "agent");
            xb_add(&bar[XB_XGEN(b.x)], 1u);
            asm volatile("s_waitcnt vmcnt(0)" ::: "memory");
        } else {
            XB_SPIN(xb_ld(&bar[XB_XGEN(b.x)]) == gen, bar);
            __builtin_amdgcn_fence(__ATOMIC_ACQUIRE, "agent");
            asm volatile("s_waitcnt vmcnt(0)" ::: "memory");
        }
    } else if (threadIdx.x >= 64) { fn(); }
    __syncthreads();
}
constexpr int NB = 16, T = 2048, D = 1024, M = NB * T;
constexpr int NEXP = 16, DEXP = 512;
constexpr int MAXT = 272, MSORT = MAXT * 256;
constexpr float LN_EPS = 1e-5f, DN_ALPHA = 1.4142135623730951f;
constexpr int NWAVES = 8;
constexpr size_t MiB = 1u << 20;
constexpr size_t WS_CTL = 0, CTL_ZERO_BYTES = 1 * MiB;
constexpr size_t WS_COND = 1 * MiB;
constexpr size_t WS_KMEAN = 512 * 1024;
constexpr size_t WS_ROUTE_E = 3 * MiB;
constexpr size_t WS_ROUTE_W = WS_ROUTE_E + 128 * 1024;
constexpr size_t WS_POS = WS_ROUTE_W + 256 * 1024;
constexpr size_t WS_CNT = WS_POS + 256 * 1024;
constexpr size_t WS_TILE = WS_CNT + 16 * 1024;
constexpr size_t WS_SEL = 4 * MiB;
constexpr size_t WS_INV = 5 * MiB;
constexpr size_t WS_WIN = 8 * MiB, WS_WOUT = 12 * MiB, WS_WQKV = 14 * MiB, WS_WO2 = 20 * MiB;
constexpr size_t WS_WGU = 22 * MiB;
constexpr size_t WS_WD = 86 * MiB;
constexpr size_t WS_XA = 118 * MiB;
constexpr size_t WS_H8 = 118 * MiB + 128 * MiB - 32 * MiB;
constexpr size_t WS_H = 246 * MiB;
constexpr size_t WS_BIG = 310 * MiB;
constexpr size_t WS_END = 502 * MiB;
constexpr int CW_BAR = 4096;
constexpr int CW_LBAR = 49152;
constexpr int CW_XMAP = 24576;
constexpr int CW_GBAR = 32768;
constexpr int CW_MOE = 16384;
constexpr int TAB_START = 512, TAB_TOT = 544, INV_CAP = 32768;

typedef unsigned v2u __attribute__((ext_vector_type(2)));
typedef float f32x2 __attribute__((ext_vector_type(2)));
__device__ __forceinline__ float bflo(unsigned w) { return __builtin_bit_cast(float, w << 16); }
__device__ __forceinline__ float bfhi(unsigned w) { return __builtin_bit_cast(float, w & 0xffff0000u); }
__device__ __forceinline__ float dpp_add(float v, float src_holder, int ctrl_unused) { return v; }
#define WS_DPP(v, ctrl, rmask) (v) += __builtin_bit_cast(float, __builtin_amdgcn_update_dpp(0, __builtin_bit_cast(int, (v)), (ctrl), (rmask), 0xF, true))
__device__ __forceinline__ float wave_sum(float v) {
    WS_DPP(v, 0xB1, 0xF);
    WS_DPP(v, 0x4E, 0xF);
    WS_DPP(v, 0x141, 0xF);
    WS_DPP(v, 0x140, 0xF);
    WS_DPP(v, 0x142, 0xA);
    WS_DPP(v, 0x143, 0xC);
    return __builtin_bit_cast(float, __builtin_amdgcn_readlane(__builtin_bit_cast(int, v), 63));
}

#define DPPF(v, ctrl) __builtin_bit_cast(float, __builtin_amdgcn_update_dpp(0, __builtin_bit_cast(int, (v)), (ctrl), 0xF, 0xF, true))
__device__ __forceinline__ float xrow_sum(float r) {
    { float x = r, y = r; asm volatile("s_nop 1\n\tv_permlane16_swap_b32 %0, %1" : "+v"(x), "+v"(y)); r = x + y; }
    { float x = r, y = r; asm volatile("s_nop 1\n\tv_permlane32_swap_b32 %0, %1" : "+v"(x), "+v"(y)); r = x + y; }
    return r;
}
__device__ __forceinline__ void wave_sum4(float a, float b, float c, float d, float& s0, float& s1, float& s2, float& s3, int lane) {
    const bool odd = (lane & 1) != 0, hi2 = (lane & 2) != 0;
    const float rab = (odd ? b : a) + DPPF(odd ? a : b, 0xB1);
    const float rcd = (odd ? d : c) + DPPF(odd ? c : d, 0xB1);
    float r = (hi2 ? rcd : rab) + DPPF(hi2 ? rab : rcd, 0x4E);
    r += DPPF(r, 0x124); r += DPPF(r, 0x128);
    r = xrow_sum(r);
    s0 = __builtin_bit_cast(float, __builtin_amdgcn_readlane(__builtin_bit_cast(int, r), 0)); s1 = __builtin_bit_cast(float, __builtin_amdgcn_readlane(__builtin_bit_cast(int, r), 1));
    s2 = __builtin_bit_cast(float, __builtin_amdgcn_readlane(__builtin_bit_cast(int, r), 2)); s3 = __builtin_bit_cast(float, __builtin_amdgcn_readlane(__builtin_bit_cast(int, r), 3));
}

#define DPPX1(v) ((unsigned)__builtin_amdgcn_update_dpp(0, (int)(v), 0xB1, 0xF, 0xF, true))
template <class T> __device__ __forceinline__ T* pair_addr(T* pa, T* pb, int lane) { return (lane & 1) ? pb - 8 : pa; }
__device__ __forceinline__ void pair_split(v4u ld, int lane, v2u& a, v2u& b) {
    const bool odd = (lane & 1) != 0; const unsigned nx = DPPX1(odd ? ld.x : ld.z), ny = DPPX1(odd ? ld.y : ld.w);
    a = odd ? (v2u){nx, ny} : (v2u){ld.x, ld.y}; b = odd ? (v2u){ld.z, ld.w} : (v2u){nx, ny}; }
__device__ __forceinline__ v4u pair_join(v2u a, v2u b, int lane) {
    const bool odd = (lane & 1) != 0; const unsigned nx = DPPX1(odd ? a.x : b.x), ny = DPPX1(odd ? a.y : b.y);
    return odd ? (v4u){nx, ny, b.x, b.y} : (v4u){a.x, a.y, nx, ny}; }
struct Params { const float* in[27]; float* out; unsigned char* ws; int ph_lo, ph_hi, li, pad; };
enum { I_X = 0, I_C, I_ADAW, I_ADAB, I_LNMG, I_LNMB, I_LNFG, I_LNFB, I_WIN, I_SLNG, I_SLNB, I_WS, I_BS, I_WDW, I_BDW, I_CLNG, I_CLNB, I_WOUT, I_WQKV, I_WO2,
       I_WGRP, I_BGRP, I_WER, I_BER, I_WGATE, I_WUP, I_WDOWN };
struct Frame {
    LAS unsigned char* lds;
    int tid, lane, wave, vcu, G;
};

__device__ __forceinline__ void p0_cond(const Frame& F, const float* c, const float* ada_w, const float* ada_b, float* cond) {
    LAS float* sc = (LAS float*)F.lds;
    LAS float* red = (LAS float*)(F.lds + 65536);
    bool loaded = false;
    for (int it = blockIdx.x; it < 192; it += F.G) {
        if (!loaded) { for (int i = F.tid; i < 16384; i += 512) { const int b = i >> 10, k = i & 1023; const float v = c[i]; sc[k * 16 + b] = v / (1.0f + __expf(-v)); } __syncthreads(); loaded = true; }
        const int L = it / 96, j0 = (it % 96) * 64, col = F.tid & 63, ks = F.tid >> 6;
        float acc[16];
#pragma unroll
        for (int b = 0; b < 16; ++b) acc[b] = 0.f;
        const float* w = ada_w + (size_t)L * 1024 * 6144 + (size_t)(ks * 128) * 6144 + j0 + col;
        for (int kb = 0; kb < 128; kb += 32) { float wv[32];
#pragma unroll
            for (int k = 0; k < 32; ++k) wv[k] = __builtin_nontemporal_load(w + (size_t)(kb + k) * 6144);
#pragma unroll
            for (int k = 0; k < 32; ++k) { const LAS f32x4* s4 = (const LAS f32x4*)(sc + (ks * 128 + kb + k) * 16);
#pragma unroll
                for (int q = 0; q < 4; ++q) { const f32x4 s = s4[q]; acc[4 * q + 0] += s[0] * wv[k]; acc[4 * q + 1] += s[1] * wv[k]; acc[4 * q + 2] += s[2] * wv[k]; acc[4 * q + 3] += s[3] * wv[k]; } } }
#pragma unroll
        for (int b = 0; b < 16; ++b) red[(ks * 16 + b) * 64 + col] = acc[b];
        __syncthreads();
        for (int o = F.tid; o < 1024; o += 512) { const int b = o >> 6, cc = o & 63; float s = ada_b[L * 6144 + j0 + cc];
#pragma unroll
            for (int k2 = 0; k2 < 8; ++k2) s += red[(k2 * 16 + b) * 64 + cc];
            cond[(size_t)(L * 16 + b) * 6144 + j0 + cc] = s; }
        __syncthreads();
    }
}
__device__ __forceinline__ void transpose_item(const float* W, int srcN, bf16* WT, int dstK, int k0, int n0, int drow0, LAS float* scr, int lane) {
    { const int kr = lane >> 3, n4 = (lane & 7) * 4; f32x4 v[8];
#pragma unroll
        for (int i = 0; i < 8; ++i) v[i] = __builtin_nontemporal_load((const f32x4*)(W + (size_t)(k0 + kr + 8 * i) * srcN + n0 + n4));
#pragma unroll
        for (int i = 0; i < 8; ++i) { LAS float* d = scr + (kr + 8 * i) * 33 + n4; d[0] = v[i][0]; d[1] = v[i][1]; d[2] = v[i][2]; d[3] = v[i][3]; } }
    LDS_WAIT(); asm volatile("" ::: "memory");
    const int c = lane & 7;
#pragma unroll
    for (int j = 0; j < 4; ++j) { const int n = (lane >> 3) + 8 * j; const LAS float* s = scr + (8 * c) * 33 + n;
        v4u o; o.x = pk2(s[0 * 33], s[1 * 33]); o.y = pk2(s[2 * 33], s[3 * 33]); o.z = pk2(s[4 * 33], s[5 * 33]); o.w = pk2(s[6 * 33], s[7 * 33]);
        *(GAS v4u*)(WT + (size_t)(drow0 + n) * dstK + k0 + 8 * c) = o; }
    LDS_WAIT(); asm volatile("" ::: "memory");
}
__device__ __forceinline__ void transpose_item_fp8(const float* W, int srcN, unsigned char* WT, int dstK, int k0, int n0, int drow0, LAS float* scr, int lane) {
    { const int kr = lane >> 3, n4 = (lane & 7) * 4; f32x4 v[8];
#pragma unroll
        for (int i = 0; i < 8; ++i) v[i] = __builtin_nontemporal_load((const f32x4*)(W + (size_t)(k0 + kr + 8 * i) * srcN + n0 + n4));
#pragma unroll
        for (int i = 0; i < 8; ++i) { LAS float* d = scr + (kr + 8 * i) * 33 + n4; d[0] = v[i][0] * 32.0f; d[1] = v[i][1] * 32.0f; d[2] = v[i][2] * 32.0f; d[3] = v[i][3] * 32.0f; } }
    LDS_WAIT(); asm volatile("" ::: "memory");
    const int c = lane & 3;
#pragma unroll
    for (int j = 0; j < 2; ++j) { const int n = (lane >> 2) + 16 * j; const LAS float* s = scr + (16 * c) * 33 + n;
        v4u o; o.x = pg8::pk_fp8x4(s[0 * 33], s[1 * 33], s[2 * 33], s[3 * 33]); o.y = pg8::pk_fp8x4(s[4 * 33], s[5 * 33], s[6 * 33], s[7 * 33]);
        o.z = pg8::pk_fp8x4(s[8 * 33], s[9 * 33], s[10 * 33], s[11 * 33]); o.w = pg8::pk_fp8x4(s[12 * 33], s[13 * 33], s[14 * 33], s[15 * 33]);
        *(GAS v4u*)(WT + (size_t)(drow0 + n) * dstK + k0 + 16 * c) = o; }
    LDS_WAIT(); asm volatile("" ::: "memory");
}
constexpr int CV_S0 = 1024, CV_S1 = CV_S0 + 512, CV_S2 = CV_S1 + 1536, CV_S3 = CV_S2 + 512, CV_S4 = CV_S3 + 8192, CV_S5 = CV_S4 + 8192, CV_S6 = CV_S5 + 8192;
__device__ __forceinline__ void convert_item(const Params& P, int it, LAS float* scr, int lane) {
    unsigned char* ws = P.ws;
    if (it < CV_S0) { const int r = it, kb = r >> 6, nb = r & 63, n0 = nb * 32;
        const int drow = n0 < 1024 ? n0 : (n0 < 1536 ? (4 + ((n0 - 1024) >> 7)) * 256 + ((n0 - 1024) & 127) : (4 + ((n0 - 1536) >> 7)) * 256 + 128 + ((n0 - 1536) & 127));
        transpose_item(P.in[I_WIN], 2048, (bf16*)(ws + WS_WIN), 1024, kb * 64, n0, drow, scr, lane); }
    else if (it < CV_S1) { const int r = it - CV_S0, kb = r >> 5, nb = r & 31; transpose_item(P.in[I_WOUT], 1024, (bf16*)(ws + WS_WOUT), 1024, kb * 64, nb * 32, nb * 32, scr, lane); }
    else if (it < CV_S2) { const int r = it - CV_S1, kb = r / 96, nb = r % 96; transpose_item_fp8(P.in[I_WQKV], 3072, ws + WS_WQKV, 1024, kb * 64, nb * 32, nb * 32, scr, lane); }
    else if (it < CV_S3) { const int r = it - CV_S2, kb = r >> 5, nb = r & 31; transpose_item_fp8(P.in[I_WO2], 1024, ws + WS_WO2, 1024, kb * 64, nb * 32, nb * 32, scr, lane); }
    else if (it < CV_S5) { const bool up = it >= CV_S4; const int r = it - (up ? CV_S4 : CV_S3), le = r >> 8, q = r & 255, kb = q >> 4, nb = q & 15, n0 = nb * 32;
        const int drow = (n0 >> 7) * 256 + (up ? 128 : 0) + (n0 & 127);
        transpose_item_fp8(P.in[up ? I_WUP : I_WGATE] + (size_t)le * 1024 * 512, 512, ws + WS_WGU + (size_t)le * 1024 * 1024, 1024, kb * 64, n0, drow, scr, lane); }
    else { const int r = it - CV_S5, le = r >> 8, q = r & 255, kb = q >> 5, nb = q & 31;
        transpose_item_fp8(P.in[I_WDOWN] + (size_t)le * 512 * 1024, 1024, ws + WS_WD + (size_t)le * 1024 * 512, 512, kb * 64, nb * 32, nb * 32, scr, lane); }
}
__device__ __forceinline__ void p0_weights(const Frame& F, const Params& P) {
    LAS float* scr = (LAS float*)(F.lds + F.wave * 16384);
    const int gw = F.vcu * NWAVES + F.wave, NGW = F.G * NWAVES;
    constexpr int NP0 = CV_S3 + 3 * 4096;
    for (int j = gw; j < NP0; j += NGW) { const int it = j < CV_S3 ? j : (j < CV_S3 + 4096 ? j : (j < CV_S3 + 8192 ? CV_S4 + (j - CV_S3 - 4096) : CV_S5 + (j - CV_S3 - 8192)));
        convert_item(P, it, scr, F.lane); }
}
__device__ __forceinline__ void bg_convert(const Frame& F, const Params& P, int rank, int ns, int j0, int j1) {
    LAS float* scr = (LAS float*)(F.lds + F.wave * 16384);
    for (int j = j0 + rank * NWAVES + F.wave; j < j1; j += ns * NWAVES) { const int it = j < 4096 ? CV_S3 + 4096 + j : (j < 8192 ? CV_S4 + 4096 + (j - 4096) : CV_S5 + 4096 + (j - 8192));
        convert_item(P, it, scr, F.lane); }
}
__device__ __forceinline__ void p_modulate(const Frame& F, const float* x, const float* cond_l  , int sh_off, bf16* H) {
    const int gw = F.vcu * NWAVES + F.wave, NGW = F.G * NWAVES;
    for (int ch = gw; ch < M / 16; ch += NGW) {
        const int r0 = ch * 16, b = r0 / T; const float* cb = cond_l + (size_t)b * 6144 + sh_off;
        f32x4 sh[4], sc[4];
#pragma unroll
        for (int j = 0; j < 4; ++j) { sh[j] = *(const f32x4*)(cb + 4 * F.lane + 256 * j); sc[j] = *(const f32x4*)(cb + 1024 + 4 * F.lane + 256 * j) + 1.0f; }
#pragma unroll 4
        for (int i = 0; i < 16; ++i) { const float* xr = x + (size_t)(r0 + i) * D + 4 * F.lane; bf16* hr = H + (size_t)(r0 + i) * D + 4 * F.lane;
#pragma unroll
            for (int j = 0; j < 4; j += 2) { v2u o[2];
#pragma unroll
                for (int k = 0; k < 2; ++k) { const f32x4 v = __builtin_nontemporal_load((const f32x4*)(xr + 256 * (j + k))) * sc[j + k] + sh[j + k]; o[k].x = pk2(v[0], v[1]); o[k].y = pk2(v[2], v[3]); }
                const bool odd = (F.lane & 1) != 0; const unsigned sx = odd ? o[0].x : o[1].x, sy = odd ? o[0].y : o[1].y;
                const unsigned nx = (unsigned)__builtin_amdgcn_update_dpp(0, (int)sx, 0xB1, 0xF, 0xF, true), ny = (unsigned)__builtin_amdgcn_update_dpp(0, (int)sy, 0xB1, 0xF, 0xF, true);
                const v4u w = odd ? (v4u){nx, ny, o[1].x, o[1].y} : (v4u){o[0].x, o[0].y, nx, ny};
                *(v4u*)(hr + 256 * (j + (odd ? 1 : 0)) - (odd ? 4 : 0)) = w; } }
    }
}
__device__ __forceinline__ void p_sgu_item(const Frame& F, const Params& P, int bc, const bf16* U, const bf16* V, bf16* YC) {
    const int r0 = bc * 128;
    LAS bf16* Vt = (LAS bf16*)F.lds;
    LAS bf16* Wl = (LAS bf16*)(F.lds + 34816);
    const float* lng = P.in[I_SLNG]; const float* lnb = P.in[I_SLNB];
    const int fr = F.lane & 15, fq = F.lane >> 4, w16 = F.wave * 16;
    v4u raw[16];
#pragma unroll
    for (int i = 0; i < 16; ++i) raw[i] = __builtin_nontemporal_load((const v4u*)(V + (size_t)(r0 + w16 + i) * 512 + 8 * F.lane));
    const f32x4 g0 = *(const f32x4*)(lng + 8 * F.lane), g1 = *(const f32x4*)(lng + 8 * F.lane + 4), b0 = *(const f32x4*)(lnb + 8 * F.lane), b1 = *(const f32x4*)(lnb + 8 * F.lane + 4);
#pragma unroll
    for (int i = 0; i < 16; ++i) { const v4u rw = raw[i];
        const float v[8] = {bflo(rw.x), bfhi(rw.x), bflo(rw.y), bfhi(rw.y), bflo(rw.z), bfhi(rw.z), bflo(rw.w), bfhi(rw.w)};
        float s = 0.f;
#pragma unroll
        for (int j = 0; j < 8; ++j) s += v[j];
        const float mu = wave_sum(s) * (1.0f / 512.0f); float s2 = 0.f;
#pragma unroll
        for (int j = 0; j < 8; ++j) { const float d = v[j] - mu; s2 += d * d; }
        const float rs = 1.0f / sqrtf(wave_sum(s2) * (1.0f / 512.0f) + LN_EPS);
        v4u nw; nw.x = pk2((v[0] - mu) * rs * g0[0] + b0[0], (v[1] - mu) * rs * g0[1] + b0[1]); nw.y = pk2((v[2] - mu) * rs * g0[2] + b0[2], (v[3] - mu) * rs * g0[3] + b0[3]);
        nw.z = pk2((v[4] - mu) * rs * g1[0] + b1[0], (v[5] - mu) * rs * g1[1] + b1[1]); nw.w = pk2((v[6] - mu) * rs * g1[2] + b1[2], (v[7] - mu) * rs * g1[3] + b1[3]); raw[i] = nw; }
    f32x4 w[8];
#pragma unroll
    for (int k = 0; k < 8; ++k) w[k] = *(const f32x4*)(P.in[I_WS] + (size_t)(F.tid + 512 * k) * 4);
    for (int g = 0; g < 4; ++g) {
        if (fq == g) { const int d0 = 8 * fr;
#define SGU_W(rw, jp) ((jp) == 0 ? (rw).x : (jp) == 1 ? (rw).y : (jp) == 2 ? (rw).z : (rw).w)
#pragma unroll
            for (int i4 = 0; i4 < 16; i4 += 4)
#pragma unroll
                for (int jp = 0; jp < 4; ++jp) { const unsigned w0 = SGU_W(raw[i4], jp), w1 = SGU_W(raw[i4 + 1], jp), w2 = SGU_W(raw[i4 + 2], jp), w3 = SGU_W(raw[i4 + 3], jp);
                    v2u lo, hi; lo.x = __builtin_amdgcn_perm(w1, w0, 0x05040100u); lo.y = __builtin_amdgcn_perm(w3, w2, 0x05040100u); hi.x = __builtin_amdgcn_perm(w1, w0, 0x07060302u); hi.y = __builtin_amdgcn_perm(w3, w2, 0x07060302u);
                    *(LAS v2u*)(Vt + (d0 + 2 * jp) * 136 + w16 + i4) = lo; *(LAS v2u*)(Vt + (d0 + 2 * jp + 1) * 136 + w16 + i4) = hi; }
#undef SGU_W
        }
        {
#pragma unroll
            for (int k = 0; k < 8; ++k) { const int i = F.tid + 512 * k, p = i >> 5, q4 = (i & 31) * 4;
                v2u o; o.x = pk2(q4 + 0 <= p ? w[k][0] : 0.f, q4 + 1 <= p ? w[k][1] : 0.f); o.y = pk2(q4 + 2 <= p ? w[k][2] : 0.f, q4 + 3 <= p ? w[k][3] : 0.f);
                *(LAS v2u*)(Wl + p * 136 + q4) = o; }
            if (g < 3) { const float* wsn = P.in[I_WS] + (size_t)(g + 1) * 128 * 128;
#pragma unroll
                for (int k = 0; k < 8; ++k) w[k] = *(const f32x4*)(wsn + (size_t)(F.tid + 512 * k) * 4); } }
        const int row = r0 + w16 + fr; const float bs = P.in[I_BS][g * 128 + w16 + fr];
        v2u uu[8];
#pragma unroll
        for (int nt = 0; nt < 8; nt += 2) { const v4u ld = __builtin_nontemporal_load((const v4u*)(U + (size_t)row * 512 + 128 * g + 16 * (nt + (fq & 1)) + 4 * (fq & ~1)));
            auto rx = __builtin_amdgcn_permlane16_swap(ld.x, ld.z, false, false); auto ry = __builtin_amdgcn_permlane16_swap(ld.y, ld.w, false, false);
            uu[nt] = (v2u){rx[0], ry[0]}; uu[nt + 1] = (v2u){rx[1], ry[1]}; }
        __syncthreads();
        f32x4 acc[8];
#pragma unroll
        for (int nt = 0; nt < 8; ++nt) acc[nt] = (f32x4){0.f, 0.f, 0.f, 0.f};
#pragma unroll
        for (int ks = 0; ks < 4; ++ks) { if (32 * ks <= w16 + 15) {
            const bf16x8 wf = *(const LAS bf16x8*)(Wl + (w16 + fr) * 136 + 32 * ks + 8 * fq);
#pragma unroll
            for (int nt = 0; nt < 8; ++nt) { const bf16x8 vf = *(const LAS bf16x8*)(Vt + (16 * nt + fr) * 136 + 32 * ks + 8 * fq);
                acc[nt] = __builtin_amdgcn_mfma_f32_16x16x32_bf16(vf, wf, acc[nt], 0, 0, 0); } } }
#pragma unroll
        for (int nt = 0; nt < 8; nt += 2) { v2u o[2];
#pragma unroll
            for (int k = 0; k < 2; ++k) { o[k].x = pk2(bflo(uu[nt + k].x) * (acc[nt + k][0] + bs), bfhi(uu[nt + k].x) * (acc[nt + k][1] + bs)); o[k].y = pk2(bflo(uu[nt + k].y) * (acc[nt + k][2] + bs), bfhi(uu[nt + k].y) * (acc[nt + k][3] + bs)); }
            auto rx = __builtin_amdgcn_permlane16_swap(o[0].x, o[1].x, false, false); auto ry = __builtin_amdgcn_permlane16_swap(o[0].y, o[1].y, false, false);
            *(v4u*)(YC + (size_t)row * D + 128 * g + 16 * (nt + (fq & 1)) + 4 * (fq & ~1)) = (v4u){rx[0], ry[0], rx[1], ry[1]}; }
        __syncthreads();
    }
}
__device__ __forceinline__ void conv_load(const Frame& F, int ci, const bf16* Gb, v4u (&v)[8]) {
    const int R0 = ci * 32, b = R0 / T, t0 = R0 % T;
#pragma unroll
    for (int k = 0; k < 8; ++k) { const int i = F.tid + 512 * k, r = i >> 6, cc = i & 63, t = t0 - 30 + r; const int tc = t < 0 ? 0 : (r > 61 ? t0 : t);
        v[k] = *(const v4u*)(Gb + (size_t)(b * T + tc) * 512 + cc * 8); if (t < 0) v[k] = (v4u){0u, 0u, 0u, 0u}; }
}
struct ConvConst { f32x2 w2[31]; f32x2 bd; f32x4 g0, g1, b0, b1; };
__device__ __forceinline__ void conv_const(const Frame& F, const Params& P, ConvConst& C) { const int cp = F.tid & 255; const float* wdw = P.in[I_WDW];
#pragma unroll
    for (int k = 0; k < 31; ++k) C.w2[k] = *(const f32x2*)(wdw + k * 512 + 2 * cp);
    C.bd = *(const f32x2*)(P.in[I_BDW] + 2 * cp); const float* lng = P.in[I_CLNG]; const float* lnb = P.in[I_CLNB];
    C.g0 = *(const f32x4*)(lng + 8 * F.lane); C.g1 = *(const f32x4*)(lng + 8 * F.lane + 4); C.b0 = *(const f32x4*)(lnb + 8 * F.lane); C.b1 = *(const f32x4*)(lnb + 8 * F.lane + 4); }
__device__ __forceinline__ void p_conv_item(const Frame& F, const Params& P, int ci, int ci_next, const bf16* Gb, bf16* YC, v4u (&v)[8], const ConvConst& C) {
    const int R0 = ci * 32;
    LAS bf16* Gin = (LAS bf16*)F.lds;
    LAS float* Yc = (LAS float*)(F.lds + 63488);
#pragma unroll
    for (int k = 0; k < 8; ++k) { const int i = F.tid + 512 * k, r = i >> 6, cc = i & 63; if (i < 62 * 64) *(LAS v4u*)(Gin + r * 512 + cc * 8) = v[k]; }
    if (ci_next >= 0) conv_load(F, ci_next, Gb, v);
    __syncthreads();
    { const int cp = F.tid & 255, th = F.tid >> 8;
        const f32x2 bd = C.bd;
#pragma unroll 1
        for (int blk = 0; blk < 2; ++blk) { const int o0 = 16 * th + 8 * blk; f32x2 a2[8];
#pragma unroll
            for (int o = 0; o < 8; ++o) a2[o] = bd;
#pragma unroll
            for (int i = 0; i < 38; ++i) { const unsigned pr = *(const LAS unsigned*)(Gin + (o0 + i) * 512 + 2 * cp); const f32x2 vv = (f32x2){bflo(pr), bfhi(pr)};
#pragma unroll
                for (int o = 0; o < 8; ++o) { const int k = i - o; if (k >= 0 && k < 31) a2[o] = __builtin_elementwise_fma(C.w2[k], vv, a2[o]); } }
#pragma unroll
            for (int o = 0; o < 8; ++o) *(LAS f32x2*)(Yc + (o0 + o) * 512 + 2 * cp) = a2[o]; }
    }
    __syncthreads();
    { const f32x4 g0 = C.g0, g1 = C.g1, b0 = C.b0, b1 = C.b1;
        f32x4 y[4][2]; float s[4], q[4];
#pragma unroll
        for (int i = 0; i < 4; ++i) { const int r = F.wave * 4 + i; y[i][0] = *(const LAS f32x4*)(Yc + r * 512 + 8 * F.lane); y[i][1] = *(const LAS f32x4*)(Yc + r * 512 + 8 * F.lane + 4); }
#pragma unroll
        for (int i = 0; i < 4; ++i) { const f32x4 a = y[i][0], b = y[i][1]; s[i] = ((a[0] + a[1]) + (a[2] + a[3])) + ((b[0] + b[1]) + (b[2] + b[3]));
            q[i] = ((a[0] * a[0] + a[1] * a[1]) + (a[2] * a[2] + a[3] * a[3])) + ((b[0] * b[0] + b[1] * b[1]) + (b[2] * b[2] + b[3] * b[3])); }
        wave_sum4(s[0], s[1], s[2], s[3], s[0], s[1], s[2], s[3], F.lane); wave_sum4(q[0], q[1], q[2], q[3], q[0], q[1], q[2], q[3], F.lane);
#pragma unroll
        for (int i = 0; i < 4; ++i) { const int r = F.wave * 4 + i; const float mean = s[i] * (1.0f / 512.0f), rstd = 1.0f / sqrtf(fmaxf(q[i] * (1.0f / 512.0f) - mean * mean, 0.f) + LN_EPS);
            float v8[8] = {y[i][0][0], y[i][0][1], y[i][0][2], y[i][0][3], y[i][1][0], y[i][1][1], y[i][1][2], y[i][1][3]};
#pragma unroll
            for (int j = 0; j < 8; ++j) { const float z = (v8[j] - mean) * rstd * (j < 4 ? g0[j & 3] : g1[j & 3]) + (j < 4 ? b0[j & 3] : b1[j & 3]); v8[j] = z * __builtin_amdgcn_rcpf(1.0f + __expf(-z)); }
            v4u o; o.x = pk2(v8[0], v8[1]); o.y = pk2(v8[2], v8[3]); o.z = pk2(v8[4], v8[5]); o.w = pk2(v8[6], v8[7]);
            *(v4u*)(YC + (size_t)(R0 + r) * D + 512 + 8 * F.lane) = o; }
    }
    __syncthreads();
}
#define COL8(q) (512 * ((q) >> 1) + 8 * F.lane + 4 * ((q) & 1))
struct RowVec { f32x4 v[4]; };
__device__ __forceinline__ f32x4 up4(v2u w) { return (f32x4){bflo(w.x), bfhi(w.x), bflo(w.y), bfhi(w.y)}; }
__device__ __forceinline__ f32x4 up4f8(unsigned w) { const f32x2 lo = __builtin_amdgcn_cvt_pk_f32_fp8((int)w, false), hi = __builtin_amdgcn_cvt_pk_f32_fp8((int)w, true); return (f32x4){lo[0], lo[1], hi[0], hi[1]}; }
__device__ __forceinline__ void ln_stats(RowVec& t, float& rstd) {
    float s = 0.f;
#pragma unroll
    for (int j = 0; j < 4; ++j) s += (t.v[j][0] + t.v[j][1]) + (t.v[j][2] + t.v[j][3]);
    const float mean = wave_sum(s) * (1.0f / D); float s2 = 0.f;
#pragma unroll
    for (int j = 0; j < 4; ++j) { t.v[j] = t.v[j] - mean; s2 += (t.v[j][0] * t.v[j][0] + t.v[j][1] * t.v[j][1]) + (t.v[j][2] * t.v[j][2] + t.v[j][3] * t.v[j][3]); }
    rstd = 1.0f / sqrtf(wave_sum(s2) * (1.0f / D) + LN_EPS);
}
struct ModVecs { f32x4 A[4], B[4], G[4], C[4], Dv[4]; };
__device__ __forceinline__ void mod_vecs(const Frame& F, ModVecs& mv, const float* cin, int sh_in, int g_off, const float* lng, const float* lnb, const float* cout, int sh_out) {
#pragma unroll
    for (int q = 0; q < 4; ++q) { const int col = COL8(q);
        const f32x4 sh = *(const f32x4*)(cin + sh_in + col), sc1 = *(const f32x4*)(cin + sh_in + 1024 + col) + 1.0f;
        f32x4 a; a[0] = DN_ALPHA / sc1[0]; a[1] = DN_ALPHA / sc1[1]; a[2] = DN_ALPHA / sc1[2]; a[3] = DN_ALPHA / sc1[3];
        mv.A[q] = a; mv.B[q] = -sh * a; mv.G[q] = *(const f32x4*)(cin + g_off + col) + 1.0f;
        const f32x4 g = *(const f32x4*)(lng + col), b = *(const f32x4*)(lnb + col);
        if (cout) { const f32x4 so = *(const f32x4*)(cout + sh_out + 1024 + col) + 1.0f; mv.C[q] = g * so; mv.Dv[q] = b * so + *(const f32x4*)(cout + sh_out + col); }
        else { mv.C[q] = g; mv.Dv[q] = b; } }
}
__device__ __forceinline__ int slot8(int c) { return (((c >> 9) << 1) | ((c >> 2) & 1)) * 256 + ((c & 511) >> 3) * 4 + (c & 3); }
__device__ __forceinline__ void moe_table(const Frame& F, unsigned* gcnt, LAS int* tl) {
    if (F.tid < 16) tl[F.tid] = (int)((__hip_atomic_load((unsigned long long*)(gcnt + 64 * (F.tid >> 2)), __ATOMIC_RELAXED, __HIP_MEMORY_SCOPE_AGENT) >> (16 * (F.tid & 3))) & 0xffffu);
    __syncthreads();
    if (F.tid == 0) { int s = 0; for (int e = 0; e < 16; ++e) { tl[16 + e] = s; s += (tl[e] + 255) & ~255; } tl[32] = s; }
    __syncthreads();
    if (F.tid < MAXT) { const int r = F.tid * 256; int e = 15; for (int k = 15; k >= 0; --k) if (r < tl[16 + k + 1]) e = k; tl[64 + F.tid] = e; }
    __syncthreads();
}
__device__ __forceinline__ void p9_fill_start(unsigned* gcnt, LAS int* dst, int t) {
    if ((unsigned)t < 64u) { const int e = t & 15;
        const int tot = (int)((__hip_atomic_load((unsigned long long*)(gcnt + 64 * (e >> 2)), __ATOMIC_RELAXED, __HIP_MEMORY_SCOPE_AGENT) >> (16 * (e & 3))) & 0xffffu), pad = (tot + 255) & ~255;
        int s = pad;
#pragma unroll
        for (int d = 1; d < 16; d <<= 1) { const int v = __shfl_up(s, d, 16); if (e >= d) s += v; }
        if (t < 16) dst[e] = s - pad; }
}
__device__ __forceinline__ void p5_fill_w(const Frame& F, const Params& P, int layer, int t, int nthr) {
    LAS float* Wr = (LAS float*)F.lds;
    const float* wg = P.in[I_WGRP] + (size_t)layer * D * 4; const float* we = P.in[I_WER] + (size_t)layer * 4 * D * 4;
    for (int d = t; d < D; d += nthr) { const f32x4 a = *(const f32x4*)(wg + d * 4); const int s = slot8(d);
#pragma unroll
        for (int o = 0; o < 4; ++o) Wr[o * D + s] = a[o];
#pragma unroll
        for (int g = 0; g < 4; ++g) { const f32x4 e = *(const f32x4*)(we + ((size_t)g * D + d) * 4);
#pragma unroll
            for (int o = 0; o < 4; ++o) Wr[(4 + 4 * g + o) * D + s] = e[o]; } }
    LAS float* bg = (LAS float*)(F.lds + 81920 + 64); LAS float* be = bg + 4;
    if (t < 4) bg[t] = P.in[I_BGRP][layer * 4 + t]; if (t >= 64 && t < 80) be[t - 64] = P.in[I_BER][layer * 16 + t - 64];
}
__device__ __forceinline__ void p5_fill_mv(const Frame& F, const Params& P, int layer, int it, int t) {
    LAS int* cntl = (LAS int*)(F.lds + 81920); LAS float* MV = (LAS float*)(F.lds + 82944);
    const float* cond_l = (const float*)(P.ws + WS_COND) + (size_t)layer * 16 * 6144; const float* lng = P.in[I_LNMG] + layer * D; const float* lnb = P.in[I_LNMB] + layer * D;
    const int b = (it * 128) / T; const float* cb = cond_l + (size_t)b * 6144;
        if (t < 16) cntl[t] = 0;
        if (t < 256) { const int col = 4 * t, s = slot8(col); const f32x4 sh = *(const f32x4*)(cb + col), sc1 = *(const f32x4*)(cb + 1024 + col) + 1.0f;
            f32x4 a; a[0] = DN_ALPHA / sc1[0]; a[1] = DN_ALPHA / sc1[1]; a[2] = DN_ALPHA / sc1[2]; a[3] = DN_ALPHA / sc1[3];
            const f32x4 g = *(const f32x4*)(lng + col), bb = *(const f32x4*)(lnb + col), so = *(const f32x4*)(cb + 4096 + col) + 1.0f;
            *(LAS f32x4*)(MV + s) = a; *(LAS f32x4*)(MV + 1024 + s) = -sh * a; *(LAS f32x4*)(MV + 2048 + s) = *(const f32x4*)(cb + 2048 + col) + 1.0f;
            *(LAS f32x4*)(MV + 3072 + s) = g * so; *(LAS f32x4*)(MV + 4096 + s) = bb * so + *(const f32x4*)(cb + 3072 + col); }
}
struct RowRaw { v4u h[2]; v4u y[2]; };
template <bool Y8> __device__ __forceinline__ void p_ln_route(const Frame& F, const Params& P, int layer, const void* Yv, bf16* H, bf16* Hout, unsigned char* H8, bool pre) {
    const bf16* Y = (const bf16*)Yv; const unsigned char* Yb = (const unsigned char*)Yv;
    unsigned char* ws = P.ws;
    LAS float* Wr = (LAS float*)F.lds;
    LAS int* cntl = (LAS int*)(F.lds + 81920);
    LAS float* MV = (LAS float*)(F.lds + 82944);
    if (!pre) p5_fill_w(F, P, layer, F.tid, 512);
    LAS float* bg = (LAS float*)(F.lds + 81920 + 64); LAS float* be = bg + 4;
    const float* cond_l = (const float*)(ws + WS_COND) + (size_t)layer * 16 * 6144;
    const float* lng = P.in[I_LNMG] + layer * D; const float* lnb = P.in[I_LNMB] + layer * D;
    int* route_e = (int*)(ws + WS_ROUTE_E); f32x2* route_w = (f32x2*)(ws + WS_ROUTE_W);
    LAS int* ael = (LAS int*)(F.lds + 103424)  ; LAS int* basel = ael + 256  ; LAS int* totl = basel + 16  ; LAS int* startl = totl + 16  ; LAS int* lastf = startl + 32;
    unsigned* gcnt = (unsigned*)(ws + WS_CTL) + CW_MOE + layer * 2048;
    int* pos = (int*)(ws + WS_POS); int* inv = (int*)(ws + WS_INV); int* tab = (int*)(ws + WS_TILE);
    for (int it = F.vcu; it < 256; it += F.G) {
        const int rbase = it * 128 + F.wave * 16, b = rbase / T; const float* cb = cond_l + (size_t)b * 6144;
        RowRaw rb[4];
#define LD_ROW(dst, r) do { _Pragma("unroll") for (int j = 0; j < 2; ++j) { (dst).h[j] = __builtin_nontemporal_load((const v4u*)(H + (size_t)(r) * D + 8 * F.lane + 512 * j)); if constexpr (Y8) { const v2u y8_ = __builtin_nontemporal_load((const v2u*)(Yb + (size_t)(r) * D + 8 * F.lane + 512 * j)); (dst).y[j] = (v4u){y8_.x, y8_.y, 0u, 0u}; } else (dst).y[j] = __builtin_nontemporal_load((const v4u*)(Y + (size_t)(r) * D + 8 * F.lane + 512 * j)); } } while (0)
        if (!(pre && it == F.vcu)) p5_fill_mv(F, P, layer, it, F.tid);
        __syncthreads();
#define P5_PAIR(bA, bB, ii, REA_, WA0_, WA1_, REB_, WB0_, WB1_) do { const int r = rbase + (ii); RowVec tA, tB; float rsA, rsB; \
            _Pragma("unroll") for (int q = 0; q < 4; ++q) { const int s = 256 * q + 4 * F.lane; const f32x4 mA = *(const LAS f32x4*)(MV + s), mB = *(const LAS f32x4*)(MV + 1024 + s), mG = *(const LAS f32x4*)(MV + 2048 + s); \
                { const v4u hw = (bA).h[q >> 1], yw = (bA).y[q >> 1]; const v2u h2 = (q & 1) ? (v2u){hw.z, hw.w} : (v2u){hw.x, hw.y}, y2 = (q & 1) ? (v2u){yw.z, yw.w} : (v2u){yw.x, yw.y}; f32x4 yv; if constexpr (Y8) yv = up4f8((q & 1) ? yw.y : yw.x) * 0.015625f; else yv = up4(y2); tA.v[q] = up4(h2) * mA + mB + mG * yv; } \
                { const v4u hw = (bB).h[q >> 1], yw = (bB).y[q >> 1]; const v2u h2 = (q & 1) ? (v2u){hw.z, hw.w} : (v2u){hw.x, hw.y}, y2 = (q & 1) ? (v2u){yw.z, yw.w} : (v2u){yw.x, yw.y}; f32x4 yv; if constexpr (Y8) yv = up4f8((q & 1) ? yw.y : yw.x) * 0.015625f; else yv = up4(y2); tB.v[q] = up4(h2) * mA + mB + mG * yv; } } \
            float sA_ = 0.f, qA_ = 0.f, sB_ = 0.f, qB_ = 0.f; \
            _Pragma("unroll") for (int q = 0; q < 4; ++q) { const f32x4 xa = tA.v[q], xb = tB.v[q]; sA_ += (xa[0] + xa[1]) + (xa[2] + xa[3]); qA_ += (xa[0] * xa[0] + xa[1] * xa[1]) + (xa[2] * xa[2] + xa[3] * xa[3]); \
                sB_ += (xb[0] + xb[1]) + (xb[2] + xb[3]); qB_ += (xb[0] * xb[0] + xb[1] * xb[1]) + (xb[2] * xb[2] + xb[3] * xb[3]); } \
            float tsA, tqA, tsB, tqB; wave_sum4(sA_, qA_, sB_, qB_, tsA, tqA, tsB, tqB, F.lane);     \
            const float mnA = tsA * (1.0f / D), mnB = tsB * (1.0f / D); rsA = __builtin_amdgcn_rsqf(fmaxf(tqA * (1.0f / D) - mnA * mnA, 0.f) + LN_EPS); rsB = __builtin_amdgcn_rsqf(fmaxf(tqB * (1.0f / D) - mnB * mnB, 0.f) + LN_EPS); \
            f32x4 aA[4] = {}, aB[4] = {}; unsigned owA[8], o8A[4], owB[8], o8B[4];     \
            _Pragma("unroll") for (int q = 0; q < 4; ++q) { const int s = 256 * q + 4 * F.lane; const f32x4 mC = *(const LAS f32x4*)(MV + 3072 + s), mD = *(const LAS f32x4*)(MV + 4096 + s); \
                const f32x4 hA = (tA.v[q] - mnA) * rsA * mC + mD, hB = (tB.v[q] - mnB) * rsB * mC + mD; tA.v[q] = hA; tB.v[q] = hB; \
                owA[2 * q] = pk2(hA[0], hA[1]); owA[2 * q + 1] = pk2(hA[2], hA[3]); o8A[q] = pg8::pk_fp8x4(hA[0], hA[1], hA[2], hA[3]); \
                owB[2 * q] = pk2(hB[0], hB[1]); owB[2 * q + 1] = pk2(hB[2], hB[3]); o8B[q] = pg8::pk_fp8x4(hB[0], hB[1], hB[2], hB[3]); \
                _Pragma("unroll") for (int o = 0; o < 4; ++o) { const f32x4 w = *(const LAS f32x4*)(Wr + o * D + s); \
                    aA[o] = __builtin_elementwise_fma(hA, w, aA[o]); aB[o] = __builtin_elementwise_fma(hB, w, aB[o]); } } \
            *(v4u*)(Hout + (size_t)r * D + 8 * F.lane) = (v4u){owA[0], owA[1], owA[2], owA[3]}; *(v4u*)(Hout + (size_t)r * D + 8 * F.lane + 512) = (v4u){owA[4], owA[5], owA[6], owA[7]}; \
            *(v4u*)(Hout + (size_t)(r + 1) * D + 8 * F.lane) = (v4u){owB[0], owB[1], owB[2], owB[3]}; *(v4u*)(Hout + (size_t)(r + 1) * D + 8 * F.lane + 512) = (v4u){owB[4], owB[5], owB[6], owB[7]}; \
            *(v4u*)pair_addr(H8 + (size_t)r * D + 8 * F.lane, H8 + (size_t)r * D + 8 * F.lane + 512, F.lane) = pair_join((v2u){o8A[0], o8A[1]}, (v2u){o8A[2], o8A[3]}, F.lane); \
            *(v4u*)pair_addr(H8 + (size_t)(r + 1) * D + 8 * F.lane, H8 + (size_t)(r + 1) * D + 8 * F.lane + 512, F.lane) = pair_join((v2u){o8B[0], o8B[1]}, (v2u){o8B[2], o8B[3]}, F.lane); \
            __builtin_amdgcn_sched_barrier(0); \
            float lA[4], lB[4]; _Pragma("unroll") for (int o = 0; o < 4; ++o) { lA[o] = (aA[o][0] + aA[o][1]) + (aA[o][2] + aA[o][3]); lB[o] = (aB[o][0] + aB[o][1]) + (aB[o][2] + aB[o][3]); } \
            wave_sum4(lA[0], lA[1], lA[2], lA[3], lA[0], lA[1], lA[2], lA[3], F.lane); wave_sum4(lB[0], lB[1], lB[2], lB[3], lB[0], lB[1], lB[2], lB[3], F.lane); \
            _Pragma("unroll") for (int o = 0; o < 4; ++o) { lA[o] += bg[o]; lB[o] += bg[o]; } \
            int gA = 0, gB = 0; float mxA = lA[0], mxB = lB[0]; \
            _Pragma("unroll") for (int j = 1; j < 4; ++j) { if (lA[j] > mxA) { mxA = lA[j]; gA = j; } if (lB[j] > mxB) { mxB = lB[j]; gB = j; } } \
            gA = __builtin_amdgcn_readfirstlane(gA); gB = __builtin_amdgcn_readfirstlane(gB); \
            float dA = 0.f, dB = 0.f; \
            _Pragma("unroll") for (int j = 0; j < 4; ++j) { dA += __expf(lA[j] - mxA); dB += __expf(lB[j] - mxB); } \
            const float gwA = __builtin_amdgcn_rcpf(dA), gwB = __builtin_amdgcn_rcpf(dB); \
            f32x4 cA[4] = {}, cB[4] = {}; const LAS float* WeA = Wr + (4 + 4 * gA) * D; const LAS float* WeB = Wr + (4 + 4 * gB) * D; \
            _Pragma("unroll") for (int q = 0; q < 4; ++q) { const int s = 256 * q + 4 * F.lane; const f32x4 hA = tA.v[q], hB = tB.v[q]; \
                _Pragma("unroll") for (int o = 0; o < 4; ++o) { const f32x4 wA = *(const LAS f32x4*)(WeA + o * D + s), wB = *(const LAS f32x4*)(WeB + o * D + s); \
                    cA[o] = __builtin_elementwise_fma(hA, wA, cA[o]); cB[o] = __builtin_elementwise_fma(hB, wB, cB[o]); } } \
            __builtin_amdgcn_sched_barrier(0); \
            float eA[4], eB[4]; _Pragma("unroll") for (int o = 0; o < 4; ++o) { eA[o] = (cA[o][0] + cA[o][1]) + (cA[o][2] + cA[o][3]); eB[o] = (cB[o][0] + cB[o][1]) + (cB[o][2] + cB[o][3]); } \
            wave_sum4(eA[0], eA[1], eA[2], eA[3], eA[0], eA[1], eA[2], eA[3], F.lane); wave_sum4(eB[0], eB[1], eB[2], eB[3], eB[0], eB[1], eB[2], eB[3], F.lane); \
            _Pragma("unroll") for (int o = 0; o < 4; ++o) { eA[o] += be[gA * 4 + o]; eB[o] += be[gB * 4 + o]; } \
            { int i0 = 0; float m0 = eA[0]; _Pragma("unroll") for (int e2 = 1; e2 < 4; ++e2) if (eA[e2] > m0) { m0 = eA[e2]; i0 = e2; } \
              int i1 = 0; float m1 = -__builtin_inff(); _Pragma("unroll") for (int e2 = 0; e2 < 4; ++e2) if (e2 != i0 && eA[e2] > m1) { m1 = eA[e2]; i1 = e2; } \
              WA0_ = gwA * __builtin_amdgcn_rcpf(1.0f + __expf(m1 - m0)); WA1_ = gwA - WA0_; REA_ = (gA * 4 + i0) | ((gA * 4 + i1) << 8); } \
            { int i0 = 0; float m0 = eB[0]; _Pragma("unroll") for (int e2 = 1; e2 < 4; ++e2) if (eB[e2] > m0) { m0 = eB[e2]; i0 = e2; } \
              int i1 = 0; float m1 = -__builtin_inff(); _Pragma("unroll") for (int e2 = 0; e2 < 4; ++e2) if (e2 != i0 && eB[e2] > m1) { m1 = eB[e2]; i1 = e2; } \
              WB0_ = gwB * __builtin_amdgcn_rcpf(1.0f + __expf(m1 - m0)); WB1_ = gwB - WB0_; REB_ = (gB * 4 + i0) | ((gB * 4 + i1) << 8); } } while (0)
        for (int i = 0; i < 16; i += 4) { asm volatile("" ::: "memory"); LD_ROW(rb[0], rbase + i); LD_ROW(rb[1], rbase + i + 1); LD_ROW(rb[2], rbase + i + 2); LD_ROW(rb[3], rbase + i + 3);
            int re0, re1, re2, re3; float wa0, wa1, wa2, wa3, wb0, wb1, wb2, wb3;
            P5_PAIR(rb[0], rb[1], i, re0, wa0, wb0, re1, wa1, wb1); __builtin_amdgcn_sched_barrier(0); P5_PAIR(rb[2], rb[3], i + 2, re2, wa2, wb2, re3, wa3, wb3);
            if (F.lane == 0) { const int r = rbase + i; *(v4u*)(route_e + r) = (v4u){(unsigned)re0, (unsigned)re1, (unsigned)re2, (unsigned)re3};
                { LAS int* ap = ael + 2 * (F.wave * 16 + i); ap[0] = re0 & 0xff; ap[1] = re0 >> 8; ap[2] = re1 & 0xff; ap[3] = re1 >> 8; ap[4] = re2 & 0xff; ap[5] = re2 >> 8; ap[6] = re3 & 0xff; ap[7] = re3 >> 8; }
                *(f32x4*)(route_w + r) = (f32x4){wa0, wb0, wa1, wb1}; *(f32x4*)(route_w + r + 2) = (f32x4){wa2, wb2, wa3, wb3};
                __hip_atomic_fetch_add(&cntl[re0 & 0xff], 1, __ATOMIC_RELAXED, __HIP_MEMORY_SCOPE_WORKGROUP); __hip_atomic_fetch_add(&cntl[re0 >> 8], 1, __ATOMIC_RELAXED, __HIP_MEMORY_SCOPE_WORKGROUP);
                __hip_atomic_fetch_add(&cntl[re1 & 0xff], 1, __ATOMIC_RELAXED, __HIP_MEMORY_SCOPE_WORKGROUP); __hip_atomic_fetch_add(&cntl[re1 >> 8], 1, __ATOMIC_RELAXED, __HIP_MEMORY_SCOPE_WORKGROUP);
                __hip_atomic_fetch_add(&cntl[re2 & 0xff], 1, __ATOMIC_RELAXED, __HIP_MEMORY_SCOPE_WORKGROUP); __hip_atomic_fetch_add(&cntl[re2 >> 8], 1, __ATOMIC_RELAXED, __HIP_MEMORY_SCOPE_WORKGROUP);
                __hip_atomic_fetch_add(&cntl[re3 & 0xff], 1, __ATOMIC_RELAXED, __HIP_MEMORY_SCOPE_WORKGROUP); __hip_atomic_fetch_add(&cntl[re3 >> 8], 1, __ATOMIC_RELAXED, __HIP_MEMORY_SCOPE_WORKGROUP); } }
#undef P5_PAIR
#undef LD_ROW
        __syncthreads();
        if (F.tid < 4) { const unsigned long long c = (unsigned long long)(unsigned)cntl[4 * F.tid] | ((unsigned long long)(unsigned)cntl[4 * F.tid + 1] << 16) | ((unsigned long long)(unsigned)cntl[4 * F.tid + 2] << 32) | ((unsigned long long)(unsigned)cntl[4 * F.tid + 3] << 48);
            const unsigned long long o = __hip_atomic_fetch_add((unsigned long long*)(gcnt + 64 * F.tid), c, __ATOMIC_RELAXED, __HIP_MEMORY_SCOPE_AGENT);
            basel[4 * F.tid] = (int)(o & 0xffffu); basel[4 * F.tid + 1] = (int)((o >> 16) & 0xffffu); basel[4 * F.tid + 2] = (int)((o >> 32) & 0xffffu); basel[4 * F.tid + 3] = (int)(o >> 48); }
        __syncthreads();
        { LAS int* wc = lastf + 16;
          int me = 0, rin = 0;
          if (F.tid < 256) { me = ael[F.tid]; int wcount = 0;
#pragma unroll 1
              for (int e = 0; e < 16; ++e) { const unsigned long long m = __ballot(me == e); const int below = (int)__builtin_amdgcn_mbcnt_hi((unsigned)(m >> 32), __builtin_amdgcn_mbcnt_lo((unsigned)m, 0u));
                  if (me == e) rin = below; if (F.lane == e) wcount = __popcll(m); }
              if (F.lane < 16) wc[F.wave * 16 + F.lane] = wcount; }
          __syncthreads();
          if (F.tid < 256) { int rank = rin; for (int w = 0; w < 3; ++w) if (w < F.wave) rank += wc[w * 16 + me];
              const int off = basel[me] + rank, token = it * 128 + (F.tid >> 1); pos[token * 2 + (F.tid & 1)] = off; inv[me * INV_CAP + off] = token; } }
        __syncthreads();
    }
}
__device__ __forceinline__ void p_positions(const Frame& F, const Params& P) {
    unsigned char* ws = P.ws;
    LAS int* part = (LAS int*)F.lds;
    LAS int* tot = part + 512; LAS int* pre = tot + 16; LAS int* start = pre + 16  ; LAS int* ae = start + 32  ; LAS int* inpart = ae + 256  ;
    const int* cnt = (const int*)(ws + WS_CNT); const int* route_e = (const int*)(ws + WS_ROUTE_E); int* pos = (int*)(ws + WS_POS); int* tile_e = (int*)(ws + WS_TILE); int* inv = (int*)(ws + WS_INV);
    for (int it = F.vcu; it < 256; it += F.G) {
        { const int e = F.tid & 15, pt = F.tid >> 4; int s = 0, pp = 0;
#pragma unroll
            for (int c = 0; c < 8; ++c) { const int v = cnt[(pt * 8 + c) * 16 + e]; s += v; if (pt * 8 + c < it) pp += v; }
            part[pt * 16 + e] = s; if (pt == (it >> 3)) inpart[e] = pp; }
        __syncthreads();
        if (F.tid < 16) { const int e = F.tid; int s = 0, p = 0;
            for (int q = 0; q < 32; ++q) { const int v = part[q * 16 + e]; s += v; if (q < (it >> 3)) p += v; }
            tot[e] = s; pre[e] = p + inpart[e]; }
        __syncthreads();
        if (F.tid == 0) { int s = 0; for (int e = 0; e < 16; ++e) { start[e] = s; s += (tot[e] + 255) & ~255; } start[16] = s; }
        if (F.tid < 256) { const int token = it * 128 + (F.tid >> 1); ae[F.tid] = (route_e[token] >> (8 * (F.tid & 1))) & 0xff; }
        __syncthreads();
        if (F.tid < 256) { const int me = ae[F.tid]; int rank = 0; for (int a = 0; a < F.tid; ++a) rank += (ae[a] == me) ? 1 : 0;
            const int p = start[me] + pre[me] + rank, token = it * 128 + (F.tid >> 1); pos[token * 2 + (F.tid & 1)] = p; inv[p] = token; }
        if (it < 16) { const int e = it; for (int p = start[e] + tot[e] + F.tid; p < start[e + 1]; p += 512) inv[p] = 0; }
        if (it == 0) { if (F.tid < MAXT) { const int r = F.tid * 256; int e = 15; for (int k = 15; k >= 0; --k) if (r < start[k + 1]) e = k; tile_e[F.tid] = e; } if (F.tid == 0) tile_e[511] = start[16] >> 8; }
        __syncthreads();
    }
}
struct Raw3 { v4u h[2]; v2u ya[2], yb[2]; f32x2 rw; };
template <bool FINAL> __device__ __forceinline__ void p9_fill_mv(const Frame& F, const Params& P, int layer, int it, int t) {
    unsigned char* ws = P.ws; LAS float* MV = (LAS float*)F.lds;
    const float* lng = P.in[I_LNFG] + layer * D; const float* lnb = P.in[I_LNFB] + layer * D;
    const int b = (it * 128) / T; const float* cb = (const float*)(ws + WS_COND) + ((size_t)layer * 16 + b) * 6144; const float* cbn = FINAL ? nullptr : (const float*)(ws + WS_COND) + ((size_t)(layer + 1) * 16 + b) * 6144;
        if (t < 256) { const int col = 4 * t, s = slot8(col); const f32x4 sh = *(const f32x4*)(cb + 3072 + col), sc1 = *(const f32x4*)(cb + 4096 + col) + 1.0f;
            f32x4 a; a[0] = DN_ALPHA / sc1[0]; a[1] = DN_ALPHA / sc1[1]; a[2] = DN_ALPHA / sc1[2]; a[3] = DN_ALPHA / sc1[3];
            const f32x4 g = *(const f32x4*)(lng + col), bb = *(const f32x4*)(lnb + col);
            *(LAS f32x4*)(MV + s) = a; *(LAS f32x4*)(MV + 1024 + s) = -sh * a; *(LAS f32x4*)(MV + 2048 + s) = *(const f32x4*)(cb + 5120 + col) + 1.0f;
            if (cbn) { const f32x4 so = *(const f32x4*)(cbn + 1024 + col) + 1.0f; *(LAS f32x4*)(MV + 3072 + s) = g * so; *(LAS f32x4*)(MV + 4096 + s) = bb * so + *(const f32x4*)(cbn + col); }
            else { *(LAS f32x4*)(MV + 3072 + s) = g; *(LAS f32x4*)(MV + 4096 + s) = bb; } }
}
template <bool FINAL> __device__ __forceinline__ void p_combine_ln(const Frame& F, const Params& P, int layer, const unsigned char* Ys, bf16* H, bf16* Hout, unsigned char* H8, float* out  , bool pre) {
    unsigned char* ws = P.ws;
    LAS float* MV = (LAS float*)F.lds;
    const float* lng = P.in[I_LNFG] + layer * D; const float* lnb = P.in[I_LNFB] + layer * D;
    const int* pos = (const int*)(ws + WS_POS); const f32x2* route_w = (const f32x2*)(ws + WS_ROUTE_W);
    for (int it = F.vcu; it < 256; it += F.G) {
        const int r0 = it * 128 + F.wave * 16, b = r0 / T; const float* cb = (const float*)(ws + WS_COND) + ((size_t)layer * 16 + b) * 6144; const float* cbn = FINAL ? nullptr : (const float*)(ws + WS_COND) + ((size_t)(layer + 1) * 16 + b) * 6144;
        const int pv = pos[2 * r0 + (F.lane & 31)] + ((const LAS int*)(F.lds + 20480))[(((const int*)(ws + WS_ROUTE_E))[r0 + ((F.lane & 31) >> 1)] >> (8 * (F.lane & 1))) & 0xff];
        const f32x2 rwv = route_w[r0 + (F.lane & 15)];
#define ROWP(i_, p0_, p1_, rw_) const int p0_ = __shfl(pv, 2 * (i_)), p1_ = __shfl(pv, 2 * (i_) + 1); const f32x2 rw_ = (f32x2){__shfl(rwv[0], (i_)) * 0.0625f, __shfl(rwv[1], (i_)) * 0.0625f}
#define LD_ROW3(dst, r, p0_, p1_, rw_) do { (dst).rw = (rw_); _Pragma("unroll") for (int j = 0; j < 2; ++j) { const int col = 8 * F.lane + 512 * j; \
            (dst).h[j] = __builtin_nontemporal_load((const v4u*)(H + (size_t)(r) * D + col)); (dst).ya[j] = __builtin_nontemporal_load((const v2u*)(Ys + (size_t)(p0_) * D + col)); (dst).yb[j] = __builtin_nontemporal_load((const v2u*)(Ys + (size_t)(p1_) * D + col)); } } while (0)
        Raw3 rb[4];
        if (!(pre && it == F.vcu)) p9_fill_mv<FINAL>(F, P, layer, it, F.tid);
        if (!pre && it == F.vcu) p9_fill_start((unsigned*)(ws + WS_CTL) + CW_MOE + layer * 2048, (LAS int*)(F.lds + 20480), F.tid);
        __syncthreads();
#define P9_T(buf, t) _Pragma("unroll") for (int q = 0; q < 4; ++q) { const v4u hw = (buf).h[q >> 1]; const v2u aw_ = (buf).ya[q >> 1], bw_ = (buf).yb[q >> 1]; \
                const v2u h2 = (q & 1) ? (v2u){hw.z, hw.w} : (v2u){hw.x, hw.y}; const unsigned a1 = (q & 1) ? aw_.y : aw_.x, b1 = (q & 1) ? bw_.y : bw_.x; \
                const int s = 256 * q + 4 * F.lane; t.v[q] = up4(h2) * *(const LAS f32x4*)(MV + s) + *(const LAS f32x4*)(MV + 1024 + s) + *(const LAS f32x4*)(MV + 2048 + s) * (up4f8(a1) * (buf).rw[0] + up4f8(b1) * (buf).rw[1]); }
#define P9_OUT(t, r, mn, rstd) do { \
            if constexpr (FINAL) { _Pragma("unroll") for (int q = 0; q < 4; ++q) { const int s = 256 * q + 4 * F.lane; *(f32x4*)(out + (size_t)(r) * D + COL8(q)) = (t.v[q] - mn) * rstd * *(const LAS f32x4*)(MV + 3072 + s) + *(const LAS f32x4*)(MV + 4096 + s); } } \
            else { unsigned ow[8], o8[4]; _Pragma("unroll") for (int q = 0; q < 4; ++q) { const int s = 256 * q + 4 * F.lane; const f32x4 o = (t.v[q] - mn) * rstd * *(const LAS f32x4*)(MV + 3072 + s) + *(const LAS f32x4*)(MV + 4096 + s); ow[2 * q] = pk2(o[0], o[1]); ow[2 * q + 1] = pk2(o[2], o[3]); o8[q] = pg8::pk_fp8x4(o[0], o[1], o[2], o[3]); } \
                *(v4u*)pair_addr(H8 + (size_t)(r) * D + 8 * F.lane, H8 + (size_t)(r) * D + 8 * F.lane + 512, F.lane) = pair_join((v2u){o8[0], o8[1]}, (v2u){o8[2], o8[3]}, F.lane);     \
                *(v4u*)(Hout + (size_t)(r) * D + 8 * F.lane) = (v4u){ow[0], ow[1], ow[2], ow[3]}; *(v4u*)(Hout + (size_t)(r) * D + 8 * F.lane + 512) = (v4u){ow[4], ow[5], ow[6], ow[7]}; } } while (0)
#define P9_PAIR(bA, bB, ii) do { RowVec tA, tB; P9_T(bA, tA) P9_T(bB, tB) \
            float sA_ = 0.f, qA_ = 0.f, sB_ = 0.f, qB_ = 0.f; \
            _Pragma("unroll") for (int q = 0; q < 4; ++q) { const f32x4 xa = tA.v[q], xb = tB.v[q]; sA_ += (xa[0] + xa[1]) + (xa[2] + xa[3]); qA_ += (xa[0] * xa[0] + xa[1] * xa[1]) + (xa[2] * xa[2] + xa[3] * xa[3]); \
                sB_ += (xb[0] + xb[1]) + (xb[2] + xb[3]); qB_ += (xb[0] * xb[0] + xb[1] * xb[1]) + (xb[2] * xb[2] + xb[3] * xb[3]); } \
            float tsA, tqA, tsB, tqB; wave_sum4(sA_, qA_, sB_, qB_, tsA, tqA, tsB, tqB, F.lane); \
            const float mnA = tsA * (1.0f / D), mnB = tsB * (1.0f / D); const float rsA = 1.0f / sqrtf(fmaxf(tqA * (1.0f / D) - mnA * mnA, 0.f) + LN_EPS), rsB = 1.0f / sqrtf(fmaxf(tqB * (1.0f / D) - mnB * mnB, 0.f) + LN_EPS); \
            P9_OUT(tA, r0 + (ii), mnA, rsA); P9_OUT(tB, r0 + (ii) + 1, mnB, rsB); } while (0)
        for (int i = 0; i < 16; i += 4) {
            { ROWP(i, a0, a1, aw); LD_ROW3(rb[0], r0 + i, a0, a1, aw); } { ROWP(i + 1, a0, a1, aw); LD_ROW3(rb[1], r0 + i + 1, a0, a1, aw); }
            { ROWP(i + 2, a0, a1, aw); LD_ROW3(rb[2], r0 + i + 2, a0, a1, aw); } { ROWP(i + 3, a0, a1, aw); LD_ROW3(rb[3], r0 + i + 3, a0, a1, aw); }
            P9_PAIR(rb[0], rb[1], i); __builtin_amdgcn_sched_barrier(0); P9_PAIR(rb[2], rb[3], i + 2); __builtin_amdgcn_sched_barrier(0); }
#undef P9_PAIR
#undef P9_OUT
#undef P9_T
#undef LD_ROW3
#undef ROWP
        __syncthreads();
    }
}
__device__ __forceinline__ void p_kmean(const Frame& F, const bf16* K, float* kmean) {
    const int gw = F.vcu * NWAVES + F.wave, NGW = F.G * NWAVES;
    for (int it = gw; it < 1024; it += NGW) { const int b = it >> 6, blk = (it >> 3) & 7, h = it & 7;
        const bf16* kp = K + (size_t)(b * T + blk * 256) * D + h * 128 + 2 * F.lane; float s0 = 0.f, s1 = 0.f;
#pragma unroll 8
        for (int r = 0; r < 256; ++r) { const unsigned w = *(const unsigned*)(kp + (size_t)r * D); s0 += bflo(w); s1 += bfhi(w); }
        *(f32x2*)(kmean + ((size_t)(b * 8 + h) * 8 + blk) * 128 + 2 * F.lane) = (f32x2){s0 * (1.0f / 256.0f), s1 * (1.0f / 256.0f)}; }
}
__device__ __forceinline__ void p_gate(const Frame& F, const bf16* Q, const float* kmean, unsigned char* sel) {
    LAS float* km = (LAS float*)F.lds;
    for (int it = F.vcu; it < 1024; it += F.G) { const int b = it >> 6, qb = (it >> 3) & 7, h = it & 7;
        const int tl = F.tid >> 1, half = F.tid & 1; const size_t row = (size_t)b * T + qb * 256 + tl;
        if (qb < 4) { if (half == 0) sel[row * 8 + h] = (unsigned char)((1u << qb) - 1u); continue; }
        for (int i = F.tid; i < qb * 128; i += 512) km[i] = kmean[((size_t)(b * 8 + h) * 8) * 128 + i];
        __syncthreads();
        float gt[7];
#pragma unroll
        for (int n = 0; n < 7; ++n) gt[n] = 0.f;
        const bf16* qp = Q + row * D + h * 128 + half * 64;
#pragma unroll
        for (int c8 = 0; c8 < 8; ++c8) { const v4u raw = *(const v4u*)(qp + 8 * c8);
            const float qv[8] = {bflo(raw.x), bfhi(raw.x), bflo(raw.y), bfhi(raw.y), bflo(raw.z), bfhi(raw.z), bflo(raw.w), bfhi(raw.w)};
#pragma unroll
            for (int n = 0; n < 7; ++n) if (n < qb) { const LAS f32x4* kk = (const LAS f32x4*)(km + n * 128 + half * 64 + 8 * c8); const f32x4 k0 = kk[0], k1 = kk[1];
                gt[n] += (qv[0] * k0[0] + qv[1] * k0[1]) + (qv[2] * k0[2] + qv[3] * k0[3]) + (qv[4] * k1[0] + qv[5] * k1[1]) + (qv[6] * k1[2] + qv[7] * k1[3]); } }
        unsigned mask = 0u;
#pragma unroll
        for (int n = 0; n < 7; ++n) gt[n] += __shfl_xor(gt[n], 1);
#pragma unroll
        for (int pick = 0; pick < 3; ++pick) { int bi = -1; float bv = -__builtin_inff();
#pragma unroll
            for (int n = 0; n < 7; ++n) if (n < qb && !((mask >> n) & 1u) && gt[n] > bv) { bv = gt[n]; bi = n; }
            if (bi >= 0) mask |= 1u << bi; }
        if (half == 0) sel[row * 8 + h] = (unsigned char)mask;
        __syncthreads();
    }
}
__device__ __forceinline__ att::BlockRef att_ref(int L, int pass, const bf16* Q, const unsigned char* Q8, const unsigned char* K8, const unsigned char* V8, unsigned char* O, const float* kmean, bool lmap) {
    const int v_ = L & 255, bh = lmap ? ((2 * (v_ >> 5) + (L >> 8)) * 8 + ((v_ >> 2) & 7)) : (L >> 2), x = L & 3, qb = pass ? 7 - x : x, b = bh >> 3, h = bh & 7; const size_t base = (size_t)b * T * D + h * 128;
    att::BlockRef r; r.Q = Q + base + (size_t)qb * 256 * D; r.Q8 = Q8 + base + (size_t)qb * 256 * D; r.O = O + base + (size_t)qb * 256 * D; r.K8 = K8 + base; r.V8 = V8 + base; r.Kmean = kmean + (size_t)bh * 8 * 128; r.P0 = qb * 256; return r;
}
__device__ __forceinline__ void p_attention(const Frame& F, const bf16* Q, const unsigned char* Q8, const unsigned char* K8, const unsigned char* V8, unsigned char* O, const float* sel, bool lmap) {
    constexpr int total = 512; int L = F.vcu; if (L >= total) return; int pass = 0;
    att::BlockRef cur = att_ref(L, 0, Q, Q8, K8, V8, O, sel, lmap); att::Seam S;
    att::moba_prime(cur, (char*)F.lds, S);
    for (;;) {
        const bool more_pass = pass == 0, more_item = L + F.G < total, last = !more_pass && !more_item;
        int passn = pass + 1, Ln = L; if (!more_pass) { passn = 0; Ln = more_item ? L + F.G : L; }
        const att::BlockRef nxt = last ? cur : att_ref(Ln, passn, Q, Q8, K8, V8, O, sel, lmap);
        att::moba_block(cur, nxt, (char*)F.lds, S);
        if (last) break;
        cur = nxt; pass = passn; L = Ln;
    }
}
constexpr int RING_BYTES = 131072, LDSCTL_OFF = RING_BYTES, MISC_OFF = LDSCTL_OFF + 320, LDS_BYTES = 147456;
constexpr int NPHASE = 20;
#ifndef NO_SGU
#define SGU_CALL p_sgu_item(F, P, it, U, V, YC);
#else
#define SGU_CALL
#endif
#ifndef NO_CONV
#define CONV_CALL p_conv_item(F, P, ci, (ci + cstep < cend) ? ci + cstep : -1, Gb, YC, cv, cc);
#else
#define CONV_CALL
#endif
#ifndef PROBE_DUP
#define PROBE_DUP 0u
#endif
#define DUP(k) (((PROBE_DUP) >> (k)) & 1u)
#define RUN(k, ...) do { __VA_ARGS__ if (DUP(k)) { __VA_ARGS__ } } while (0)
#if MK_ONE_LAUNCH
#define GRID_BAR() xcd_barrier(bar)
#define GRID_BAR_OV(...) xcd_barrier_ov(bar, [&]() { __VA_ARGS__ })
#define SEAM_BAR_OV(s, ...) do { if (local_ok) local_barrier_ov(bar.bar, (unsigned*)(ws + WS_CTL) + CW_LBAR + (s) * 512 + (F.vcu >> 5) * 64, 32u, [&]() { __VA_ARGS__ }); else xcd_barrier_ov(bar, [&]() { __VA_ARGS__ }); } while (0)
#define SEAM_BAR(s) SEAM_BAR_OV(s, )
#else
#define GRID_BAR() do { } while (0)
#define GRID_BAR_OV(...) do { } while (0)
#define SEAM_BAR_OV(s, ...) do { } while (0)
#define SEAM_BAR(s) do { } while (0)
#endif
template <int LAYER, int pbase>
__device__ __forceinline__ void moe_phases(const Frame& F, const Params& P, XcdBarrier& bar, int lo, int hi, const bf16* Ymix, float* out_final) {
    unsigned char* ws = P.ws;
    bf16* H = (bf16*)(ws + WS_H); unsigned char* YS = ws + WS_BIG;   unsigned char* HID = (unsigned char*)P.out; unsigned char* H8 = ws + WS_H8;
    LAS int* tl = (LAS int*)(F.lds + LDSCTL_OFF + 8192);
    unsigned* gcnt = (unsigned*)(ws + WS_CTL) + CW_MOE + LAYER * 2048;
#ifdef PH_SEL
#define IN(k) ((k) == PH_SEL && lo <= (k) && (k) < hi)
#else
#define IN(k) (lo <= (k) && (k) < hi)
#endif
#define BOTH(k) (IN(k) && IN((k) + 1))
    if (IN(pbase + 0)) { p_ln_route<LAYER == 1>(F, P, LAYER, Ymix, H, H, H8, MK_ONE_LAUNCH && IN(pbase - 1)); if (BOTH(pbase + 0)) GRID_BAR(); }
    if (IN(pbase + 2)) {
        moe_table(F, gcnt, tl); const int nt = __builtin_amdgcn_readfirstlane(tl[32]) >> 8;
        pg8::Gemm g{(const bf16*)H8, (const bf16*)(ws + WS_WGU + (size_t)LAYER * NEXP * 1024 * 1024), MSORT, 1024, 1024}; pg8::GroupedOrder<true> S; S.init(tl + 64, nt, 4, F.G, (int)blockIdx.x, (size_t)1024 * 1024); S.stage_rows((const int*)(ws + WS_INV), INV_CAP, tl + 16, tl, (LAS int*)(F.lds + LDSCTL_OFF + 1024));
        pg8::EpiSwiGLU8 E{HID};
        RUN(pbase + 2, pg8::gemm_phase<pg8::EpiSwiGLU8, pg8::GroupedOrder<true>, true, true, true>(F.lds, g, S, E););
        if (LAYER == 0) { const int nfull = S.nwg % F.G; if (nfull == 0) bg_convert(F, P, S.c, F.G, 0, 8192); else if (S.c >= nfull) bg_convert(F, P, S.c - nfull, F.G - nfull, 0, 8192); }
        if (BOTH(pbase + 2)) { if (MK_ONE_LAUNCH && (F.G & 3) == 0) group4_barrier(bar.bar, (unsigned*)(ws + WS_CTL) + CW_GBAR + LAYER * 4096 + (F.vcu >> 2) * 64, (unsigned*)(ws + WS_CTL) + CW_XMAP + (F.vcu & ~3)); else GRID_BAR(); } }
    if (IN(pbase + 3)) {
        if (!(MK_ONE_LAUNCH && IN(pbase + 2))) moe_table(F, gcnt, tl);
        const int nt = __builtin_amdgcn_readfirstlane(tl[32]) >> 8;
        pg8::Gemm g{(const bf16*)HID, (const bf16*)(ws + WS_WD + (size_t)LAYER * NEXP * 1024 * 512), MSORT, 1024, 512}; pg8::GroupedOrder<false> S; S.init(tl + 64, nt, 4, F.G, (int)blockIdx.x, (size_t)1024 * 512);
        pg8::EpiYsF8 E{YS, pg8::W8INV * 16.0f};
        RUN(pbase + 3, pg8::gemm_phase<pg8::EpiYsF8, pg8::GroupedOrder<false>, true, true, true>(F.lds, g, S, E););
        if (LAYER == 0) { const int nfull = S.nwg % F.G; if (nfull == 0) bg_convert(F, P, S.c, F.G, 8192, 12288); else if (S.c >= nfull) bg_convert(F, P, S.c - nfull, F.G - nfull, 8192, 12288); }
        if (BOTH(pbase + 3)) GRID_BAR_OV(p9_fill_mv<LAYER == 1>(F, P, LAYER, F.vcu, F.tid - 64); p9_fill_start(gcnt, (LAS int*)(F.lds + 20480), F.tid - 320););     }
    if (IN(pbase + 4)) { p_combine_ln<LAYER == 1>(F, P, LAYER, YS, H, H, H8, out_final, MK_ONE_LAUNCH && IN(pbase + 3)); if (BOTH(pbase + 4)) GRID_BAR(); }
#undef IN
#undef BOTH
}
__global__ void __launch_bounds__(NWAVES * 64, 2) fwd_kernel(Params P) {
    extern __shared__ __attribute__((aligned(16))) unsigned char lds_raw[];
    Frame F; F.lds = (LAS unsigned char*)lds_raw;
    F.tid = threadIdx.x; F.lane = F.tid & 63; F.wave = __builtin_amdgcn_readfirstlane(F.tid >> 6);
    F.G = gridDim.x; { const int bx = blockIdx.x; F.vcu = (F.G % 8 == 0) ? (bx % 8) * (F.G / 8) + bx / 8 : bx; }
    unsigned char* ws = P.ws;
    volatile LAS unsigned* MISC = (volatile LAS unsigned*)(F.lds + MISC_OFF);
    for (int u = F.tid; u < (LDS_BYTES - LDSCTL_OFF) / 4; u += NWAVES * 64) ((LAS unsigned*)(F.lds + LDSCTL_OFF))[u] = 0u;
    __syncthreads();
    XcdBarrier bar; bar.bar = (unsigned*)(ws + WS_CTL) + CW_BAR; bar.x = 0; bar.st = nullptr;
#if MK_ONE_LAUNCH
    bar = xcd_barrier_post((unsigned*)(ws + WS_CTL) + CW_BAR, MISC + 8);
    if (F.tid == 0) __hip_atomic_store((unsigned*)(ws + WS_CTL) + CW_XMAP + F.vcu, xb_xcc_id() + 1u, __ATOMIC_RELAXED, __HIP_MEMORY_SCOPE_AGENT);
#endif
    const int lo = P.ph_lo, hi = P.ph_hi;
#ifdef PH_SEL
#define IN(k) ((k) == PH_SEL && lo <= (k) && (k) < hi)
#else
#define IN(k) (lo <= (k) && (k) < hi)
#endif
#define BOTH(k) (IN(k) && IN((k) + 1))
    float* cond = (float*)(ws + WS_COND); bf16* H = (bf16*)(ws + WS_H);
    unsigned char* big = ws + WS_BIG;
    if (IN(0)) { RUN(0, p0_cond(F, P.in[I_C], P.in[I_ADAW], P.in[I_ADAB], cond); p0_weights(F, P); __syncthreads();); if (BOTH(0)) GRID_BAR(); }
    bool local_ok = false;
#if MK_ONE_LAUNCH
    if (lo == 0 && hi >= 20 && F.G == 256) { if (F.tid == 0) MISC[16] = 1u; __syncthreads();
        if (F.tid < 256) { unsigned* xm = (unsigned*)(ws + WS_CTL) + CW_XMAP; const unsigned a = xb_ld(xm + F.tid), b = xb_ld(xm + (F.tid & ~31)); if (a == 0u || a != b) MISC[16] = 0u; }
        __syncthreads(); local_ok = __builtin_amdgcn_readfirstlane((int)MISC[16]) != 0; }
#endif
    if (IN(1)) { RUN(1, p_modulate(F, P.in[I_X], cond, 0, H);); if (BOTH(1)) SEAM_BAR(0); }
    if (IN(2)) { bf16* U = (bf16*)big; bf16* V = (bf16*)(big + 32 * MiB); bf16* Gb = (bf16*)(big + 64 * MiB);
        pg8::Gemm g{H, (const bf16*)(ws + WS_WIN), M, 2048, 1024}; pg8::StaticOrder S; S.init(M, 2048, F.G, (int)blockIdx.x);
        pg8::EpiIn E{U, V, Gb};
        RUN(2, pg8::gemm_phase<pg8::EpiIn, pg8::StaticOrder, true, true>(F.lds, g, S, E););
        if (BOTH(2)) SEAM_BAR(1); }
    if (IN(3)) { const bf16* U = (const bf16*)big; const bf16* V = (const bf16*)(big + 32 * MiB); const bf16* Gb = (const bf16*)(big + 64 * MiB); bf16* YC = (bf16*)(big + 96 * MiB);
        RUN(20, for (int it = F.vcu; it < 256; it += F.G) { SGU_CALL }); RUN(21, { v4u cv[8]; ConvConst cc; conv_const(F, P, cc); const int cstep = local_ok ? 1 : F.G, c0 = local_ok ? 4 * F.vcu : F.vcu, cend = local_ok ? 4 * F.vcu + 4 : 1024;
            if (c0 < cend) conv_load(F, c0, Gb, cv); for (int ci = c0; ci < cend; ci += cstep) { CONV_CALL } });
        if (BOTH(3)) SEAM_BAR(2); }
    if (IN(4)) { const bf16* YC = (const bf16*)(big + 96 * MiB); bf16* YM = (bf16*)(ws + WS_XA);
        pg8::Gemm g{YC, (const bf16*)(ws + WS_WOUT), M, 1024, 1024}; pg8::StaticOrder S; S.init(M, 1024, F.G, (int)blockIdx.x);
        pg8::EpiBf16<0> E{YM, 1024, nullptr, 0, 0, 1.f};
        RUN(4, pg8::gemm_phase<pg8::EpiBf16<0>, pg8::StaticOrder, true, true>(F.lds, g, S, E););
        if (BOTH(4)) SEAM_BAR_OV(3, p5_fill_w(F, P, 0, F.tid - 64, 448); p5_fill_mv(F, P, 0, F.vcu, F.tid - 64);); }
    moe_phases<0, 5>(F, P, bar, lo, hi, (const bf16*)(ws + WS_XA), nullptr);
    bf16* Qb = (bf16*)big; unsigned char* Q8b = big + 64 * MiB; unsigned char* K8b = big + 96 * MiB; unsigned char* V8b = big + 128 * MiB;
    if (IN(10)) { pg8::Gemm g{(const bf16*)(ws + WS_H8), (const bf16*)(ws + WS_WQKV), M, 3072, 1024};
        pg8::StaticOrder S; S.init(M, 3072, F.G, (int)blockIdx.x);
        pg8::EpiQKV E{Qb, (size_t)M * D, (float*)(ws + WS_KMEAN), Q8b};
        RUN(10, pg8::gemm_phase<pg8::EpiQKV, pg8::StaticOrder, true, true, true>(F.lds, g, S, E););
        if (BOTH(10)) SEAM_BAR(4); }
    if (IN(13)) { RUN(13, p_attention(F, Qb, Q8b, K8b, V8b, ws + WS_XA  , (const float*)(ws + WS_KMEAN), local_ok);); if (BOTH(13)) SEAM_BAR(5); }
    if (IN(14)) { bf16* YM = (bf16*)(ws + WS_XA + 32 * MiB);
        pg8::Gemm g{(const bf16*)(ws + WS_XA), (const bf16*)(ws + WS_WO2), M, 1024, 1024}; pg8::StaticOrder S; S.init(M, 1024, F.G, (int)blockIdx.x);
        pg8::EpiYsF8 E{(unsigned char*)YM, pg8::W8INV * (1.0f / 16.0f) * 64.0f};
        RUN(14, pg8::gemm_phase<pg8::EpiYsF8, pg8::StaticOrder, true, true, true>(F.lds, g, S, E););
        if (BOTH(14)) SEAM_BAR_OV(6, p5_fill_w(F, P, 1, F.tid - 64, 448); p5_fill_mv(F, P, 1, F.vcu, F.tid - 64);); }
    moe_phases<1, 15>(F, P, bar, lo, hi, (const bf16*)(ws + WS_XA + 32 * MiB), P.out);
#undef IN
#undef BOTH
}

extern "C" void kernel_launch(void* const* d_in, const int* in_sizes, int n_in, void* d_out, int out_size, void* d_ws, size_t ws_size, hipStream_t stream) {
    static int grid = 0;
    if (grid == 0) {
        if (n_in != 27 || in_sizes[0] != M * D || out_size != M * D || ws_size < WS_END) { fprintf(stderr, "kernel_launch: unexpected shapes (n_in %d, in0 %d, out %d, ws %zu); nothing launched\n", n_in, n_in > 0 ? in_sizes[0] : -1, out_size, ws_size); grid = -1; return; }
        int dev = 0, cus = 0, per_cu = 0;
        if (hipGetDevice(&dev) != hipSuccess || hipDeviceGetAttribute(&cus, hipDeviceAttributeMultiprocessorCount, dev) != hipSuccess) { grid = -1; return; }
        if (hipFuncSetAttribute((const void*)fwd_kernel, hipFuncAttributeMaxDynamicSharedMemorySize, LDS_BYTES) != hipSuccess) { fprintf(stderr, "kernel_launch: hipFuncSetAttribute failed\n"); grid = -1; return; }
        if (hipOccupancyMaxActiveBlocksPerMultiprocessor(&per_cu, (const void*)fwd_kernel, NWAVES * 64, LDS_BYTES) != hipSuccess || per_cu < 1) fprintf(stderr, "kernel_launch: occupancy query reports %d workgroups per CU\n", per_cu);
        (void)hipGetLastError();
        grid = cus;
    }
    if (grid < 0) return;
    if (hipMemsetAsync((char*)d_ws + WS_CTL, 0, CTL_ZERO_BYTES, stream) != hipSuccess) return;
    Params p{};
    for (int i = 0; i < 27; ++i) p.in[i] = (const float*)d_in[i];
    p.out = (float*)d_out; p.ws = (unsigned char*)d_ws;
#if MK_ONE_LAUNCH
    p.ph_lo = 0; p.ph_hi = NPHASE; p.li = 0;
    hipLaunchKernelGGL(fwd_kernel, dim3(grid), dim3(NWAVES * 64), LDS_BYTES, stream, p);
#else
    for (int k = 0; k < NPHASE; ++k) { p.ph_lo = k; p.ph_hi = k + 1; p.li = k; hipLaunchKernelGGL(fwd_kernel, dim3(grid), dim3(NWAVES * 64), LDS_BYTES, stream, p); }
#endif
}
```

```cpp
#include <hip/hip_runtime.h>
#include <cstdio>
#include <cstdint>
#ifndef MK_ONE_LAUNCH
#define MK_ONE_LAUNCH 1
#endif
namespace pg8 {
#define PG8_LAS __attribute__((address_space(3)))
typedef unsigned short bf16_t;
typedef short bf16x8 __attribute__((ext_vector_type(8)));
typedef float f32x4 __attribute__((ext_vector_type(4)));
typedef unsigned u32x4 __attribute__((ext_vector_type(4)));
typedef int i32x4 __attribute__((ext_vector_type(4)));
typedef int i32x8 __attribute__((ext_vector_type(8)));
constexpr int BM = 256, BK = 64, HALF = 128, HTB = HALF * BK * 2  , STAGE_BYTES = 8 * HTB, NXCD = 8, WGM = 8;

__host__ __device__ __forceinline__ int lds_byte(int r, int c) { const int st = (r >> 4) * 2 + (c >> 5), rr = r & 15, cc = c & 31, ob = rr * 64 + cc * 2; return st * 1024 + (ob ^ (((ob >> 9) & 1) << 5)); }
__host__ __device__ __forceinline__ void stage_rc(int b, int& R, int& C) { const int st = b / 1024, sb = b % 1024, swz = sb ^ (((sb >> 9) & 1) << 5); R = (st >> 1) * 16 + swz / 64; C = (st & 1) * 32 + (swz % 64) / 2; }
__host__ __device__ __forceinline__ int perm32(int rho) { const int n = rho >> 4, i = rho & 15; return 8 * (i >> 2) + 4 * n + (i & 3); }

struct Unit { int pm, pn; };
struct Gemm { const bf16_t* A; const bf16_t* Bt; int M, N, K; };

struct StaticOrder {
    static constexpr bool GATHER = false;
    __device__ __forceinline__ int rowof(const Unit&, int, int) const { return 0; }
    int nM, nN, nwg, G, c;
    __host__ __device__ void init(int M, int N, int G_, int c_) { nM = M / BM; nN = N / BM; nwg = nM * nN; G = G_; c = c_; }
    __host__ __device__ bool next(int i, Unit& u) const {
        const long L = (long)i * G + c; if (L >= nwg) return false;
        int wgid = (int)L; { const int q = nwg / NXCD, r = nwg % NXCD, xcd = wgid % NXCD, off = wgid / NXCD; wgid = (xcd < r ? xcd * (q + 1) : r * (q + 1) + (xcd - r) * q) + off; }
        const int nig = WGM * nN, gid = wgid / nig, fm = gid * WGM, gsz = (nM - fm) < WGM ? (nM - fm) : WGM;
        u.pm = fm + ((wgid % nig) % gsz); u.pn = (wgid % nig) / gsz; return true;
    }
    __device__ __forceinline__ void a_ready(const Unit&) const {}
    __device__ __forceinline__ const char* bptr(const Gemm& g, const Unit& u, size_t tstep) const { return (const char*)g.Bt + (size_t)u.pn * tstep; }
    __device__ __forceinline__ void done(const Unit&) const {}
};

__device__ __forceinline__ unsigned cvt_pk_bf16(float lo, float hi) { unsigned r; asm volatile("v_cvt_pk_bf16_f32 %0, %1, %2" : "=v"(r) : "v"(lo), "v"(hi)); return r; }
typedef float f32x2 __attribute__((ext_vector_type(2)));
__device__ __forceinline__ f32x2 gelu_pk(f32x2 v) {
    const f32x2 av = __builtin_elementwise_abs(v), d = av * 0.2316418882f + 1.0f;
    f32x2 t; t.x = __builtin_amdgcn_rcpf(d.x); t.y = __builtin_amdgcn_rcpf(d.y);
    f32x2 q = t * 0.5307027145f + (-0.7265760135f); q = q * t + 0.7107068705f; q = q * t + (-0.142248368f); q = q * t + 0.127414796f; q = q * t;
    const f32x2 s = (v * v) * (-0.72134752044f);
    f32x2 e; e.x = __builtin_amdgcn_exp2f(s.x); e.y = __builtin_amdgcn_exp2f(s.y);
    const f32x2 m = v * (q * e), r = v - m;
    f32x2 o; o.x = v.x < 0.f ? m.x : r.x; o.y = v.y < 0.f ? m.y : r.y; return o;
}

template <int ACT  > struct EpiBf16 {
    static constexpr bool PERM = true, AFTER_DRAIN = false; static_assert(ACT == 0 || ACT == 1, "EpiBf16: ACT is 0 (none) or 1 (gelu_pk)");
    bf16_t* O; int ldc; const float* bias; int split_cols; size_t split_stride; float scale0;
    __device__ __forceinline__ void operator()(const f32x4 (&acc)[2][2][4][2], const Unit& u, int wr, int wc, int fr, int fq) const {
        const int row0 = u.pm * BM + wr * 64 + fr; int colt = u.pn * BM; bf16_t* base = O;
        float sc = 1.f; if (split_cols) { const int t = colt / split_cols; base += (size_t)t * split_stride; colt -= t * split_cols; if (t == 0) sc = scale0; }
        const int col0 = colt + wc * 32 + 8 * fq, bcol0 = u.pn * BM + wc * 32 + 8 * fq;
        f32x4 bv[2][2];
#pragma unroll
        for (int bj = 0; bj < 2; ++bj)
#pragma unroll
            for (int n = 0; n < 2; ++n) bv[bj][n] = bias ? *(const f32x4*)(bias + bcol0 + bj * HALF + 4 * n) : (f32x4){0.f, 0.f, 0.f, 0.f};
#pragma unroll
        for (int ai = 0; ai < 2; ++ai)
#pragma unroll
            for (int m = 0; m < 4; ++m) { bf16_t* rowp = base + (size_t)(row0 + ai * HALF + m * 16) * ldc + col0;
#pragma unroll
                for (int bj = 0; bj < 2; ++bj) { f32x4 v0 = acc[ai][bj][m][0] + bv[bj][0], v1 = acc[ai][bj][m][1] + bv[bj][1];
                    if (ACT == 1) { f32x2 a = gelu_pk((f32x2){v0[0], v0[1]}), b = gelu_pk((f32x2){v0[2], v0[3]}), c = gelu_pk((f32x2){v1[0], v1[1]}), d = gelu_pk((f32x2){v1[2], v1[3]});
                        v0 = (f32x4){a.x, a.y, b.x, b.y}; v1 = (f32x4){c.x, c.y, d.x, d.y}; }
                    v0 = v0 * sc; v1 = v1 * sc; u32x4 w; w.x = cvt_pk_bf16(v0[0], v0[1]); w.y = cvt_pk_bf16(v0[2], v0[3]); w.z = cvt_pk_bf16(v1[0], v1[1]); w.w = cvt_pk_bf16(v1[2], v1[3]);
                    *(u32x4*)(rowp + bj * HALF) = w; } }
    }
};
template <class Epi, class Sched, bool ALIGN_EPI = false, bool SP2 = false, bool ELT8 = false>
__device__ __forceinline__ void gemm_phase(PG8_LAS unsigned char* lds, const Gemm g, const Sched& S, const Epi& E) {
    const int tid = threadIdx.x, wid = __builtin_amdgcn_readfirstlane(tid >> 6), lane = tid & 63, wr = wid >> 2, wc = wid & 3, fr = lane & 15, fq = lane >> 4;
    const int K = g.K, rowb = ELT8 ? K : 2 * K  , nt = rowb / (2 * BK);
    constexpr bool GATHER = Sched::GATHER; static_assert(!GATHER || SP2, "gathered A: SP2 loop only");
    unsigned voffA[2], voffB[2]; int gR[2]; unsigned gC2[2];
#pragma unroll
    for (int i = 0; i < 2; ++i) { int R, C; stage_rc(tid * 16 + i * 8192, R, C); const int Rb = Epi::PERM ? ((R & ~31) + perm32(R & 31)) : R;
        voffA[i] = (unsigned)(R * rowb + C * 2); voffB[i] = (unsigned)(Rb * rowb + C * 2); gR[i] = R; gC2[i] = (unsigned)C * 2u; }
    unsigned gc0[2] = {0u, 0u}, gc1[2] = {0u, 0u}, gn0[2] = {0u, 0u}, gn1[2] = {0u, 0u};
#define PG8_GOFF(dst0, dst1, u, ord) do { _Pragma("unroll") for (int _i = 0; _i < 2; ++_i) { dst0[_i] = (unsigned)S.rowof((u), (ord), gR[_i]) * (unsigned)rowb + gC2[_i]; dst1[_i] = (unsigned)S.rowof((u), (ord), HALF + gR[_i]) * (unsigned)rowb + gC2[_i]; } } while (0)
#define PG8_STAGE_A(bufoff, base, h, G0, G1) do { if constexpr (GATHER) { if constexpr ((h) != 0) PG8_STAGE(bufoff, base, G1); else PG8_STAGE(bufoff, base, G0); } else { PG8_STAGE(bufoff, (base) + (h) * hstep, voffA); } } while (0)
    const size_t kstep = (size_t)(BK * 2);
    const size_t hstep = (size_t)HALF * rowb;
    const size_t tstep = 2 * hstep;
    const unsigned ldsw = (unsigned)wid * 1024u;
    const int aoff = lds_byte(wr * 64 + fr, fq * 8), boff = lds_byte(wc * 32 + fr, fq * 8);
#define PG8_SA(b, h) (((b) * 2 + (h)) * HTB)
#define PG8_SB(b, h) ((4 + (b) * 2 + (h)) * HTB)
#define PG8_STAGE(bufoff, gbase, voff) do { _Pragma("unroll") for (int _i = 0; _i < 2; ++_i) \
        __builtin_amdgcn_global_load_lds((const unsigned*)((const char*)(gbase) + (voff)[_i]), (PG8_LAS unsigned*)(lds + (bufoff) + ldsw + _i * 8192), 16, 0, 0); } while (0)
#define PG8_RD16(off) (*(const PG8_LAS i32x4*)(lds + (off)))
#define PG8_LDA(dst, b, h) do { _Pragma("unroll") for (int m = 0; m < 4; ++m) { const i32x4 lo_ = PG8_RD16(PG8_SA(b, h) + aoff + m * 2048), hi_ = PG8_RD16(PG8_SA(b, h) + aoff + m * 2048 + 1024); dst[m] = __builtin_shufflevector(lo_, hi_, 0, 1, 2, 3, 4, 5, 6, 7); } } while (0)
#define PG8_LDB(dst, b, h) do { _Pragma("unroll") for (int n = 0; n < 2; ++n) { const i32x4 lo_ = PG8_RD16(PG8_SB(b, h) + boff + n * 2048), hi_ = PG8_RD16(PG8_SB(b, h) + boff + n * 2048 + 1024); dst[n] = __builtin_shufflevector(lo_, hi_, 0, 1, 2, 3, 4, 5, 6, 7); } } while (0)
#define PG8_MMA(ai, bj, At, Bt) do { __builtin_amdgcn_s_setprio(1); _Pragma("unroll") for (int m = 0; m < 4; ++m) _Pragma("unroll") for (int n = 0; n < 2; ++n) { \
        if constexpr (ELT8) { asm volatile("v_mfma_scale_f32_16x16x128_f8f6f4 %0, %1, %2, %0, %3, %3 op_sel_hi:[0,0,0]" : "+v"(acc[ai][bj][m][n]) : "v"(Bt[n]), "v"(At[m]), "v"(scale1)); }     \
        else { acc[ai][bj][m][n] = __builtin_amdgcn_mfma_f32_16x16x32_bf16(__builtin_bit_cast(bf16x8, __builtin_shufflevector(Bt[n], Bt[n], 0, 1, 2, 3)), __builtin_bit_cast(bf16x8, __builtin_shufflevector(At[m], At[m], 0, 1, 2, 3)), acc[ai][bj][m][n], 0, 0, 0); \
               acc[ai][bj][m][n] = __builtin_amdgcn_mfma_f32_16x16x32_bf16(__builtin_bit_cast(bf16x8, __builtin_shufflevector(Bt[n], Bt[n], 4, 5, 6, 7)), __builtin_bit_cast(bf16x8, __builtin_shufflevector(At[m], At[m], 4, 5, 6, 7)), acc[ai][bj][m][n], 0, 0, 0); } } \
        __builtin_amdgcn_s_setprio(0); } while (0)
#define PG8_WAIT_V(n) asm volatile("s_waitcnt vmcnt(" #n ")" ::: "memory")
#define PG8_WAIT_L(n) asm volatile("s_waitcnt lgkmcnt(" #n ")" ::: "memory")
#define PG8_BAR __builtin_amdgcn_s_barrier()
#define PG8_SCHED __builtin_amdgcn_sched_barrier(0)
    Unit cur, nxt; int ui = 0;
    if (!S.next(0, cur)) return;
    f32x4 acc[2][2][4][2];
#pragma unroll
    for (int a = 0; a < 2; ++a)
#pragma unroll
        for (int b = 0; b < 2; ++b)
#pragma unroll
            for (int m = 0; m < 4; ++m)
#pragma unroll
                for (int n = 0; n < 2; ++n) acc[a][b][m][n] = (f32x4){0.f, 0.f, 0.f, 0.f};
    const int scale1 = 0x7f7f7f7f;
    i32x8 At[4], B0[2], B1[2];
    const char* cA = GATHER ? (const char*)g.A : (const char*)g.A + (size_t)cur.pm * tstep; const char* cB = S.bptr(g, cur, tstep);
    if constexpr (GATHER) PG8_GOFF(gc0, gc1, cur, 0);
    S.a_ready(cur);
    if constexpr (SP2) {
        PG8_STAGE(PG8_SB(0, 0), cB, voffB); PG8_STAGE(PG8_SB(0, 1), cB + hstep, voffB); PG8_STAGE_A(PG8_SA(0, 0), cA, 0, gc0, gc1); PG8_STAGE_A(PG8_SA(0, 1), cA, 1, gc0, gc1);
        if (wr == 1) PG8_BAR;
        PG8_WAIT_V(2); PG8_BAR;
        PG8_STAGE(PG8_SB(1, 0), cB + kstep, voffB); PG8_STAGE_A(PG8_SA(1, 0), cA + kstep, 0, gc0, gc1); PG8_STAGE(PG8_SB(1, 1), cB + hstep + kstep, voffB);
        PG8_WAIT_V(6); PG8_BAR;
    } else {
        PG8_STAGE(PG8_SB(0, 0), cB, voffB); PG8_STAGE(PG8_SA(0, 0), cA, voffA); PG8_STAGE(PG8_SB(0, 1), cB + hstep, voffB); PG8_STAGE(PG8_SA(0, 1), cA + hstep, voffA);
        if (wr == 1) PG8_BAR;
        PG8_WAIT_V(4); PG8_BAR;
        PG8_STAGE(PG8_SB(1, 0), cB + kstep, voffB); PG8_STAGE(PG8_SA(1, 0), cA + kstep, voffA); PG8_STAGE(PG8_SB(1, 1), cB + hstep + kstep, voffB);
        PG8_WAIT_V(6); PG8_BAR;
    }
    for (;;) {
        const bool has_next = S.next(ui + 1, nxt);
        const char* nA = has_next ? (GATHER ? (const char*)g.A : (const char*)g.A + (size_t)nxt.pm * tstep) : cA; const char* nB = has_next ? S.bptr(g, nxt, tstep) : cB;
        if constexpr (GATHER) { if (has_next) PG8_GOFF(gn0, gn1, nxt, ui + 1); else { gn0[0] = gc0[0]; gn0[1] = gc0[1]; gn1[0] = gc1[0]; gn1[1] = gc1[1]; } }
#pragma unroll 1
        for (int t = 0; t < nt; t += 2) {
            const bool last = (t == nt - 2);
            const char* a1 = cA + (size_t)(t + 1) * kstep;
            const char* a2 = last ? nA : cA + (size_t)(t + 2) * kstep; const char* b2 = last ? nB : cB + (size_t)(t + 2) * kstep;
            const char* a3 = a2 + kstep; const char* b3 = b2 + kstep;
            if (last && has_next) S.a_ready(nxt);
            unsigned o20[2] = {0u, 0u}, o21[2] = {0u, 0u};
            if constexpr (GATHER) { o20[0] = last ? gn0[0] : gc0[0]; o20[1] = last ? gn0[1] : gc0[1]; o21[0] = last ? gn1[0] : gc1[0]; o21[1] = last ? gn1[1] : gc1[1]; }
            if constexpr (SP2) {
            PG8_LDB(B0, 0, 0); PG8_LDB(B1, 0, 1); PG8_SCHED; PG8_LDA(At, 0, 0); PG8_STAGE_A(PG8_SA(1, 1), a1, 1, gc0, gc1);
            PG8_WAIT_V(8); PG8_WAIT_L(0); PG8_BAR; PG8_MMA(0, 0, At, B0); PG8_MMA(0, 1, At, B1); PG8_BAR; PG8_SCHED;
            PG8_LDA(At, 0, 1); PG8_STAGE(PG8_SB(0, 0), b2, voffB); PG8_STAGE(PG8_SB(0, 1), b2 + hstep, voffB); PG8_STAGE_A(PG8_SA(0, 0), a2, 0, o20, o21);
            PG8_WAIT_V(8); PG8_WAIT_L(0); PG8_BAR; PG8_MMA(1, 0, At, B0); PG8_MMA(1, 1, At, B1); PG8_BAR; PG8_SCHED;
            PG8_LDB(B0, 1, 0); PG8_LDB(B1, 1, 1); PG8_SCHED; PG8_LDA(At, 1, 0); PG8_STAGE_A(PG8_SA(0, 1), a2, 1, o20, o21);
            PG8_WAIT_V(8); PG8_WAIT_L(0); PG8_BAR; PG8_MMA(0, 0, At, B0); PG8_MMA(0, 1, At, B1); PG8_BAR; PG8_SCHED;
            PG8_LDA(At, 1, 1); PG8_STAGE(PG8_SB(1, 0), b3, voffB); PG8_STAGE(PG8_SB(1, 1), b3 + hstep, voffB); PG8_STAGE_A(PG8_SA(1, 0), a3, 0, o20, o21);
            PG8_WAIT_V(8); PG8_WAIT_L(0); PG8_BAR; PG8_MMA(1, 0, At, B0); PG8_MMA(1, 1, At, B1); PG8_BAR; PG8_SCHED;
            } else {
            PG8_LDB(B0, 0, 0); PG8_SCHED; PG8_LDA(At, 0, 0); PG8_STAGE(PG8_SA(1, 1), a1 + hstep, voffA);
            PG8_WAIT_L(8); PG8_BAR; PG8_WAIT_L(0); PG8_MMA(0, 0, At, B0); PG8_BAR; PG8_SCHED;
            PG8_LDB(B1, 0, 1); PG8_STAGE(PG8_SB(0, 0), b2, voffB);
            PG8_BAR; PG8_WAIT_L(0); PG8_MMA(0, 1, At, B1); PG8_BAR;
            PG8_LDA(At, 0, 1); PG8_STAGE(PG8_SA(0, 0), a2, voffA);
            PG8_BAR; PG8_WAIT_L(0); PG8_MMA(1, 0, At, B0); PG8_BAR; PG8_SCHED;
            PG8_STAGE(PG8_SB(0, 1), b2 + hstep, voffB);
            PG8_WAIT_V(6); PG8_BAR; PG8_MMA(1, 1, At, B1); PG8_BAR;
            PG8_LDB(B0, 1, 0); PG8_SCHED; PG8_LDA(At, 1, 0); PG8_STAGE(PG8_SA(0, 1), a2 + hstep, voffA);
            PG8_WAIT_L(8); PG8_BAR; PG8_WAIT_L(0); PG8_MMA(0, 0, At, B0); PG8_BAR; PG8_SCHED;
            PG8_LDB(B1, 1, 1); PG8_STAGE(PG8_SB(1, 0), b3, voffB);
            PG8_BAR; PG8_WAIT_L(0); PG8_MMA(0, 1, At, B1); PG8_BAR;
            PG8_LDA(At, 1, 1); PG8_STAGE(PG8_SA(1, 0), a3, voffA);
            PG8_BAR; PG8_WAIT_L(0); PG8_MMA(1, 0, At, B0); PG8_BAR; PG8_SCHED;
            PG8_STAGE(PG8_SB(1, 1), b3 + hstep, voffB);
            PG8_WAIT_V(6); PG8_BAR; PG8_MMA(1, 1, At, B1); PG8_BAR;
            }
        }
        if constexpr (ALIGN_EPI) { if (wr == 0) PG8_BAR; }
        if constexpr (ELT8) asm volatile("s_nop 15\n\ts_nop 15" ::: "memory");
        if constexpr (!Epi::AFTER_DRAIN) { E(acc, cur, wr, wc, fr, fq); S.done(cur); }
        if (!has_next) break;
#pragma unroll
        for (int a = 0; a < 2; ++a)
#pragma unroll
            for (int b = 0; b < 2; ++b)
#pragma unroll
                for (int m = 0; m < 4; ++m)
#pragma unroll
                    for (int n = 0; n < 2; ++n) acc[a][b][m][n] = (f32x4){0.f, 0.f, 0.f, 0.f};
        cur = nxt; cA = nA; cB = nB; ++ui;
        if constexpr (GATHER) { gc0[0] = gn0[0]; gc0[1] = gn0[1]; gc1[0] = gn1[0]; gc1[1] = gn1[1]; }
        if constexpr (ALIGN_EPI) { if (wr == 1) PG8_BAR; }
    }
    PG8_WAIT_V(0);
    if constexpr (!ALIGN_EPI) { if (wr == 0) PG8_BAR; }
    PG8_BAR;
    if constexpr (Epi::AFTER_DRAIN) { E.fused(acc, cur, wr, wc, fr, fq, lds, wid, lane); S.done(cur); }
#undef PG8_SA
#undef PG8_SB
#undef PG8_STAGE
#undef PG8_STAGE_A
#undef PG8_GOFF
#undef PG8_LDA
#undef PG8_RD16
#undef PG8_LDB
#undef PG8_MMA
#undef PG8_WAIT_V
#undef PG8_WAIT_L
#undef PG8_BAR
#undef PG8_SCHED
}
}
namespace pg8 {
__device__ __forceinline__ float sigm(float v) { return __builtin_amdgcn_rcpf(1.0f + __builtin_amdgcn_exp2f(-1.4426950408889634f * v)); }
struct EpiIn {
    static constexpr bool PERM = true, AFTER_DRAIN = false;
    bf16_t* U; bf16_t* V; bf16_t* G;
    __device__ __forceinline__ void operator()(const f32x4 (&acc)[2][2][4][2], const Unit& u, int wr, int wc, int fr, int fq) const {
        const int row0 = u.pm * BM + wr * 64 + fr;
        if (u.pn < 4) {
            bf16_t* base = (u.pn < 2) ? U : V; const int col0 = (u.pn & 1) * 256 + wc * 32 + 8 * fq;
#pragma unroll
            for (int ai = 0; ai < 2; ++ai)
#pragma unroll
                for (int m = 0; m < 4; ++m) { bf16_t* rowp = base + (size_t)(row0 + ai * HALF + m * 16) * 512 + col0;
#pragma unroll
                    for (int bj = 0; bj < 2; ++bj) { f32x4 v0 = acc[ai][bj][m][0], v1 = acc[ai][bj][m][1];
                        f32x2 a = gelu_pk((f32x2){v0[0], v0[1]}), b = gelu_pk((f32x2){v0[2], v0[3]}), c = gelu_pk((f32x2){v1[0], v1[1]}), d = gelu_pk((f32x2){v1[2], v1[3]});
                        u32x4 w; w.x = cvt_pk_bf16(a.x, a.y); w.y = cvt_pk_bf16(b.x, b.y); w.z = cvt_pk_bf16(c.x, c.y); w.w = cvt_pk_bf16(d.x, d.y);
                        *(u32x4*)(rowp + bj * HALF) = w; } }
        } else {
            const int col0 = (u.pn - 4) * 128 + wc * 32 + 8 * fq;
#pragma unroll
            for (int ai = 0; ai < 2; ++ai)
#pragma unroll
                for (int m = 0; m < 4; ++m) { bf16_t* rowp = G + (size_t)(row0 + ai * HALF + m * 16) * 512 + col0;
                    const f32x4 a0 = acc[ai][0][m][0], a1 = acc[ai][0][m][1], g0 = acc[ai][1][m][0], g1 = acc[ai][1][m][1];
                    u32x4 w; w.x = cvt_pk_bf16(a0[0] * sigm(g0[0]), a0[1] * sigm(g0[1])); w.y = cvt_pk_bf16(a0[2] * sigm(g0[2]), a0[3] * sigm(g0[3]));
                    w.z = cvt_pk_bf16(a1[0] * sigm(g1[0]), a1[1] * sigm(g1[1])); w.w = cvt_pk_bf16(a1[2] * sigm(g1[2]), a1[3] * sigm(g1[3]));
                    *(u32x4*)rowp = w; }
        }
    }
};
__device__ __forceinline__ unsigned pk_fp8x4(float a, float b, float c, float d);
__device__ __forceinline__ void st8x2_wide(unsigned char* pa, unsigned ax, unsigned ay, unsigned char* pb, unsigned bx, unsigned by, int fq) {
    auto rx = __builtin_amdgcn_permlane16_swap(ax, bx, false, false); auto ry = __builtin_amdgcn_permlane16_swap(ay, by, false, false);
    const u32x4 w = {rx[0], ry[0], rx[1], ry[1]};
    *(u32x4*)((fq & 1) ? pb - 8 : pa) = w;
}
struct EpiQKV {
    static constexpr bool PERM = true, AFTER_DRAIN = false;
    bf16_t* Q; size_t tstride; float* kmean; static constexpr float sc = 0.03125f;
    unsigned char* QK8;
    __device__ __forceinline__ void operator()(const f32x4 (&acc)[2][2][4][2], const Unit& u, int wr, int wc, int fr, int fq) const {
        const int row0 = u.pm * BM + wr * 64 + fr; const int t = u.pn >> 2; bf16_t* base = Q + (size_t)t * tstride; const int col0 = (u.pn & 3) * 256 + wc * 32 + 8 * fq;
#pragma unroll
        for (int ai = 0; ai < 2; ++ai)
#pragma unroll
            for (int m = 0; m < 4; ++m) { bf16_t* rowp = base + (size_t)(row0 + ai * HALF + m * 16) * 1024 + col0; unsigned w8x[2], w8y[2];
#pragma unroll
                for (int bj = 0; bj < 2; ++bj) { const f32x4 v0 = acc[ai][bj][m][0] * sc, v1 = acc[ai][bj][m][1] * sc;
                    if (t == 0 && (u.pm & 4)) { u32x4 w; w.x = cvt_pk_bf16(v0[0], v0[1]);     w.y = cvt_pk_bf16(v0[2], v0[3]); w.z = cvt_pk_bf16(v1[0], v1[1]); w.w = cvt_pk_bf16(v1[2], v1[3]);
                        *(u32x4*)(rowp + bj * HALF) = w; }
                    w8x[bj] = pk_fp8x4(v0[0], v0[1], v0[2], v0[3]); w8y[bj] = pk_fp8x4(v1[0], v1[1], v1[2], v1[3]); }
                { unsigned char* p8 = QK8 + (size_t)t * ((size_t)32 << 20) + (size_t)(row0 + ai * HALF + m * 16) * 1024 + col0; st8x2_wide(p8, w8x[0], w8y[0], p8 + HALF, w8x[1], w8y[1], fq); } }
        if (t == 1) { const int b = u.pm >> 3, blk = u.pm & 7;
#pragma unroll
            for (int bj = 0; bj < 2; ++bj)
#pragma unroll
                for (int n = 0; n < 2; ++n) { f32x4 s = (f32x4){0.f, 0.f, 0.f, 0.f};
#pragma unroll
                    for (int ai = 0; ai < 2; ++ai)
#pragma unroll
                        for (int m = 0; m < 4; ++m) s += acc[ai][bj][m][n];
#pragma unroll
                    for (int j = 0; j < 4; ++j) { float v = s[j]; v += __shfl_xor(v, 1); v += __shfl_xor(v, 2); v += __shfl_xor(v, 4); v += __shfl_xor(v, 8); s[j] = v; }
                    if (fr == 0) { const int kc = (u.pn & 3) * 256 + bj * HALF + wc * 32 + 8 * fq + 4 * n, h = kc >> 7, d = kc & 127; float* kp = kmean + ((size_t)(b * 8 + h) * 8 + blk) * 128 + d;
#pragma unroll
                        for (int j = 0; j < 4; ++j) atomicAdd(kp + j, s[j] * (sc * (1.0f / 256.0f))); } }
        }
    }
};
struct EpiSwiGLU {
    static constexpr bool PERM = true, AFTER_DRAIN = false;
    bf16_t* Hid;
    __device__ __forceinline__ void operator()(const f32x4 (&acc)[2][2][4][2], const Unit& u, int wr, int wc, int fr, int fq) const {
        const int row0 = u.pm * BM + wr * 64 + fr, col0 = u.pn * 128 + wc * 32 + 8 * fq;
#pragma unroll
        for (int ai = 0; ai < 2; ++ai)
#pragma unroll
            for (int m = 0; m < 4; ++m) { bf16_t* rowp = Hid + (size_t)(row0 + ai * HALF + m * 16) * 512 + col0;
                const f32x4 g0 = acc[ai][0][m][0], g1 = acc[ai][0][m][1], u0 = acc[ai][1][m][0], u1 = acc[ai][1][m][1];
                u32x4 w; w.x = cvt_pk_bf16(g0[0] * sigm(g0[0]) * u0[0], g0[1] * sigm(g0[1]) * u0[1]); w.y = cvt_pk_bf16(g0[2] * sigm(g0[2]) * u0[2], g0[3] * sigm(g0[3]) * u0[3]);
                w.z = cvt_pk_bf16(g1[0] * sigm(g1[0]) * u1[0], g1[1] * sigm(g1[1]) * u1[1]); w.w = cvt_pk_bf16(g1[2] * sigm(g1[2]) * u1[2], g1[3] * sigm(g1[3]) * u1[3]);
                *(u32x4*)rowp = w; }
    }
};
constexpr float W8SCALE = 32.0f, W8INV = 1.0f / 32.0f;
__device__ __forceinline__ unsigned pk_fp8x4(float a, float b, float c, float d) { int w = __builtin_amdgcn_cvt_pk_fp8_f32(a, b, 0, false); w = __builtin_amdgcn_cvt_pk_fp8_f32(c, d, w, true); return (unsigned)w; }
struct EpiSwiGLU8 {
    static constexpr bool PERM = true, AFTER_DRAIN = false;
    unsigned char* Hid;
    __device__ __forceinline__ void operator()(const f32x4 (&acc)[2][2][4][2], const Unit& u, int wr, int wc, int fr, int fq) const {
        const int row0 = u.pm * BM + wr * 64 + fr, col0 = u.pn * 128 + wc * 32 + 8 * fq;
#pragma unroll
        for (int ai = 0; ai < 2; ++ai)
#pragma unroll
            for (int m2 = 0; m2 < 4; m2 += 2) { unsigned wx[2], wy[2];
#pragma unroll
                for (int mm = 0; mm < 2; ++mm) { const int m = m2 + mm;
                    const f32x4 g0 = acc[ai][0][m][0] * W8INV, g1 = acc[ai][0][m][1] * W8INV, u0 = acc[ai][1][m][0] * W8INV, u1 = acc[ai][1][m][1] * W8INV;
                    wx[mm] = pk_fp8x4(g0[0] * sigm(g0[0]) * u0[0], g0[1] * sigm(g0[1]) * u0[1], g0[2] * sigm(g0[2]) * u0[2], g0[3] * sigm(g0[3]) * u0[3]);
                    wy[mm] = pk_fp8x4(g1[0] * sigm(g1[0]) * u1[0], g1[1] * sigm(g1[1]) * u1[1], g1[2] * sigm(g1[2]) * u1[2], g1[3] * sigm(g1[3]) * u1[3]); }
                unsigned char* rowp = Hid + (size_t)(row0 + ai * HALF + m2 * 16) * 512 + col0;
                st8x2_wide(rowp, wx[0], wy[0], rowp + 16 * 512, wx[1], wy[1], fq); }
    }
};
struct EpiYs8 {
    static constexpr bool PERM = true, AFTER_DRAIN = false;
    bf16_t* O; float sc;
    __device__ __forceinline__ void operator()(const f32x4 (&acc)[2][2][4][2], const Unit& u, int wr, int wc, int fr, int fq) const {
        const int row0 = u.pm * BM + wr * 64 + fr, col0 = u.pn * BM + wc * 32 + 8 * fq;
#pragma unroll
        for (int ai = 0; ai < 2; ++ai)
#pragma unroll
            for (int m = 0; m < 4; ++m) { bf16_t* rowp = O + (size_t)(row0 + ai * HALF + m * 16) * 1024 + col0;
#pragma unroll
                for (int bj = 0; bj < 2; ++bj) { const f32x4 v0 = acc[ai][bj][m][0] * sc, v1 = acc[ai][bj][m][1] * sc;
                    u32x4 w; w.x = cvt_pk_bf16(v0[0], v0[1]); w.y = cvt_pk_bf16(v0[2], v0[3]); w.z = cvt_pk_bf16(v1[0], v1[1]); w.w = cvt_pk_bf16(v1[2], v1[3]);
                    *(u32x4*)(rowp + bj * HALF) = w; } }
    }
};
struct EpiYsF8 {
    static constexpr bool PERM = true, AFTER_DRAIN = false;
    unsigned char* O; float sc;
    __device__ __forceinline__ void operator()(const f32x4 (&acc)[2][2][4][2], const Unit& u, int wr, int wc, int fr, int fq) const {
        const int row0 = u.pm * BM + wr * 64 + fr, col0 = u.pn * BM + wc * 32 + 8 * fq; typedef unsigned u32x2 __attribute__((ext_vector_type(2)));
#pragma unroll
        for (int ai = 0; ai < 2; ++ai)
#pragma unroll
            for (int m = 0; m < 4; ++m) { unsigned char* rowp = O + (size_t)(row0 + ai * HALF + m * 16) * 1024 + col0;
                unsigned wx[2], wy[2];
#pragma unroll
                for (int bj = 0; bj < 2; ++bj) { const f32x4 v0 = acc[ai][bj][m][0] * sc, v1 = acc[ai][bj][m][1] * sc; wx[bj] = pk_fp8x4(v0[0], v0[1], v0[2], v0[3]); wy[bj] = pk_fp8x4(v1[0], v1[1], v1[2], v1[3]); }
                st8x2_wide(rowp, wx[0], wy[0], rowp + HALF, wx[1], wy[1], fq); }
    }
};
template <bool GATHER_> struct GroupedOrder {
    static constexpr bool GATHER = GATHER_; const PG8_LAS int* rowlds = nullptr;
    __device__ __forceinline__ int rowof(const Unit&, int ord, int r) const { return rowlds[ord * BM + r]; }
    static constexpr int MAXU = 6;
    __device__ __forceinline__ void stage_rows(const int* inv  , int cap, const PG8_LAS int* start, const PG8_LAS int* tot, PG8_LAS int* dst) { rowlds = dst; Unit u;
        for (int i = 0; i < MAXU && next(i, u); ++i) if (threadIdx.x < BM) { const int e = tile_e[u.pm], off = u.pm * BM - start[e] + (int)threadIdx.x; dst[i * BM + threadIdx.x] = off < tot[e] ? inv[e * cap + off] : 0; }
        __syncthreads(); }
    const PG8_LAS int* tile_e;   int nwg, nN, G, c; size_t estride;
    __device__ __forceinline__ void init(const PG8_LAS int* te, int ntiles, int nN_, int G_, int blk, size_t es) { tile_e = te; nN = nN_; nwg = ntiles * nN_; G = G_; estride = es;
        c = (G_ % 8 == 0) ? (blk % 8) * (G_ / 8) + blk / 8 : blk; }
    __device__ __forceinline__ bool next(int i, Unit& u) const { const long L = (long)i * G + c; if (L >= nwg) return false; u.pm = (int)(L / nN); u.pn = (int)(L % nN); return true; }
    __device__ __forceinline__ void a_ready(const Unit&) const {}
    __device__ __forceinline__ const char* bptr(const Gemm& g, const Unit& u, size_t tstep) const {
        const int e = __builtin_amdgcn_readfirstlane(tile_e[u.pm]); return (const char*)g.Bt + (size_t)e * estride + (size_t)u.pn * tstep; }
    __device__ __forceinline__ void done(const Unit&) const {}
};
}
namespace att {
typedef unsigned short bf16;
constexpr int D = 128, PITCH = 1024;
constexpr float SCALE = 0.08838834764831845f;
constexpr float THR = 0.f;
constexpr int NW = 8, QBLK = 32, KVBLK = 64, QB = NW * QBLK;
constexpr int SHM_V = KVBLK * D * 2, SHM_K = KVBLK * D * 2;
constexpr int LDS_BYTES = 2 * SHM_V + 2 * SHM_K + NW * 64 * 4;
typedef short bf16x8 __attribute__((ext_vector_type(8)));
typedef short s16x4 __attribute__((ext_vector_type(4)));
typedef float f32x16 __attribute__((ext_vector_type(16)));
typedef float f32x4 __attribute__((ext_vector_type(4)));
typedef unsigned u32x4 __attribute__((ext_vector_type(4)));
#define KSWZ(row, colB) ((row) * 256 + ((colB) ^ (((row) & 7) << 4)))
#define SBAR() __builtin_amdgcn_sched_barrier(0)
__device__ __forceinline__ int v_st(int k, int c) { const int kk = (k & ~0xC) | ((k & 4) << 1) | ((k & 8) >> 1); return ((kk >> 3) * 4 + (c >> 5)) * 512 + ((kk & 7) * 32 + (c & 31)) * 2; }
__device__ __forceinline__ int v_rd_base(int lane) { return ((lane & 3) << 3) | (((lane >> 2) & 3) << 6) | (((lane >> 4) & 1) << 5) | (((lane >> 5) & 1) << 8); }
constexpr int v_rd_off(int d0, int ks, int half) { return d0 * 512 + ks * 4096 + half * 2048; }
__device__ __forceinline__ int crow(int r, int hi) { return (r & 3) + 8 * (r >> 2) + 4 * hi; }
__device__ __forceinline__ unsigned cvtpk(float lo, float hi) { unsigned r; asm volatile("v_cvt_pk_bf16_f32 %0, %1, %2" : "=v"(r) : "v"(lo), "v"(hi)); return r; }
__device__ __forceinline__ bf16x8 load8(const bf16* p) { return *reinterpret_cast<const bf16x8*>(p); }
__device__ __forceinline__ void mask_tile(f32x16& p0, f32x16& p1, int dq) {
    const float NEG = -__builtin_inff();
#pragma unroll
    for (int r = 0; r < 16; ++r) {
        const int c = (r & 3) + 8 * (r >> 2);
        if (dq - c < 0) p0[r] = NEG;
        if (dq - c - 32 < 0) p1[r] = NEG;
    }
}
__device__ __forceinline__ void partialSM(f32x16& p0, f32x16& p1, float& m_reg, float& mn, float& alpha, bool keep) {
    float pmax = p0[0]; for (int r = 1; r < 16; ++r) pmax = fmaxf(pmax, p0[r]); for (int r = 0; r < 16; ++r) pmax = fmaxf(pmax, p1[r]);
    pmax = keep ? pmax : -__builtin_inff();
    { auto rr = __builtin_amdgcn_permlane32_swap(__float_as_uint(pmax), __float_as_uint(pmax), false, false);
      pmax = fmaxf(__uint_as_float(rr[0]), __uint_as_float(rr[1])); }
    constexpr float C2 = 1.4426950408889634f * SCALE;
    if (__builtin_expect(__all((pmax - m_reg) * SCALE <= THR), 1)) { mn = m_reg; alpha = 1.f; }
    else { mn = fmaxf(m_reg, pmax); alpha = __builtin_amdgcn_exp2f((m_reg - mn) * C2); m_reg = mn; }
    const float mnL = keep ? 8.0f - mn * C2 : -__builtin_inff();
    { typedef float f2_ __attribute__((ext_vector_type(2))); const f2_ c2 = {C2, C2}, ml = {mnL, mnL};
      for (int r = 0; r < 16; r += 2) { const f2_ a = __builtin_elementwise_fma((f2_){p0[r], p0[r + 1]}, c2, ml), b = __builtin_elementwise_fma((f2_){p1[r], p1[r + 1]}, c2, ml); p0[r] = a[0]; p0[r + 1] = a[1]; p1[r] = b[0]; p1[r + 1] = b[1]; } }
    for (int r = 0; r < 16; ++r) p0[r] = __builtin_amdgcn_exp2f(p0[r]);
}
__device__ __forceinline__ void finishSM(f32x16& p0, f32x16& p1, float alpha, float& l_reg, bf16x8& pa0, bf16x8& pa1, bf16x8& pa2, bf16x8& pa3) {
    for (int r = 0; r < 16; ++r) p1[r] = __builtin_amdgcn_exp2f(p1[r]);
    float ps = 0; for (int r = 0; r < 16; ++r) ps += p0[r]; for (int r = 0; r < 16; ++r) ps += p1[r];
    { auto rr = __builtin_amdgcn_permlane32_swap(__float_as_uint(ps), __float_as_uint(ps), false, false);
      ps = __uint_as_float(rr[0]) + __uint_as_float(rr[1]); }
    l_reg = l_reg * alpha + ps;
#define PK4(P, B_, OUT) do { unsigned a0 = cvtpk(P[B_+0], P[B_+1]), a1 = cvtpk(P[B_+2], P[B_+3]);                          \
        unsigned b0 = cvtpk(P[B_+4], P[B_+5]), b1 = cvtpk(P[B_+6], P[B_+7]);                                             \
        auto r0 = __builtin_amdgcn_permlane32_swap(a0, b0, false, false); auto r1 = __builtin_amdgcn_permlane32_swap(a1, b1, false, false); \
        u32x4 w = {r0[0], r1[0], r0[1], r1[1]}; OUT = *reinterpret_cast<bf16x8*>(&w); } while (0)
    PK4(p0, 0, pa0); PK4(p0, 8, pa1); PK4(p1, 0, pa2); PK4(p1, 8, pa3);
#undef PK4
}
template <int KB>
__device__ __forceinline__ void qkt(f32x16& p0, f32x16& p1, const char* K_lds, int r32, int hi, const bf16x8* qr) {
    p0 = f32x16{}; p1 = f32x16{};
    const char* kb[4];
#pragma unroll
    for (int dd = 0; dd < 4; ++dd) kb[dd] = K_lds + KB * SHM_K + KSWZ(r32, (dd * 16 + hi * 8) * 2);
#pragma unroll
    for (int d0 = 0; d0 < 8; ++d0) { const char* a = kb[d0 & 3] + (d0 >> 2) * 128;
        bf16x8 b0 = *reinterpret_cast<const bf16x8*>(a);
        bf16x8 b1 = *reinterpret_cast<const bf16x8*>(a + 32 * 256);
        p0 = __builtin_amdgcn_mfma_f32_32x32x16_bf16(b0, qr[d0], p0, 0, 0, 0);
        p1 = __builtin_amdgcn_mfma_f32_32x32x16_bf16(b1, qr[d0], p1, 0, 0, 0); }
}
typedef int i32x8_ __attribute__((ext_vector_type(8)));
template <int KB>
__device__ __forceinline__ void qkt8(f32x16& p0, f32x16& p1, const char* K_lds, int r32, int hi, const u32x4* q8) {
    p0 = f32x16{}; p1 = f32x16{};
    const char* kr = K_lds + KB * SHM_K + r32 * 128; const int kx = r32 & 7;
#pragma unroll
    for (int j = 0; j < 2; ++j) { const int c0 = ((4 * j + 2 * hi) ^ kx) << 4, c1 = ((4 * j + 2 * hi + 1) ^ kx) << 4;
        const u32x4 a0 = *(const u32x4*)(kr + c0), a1 = *(const u32x4*)(kr + c1), b0 = *(const u32x4*)(kr + 32 * 128 + c0), b1 = *(const u32x4*)(kr + 32 * 128 + c1);
        const i32x8_ qa = {(int)q8[2 * j][0], (int)q8[2 * j][1], (int)q8[2 * j][2], (int)q8[2 * j][3], (int)q8[2 * j + 1][0], (int)q8[2 * j + 1][1], (int)q8[2 * j + 1][2], (int)q8[2 * j + 1][3]};
        const i32x8_ ka = {(int)a0[0], (int)a0[1], (int)a0[2], (int)a0[3], (int)a1[0], (int)a1[1], (int)a1[2], (int)a1[3]}, kb = {(int)b0[0], (int)b0[1], (int)b0[2], (int)b0[3], (int)b1[0], (int)b1[1], (int)b1[2], (int)b1[3]};
        p0 = __builtin_amdgcn_mfma_scale_f32_32x32x64_f8f6f4(ka, qa, p0, 0, 0, 0, 0x7f7f7f7f, 0, 0x7f7f7f7f);
        p1 = __builtin_amdgcn_mfma_scale_f32_32x32x64_f8f6f4(kb, qa, p1, 0, 0, 0, 0x7f7f7f7f, 0, 0x7f7f7f7f); }
}
template <int VB>
__device__ __forceinline__ void pv_tile(f32x16* o, int vb0, bf16x8 pa0, bf16x8 pa1, bf16x8 pa2, bf16x8 pa3) {
#define TRRD(dst, off) asm volatile("ds_read_b64_tr_b16 %0, %1 offset:%2" : "=&v"(dst) : "v"(vb0), "i"(off) : "memory")
#define PV_D0(d0) do { s16x4 l0, l1, l2, l3, h0, h1, h2, h3; constexpr int b_ = VB * SHM_V + v_rd_off(d0, 0, 0);  \
        TRRD(l0, b_); TRRD(h0, b_ + 2048); TRRD(l1, b_ + 4096); TRRD(h1, b_ + 6144); TRRD(l2, b_ + 8192); TRRD(h2, b_ + 10240); TRRD(l3, b_ + 12288); TRRD(h3, b_ + 14336); \
        asm volatile("s_waitcnt lgkmcnt(0)" ::: "memory"); SBAR();   \
        o[d0] = __builtin_amdgcn_mfma_f32_32x32x16_bf16(pa0, (bf16x8){l0[0], l0[1], l0[2], l0[3], h0[0], h0[1], h0[2], h0[3]}, o[d0], 0, 0, 0);   \
        o[d0] = __builtin_amdgcn_mfma_f32_32x32x16_bf16(pa1, (bf16x8){l1[0], l1[1], l1[2], l1[3], h1[0], h1[1], h1[2], h1[3]}, o[d0], 0, 0, 0);   \
        o[d0] = __builtin_amdgcn_mfma_f32_32x32x16_bf16(pa2, (bf16x8){l2[0], l2[1], l2[2], l2[3], h2[0], h2[1], h2[2], h2[3]}, o[d0], 0, 0, 0);   \
        o[d0] = __builtin_amdgcn_mfma_f32_32x32x16_bf16(pa3, (bf16x8){l3[0], l3[1], l3[2], l3[3], h3[0], h3[1], h3[2], h3[3]}, o[d0], 0, 0, 0); } while (0)
    PV_D0(0); PV_D0(1); PV_D0(2); PV_D0(3);
#undef PV_D0
#undef TRRD
}
typedef int i32x8v __attribute__((ext_vector_type(8)));
__device__ __forceinline__ unsigned pk8(float a, float b, float c, float d) { int w = __builtin_amdgcn_cvt_pk_fp8_f32(a, b, 0, false); w = __builtin_amdgcn_cvt_pk_fp8_f32(c, d, w, true); return (unsigned)w; }
__device__ __forceinline__ void finishSM8(f32x16& p0, f32x16& p1, float alpha, float& l_reg, i32x8v& pa) {
    for (int r = 0; r < 16; ++r) p1[r] = __builtin_amdgcn_exp2f(p1[r]);
    float ps; { typedef float f2_ __attribute__((ext_vector_type(2))); f2_ s2 = {0.f, 0.f};
      for (int r = 0; r < 16; r += 2) { s2 += (f2_){p0[r], p0[r + 1]}; s2 += (f2_){p1[r], p1[r + 1]}; } ps = s2[0] + s2[1]; }
    { auto rr = __builtin_amdgcn_permlane32_swap(__float_as_uint(ps), __float_as_uint(ps), false, false);
      ps = __uint_as_float(rr[0]) + __uint_as_float(rr[1]); }
    l_reg = l_reg * alpha + ps;
#pragma unroll
    for (int j = 0; j < 4; ++j) { const unsigned w0 = pk8(p0[4 * j], p0[4 * j + 1], p0[4 * j + 2], p0[4 * j + 3]), w1 = pk8(p1[4 * j], p1[4 * j + 1], p1[4 * j + 2], p1[4 * j + 3]);
        auto rr = __builtin_amdgcn_permlane32_swap(w0, w1, false, false); pa[j] = (int)rr[0]; pa[4 + j] = (int)rr[1]; }
}
template <int VB>
__device__ __forceinline__ void pv_tile8(f32x16* o, int vb0, i32x8v pa) {
    typedef int v2i_ __attribute__((ext_vector_type(2))); typedef __attribute__((address_space(3))) v2i_ lds_v2i;
#define TR8(off) __builtin_amdgcn_ds_read_tr8_b64_v2i32((lds_v2i*)(unsigned)(vb0 + (off)))
#pragma unroll
    for (int d0 = 0; d0 < 4; ++d0) { constexpr int R0 = 0 * 32, R1 = 16 * 32, R2 = 8 * 32, R3 = 24 * 32; const int b_ = VB * SHM_V + d0 * 2048;
        const v2i_ t0 = TR8(b_ + R0), t1 = TR8(b_ + R1), t2 = TR8(b_ + R2), t3 = TR8(b_ + R3);
        const i32x8v vb = {t0[0], t0[1], t1[0], t1[1], t2[0], t2[1], t3[0], t3[1]};
        o[d0] = __builtin_amdgcn_mfma_scale_f32_32x32x64_f8f6f4(pa, vb, o[d0], 0, 0, 0, 0x77777777, 0, 0x7f7f7f7f); }
#undef TR8
}
struct BlockRef { const bf16* Q;   const unsigned char* Q8; const unsigned char* K8;   const unsigned char* V8;   unsigned char* O;     const float* Kmean; int P0; };
struct Seam { u32x4 q8[4];   u32x4 st_v; u32x4 st_k; };
#define ROW(p, k0, rr) ((p) + (unsigned)(((k0) + (rr)) * PITCH + sc))
#define VMW() asm volatile("s_waitcnt vmcnt(0)" ::: "memory")
#define VMWN(n) asm volatile("s_waitcnt vmcnt(%0)" :: "i"(n) : "memory")
#define SLOAD_H(Kp, Vp, k0) do { S.st_v = *(const u32x4*)((Vp) + (unsigned)(((k0) + krow) * PITCH + kch * 16));              \
                         S.st_k = *(const u32x4*)((Kp) + (unsigned)(((k0) + krow) * PITCH + kch * 16)); } while (0)
#define SWRITE_HK(bf) do { *(u32x4*)(K_lds + (bf) * SHM_K + kw8) = S.st_k; } while (0)
#define SWRITE_HV(bf) do { *(u32x4*)(V_lds + (bf) * SHM_V + vw8) = S.st_v; } while (0)
#define SWRITE_H(bf) do { SWRITE_HV(bf); SWRITE_HK(bf); } while (0)
__device__ __forceinline__ void moba_prime(const BlockRef& cur, char* lds, Seam& S) {
    const int tid = threadIdx.x, wid = __builtin_amdgcn_readfirstlane(tid >> 6), lane = tid & 63, r32 = lane & 31, hi = lane >> 5;
    const int sr = tid >> 4, sc = (tid & 15) * 8, krow = tid >> 3, kch = tid & 7, kw8 = krow * 128 + ((kch ^ (krow & 7)) << 4); char* K_lds = lds + 2 * SHM_V;
#pragma unroll
    for (int i = 0; i < 4; ++i) S.q8[i] = *(const u32x4*)(cur.Q8 + (unsigned)((wid * QBLK + r32) * PITCH + 64 * (i >> 1) + 32 * hi + 16 * (i & 1)));
    SLOAD_H(cur.K8, cur.V8, 0); VMW(); SWRITE_HK(0);
    __syncthreads();
}
__device__ __forceinline__ void moba_block(const BlockRef& cur, const BlockRef& nxt, char* lds, Seam& S) {
    const int tid = threadIdx.x, wid = __builtin_amdgcn_readfirstlane(tid >> 6), lane = tid & 63, r32 = lane & 31, hi = lane >> 5;
    const int NT = cur.P0 / KVBLK + 4;
    const int qlo = cur.P0 + wid * QBLK, qm = qlo + r32 - 4 * hi;
    unsigned selfull = 0xFFu;
    { const int qb = cur.P0 >> 8;
      if (qb >= 4) { float b1 = -__builtin_inff(), b2 = b1, b3 = b1; int i1 = 0, i2 = 0, i3 = 0;
        bf16x8 qg[8];
#pragma unroll
        for (int d0 = 0; d0 < 8; ++d0) qg[d0] = load8(cur.Q + (unsigned)((wid * QBLK + r32) * PITCH + hi * 8) + d0 * 16);
        float* kml = (float*)(lds + LDS_BYTES);
        for (int i = tid; i < qb * 128; i += NW * 64) kml[i] = cur.Kmean[i];
        __syncthreads();
#pragma unroll 1
        for (int n = 0; n < qb; ++n) { float g = 0.f; const float* kmn = kml + n * 128 + 8 * hi;
#pragma unroll
            for (int d0 = 0; d0 < 8; ++d0) { const u32x4 qw = *reinterpret_cast<const u32x4*>(&qg[d0]); const f32x4 k0 = *(const f32x4*)(kmn + 16 * d0), k1 = *(const f32x4*)(kmn + 16 * d0 + 4);
                g += (__uint_as_float(qw.x << 16) * k0[0] + __uint_as_float(qw.x & 0xffff0000u) * k0[1]) + (__uint_as_float(qw.y << 16) * k0[2] + __uint_as_float(qw.y & 0xffff0000u) * k0[3])
                   + (__uint_as_float(qw.z << 16) * k1[0] + __uint_as_float(qw.z & 0xffff0000u) * k1[1]) + (__uint_as_float(qw.w << 16) * k1[2] + __uint_as_float(qw.w & 0xffff0000u) * k1[3]); }
            g += __shfl_xor(g, 32);
            if (g > b1) { b3 = b2; i3 = i2; b2 = b1; i2 = i1; b1 = g; i1 = n; } else if (g > b2) { b3 = b2; i3 = i2; b2 = g; i2 = n; } else if (g > b3) { b3 = g; i3 = n; } }
        const unsigned mask = (1u << i1) | (1u << i2) | (1u << i3);
        selfull = mask | (0xFFu << qb); } }
    char* V_lds = lds; char* K_lds = lds + 2 * SHM_V;
    float* ws = (float*)(lds + 2 * SHM_V + 2 * SHM_K) + wid * 64; float* li_l = ws, * al_l = ws + 32;
    float m_reg = -1e30f, l_reg = 0; f32x16 o[4] = {};
    const int sr = tid >> 4, sc = (tid & 15) * 8, krow = tid >> 3, kch = tid & 7, kw8 = krow * 128 + ((kch ^ (krow & 7)) << 4), vw8 = (kch >> 1) * 2048 + ((krow & ~12) | ((krow & 4) << 1) | ((krow & 8) >> 1)) * 32 + (kch & 1) * 16;
    const int vb0 = (int)(uintptr_t)V_lds + (32 * hi + ((lane & 15) >> 1)) * 32 + 16 * ((lane >> 4) & 1) + 8 * (lane & 1);
    const unsigned char* Kh = cur.K8; const unsigned char* Vh = cur.V8;
#define RESC(a) do { if (__any((a) < 1.f)) { if (hi == 0) al_l[r32] = (a); asm volatile("s_waitcnt lgkmcnt(0)" ::: "memory");              \
                     for (int d_ = 0; d_ < 4; ++d_) for (int r = 0; r < 16; ++r) o[d_][r] *= al_l[crow(r, hi)]; } } while (0)
#define KBASE(t) ((t) * KVBLK)
#define KEEP(t) (((selfull >> (KBASE(t) >> 8)) & 1u) != 0u)
#define MASKT(P0_, P1_, t) do { const int kb_ = KBASE(t); if (kb_ + KVBLK - 1 > qlo) mask_tile(P0_, P1_, qm - kb_); } while (0)
    constexpr int NQL = 4;
#define SEAM_K0() do { VMWN(NQL); SWRITE_HK(0); SBAR(); } while (0)
    f32x16 pA0, pA1, pB0, pB1; float mnA, mnB, alA, alB; i32x8v pa;
    SWRITE_HV(0); SBAR();
    if (NT > 1) { SLOAD_H(Kh, Vh, KBASE(1)); }
    SBAR(); qkt8<0>(pA0, pA1, K_lds, r32, hi, S.q8);
    MASKT(pA0, pA1, 0); partialSM(pA0, pA1, m_reg, mnA, alA, KEEP(0));
    if (NT > 1) { VMW(); SWRITE_H(1); }
    __syncthreads();
#define HALF_STEP(PX0, PX1, mnX, alX, PY0, PY1, alY, t, KB, VB, SB) do {                                                      \
        SBAR(); qkt8<KB>(PX0, PX1, K_lds, r32, hi, S.q8);                                             \
        finishSM8(PY0, PY1, alY, l_reg, pa); SBAR();                                                           \
        if ((t) + 1 < NT) { SLOAD_H(Kh, Vh, KBASE((t) + 1)); SBAR(); }                                               \
        pv_tile8<VB>(o, vb0, pa); MASKT(PX0, PX1, (t)); partialSM(PX0, PX1, m_reg, mnX, alX, KEEP(t));                                        \
        __syncthreads();                                                                                                      \
        if ((t) + 1 < NT) { VMW(); SWRITE_H(SB); }                                                                          \
        RESC(alX); __syncthreads(); } while (0)
    for (int t = 1; t + 1 < NT; t += 2) {
        HALF_STEP(pB0, pB1, mnB, alB, pA0, pA1, alA, t, 1, 0, 0);
        HALF_STEP(pA0, pA1, mnA, alA, pB0, pB1, alB, t + 1, 0, 1, 1);
    }
    const bool even = (NT & 1) == 0;
    if (even) { SBAR(); qkt8<1>(pB0, pB1, K_lds, r32, hi, S.q8); SBAR(); }
    SLOAD_H(nxt.K8, nxt.V8, 0); SBAR();
#pragma unroll
    for (int i = 0; i < 4; ++i) S.q8[i] = *(const u32x4*)(nxt.Q8 + (unsigned)((wid * QBLK + r32) * PITCH + 64 * (i >> 1) + 32 * hi + 16 * (i & 1)));
    SBAR();
    finishSM8(pA0, pA1, alA, l_reg, pa); SBAR();
    pv_tile8<0>(o, vb0, pa);
    if (even) { MASKT(pB0, pB1, NT - 1); partialSM(pB0, pB1, m_reg, mnB, alB, KEEP(NT - 1)); __syncthreads(); RESC(alB);
        finishSM8(pB0, pB1, alB, l_reg, pa); SBAR(); pv_tile8<1>(o, vb0, pa); }
    SBAR(); SEAM_K0();
    if (hi == 0) li_l[r32] = l_reg; asm volatile("s_waitcnt lgkmcnt(0)" ::: "memory");
    float rli[16];
#pragma unroll
    for (int r = 0; r < 16; ++r) rli[r] = __builtin_amdgcn_rcpf(li_l[crow(r, hi)]);
    unsigned char* ost = (unsigned char*)lds + 73728 + wid * 4096;
#pragma unroll
    for (int r = 0; r < 16; ++r) { const float sc16 = rli[r] * (16.0f * 256.0f);     unsigned char* orow = ost + crow(r, hi) * 128 + r32;
#pragma unroll
        for (int d0 = 0; d0 < 4; ++d0) { const float v = o[d0][r] * sc16; orow[d0 * 32] = (unsigned char)__builtin_amdgcn_cvt_pk_fp8_f32(v, v, 0, false); } }
#pragma unroll
    for (int i = 0; i < 4; ++i) { const int ch = lane + 64 * i, row = ch >> 3, c16 = ch & 7;
        const u32x4 d = *(const u32x4*)(ost + row * 128 + c16 * 16);
        *(u32x4*)(cur.O + (unsigned)((wid * QBLK + row) * PITCH + c16 * 16)) = d; }
    __syncthreads();
#undef RESC
#undef KBASE
#undef KEEP
#undef MASKT
#undef SEAM_K0
#undef HALF_STEP
}
#undef ROW
#undef VMW
#undef VMWN
#undef SLOAD_H
#undef SWRITE_HK
#undef SWRITE_HV
#undef SWRITE_H
}
#define GAS __attribute__((address_space(1)))
#define LAS __attribute__((address_space(3)))
typedef unsigned short bf16;
typedef unsigned v4u __attribute__((ext_vector_type(4)));
typedef float f32x4 __attribute__((ext_vector_type(4)));
typedef short bf16x8 __attribute__((ext_vector_type(8)));
typedef GAS unsigned gu32;
typedef GAS unsigned long long gu64;
#define RLX_AGENT __ATOMIC_RELAXED, __HIP_MEMORY_SCOPE_AGENT
#define LDS_WAIT() asm volatile("s_waitcnt lgkmcnt(0)" ::: "memory")
#define VM_WAIT() asm volatile("s_waitcnt vmcnt(0)" ::: "memory")
__device__ __forceinline__ unsigned long long rt() { return __builtin_amdgcn_s_memrealtime(); }
__device__ __forceinline__ unsigned f2bf(float f) { unsigned u = __builtin_bit_cast(unsigned, f); return (u + 0x7fffu + ((u >> 16) & 1u)) >> 16; }
__device__ __forceinline__ unsigned pk2(float lo, float hi) { unsigned r; asm("v_cvt_pk_bf16_f32 %0, %1, %2" : "=v"(r) : "v"(lo), "v"(hi)); return r; }

#define XB_TMO      128
#define XB_XCNT(j)  (256  + 64 * (j))
#define XB_XSUB(j)  (1280 + 64 * (j))
#define XB_XGEN(j)  (2304 + 64 * (j))
#define XB_TOP      3328
#define XB_TOPGEN   3392
#define XCD_BAR_WORDS 3456
#define XB_SPIN_CAP (1u << 18)

__device__ __forceinline__ unsigned xb_ld(unsigned* p)              { return __hip_atomic_load(p, __ATOMIC_RELAXED, __HIP_MEMORY_SCOPE_AGENT); }
__device__ __forceinline__ unsigned xb_add(unsigned* p, unsigned v) { return __hip_atomic_fetch_add(p, v, __ATOMIC_RELAXED, __HIP_MEMORY_SCOPE_AGENT); }
__device__ __forceinline__ unsigned xb_xcc_id() { return (unsigned)__builtin_amdgcn_s_getreg((3 << 11) | 20) & 0xFu; }
#define XB_SPIN(cond, bar) do { unsigned _sp = 0; while (cond) { __builtin_amdgcn_s_sleep(1); \
    if ((++_sp & 255u) == 0u) { if (xb_ld(&(bar)[XB_TMO])) break; if (_sp > XB_SPIN_CAP) { atomicAdd(&(bar)[XB_TMO], 1u); break; } } } } while (0)

struct XcdBarrier {
    unsigned* bar; unsigned x;
    volatile LAS unsigned* st;
};

__device__ __forceinline__ XcdBarrier xcd_barrier_post(unsigned* bar, volatile LAS unsigned* st) {
    XcdBarrier b; b.bar = bar; b.x = xb_xcc_id(); b.st = st;
    if (threadIdx.x == 0) (void)xb_add(&bar[XB_XCNT(b.x)], 1u);
    return b;
}
__device__ __forceinline__ void xcd_barrier_complete(unsigned* bar, unsigned x, unsigned& nloc, unsigned& nx) {
    const unsigned G = gridDim.x * gridDim.y * gridDim.z;
    unsigned sum, cnt, mine, sp = 0u;
    for (;;) {
        sum = 0u; cnt = 0u; mine = 0u;
#pragma unroll
        for (unsigned j = 0; j < 16; ++j) { const unsigned c = xb_ld(&bar[XB_XCNT(j)]); sum += c; cnt += (c > 0u) ? 1u : 0u; mine = (j == x) ? c : mine; }
        if (sum == G) break;
        __builtin_amdgcn_s_sleep(1);
        if ((++sp & 255u) == 0u) { if (xb_ld(&bar[XB_TMO])) break; if (sp > XB_SPIN_CAP) { atomicAdd(&bar[XB_TMO], 1u); break; } }
    }
    nloc = mine > 0u ? mine : 1u; nx = cnt > 0u ? cnt : 1u;
}

__device__ __forceinline__ void xcd_barrier(const XcdBarrier& b) {
    asm volatile("s_waitcnt vmcnt(0)" ::: "memory");
    __syncthreads();
    if (threadIdx.x == 0) {
        unsigned* bar = b.bar;
        __builtin_amdgcn_s_waitcnt(0);
        unsigned nloc = b.st[0], nx = b.st[1];
        if (nloc == 0u) { xcd_barrier_complete(bar, b.x, nloc, nx); b.st[0] = nloc; b.st[1] = nx; }
        const unsigned old = xb_add(&bar[XB_XSUB(b.x)], 1u);
        const unsigned gen = old / nloc;
        if (old + 1u == (gen + 1u) * nloc) {
            __builtin_amdgcn_fence(__ATOMIC_RELEASE, "agent");
            asm volatile("s_waitcnt vmcnt(0)" ::: "memory");
            const unsigned og = xb_add(&bar[XB_TOP], 1u);
            const unsigned tg = og / nx;
            if (og + 1u == (tg + 1u) * nx) xb_add(&bar[XB_TOPGEN], 1u);
            else XB_SPIN(xb_ld(&bar[XB_TOPGEN]) == tg, bar);
            __builtin_amdgcn_fence(__ATOMIC_ACQUIRE, "agent");
            xb_add(&bar[XB_XGEN(b.x)], 1u);
            asm volatile("s_waitcnt vmcnt(0)" ::: "memory");
        } else {
            XB_SPIN(xb_ld(&bar[XB_XGEN(b.x)]) == gen, bar);
            __builtin_amdgcn_fence(__ATOMIC_ACQUIRE, "agent");
            asm volatile("s_waitcnt vmcnt(0)" ::: "memory");
        }
    }
    __syncthreads();
}
__device__ __forceinline__ void group4_barrier(unsigned* bar, unsigned* gword, unsigned* xmap4) {
    asm volatile("s_waitcnt vmcnt(0)" ::: "memory");
    __syncthreads();
    if (threadIdx.x == 0) {
        const unsigned x0 = xb_ld(xmap4), x1 = xb_ld(xmap4 + 1), x2 = xb_ld(xmap4 + 2), x3 = xb_ld(xmap4 + 3);
        if (!(x0 != 0u && x0 == x1 && x1 == x2 && x2 == x3)) { __builtin_amdgcn_fence(__ATOMIC_RELEASE, "agent"); asm volatile("s_waitcnt vmcnt(0)" ::: "memory"); }
        (void)xb_add(gword, 1u);
        XB_SPIN(xb_ld(gword) < 4u, bar);
        __builtin_amdgcn_fence(__ATOMIC_ACQUIRE, "agent");
        asm volatile("s_waitcnt vmcnt(0)" ::: "memory");
    }
    __syncthreads();
}
template <class Fn> __device__ __forceinline__ void local_barrier_ov(unsigned* bar, unsigned* word, unsigned n, Fn fn) {
    asm volatile("s_waitcnt vmcnt(0)" ::: "memory");
    __syncthreads();
    if (threadIdx.x == 0) {
        (void)xb_add(word, 1u);
        XB_SPIN(xb_ld(word) < n, bar);
        __builtin_amdgcn_fence(__ATOMIC_ACQUIRE, "agent");
        asm volatile("s_waitcnt vmcnt(0)" ::: "memory");
    } else if (threadIdx.x >= 64) { fn(); }
    __syncthreads();
}
template <class Fn> __device__ __forceinline__ void xcd_barrier_ov(const XcdBarrier& b, Fn fn) {
    asm volatile("s_waitcnt vmcnt(0)" ::: "memory");
    __syncthreads();
    if (threadIdx.x == 0) {
        unsigned* bar = b.bar;
        __builtin_amdgcn_s_waitcnt(0);
        unsigned nloc = b.st[0], nx = b.st[1];
        if (nloc == 0u) { xcd_barrier_complete(bar, b.x, nloc, nx); b.st[0] = nloc; b.st[1] = nx; }
        const unsigned old = xb_add(&bar[XB_XSUB(b.x)], 1u);
        const unsigned gen = old / nloc;
        if (old + 1u == (gen + 1u) * nloc) {
            __builtin_amdgcn_fence(__ATOMIC_RELEASE, "agent");
            asm volatile("s_waitcnt vmcnt(0)" ::: "memory");
            const unsigned og = xb_add(&bar[XB_TOP], 1u);
            const unsigned tg = og / nx;
            if (og + 1u == (tg + 1u) * nx) xb_add(&bar[XB_TOPGEN], 1u);
            else XB_SPIN(xb_ld(&bar[XB_TOPGEN]) == tg, bar);
            __builtin_amdgcn_fence(__ATOMIC_ACQUIRE, "agent");
            xb_add(&bar[XB_XGEN(b.x)], 1u);
            asm volatile("s_waitcnt vmcnt(0)" ::: "memory");
        } else {
            XB_SPIN(xb_ld(&bar[XB_XGEN(b.x)]) == gen, bar);
            __builtin_amdgcn_fence(__ATOMIC_ACQUIRE, "agent");
            asm volatile("s_waitcnt vmcnt(0)" ::: "memory");
        }
    } else if (threadIdx.x >= 64) { fn(); }
    __syncthreads();
}
constexpr int NB = 16, T = 2048, D = 1024, M = NB * T;
constexpr int NEXP = 16, DEXP = 512;
constexpr int MAXT = 272, MSORT = MAXT * 256;
constexpr float LN_EPS = 1e-5f, DN_ALPHA = 1.4142135623730951f;
constexpr int NWAVES = 8;
constexpr size_t MiB = 1u << 20;
constexpr size_t WS_CTL = 0, CTL_ZERO_BYTES = 1 * MiB;
constexpr size_t WS_COND = 1 * MiB;
constexpr size_t WS_KMEAN = 512 * 1024;
constexpr size_t WS_ROUTE_E = 3 * MiB;
constexpr size_t WS_ROUTE_W = WS_ROUTE_E + 128 * 1024;
constexpr size_t WS_POS = WS_ROUTE_W + 256 * 1024;
constexpr size_t WS_CNT = WS_POS + 256 * 1024;
constexpr size_t WS_TILE = WS_CNT + 16 * 1024;
constexpr size_t WS_SEL = 4 * MiB;
constexpr size_t WS_INV = 5 * MiB;
constexpr size_t WS_WIN = 8 * MiB, WS_WOUT = 12 * MiB, WS_WQKV = 14 * MiB, WS_WO2 = 20 * MiB;
constexpr size_t WS_WGU = 22 * MiB;
constexpr size_t WS_WD = 86 * MiB;
constexpr size_t WS_XA = 118 * MiB;
constexpr size_t WS_H8 = 118 * MiB + 128 * MiB - 32 * MiB;
constexpr size_t WS_H = 246 * MiB;
constexpr size_t WS_BIG = 310 * MiB;
constexpr size_t WS_END = 502 * MiB;
constexpr int CW_BAR = 4096;
constexpr int CW_LBAR = 49152;
constexpr int CW_XMAP = 24576;
constexpr int CW_GBAR = 32768;
constexpr int CW_MOE = 16384;
constexpr int TAB_START = 512, TAB_TOT = 544, INV_CAP = 32768;

typedef unsigned v2u __attribute__((ext_vector_type(2)));
typedef float f32x2 __attribute__((ext_vector_type(2)));
__device__ __forceinline__ float bflo(unsigned w) { return __builtin_bit_cast(float, w << 16); }
__device__ __forceinline__ float bfhi(unsigned w) { return __builtin_bit_cast(float, w & 0xffff0000u); }
__device__ __forceinline__ float dpp_add(float v, float src_holder, int ctrl_unused) { return v; }
#define WS_DPP(v, ctrl, rmask) (v) += __builtin_bit_cast(float, __builtin_amdgcn_update_dpp(0, __builtin_bit_cast(int, (v)), (ctrl), (rmask), 0xF, true))
__device__ __forceinline__ float wave_sum(float v) {
    WS_DPP(v, 0xB1, 0xF);
    WS_DPP(v, 0x4E, 0xF);
    WS_DPP(v, 0x141, 0xF);
    WS_DPP(v, 0x140, 0xF);
    WS_DPP(v, 0x142, 0xA);
    WS_DPP(v, 0x143, 0xC);
    return __builtin_bit_cast(float, __builtin_amdgcn_readlane(__builtin_bit_cast(int, v), 63));
}

#define DPPF(v, ctrl) __builtin_bit_cast(float, __builtin_amdgcn_update_dpp(0, __builtin_bit_cast(int, (v)), (ctrl), 0xF, 0xF, true))
__device__ __forceinline__ float xrow_sum(float r) {
    { float x = r, y = r; asm volatile("s_nop 1\n\tv_permlane16_swap_b32 %0, %1" : "+v"(x), "+v"(y)); r = x + y; }
    { float x = r, y = r; asm volatile("s_nop 1\n\tv_permlane32_swap_b32 %0, %1" : "+v"(x), "+v"(y)); r = x + y; }
    return r;
}
__device__ __forceinline__ void wave_sum4(float a, float b, float c, float d, float& s0, float& s1, float& s2, float& s3, int lane) {
    const bool odd = (lane & 1) != 0, hi2 = (lane & 2) != 0;
    const float rab = (odd ? b : a) + DPPF(odd ? a : b, 0xB1);
    const float rcd = (odd ? d : c) + DPPF(odd ? c : d, 0xB1);
    float r = (hi2 ? rcd : rab) + DPPF(hi2 ? rab : rcd, 0x4E);
    r += DPPF(r, 0x124); r += DPPF(r, 0x128);
    r = xrow_sum(r);
    s0 = __builtin_bit_cast(float, __builtin_amdgcn_readlane(__builtin_bit_cast(int, r), 0)); s1 = __builtin_bit_cast(float, __builtin_amdgcn_readlane(__builtin_bit_cast(int, r), 1));
    s2 = __builtin_bit_cast(float, __builtin_amdgcn_readlane(__builtin_bit_cast(int, r), 2)); s3 = __builtin_bit_cast(float, __builtin_amdgcn_readlane(__builtin_bit_cast(int, r), 3));
}
struct Params { const float* in[27]; float* out; unsigned char* ws; int ph_lo, ph_hi, li, pad; };
enum { I_X = 0, I_C, I_ADAW, I_ADAB, I_LNMG, I_LNMB, I_LNFG, I_LNFB, I_WIN, I_SLNG, I_SLNB, I_WS, I_BS, I_WDW, I_BDW, I_CLNG, I_CLNB, I_WOUT, I_WQKV, I_WO2,
       I_WGRP, I_BGRP, I_WER, I_BER, I_WGATE, I_WUP, I_WDOWN };
struct Frame {
    LAS unsigned char* lds;
    int tid, lane, wave, vcu, G;
};

__device__ __forceinline__ void p0_cond(const Frame& F, const float* c, const float* ada_w, const float* ada_b, float* cond) {
    LAS float* sc = (LAS float*)F.lds;
    LAS float* red = (LAS float*)(F.lds + 65536);
    bool loaded = false;
    for (int it = blockIdx.x; it < 192; it += F.G) {
        if (!loaded) { for (int i = F.tid; i < 16384; i += 512) { const int b = i >> 10, k = i & 1023; const float v = c[i]; sc[k * 16 + b] = v / (1.0f + __expf(-v)); } __syncthreads(); loaded = true; }
        const int L = it / 96, j0 = (it % 96) * 64, col = F.tid & 63, ks = F.tid >> 6;
        float acc[16];
#pragma unroll
        for (int b = 0; b < 16; ++b) acc[b] = 0.f;
        const float* w = ada_w + (size_t)L * 1024 * 6144 + (size_t)(ks * 128) * 6144 + j0 + col;
        for (int kb = 0; kb < 128; kb += 32) { float wv[32];
#pragma unroll
            for (int k = 0; k < 32; ++k) wv[k] = __builtin_nontemporal_load(w + (size_t)(kb + k) * 6144);
#pragma unroll
            for (int k = 0; k < 32; ++k) { const LAS f32x4* s4 = (const LAS f32x4*)(sc + (ks * 128 + kb + k) * 16);
#pragma unroll
                for (int q = 0; q < 4; ++q) { const f32x4 s = s4[q]; acc[4 * q + 0] += s[0] * wv[k]; acc[4 * q + 1] += s[1] * wv[k]; acc[4 * q + 2] += s[2] * wv[k]; acc[4 * q + 3] += s[3] * wv[k]; } } }
#pragma unroll
        for (int b = 0; b < 16; ++b) red[(ks * 16 + b) * 64 + col] = acc[b];
        __syncthreads();
        for (int o = F.tid; o < 1024; o += 512) { const int b = o >> 6, cc = o & 63; float s = ada_b[L * 6144 + j0 + cc];
#pragma unroll
            for (int k2 = 0; k2 < 8; ++k2) s += red[(k2 * 16 + b) * 64 + cc];
            cond[(size_t)(L * 16 + b) * 6144 + j0 + cc] = s; }
        __syncthreads();
    }
}
__device__ __forceinline__ void transpose_item(const float* W, int srcN, bf16* WT, int dstK, int k0, int n0, int drow0, LAS float* scr, int lane) {
    { const int kr = lane >> 3, n4 = (lane & 7) * 4; f32x4 v[8];
#pragma unroll
        for (int i = 0; i < 8; ++i) v[i] = __builtin_nontemporal_load((const f32x4*)(W + (size_t)(k0 + kr + 8 * i) * srcN + n0 + n4));
#pragma unroll
        for (int i = 0; i < 8; ++i) { LAS float* d = scr + (kr + 8 * i) * 33 + n4; d[0] = v[i][0]; d[1] = v[i][1]; d[2] = v[i][2]; d[3] = v[i][3]; } }
    LDS_WAIT(); asm volatile("" ::: "memory");
    const int c = lane & 7;
#pragma unroll
    for (int j = 0; j < 4; ++j) { const int n = (lane >> 3) + 8 * j; const LAS float* s = scr + (8 * c) * 33 + n;
        v4u o; o.x = pk2(s[0 * 33], s[1 * 33]); o.y = pk2(s[2 * 33], s[3 * 33]); o.z = pk2(s[4 * 33], s[5 * 33]); o.w = pk2(s[6 * 33], s[7 * 33]);
        *(GAS v4u*)(WT + (size_t)(drow0 + n) * dstK + k0 + 8 * c) = o; }
    LDS_WAIT(); asm volatile("" ::: "memory");
}
__device__ __forceinline__ void transpose_item_fp8(const float* W, int srcN, unsigned char* WT, int dstK, int k0, int n0, int drow0, LAS float* scr, int lane) {
    { const int kr = lane >> 3, n4 = (lane & 7) * 4; f32x4 v[8];
#pragma unroll
        for (int i = 0; i < 8; ++i) v[i] = __builtin_nontemporal_load((const f32x4*)(W + (size_t)(k0 + kr + 8 * i) * srcN + n0 + n4));
#pragma unroll
        for (int i = 0; i < 8; ++i) { LAS float* d = scr + (kr + 8 * i) * 33 + n4; d[0] = v[i][0] * 32.0f; d[1] = v[i][1] * 32.0f; d[2] = v[i][2] * 32.0f; d[3] = v[i][3] * 32.0f; } }
    LDS_WAIT(); asm volatile("" ::: "memory");
    const int c = lane & 3;
#pragma unroll
    for (int j = 0; j < 2; ++j) { const int n = (lane >> 2) + 16 * j; const LAS float* s = scr + (16 * c) * 33 + n;
        v4u o; o.x = pg8::pk_fp8x4(s[0 * 33], s[1 * 33], s[2 * 33], s[3 * 33]); o.y = pg8::pk_fp8x4(s[4 * 33], s[5 * 33], s[6 * 33], s[7 * 33]);
        o.z = pg8::pk_fp8x4(s[8 * 33], s[9 * 33], s[10 * 33], s[11 * 33]); o.w = pg8::pk_fp8x4(s[12 * 33], s[13 * 33], s[14 * 33], s[15 * 33]);
        *(GAS v4u*)(WT + (size_t)(drow0 + n) * dstK + k0 + 16 * c) = o; }
    LDS_WAIT(); asm volatile("" ::: "memory");
}
constexpr int CV_S0 = 1024, CV_S1 = CV_S0 + 512, CV_S2 = CV_S1 + 1536, CV_S3 = CV_S2 + 512, CV_S4 = CV_S3 + 8192, CV_S5 = CV_S4 + 8192, CV_S6 = CV_S5 + 8192;
__device__ __forceinline__ void convert_item(const Params& P, int it, LAS float* scr, int lane) {
    unsigned char* ws = P.ws;
    if (it < CV_S0) { const int r = it, kb = r >> 6, nb = r & 63, n0 = nb * 32;
        const int drow = n0 < 1024 ? n0 : (n0 < 1536 ? (4 + ((n0 - 1024) >> 7)) * 256 + ((n0 - 1024) & 127) : (4 + ((n0 - 1536) >> 7)) * 256 + 128 + ((n0 - 1536) & 127));
        transpose_item(P.in[I_WIN], 2048, (bf16*)(ws + WS_WIN), 1024, kb * 64, n0, drow, scr, lane); }
    else if (it < CV_S1) { const int r = it - CV_S0, kb = r >> 5, nb = r & 31; transpose_item(P.in[I_WOUT], 1024, (bf16*)(ws + WS_WOUT), 1024, kb * 64, nb * 32, nb * 32, scr, lane); }
    else if (it < CV_S2) { const int r = it - CV_S1, kb = r / 96, nb = r % 96; transpose_item_fp8(P.in[I_WQKV], 3072, ws + WS_WQKV, 1024, kb * 64, nb * 32, nb * 32, scr, lane); }
    else if (it < CV_S3) { const int r = it - CV_S2, kb = r >> 5, nb = r & 31; transpose_item_fp8(P.in[I_WO2], 1024, ws + WS_WO2, 1024, kb * 64, nb * 32, nb * 32, scr, lane); }
    else if (it < CV_S5) { const bool up = it >= CV_S4; const int r = it - (up ? CV_S4 : CV_S3), le = r >> 8, q = r & 255, kb = q >> 4, nb = q & 15, n0 = nb * 32;
        const int drow = (n0 >> 7) * 256 + (up ? 128 : 0) + (n0 & 127);
        transpose_item_fp8(P.in[up ? I_WUP : I_WGATE] + (size_t)le * 1024 * 512, 512, ws + WS_WGU + (size_t)le * 1024 * 1024, 1024, kb * 64, n0, drow, scr, lane); }
    else { const int r = it - CV_S5, le = r >> 8, q = r & 255, kb = q >> 5, nb = q & 31;
        transpose_item_fp8(P.in[I_WDOWN] + (size_t)le * 512 * 1024, 1024, ws + WS_WD + (size_t)le * 1024 * 512, 512, kb * 64, nb * 32, nb * 32, scr, lane); }
}
__device__ __forceinline__ void p0_weights(const Frame& F, const Params& P) {
    LAS float* scr = (LAS float*)(F.lds + F.wave * 16384);
    const int gw = F.vcu * NWAVES + F.wave, NGW = F.G * NWAVES;
    constexpr int NP0 = CV_S3 + 3 * 4096;
    for (int j = gw; j < NP0; j += NGW) { const int it = j < CV_S3 ? j : (j < CV_S3 + 4096 ? j : (j < CV_S3 + 8192 ? CV_S4 + (j - CV_S3 - 4096) : CV_S5 + (j - CV_S3 - 8192)));
        convert_item(P, it, scr, F.lane); }
}
__device__ __forceinline__ void bg_convert(const Frame& F, const Params& P, int rank, int ns, int j0, int j1) {
    LAS float* scr = (LAS float*)(F.lds + F.wave * 16384);
    for (int j = j0 + rank * NWAVES + F.wave; j < j1; j += ns * NWAVES) { const int it = j < 4096 ? CV_S3 + 4096 + j : (j < 8192 ? CV_S4 + 4096 + (j - 4096) : CV_S5 + 4096 + (j - 8192));
        convert_item(P, it, scr, F.lane); }
}
__device__ __forceinline__ void p_modulate(const Frame& F, const float* x, const float* cond_l  , int sh_off, bf16* H) {
    const int gw = F.vcu * NWAVES + F.wave, NGW = F.G * NWAVES;
    for (int ch = gw; ch < M / 16; ch += NGW) {
        const int r0 = ch * 16, b = r0 / T; const float* cb = cond_l + (size_t)b * 6144 + sh_off;
        f32x4 sh[4], sc[4];
#pragma unroll
        for (int j = 0; j < 4; ++j) { sh[j] = *(const f32x4*)(cb + 4 * F.lane + 256 * j); sc[j] = *(const f32x4*)(cb + 1024 + 4 * F.lane + 256 * j) + 1.0f; }
#pragma unroll 4
        for (int i = 0; i < 16; ++i) { const float* xr = x + (size_t)(r0 + i) * D + 4 * F.lane; bf16* hr = H + (size_t)(r0 + i) * D + 4 * F.lane;
#pragma unroll
            for (int j = 0; j < 4; j += 2) { v2u o[2];
#pragma unroll
                for (int k = 0; k < 2; ++k) { const f32x4 v = __builtin_nontemporal_load((const f32x4*)(xr + 256 * (j + k))) * sc[j + k] + sh[j + k]; o[k].x = pk2(v[0], v[1]); o[k].y = pk2(v[2], v[3]); }
                const bool odd = (F.lane & 1) != 0; const unsigned sx = odd ? o[0].x : o[1].x, sy = odd ? o[0].y : o[1].y;
                const unsigned nx = (unsigned)__builtin_amdgcn_update_dpp(0, (int)sx, 0xB1, 0xF, 0xF, true), ny = (unsigned)__builtin_amdgcn_update_dpp(0, (int)sy, 0xB1, 0xF, 0xF, true);
                const v4u w = odd ? (v4u){nx, ny, o[1].x, o[1].y} : (v4u){o[0].x, o[0].y, nx, ny};
                *(v4u*)(hr + 256 * (j + (odd ? 1 : 0)) - (odd ? 4 : 0)) = w; } }
    }
}
__device__ __forceinline__ void p_sgu_item(const Frame& F, const Params& P, int bc, const bf16* U, const bf16* V, bf16* YC) {
    const int r0 = bc * 128;
    LAS bf16* Vt = (LAS bf16*)F.lds;
    LAS bf16* Wl = (LAS bf16*)(F.lds + 34816);
    const float* lng = P.in[I_SLNG]; const float* lnb = P.in[I_SLNB];
    const int fr = F.lane & 15, fq = F.lane >> 4, w16 = F.wave * 16;
    v4u raw[16];
#pragma unroll
    for (int i = 0; i < 16; ++i) raw[i] = __builtin_nontemporal_load((const v4u*)(V + (size_t)(r0 + w16 + i) * 512 + 8 * F.lane));
    const f32x4 g0 = *(const f32x4*)(lng + 8 * F.lane), g1 = *(const f32x4*)(lng + 8 * F.lane + 4), b0 = *(const f32x4*)(lnb + 8 * F.lane), b1 = *(const f32x4*)(lnb + 8 * F.lane + 4);
#pragma unroll
    for (int i = 0; i < 16; ++i) { const v4u rw = raw[i];
        const float v[8] = {bflo(rw.x), bfhi(rw.x), bflo(rw.y), bfhi(rw.y), bflo(rw.z), bfhi(rw.z), bflo(rw.w), bfhi(rw.w)};
        float s = 0.f;
#pragma unroll
        for (int j = 0; j < 8; ++j) s += v[j];
        const float mu = wave_sum(s) * (1.0f / 512.0f); float s2 = 0.f;
#pragma unroll
        for (int j = 0; j < 8; ++j) { const float d = v[j] - mu; s2 += d * d; }
        const float rs = 1.0f / sqrtf(wave_sum(s2) * (1.0f / 512.0f) + LN_EPS);
        v4u nw; nw.x = pk2((v[0] - mu) * rs * g0[0] + b0[0], (v[1] - mu) * rs * g0[1] + b0[1]); nw.y = pk2((v[2] - mu) * rs * g0[2] + b0[2], (v[3] - mu) * rs * g0[3] + b0[3]);
        nw.z = pk2((v[4] - mu) * rs * g1[0] + b1[0], (v[5] - mu) * rs * g1[1] + b1[1]); nw.w = pk2((v[6] - mu) * rs * g1[2] + b1[2], (v[7] - mu) * rs * g1[3] + b1[3]); raw[i] = nw; }
    f32x4 w[8];
#pragma unroll
    for (int k = 0; k < 8; ++k) w[k] = *(const f32x4*)(P.in[I_WS] + (size_t)(F.tid + 512 * k) * 4);
    for (int g = 0; g < 4; ++g) {
        if (fq == g) { const int d0 = 8 * fr;
#define SGU_W(rw, jp) ((jp) == 0 ? (rw).x : (jp) == 1 ? (rw).y : (jp) == 2 ? (rw).z : (rw).w)
#pragma unroll
            for (int i4 = 0; i4 < 16; i4 += 4)
#pragma unroll
                for (int jp = 0; jp < 4; ++jp) { const unsigned w0 = SGU_W(raw[i4], jp), w1 = SGU_W(raw[i4 + 1], jp), w2 = SGU_W(raw[i4 + 2], jp), w3 = SGU_W(raw[i4 + 3], jp);
                    v2u lo, hi; lo.x = __builtin_amdgcn_perm(w1, w0, 0x05040100u); lo.y = __builtin_amdgcn_perm(w3, w2, 0x05040100u); hi.x = __builtin_amdgcn_perm(w1, w0, 0x07060302u); hi.y = __builtin_amdgcn_perm(w3, w2, 0x07060302u);
                    *(LAS v2u*)(Vt + (d0 + 2 * jp) * 136 + w16 + i4) = lo; *(LAS v2u*)(Vt + (d0 + 2 * jp + 1) * 136 + w16 + i4) = hi; }
#undef SGU_W
        }
        {
#pragma unroll
            for (int k = 0; k < 8; ++k) { const int i = F.tid + 512 * k, p = i >> 5, q4 = (i & 31) * 4;
                v2u o; o.x = pk2(q4 + 0 <= p ? w[k][0] : 0.f, q4 + 1 <= p ? w[k][1] : 0.f); o.y = pk2(q4 + 2 <= p ? w[k][2] : 0.f, q4 + 3 <= p ? w[k][3] : 0.f);
                *(LAS v2u*)(Wl + p * 136 + q4) = o; }
            if (g < 3) { const float* wsn = P.in[I_WS] + (size_t)(g + 1) * 128 * 128;
#pragma unroll
                for (int k = 0; k < 8; ++k) w[k] = *(const f32x4*)(wsn + (size_t)(F.tid + 512 * k) * 4); } }
        const int row = r0 + w16 + fr; const float bs = P.in[I_BS][g * 128 + w16 + fr];
        v2u uu[8];
#pragma unroll
        for (int nt = 0; nt < 8; nt += 2) { const v4u ld = __builtin_nontemporal_load((const v4u*)(U + (size_t)row * 512 + 128 * g + 16 * (nt + (fq & 1)) + 4 * (fq & ~1)));
            auto rx = __builtin_amdgcn_permlane16_swap(ld.x, ld.z, false, false); auto ry = __builtin_amdgcn_permlane16_swap(ld.y, ld.w, false, false);
            uu[nt] = (v2u){rx[0], ry[0]}; uu[nt + 1] = (v2u){rx[1], ry[1]}; }
        __syncthreads();
        f32x4 acc[8];
#pragma unroll
        for (int nt = 0; nt < 8; ++nt) acc[nt] = (f32x4){0.f, 0.f, 0.f, 0.f};
#pragma unroll
        for (int ks = 0; ks < 4; ++ks) { if (32 * ks <= w16 + 15) {
            const bf16x8 wf = *(const LAS bf16x8*)(Wl + (w16 + fr) * 136 + 32 * ks + 8 * fq);
#pragma unroll
            for (int nt = 0; nt < 8; ++nt) { const bf16x8 vf = *(const LAS bf16x8*)(Vt + (16 * nt + fr) * 136 + 32 * ks + 8 * fq);
                acc[nt] = __builtin_amdgcn_mfma_f32_16x16x32_bf16(vf, wf, acc[nt], 0, 0, 0); } } }
#pragma unroll
        for (int nt = 0; nt < 8; nt += 2) { v2u o[2];
#pragma unroll
            for (int k = 0; k < 2; ++k) { o[k].x = pk2(bflo(uu[nt + k].x) * (acc[nt + k][0] + bs), bfhi(uu[nt + k].x) * (acc[nt + k][1] + bs)); o[k].y = pk2(bflo(uu[nt + k].y) * (acc[nt + k][2] + bs), bfhi(uu[nt + k].y) * (acc[nt + k][3] + bs)); }
            auto rx = __builtin_amdgcn_permlane16_swap(o[0].x, o[1].x, false, false); auto ry = __builtin_amdgcn_permlane16_swap(o[0].y, o[1].y, false, false);
            *(v4u*)(YC + (size_t)row * D + 128 * g + 16 * (nt + (fq & 1)) + 4 * (fq & ~1)) = (v4u){rx[0], ry[0], rx[1], ry[1]}; }
        __syncthreads();
    }
}
__device__ __forceinline__ void conv_load(const Frame& F, int ci, const bf16* Gb, v4u (&v)[8]) {
    const int R0 = ci * 32, b = R0 / T, t0 = R0 % T;
#pragma unroll
    for (int k = 0; k < 8; ++k) { const int i = F.tid + 512 * k, r = i >> 6, cc = i & 63, t = t0 - 30 + r; const int tc = t < 0 ? 0 : (r > 61 ? t0 : t);
        v[k] = *(const v4u*)(Gb + (size_t)(b * T + tc) * 512 + cc * 8); if (t < 0) v[k] = (v4u){0u, 0u, 0u, 0u}; }
}
struct ConvConst { f32x2 w2[31]; f32x2 bd; f32x4 g0, g1, b0, b1; };
__device__ __forceinline__ void conv_const(const Frame& F, const Params& P, ConvConst& C) { const int cp = F.tid & 255; const float* wdw = P.in[I_WDW];
#pragma unroll
    for (int k = 0; k < 31; ++k) C.w2[k] = *(const f32x2*)(wdw + k * 512 + 2 * cp);
    C.bd = *(const f32x2*)(P.in[I_BDW] + 2 * cp); const float* lng = P.in[I_CLNG]; const float* lnb = P.in[I_CLNB];
    C.g0 = *(const f32x4*)(lng + 8 * F.lane); C.g1 = *(const f32x4*)(lng + 8 * F.lane + 4); C.b0 = *(const f32x4*)(lnb + 8 * F.lane); C.b1 = *(const f32x4*)(lnb + 8 * F.lane + 4); }
__device__ __forceinline__ void p_conv_item(const Frame& F, const Params& P, int ci, int ci_next, const bf16* Gb, bf16* YC, v4u (&v)[8], const ConvConst& C) {
    const int R0 = ci * 32;
    LAS bf16* Gin = (LAS bf16*)F.lds;
    LAS float* Yc = (LAS float*)(F.lds + 63488);
#pragma unroll
    for (int k = 0; k < 8; ++k) { const int i = F.tid + 512 * k, r = i >> 6, cc = i & 63; if (i < 62 * 64) *(LAS v4u*)(Gin + r * 512 + cc * 8) = v[k]; }
    if (ci_next >= 0) conv_load(F, ci_next, Gb, v);
    __syncthreads();
    { const int cp = F.tid & 255, th = F.tid >> 8;
        const f32x2 bd = C.bd;
#pragma unroll 1
        for (int blk = 0; blk < 2; ++blk) { const int o0 = 16 * th + 8 * blk; f32x2 a2[8];
#pragma unroll
            for (int o = 0; o < 8; ++o) a2[o] = bd;
#pragma unroll
            for (int i = 0; i < 38; ++i) { const unsigned pr = *(const LAS unsigned*)(Gin + (o0 + i) * 512 + 2 * cp); const f32x2 vv = (f32x2){bflo(pr), bfhi(pr)};
#pragma unroll
                for (int o = 0; o < 8; ++o) { const int k = i - o; if (k >= 0 && k < 31) a2[o] = __builtin_elementwise_fma(C.w2[k], vv, a2[o]); } }
#pragma unroll
            for (int o = 0; o < 8; ++o) *(LAS f32x2*)(Yc + (o0 + o) * 512 + 2 * cp) = a2[o]; }
    }
    __syncthreads();
    { const f32x4 g0 = C.g0, g1 = C.g1, b0 = C.b0, b1 = C.b1;
        f32x4 y[4][2]; float s[4], q[4];
#pragma unroll
        for (int i = 0; i < 4; ++i) { const int r = F.wave * 4 + i; y[i][0] = *(const LAS f32x4*)(Yc + r * 512 + 8 * F.lane); y[i][1] = *(const LAS f32x4*)(Yc + r * 512 + 8 * F.lane + 4); }
#pragma unroll
        for (int i = 0; i < 4; ++i) { const f32x4 a = y[i][0], b = y[i][1]; s[i] = ((a[0] + a[1]) + (a[2] + a[3])) + ((b[0] + b[1]) + (b[2] + b[3]));
            q[i] = ((a[0] * a[0] + a[1] * a[1]) + (a[2] * a[2] + a[3] * a[3])) + ((b[0] * b[0] + b[1] * b[1]) + (b[2] * b[2] + b[3] * b[3])); }
        wave_sum4(s[0], s[1], s[2], s[3], s[0], s[1], s[2], s[3], F.lane); wave_sum4(q[0], q[1], q[2], q[3], q[0], q[1], q[2], q[3], F.lane);
#pragma unroll
        for (int i = 0; i < 4; ++i) { const int r = F.wave * 4 + i; const float mean = s[i] * (1.0f / 512.0f), rstd = 1.0f / sqrtf(fmaxf(q[i] * (1.0f / 512.0f) - mean * mean, 0.f) + LN_EPS);
            float v8[8] = {y[i][0][0], y[i][0][1], y[i][0][2], y[i][0][3], y[i][1][0], y[i][1][1], y[i][1][2], y[i][1][3]};
#pragma unroll
            for (int j = 0; j < 8; ++j) { const float z = (v8[j] - mean) * rstd * (j < 4 ? g0[j & 3] : g1[j & 3]) + (j < 4 ? b0[j & 3] : b1[j & 3]); v8[j] = z * __builtin_amdgcn_rcpf(1.0f + __expf(-z)); }
            v4u o; o.x = pk2(v8[0], v8[1]); o.y = pk2(v8[2], v8[3]); o.z = pk2(v8[4], v8[5]); o.w = pk2(v8[6], v8[7]);
            *(v4u*)(YC + (size_t)(R0 + r) * D + 512 + 8 * F.lane) = o; }
    }
    __syncthreads();
}
#define COL8(q) (512 * ((q) >> 1) + 8 * F.lane + 4 * ((q) & 1))
struct RowVec { f32x4 v[4]; };
__device__ __forceinline__ f32x4 up4(v2u w) { return (f32x4){bflo(w.x), bfhi(w.x), bflo(w.y), bfhi(w.y)}; }
__device__ __forceinline__ f32x4 up4f8(unsigned w) { const f32x2 lo = __builtin_amdgcn_cvt_pk_f32_fp8((int)w, false), hi = __builtin_amdgcn_cvt_pk_f32_fp8((int)w, true); return (f32x4){lo[0], lo[1], hi[0], hi[1]}; }
__device__ __forceinline__ void ln_stats(RowVec& t, float& rstd) {
    float s = 0.f;
#pragma unroll
    for (int j = 0; j < 4; ++j) s += (t.v[j][0] + t.v[j][1]) + (t.v[j][2] + t.v[j][3]);
    const float mean = wave_sum(s) * (1.0f / D); float s2 = 0.f;
#pragma unroll
    for (int j = 0; j < 4; ++j) { t.v[j] = t.v[j] - mean; s2 += (t.v[j][0] * t.v[j][0] + t.v[j][1] * t.v[j][1]) + (t.v[j][2] * t.v[j][2] + t.v[j][3] * t.v[j][3]); }
    rstd = 1.0f / sqrtf(wave_sum(s2) * (1.0f / D) + LN_EPS);
}
struct ModVecs { f32x4 A[4], B[4], G[4], C[4], Dv[4]; };
__device__ __forceinline__ void mod_vecs(const Frame& F, ModVecs& mv, const float* cin, int sh_in, int g_off, const float* lng, const float* lnb, const float* cout, int sh_out) {
#pragma unroll
    for (int q = 0; q < 4; ++q) { const int col = COL8(q);
        const f32x4 sh = *(const f32x4*)(cin + sh_in + col), sc1 = *(const f32x4*)(cin + sh_in + 1024 + col) + 1.0f;
        f32x4 a; a[0] = DN_ALPHA / sc1[0]; a[1] = DN_ALPHA / sc1[1]; a[2] = DN_ALPHA / sc1[2]; a[3] = DN_ALPHA / sc1[3];
        mv.A[q] = a; mv.B[q] = -sh * a; mv.G[q] = *(const f32x4*)(cin + g_off + col) + 1.0f;
        const f32x4 g = *(const f32x4*)(lng + col), b = *(const f32x4*)(lnb + col);
        if (cout) { const f32x4 so = *(const f32x4*)(cout + sh_out + 1024 + col) + 1.0f; mv.C[q] = g * so; mv.Dv[q] = b * so + *(const f32x4*)(cout + sh_out + col); }
        else { mv.C[q] = g; mv.Dv[q] = b; } }
}
__device__ __forceinline__ int slot8(int c) { return (((c >> 9) << 1) | ((c >> 2) & 1)) * 256 + ((c & 511) >> 3) * 4 + (c & 3); }
__device__ __forceinline__ void moe_table(const Frame& F, unsigned* gcnt, LAS int* tl) {
    if (F.tid < 16) tl[F.tid] = (int)((__hip_atomic_load((unsigned long long*)(gcnt + 64 * (F.tid >> 2)), __ATOMIC_RELAXED, __HIP_MEMORY_SCOPE_AGENT) >> (16 * (F.tid & 3))) & 0xffffu);
    __syncthreads();
    if (F.tid == 0) { int s = 0; for (int e = 0; e < 16; ++e) { tl[16 + e] = s; s += (tl[e] + 255) & ~255; } tl[32] = s; }
    __syncthreads();
    if (F.tid < MAXT) { const int r = F.tid * 256; int e = 15; for (int k = 15; k >= 0; --k) if (r < tl[16 + k + 1]) e = k; tl[64 + F.tid] = e; }
    __syncthreads();
}
__device__ __forceinline__ void p9_fill_start(unsigned* gcnt, LAS int* dst, int t) {
    if ((unsigned)t < 64u) { const int e = t & 15;
        const int tot = (int)((__hip_atomic_load((unsigned long long*)(gcnt + 64 * (e >> 2)), __ATOMIC_RELAXED, __HIP_MEMORY_SCOPE_AGENT) >> (16 * (e & 3))) & 0xffffu), pad = (tot + 255) & ~255;
        int s = pad;
#pragma unroll
        for (int d = 1; d < 16; d <<= 1) { const int v = __shfl_up(s, d, 16); if (e >= d) s += v; }
        if (t < 16) dst[e] = s - pad; }
}
__device__ __forceinline__ void p5_fill_w(const Frame& F, const Params& P, int layer, int t, int nthr) {
    LAS float* Wr = (LAS float*)F.lds;
    const float* wg = P.in[I_WGRP] + (size_t)layer * D * 4; const float* we = P.in[I_WER] + (size_t)layer * 4 * D * 4;
    for (int d = t; d < D; d += nthr) { const f32x4 a = *(const f32x4*)(wg + d * 4); const int s = slot8(d);
#pragma unroll
        for (int o = 0; o < 4; ++o) Wr[o * D + s] = a[o];
#pragma unroll
        for (int g = 0; g < 4; ++g) { const f32x4 e = *(const f32x4*)(we + ((size_t)g * D + d) * 4);
#pragma unroll
            for (int o = 0; o < 4; ++o) Wr[(4 + 4 * g + o) * D + s] = e[o]; } }
    LAS float* bg = (LAS float*)(F.lds + 81920 + 64); LAS float* be = bg + 4;
    if (t < 4) bg[t] = P.in[I_BGRP][layer * 4 + t]; if (t >= 64 && t < 80) be[t - 64] = P.in[I_BER][layer * 16 + t - 64];
}
__device__ __forceinline__ void p5_fill_mv(const Frame& F, const Params& P, int layer, int it, int t) {
    LAS int* cntl = (LAS int*)(F.lds + 81920); LAS float* MV = (LAS float*)(F.lds + 82944);
    const float* cond_l = (const float*)(P.ws + WS_COND) + (size_t)layer * 16 * 6144; const float* lng = P.in[I_LNMG] + layer * D; const float* lnb = P.in[I_LNMB] + layer * D;
    const int b = (it * 128) / T; const float* cb = cond_l + (size_t)b * 6144;
        if (t < 16) cntl[t] = 0;
        if (t < 256) { const int col = 4 * t, s = slot8(col); const f32x4 sh = *(const f32x4*)(cb + col), sc1 = *(const f32x4*)(cb + 1024 + col) + 1.0f;
            f32x4 a; a[0] = DN_ALPHA / sc1[0]; a[1] = DN_ALPHA / sc1[1]; a[2] = DN_ALPHA / sc1[2]; a[3] = DN_ALPHA / sc1[3];
            const f32x4 g = *(const f32x4*)(lng + col), bb = *(const f32x4*)(lnb + col), so = *(const f32x4*)(cb + 4096 + col) + 1.0f;
            *(LAS f32x4*)(MV + s) = a; *(LAS f32x4*)(MV + 1024 + s) = -sh * a; *(LAS f32x4*)(MV + 2048 + s) = *(const f32x4*)(cb + 2048 + col) + 1.0f;
            *(LAS f32x4*)(MV + 3072 + s) = g * so; *(LAS f32x4*)(MV + 4096 + s) = bb * so + *(const f32x4*)(cb + 3072 + col); }
}
struct RowRaw { v4u h[2]; v4u y[2]; };
template <bool Y8> __device__ __forceinline__ void p_ln_route(const Frame& F, const Params& P, int layer, const void* Yv, bf16* H, bf16* Hout, unsigned char* H8, bool pre) {
    const bf16* Y = (const bf16*)Yv; const unsigned char* Yb = (const unsigned char*)Yv;
    unsigned char* ws = P.ws;
    LAS float* Wr = (LAS float*)F.lds;
    LAS int* cntl = (LAS int*)(F.lds + 81920);
    LAS float* MV = (LAS float*)(F.lds + 82944);
    if (!pre) p5_fill_w(F, P, layer, F.tid, 512);
    LAS float* bg = (LAS float*)(F.lds + 81920 + 64); LAS float* be = bg + 4;
    const float* cond_l = (const float*)(ws + WS_COND) + (size_t)layer * 16 * 6144;
    const float* lng = P.in[I_LNMG] + layer * D; const float* lnb = P.in[I_LNMB] + layer * D;
    int* route_e = (int*)(ws + WS_ROUTE_E); f32x2* route_w = (f32x2*)(ws + WS_ROUTE_W);
    LAS int* ael = (LAS int*)(F.lds + 103424)  ; LAS int* basel = ael + 256  ; LAS int* totl = basel + 16  ; LAS int* startl = totl + 16  ; LAS int* lastf = startl + 32;
    unsigned* gcnt = (unsigned*)(ws + WS_CTL) + CW_MOE + layer * 2048;
    int* pos = (int*)(ws + WS_POS); int* inv = (int*)(ws + WS_INV); int* tab = (int*)(ws + WS_TILE);
    for (int it = F.vcu; it < 256; it += F.G) {
        const int rbase = it * 128 + F.wave * 16, b = rbase / T; const float* cb = cond_l + (size_t)b * 6144;
        RowRaw rb[4];
#define LD_ROW(dst, r) do { _Pragma("unroll") for (int j = 0; j < 2; ++j) { (dst).h[j] = __builtin_nontemporal_load((const v4u*)(H + (size_t)(r) * D + 8 * F.lane + 512 * j)); if constexpr (Y8) { const v2u y8_ = __builtin_nontemporal_load((const v2u*)(Yb + (size_t)(r) * D + 8 * F.lane + 512 * j)); (dst).y[j] = (v4u){y8_.x, y8_.y, 0u, 0u}; } else (dst).y[j] = __builtin_nontemporal_load((const v4u*)(Y + (size_t)(r) * D + 8 * F.lane + 512 * j)); } } while (0)
        if (!(pre && it == F.vcu)) p5_fill_mv(F, P, layer, it, F.tid);
        __syncthreads();
#define P5_PAIR(bA, bB, ii, REA_, WA0_, WA1_, REB_, WB0_, WB1_) do { const int r = rbase + (ii); RowVec tA, tB; float rsA, rsB; \
            _Pragma("unroll") for (int q = 0; q < 4; ++q) { const int s = 256 * q + 4 * F.lane; const f32x4 mA = *(const LAS f32x4*)(MV + s), mB = *(const LAS f32x4*)(MV + 1024 + s), mG = *(const LAS f32x4*)(MV + 2048 + s); \
                { const v4u hw = (bA).h[q >> 1], yw = (bA).y[q >> 1]; const v2u h2 = (q & 1) ? (v2u){hw.z, hw.w} : (v2u){hw.x, hw.y}, y2 = (q & 1) ? (v2u){yw.z, yw.w} : (v2u){yw.x, yw.y}; f32x4 yv; if constexpr (Y8) yv = up4f8((q & 1) ? yw.y : yw.x) * 0.015625f; else yv = up4(y2); tA.v[q] = up4(h2) * mA + mB + mG * yv; } \
                { const v4u hw = (bB).h[q >> 1], yw = (bB).y[q >> 1]; const v2u h2 = (q & 1) ? (v2u){hw.z, hw.w} : (v2u){hw.x, hw.y}, y2 = (q & 1) ? (v2u){yw.z, yw.w} : (v2u){yw.x, yw.y}; f32x4 yv; if constexpr (Y8) yv = up4f8((q & 1) ? yw.y : yw.x) * 0.015625f; else yv = up4(y2); tB.v[q] = up4(h2) * mA + mB + mG * yv; } } \
            float sA_ = 0.f, qA_ = 0.f, sB_ = 0.f, qB_ = 0.f; \
            _Pragma("unroll") for (int q = 0; q < 4; ++q) { const f32x4 xa = tA.v[q], xb = tB.v[q]; sA_ += (xa[0] + xa[1]) + (xa[2] + xa[3]); qA_ += (xa[0] * xa[0] + xa[1] * xa[1]) + (xa[2] * xa[2] + xa[3] * xa[3]); \
                sB_ += (xb[0] + xb[1]) + (xb[2] + xb[3]); qB_ += (xb[0] * xb[0] + xb[1] * xb[1]) + (xb[2] * xb[2] + xb[3] * xb[3]); } \
            float tsA, tqA, tsB, tqB; wave_sum4(sA_, qA_, sB_, qB_, tsA, tqA, tsB, tqB, F.lane);     \
            const float mnA = tsA * (1.0f / D), mnB = tsB * (1.0f / D); rsA = __builtin_amdgcn_rsqf(fmaxf(tqA * (1.0f / D) - mnA * mnA, 0.f) + LN_EPS); rsB = __builtin_amdgcn_rsqf(fmaxf(tqB * (1.0f / D) - mnB * mnB, 0.f) + LN_EPS); \
            f32x4 aA[4] = {}, aB[4] = {}; unsigned owA[8], o8A[4], owB[8], o8B[4];     \
            _Pragma("unroll") for (int q = 0; q < 4; ++q) { const int s = 256 * q + 4 * F.lane; const f32x4 mC = *(const LAS f32x4*)(MV + 3072 + s), mD = *(const LAS f32x4*)(MV + 4096 + s); \
                const f32x4 hA = (tA.v[q] - mnA) * rsA * mC + mD, hB = (tB.v[q] - mnB) * rsB * mC + mD; tA.v[q] = hA; tB.v[q] = hB; \
                owA[2 * q] = pk2(hA[0], hA[1]); owA[2 * q + 1] = pk2(hA[2], hA[3]); o8A[q] = pg8::pk_fp8x4(hA[0], hA[1], hA[2], hA[3]); \
                owB[2 * q] = pk2(hB[0], hB[1]); owB[2 * q + 1] = pk2(hB[2], hB[3]); o8B[q] = pg8::pk_fp8x4(hB[0], hB[1], hB[2], hB[3]); \
                _Pragma("unroll") for (int o = 0; o < 4; ++o) { const f32x4 w = *(const LAS f32x4*)(Wr + o * D + s); \
                    aA[o] = __builtin_elementwise_fma(hA, w, aA[o]); aB[o] = __builtin_elementwise_fma(hB, w, aB[o]); } } \
            *(v4u*)(Hout + (size_t)r * D + 8 * F.lane) = (v4u){owA[0], owA[1], owA[2], owA[3]}; *(v4u*)(Hout + (size_t)r * D + 8 * F.lane + 512) = (v4u){owA[4], owA[5], owA[6], owA[7]}; \
            *(v4u*)(Hout + (size_t)(r + 1) * D + 8 * F.lane) = (v4u){owB[0], owB[1], owB[2], owB[3]}; *(v4u*)(Hout + (size_t)(r + 1) * D + 8 * F.lane + 512) = (v4u){owB[4], owB[5], owB[6], owB[7]}; \
            *(v2u*)(H8 + (size_t)r * D + 8 * F.lane) = (v2u){o8A[0], o8A[1]}; *(v2u*)(H8 + (size_t)r * D + 8 * F.lane + 512) = (v2u){o8A[2], o8A[3]}; \
            *(v2u*)(H8 + (size_t)(r + 1) * D + 8 * F.lane) = (v2u){o8B[0], o8B[1]}; *(v2u*)(H8 + (size_t)(r + 1) * D + 8 * F.lane + 512) = (v2u){o8B[2], o8B[3]}; \
            __builtin_amdgcn_sched_barrier(0); \
            float lA[4], lB[4]; _Pragma("unroll") for (int o = 0; o < 4; ++o) { lA[o] = (aA[o][0] + aA[o][1]) + (aA[o][2] + aA[o][3]); lB[o] = (aB[o][0] + aB[o][1]) + (aB[o][2] + aB[o][3]); } \
            wave_sum4(lA[0], lA[1], lA[2], lA[3], lA[0], lA[1], lA[2], lA[3], F.lane); wave_sum4(lB[0], lB[1], lB[2], lB[3], lB[0], lB[1], lB[2], lB[3], F.lane); \
            _Pragma("unroll") for (int o = 0; o < 4; ++o) { lA[o] += bg[o]; lB[o] += bg[o]; } \
            int gA = 0, gB = 0; float mxA = lA[0], mxB = lB[0]; \
            _Pragma("unroll") for (int j = 1; j < 4; ++j) { if (lA[j] > mxA) { mxA = lA[j]; gA = j; } if (lB[j] > mxB) { mxB = lB[j]; gB = j; } } \
            gA = __builtin_amdgcn_readfirstlane(gA); gB = __builtin_amdgcn_readfirstlane(gB); \
            float dA = 0.f, dB = 0.f; \
            _Pragma("unroll") for (int j = 0; j < 4; ++j) { dA += __expf(lA[j] - mxA); dB += __expf(lB[j] - mxB); } \
            const float gwA = __builtin_amdgcn_rcpf(dA), gwB = __builtin_amdgcn_rcpf(dB); \
            f32x4 cA[4] = {}, cB[4] = {}; const LAS float* WeA = Wr + (4 + 4 * gA) * D; const LAS float* WeB = Wr + (4 + 4 * gB) * D; \
            _Pragma("unroll") for (int q = 0; q < 4; ++q) { const int s = 256 * q + 4 * F.lane; const f32x4 hA = tA.v[q], hB = tB.v[q]; \
                _Pragma("unroll") for (int o = 0; o < 4; ++o) { const f32x4 wA = *(const LAS f32x4*)(WeA + o * D + s), wB = *(const LAS f32x4*)(WeB + o * D + s); \
                    cA[o] = __builtin_elementwise_fma(hA, wA, cA[o]); cB[o] = __builtin_elementwise_fma(hB, wB, cB[o]); } } \
            __builtin_amdgcn_sched_barrier(0); \
            float eA[4], eB[4]; _Pragma("unroll") for (int o = 0; o < 4; ++o) { eA[o] = (cA[o][0] + cA[o][1]) + (cA[o][2] + cA[o][3]); eB[o] = (cB[o][0] + cB[o][1]) + (cB[o][2] + cB[o][3]); } \
            wave_sum4(eA[0], eA[1], eA[2], eA[3], eA[0], eA[1], eA[2], eA[3], F.lane); wave_sum4(eB[0], eB[1], eB[2], eB[3], eB[0], eB[1], eB[2], eB[3], F.lane); \
            _Pragma("unroll") for (int o = 0; o < 4; ++o) { eA[o] += be[gA * 4 + o]; eB[o] += be[gB * 4 + o]; } \
            { int i0 = 0; float m0 = eA[0]; _Pragma("unroll") for (int e2 = 1; e2 < 4; ++e2) if (eA[e2] > m0) { m0 = eA[e2]; i0 = e2; } \
              int i1 = 0; float m1 = -__builtin_inff(); _Pragma("unroll") for (int e2 = 0; e2 < 4; ++e2) if (e2 != i0 && eA[e2] > m1) { m1 = eA[e2]; i1 = e2; } \
              WA0_ = gwA * __builtin_amdgcn_rcpf(1.0f + __expf(m1 - m0)); WA1_ = gwA - WA0_; REA_ = (gA * 4 + i0) | ((gA * 4 + i1) << 8); } \
            { int i0 = 0; float m0 = eB[0]; _Pragma("unroll") for (int e2 = 1; e2 < 4; ++e2) if (eB[e2] > m0) { m0 = eB[e2]; i0 = e2; } \
              int i1 = 0; float m1 = -__builtin_inff(); _Pragma("unroll") for (int e2 = 0; e2 < 4; ++e2) if (e2 != i0 && eB[e2] > m1) { m1 = eB[e2]; i1 = e2; } \
              WB0_ = gwB * __builtin_amdgcn_rcpf(1.0f + __expf(m1 - m0)); WB1_ = gwB - WB0_; REB_ = (gB * 4 + i0) | ((gB * 4 + i1) << 8); } } while (0)
        for (int i = 0; i < 16; i += 4) { asm volatile("" ::: "memory"); LD_ROW(rb[0], rbase + i); LD_ROW(rb[1], rbase + i + 1); LD_ROW(rb[2], rbase + i + 2); LD_ROW(rb[3], rbase + i + 3);
            int re0, re1, re2, re3; float wa0, wa1, wa2, wa3, wb0, wb1, wb2, wb3;
            P5_PAIR(rb[0], rb[1], i, re0, wa0, wb0, re1, wa1, wb1); __builtin_amdgcn_sched_barrier(0); P5_PAIR(rb[2], rb[3], i + 2, re2, wa2, wb2, re3, wa3, wb3);
            if (F.lane == 0) { const int r = rbase + i; *(v4u*)(route_e + r) = (v4u){(unsigned)re0, (unsigned)re1, (unsigned)re2, (unsigned)re3};
                { LAS int* ap = ael + 2 * (F.wave * 16 + i); ap[0] = re0 & 0xff; ap[1] = re0 >> 8; ap[2] = re1 & 0xff; ap[3] = re1 >> 8; ap[4] = re2 & 0xff; ap[5] = re2 >> 8; ap[6] = re3 & 0xff; ap[7] = re3 >> 8; }
                *(f32x4*)(route_w + r) = (f32x4){wa0, wb0, wa1, wb1}; *(f32x4*)(route_w + r + 2) = (f32x4){wa2, wb2, wa3, wb3};
                __hip_atomic_fetch_add(&cntl[re0 & 0xff], 1, __ATOMIC_RELAXED, __HIP_MEMORY_SCOPE_WORKGROUP); __hip_atomic_fetch_add(&cntl[re0 >> 8], 1, __ATOMIC_RELAXED, __HIP_MEMORY_SCOPE_WORKGROUP);
                __hip_atomic_fetch_add(&cntl[re1 & 0xff], 1, __ATOMIC_RELAXED, __HIP_MEMORY_SCOPE_WORKGROUP); __hip_atomic_fetch_add(&cntl[re1 >> 8], 1, __ATOMIC_RELAXED, __HIP_MEMORY_SCOPE_WORKGROUP);
                __hip_atomic_fetch_add(&cntl[re2 & 0xff], 1, __ATOMIC_RELAXED, __HIP_MEMORY_SCOPE_WORKGROUP); __hip_atomic_fetch_add(&cntl[re2 >> 8], 1, __ATOMIC_RELAXED, __HIP_MEMORY_SCOPE_WORKGROUP);
                __hip_atomic_fetch_add(&cntl[re3 & 0xff], 1, __ATOMIC_RELAXED, __HIP_MEMORY_SCOPE_WORKGROUP); __hip_atomic_fetch_add(&cntl[re3 >> 8], 1, __ATOMIC_RELAXED, __HIP_MEMORY_SCOPE_WORKGROUP); } }
#undef P5_PAIR
#undef LD_ROW
        __syncthreads();
        if (F.tid < 4) { const unsigned long long c = (unsigned long long)(unsigned)cntl[4 * F.tid] | ((unsigned long long)(unsigned)cntl[4 * F.tid + 1] << 16) | ((unsigned long long)(unsigned)cntl[4 * F.tid + 2] << 32) | ((unsigned long long)(unsigned)cntl[4 * F.tid + 3] << 48);
            const unsigned long long o = __hip_atomic_fetch_add((unsigned long long*)(gcnt + 64 * F.tid), c, __ATOMIC_RELAXED, __HIP_MEMORY_SCOPE_AGENT);
            basel[4 * F.tid] = (int)(o & 0xffffu); basel[4 * F.tid + 1] = (int)((o >> 16) & 0xffffu); basel[4 * F.tid + 2] = (int)((o >> 32) & 0xffffu); basel[4 * F.tid + 3] = (int)(o >> 48); }
        __syncthreads();
        { LAS int* wc = lastf + 16;
          int me = 0, rin = 0;
          if (F.tid < 256) { me = ael[F.tid]; int wcount = 0;
#pragma unroll 1
              for (int e = 0; e < 16; ++e) { const unsigned long long m = __ballot(me == e); const int below = (int)__builtin_amdgcn_mbcnt_hi((unsigned)(m >> 32), __builtin_amdgcn_mbcnt_lo((unsigned)m, 0u));
                  if (me == e) rin = below; if (F.lane == e) wcount = __popcll(m); }
              if (F.lane < 16) wc[F.wave * 16 + F.lane] = wcount; }
          __syncthreads();
          if (F.tid < 256) { int rank = rin; for (int w = 0; w < 3; ++w) if (w < F.wave) rank += wc[w * 16 + me];
              const int off = basel[me] + rank, token = it * 128 + (F.tid >> 1); pos[token * 2 + (F.tid & 1)] = off; inv[me * INV_CAP + off] = token; } }
        __syncthreads();
    }
}
__device__ __forceinline__ void p_positions(const Frame& F, const Params& P) {
    unsigned char* ws = P.ws;
    LAS int* part = (LAS int*)F.lds;
    LAS int* tot = part + 512; LAS int* pre = tot + 16; LAS int* start = pre + 16  ; LAS int* ae = start + 32  ; LAS int* inpart = ae + 256  ;
    const int* cnt = (const int*)(ws + WS_CNT); const int* route_e = (const int*)(ws + WS_ROUTE_E); int* pos = (int*)(ws + WS_POS); int* tile_e = (int*)(ws + WS_TILE); int* inv = (int*)(ws + WS_INV);
    for (int it = F.vcu; it < 256; it += F.G) {
        { const int e = F.tid & 15, pt = F.tid >> 4; int s = 0, pp = 0;
#pragma unroll
            for (int c = 0; c < 8; ++c) { const int v = cnt[(pt * 8 + c) * 16 + e]; s += v; if (pt * 8 + c < it) pp += v; }
            part[pt * 16 + e] = s; if (pt == (it >> 3)) inpart[e] = pp; }
        __syncthreads();
        if (F.tid < 16) { const int e = F.tid; int s = 0, p = 0;
            for (int q = 0; q < 32; ++q) { const int v = part[q * 16 + e]; s += v; if (q < (it >> 3)) p += v; }
            tot[e] = s; pre[e] = p + inpart[e]; }
        __syncthreads();
        if (F.tid == 0) { int s = 0; for (int e = 0; e < 16; ++e) { start[e] = s; s += (tot[e] + 255) & ~255; } start[16] = s; }
        if (F.tid < 256) { const int token = it * 128 + (F.tid >> 1); ae[F.tid] = (route_e[token] >> (8 * (F.tid & 1))) & 0xff; }
        __syncthreads();
        if (F.tid < 256) { const int me = ae[F.tid]; int rank = 0; for (int a = 0; a < F.tid; ++a) rank += (ae[a] == me) ? 1 : 0;
            const int p = start[me] + pre[me] + rank, token = it * 128 + (F.tid >> 1); pos[token * 2 + (F.tid & 1)] = p; inv[p] = token; }
        if (it < 16) { const int e = it; for (int p = start[e] + tot[e] + F.tid; p < start[e + 1]; p += 512) inv[p] = 0; }
        if (it == 0) { if (F.tid < MAXT) { const int r = F.tid * 256; int e = 15; for (int k = 15; k >= 0; --k) if (r < start[k + 1]) e = k; tile_e[F.tid] = e; } if (F.tid == 0) tile_e[511] = start[16] >> 8; }
        __syncthreads();
    }
}
struct Raw3 { v4u h[2]; v2u ya[2], yb[2]; f32x2 rw; };
template <bool FINAL> __device__ __forceinline__ void p9_fill_mv(const Frame& F, const Params& P, int layer, int it, int t) {
    unsigned char* ws = P.ws; LAS float* MV = (LAS float*)F.lds;
    const float* lng = P.in[I_LNFG] + layer * D; const float* lnb = P.in[I_LNFB] + layer * D;
    const int b = (it * 128) / T; const float* cb = (const float*)(ws + WS_COND) + ((size_t)layer * 16 + b) * 6144; const float* cbn = FINAL ? nullptr : (const float*)(ws + WS_COND) + ((size_t)(layer + 1) * 16 + b) * 6144;
        if (t < 256) { const int col = 4 * t, s = slot8(col); const f32x4 sh = *(const f32x4*)(cb + 3072 + col), sc1 = *(const f32x4*)(cb + 4096 + col) + 1.0f;
            f32x4 a; a[0] = DN_ALPHA / sc1[0]; a[1] = DN_ALPHA / sc1[1]; a[2] = DN_ALPHA / sc1[2]; a[3] = DN_ALPHA / sc1[3];
            const f32x4 g = *(const f32x4*)(lng + col), bb = *(const f32x4*)(lnb + col);
            *(LAS f32x4*)(MV + s) = a; *(LAS f32x4*)(MV + 1024 + s) = -sh * a; *(LAS f32x4*)(MV + 2048 + s) = *(const f32x4*)(cb + 5120 + col) + 1.0f;
            if (cbn) { const f32x4 so = *(const f32x4*)(cbn + 1024 + col) + 1.0f; *(LAS f32x4*)(MV + 3072 + s) = g * so; *(LAS f32x4*)(MV + 4096 + s) = bb * so + *(const f32x4*)(cbn + col); }
            else { *(LAS f32x4*)(MV + 3072 + s) = g; *(LAS f32x4*)(MV + 4096 + s) = bb; } }
}
template <bool FINAL> __device__ __forceinline__ void p_combine_ln(const Frame& F, const Params& P, int layer, const unsigned char* Ys, bf16* H, bf16* Hout, unsigned char* H8, float* out  , bool pre) {
    unsigned char* ws = P.ws;
    LAS float* MV = (LAS float*)F.lds;
    const float* lng = P.in[I_LNFG] + layer * D; const float* lnb = P.in[I_LNFB] + layer * D;
    const int* pos = (const int*)(ws + WS_POS); const f32x2* route_w = (const f32x2*)(ws + WS_ROUTE_W);
    for (int it = F.vcu; it < 256; it += F.G) {
        const int r0 = it * 128 + F.wave * 16, b = r0 / T; const float* cb = (const float*)(ws + WS_COND) + ((size_t)layer * 16 + b) * 6144; const float* cbn = FINAL ? nullptr : (const float*)(ws + WS_COND) + ((size_t)(layer + 1) * 16 + b) * 6144;
        const int pv = pos[2 * r0 + (F.lane & 31)] + ((const LAS int*)(F.lds + 20480))[(((const int*)(ws + WS_ROUTE_E))[r0 + ((F.lane & 31) >> 1)] >> (8 * (F.lane & 1))) & 0xff];
        const f32x2 rwv = route_w[r0 + (F.lane & 15)];
#define ROWP(i_, p0_, p1_, rw_) const int p0_ = __shfl(pv, 2 * (i_)), p1_ = __shfl(pv, 2 * (i_) + 1); const f32x2 rw_ = (f32x2){__shfl(rwv[0], (i_)) * 0.0625f, __shfl(rwv[1], (i_)) * 0.0625f}
#define LD_ROW3(dst, r, p0_, p1_, rw_) do { (dst).rw = (rw_); _Pragma("unroll") for (int j = 0; j < 2; ++j) { const int col = 8 * F.lane + 512 * j; \
            (dst).h[j] = __builtin_nontemporal_load((const v4u*)(H + (size_t)(r) * D + col)); (dst).ya[j] = __builtin_nontemporal_load((const v2u*)(Ys + (size_t)(p0_) * D + col)); (dst).yb[j] = __builtin_nontemporal_load((const v2u*)(Ys + (size_t)(p1_) * D + col)); } } while (0)
        Raw3 rb[4];
        if (!(pre && it == F.vcu)) p9_fill_mv<FINAL>(F, P, layer, it, F.tid);
        if (!pre && it == F.vcu) p9_fill_start((unsigned*)(ws + WS_CTL) + CW_MOE + layer * 2048, (LAS int*)(F.lds + 20480), F.tid);
        __syncthreads();
#define P9_T(buf, t) _Pragma("unroll") for (int q = 0; q < 4; ++q) { const v4u hw = (buf).h[q >> 1]; const v2u aw_ = (buf).ya[q >> 1], bw_ = (buf).yb[q >> 1]; \
                const v2u h2 = (q & 1) ? (v2u){hw.z, hw.w} : (v2u){hw.x, hw.y}; const unsigned a1 = (q & 1) ? aw_.y : aw_.x, b1 = (q & 1) ? bw_.y : bw_.x; \
                const int s = 256 * q + 4 * F.lane; t.v[q] = up4(h2) * *(const LAS f32x4*)(MV + s) + *(const LAS f32x4*)(MV + 1024 + s) + *(const LAS f32x4*)(MV + 2048 + s) * (up4f8(a1) * (buf).rw[0] + up4f8(b1) * (buf).rw[1]); }
#define P9_OUT(t, r, mn, rstd) do { \
            if constexpr (FINAL) { _Pragma("unroll") for (int q = 0; q < 4; ++q) { const int s = 256 * q + 4 * F.lane; *(f32x4*)(out + (size_t)(r) * D + COL8(q)) = (t.v[q] - mn) * rstd * *(const LAS f32x4*)(MV + 3072 + s) + *(const LAS f32x4*)(MV + 4096 + s); } } \
            else { unsigned ow[8], o8[4]; _Pragma("unroll") for (int q = 0; q < 4; ++q) { const int s = 256 * q + 4 * F.lane; const f32x4 o = (t.v[q] - mn) * rstd * *(const LAS f32x4*)(MV + 3072 + s) + *(const LAS f32x4*)(MV + 4096 + s); ow[2 * q] = pk2(o[0], o[1]); ow[2 * q + 1] = pk2(o[2], o[3]); o8[q] = pg8::pk_fp8x4(o[0], o[1], o[2], o[3]); } \
                *(v2u*)(H8 + (size_t)(r) * D + 8 * F.lane) = (v2u){o8[0], o8[1]}; *(v2u*)(H8 + (size_t)(r) * D + 8 * F.lane + 512) = (v2u){o8[2], o8[3]};     \
                *(v4u*)(Hout + (size_t)(r) * D + 8 * F.lane) = (v4u){ow[0], ow[1], ow[2], ow[3]}; *(v4u*)(Hout + (size_t)(r) * D + 8 * F.lane + 512) = (v4u){ow[4], ow[5], ow[6], ow[7]}; } } while (0)
#define P9_PAIR(bA, bB, ii) do { RowVec tA, tB; P9_T(bA, tA) P9_T(bB, tB) \
            float sA_ = 0.f, qA_ = 0.f, sB_ = 0.f, qB_ = 0.f; \
            _Pragma("unroll") for (int q = 0; q < 4; ++q) { const f32x4 xa = tA.v[q], xb = tB.v[q]; sA_ += (xa[0] + xa[1]) + (xa[2] + xa[3]); qA_ += (xa[0] * xa[0] + xa[1] * xa[1]) + (xa[2] * xa[2] + xa[3] * xa[3]); \
                sB_ += (xb[0] + xb[1]) + (xb[2] + xb[3]); qB_ += (xb[0] * xb[0] + xb[1] * xb[1]) + (xb[2] * xb[2] + xb[3] * xb[3]); } \
            float tsA, tqA, tsB, tqB; wave_sum4(sA_, qA_, sB_, qB_, tsA, tqA, tsB, tqB, F.lane); \
            const float mnA = tsA * (1.0f / D), mnB = tsB * (1.0f / D); const float rsA = 1.0f / sqrtf(fmaxf(tqA * (1.0f / D) - mnA * mnA, 0.f) + LN_EPS), rsB = 1.0f / sqrtf(fmaxf(tqB * (1.0f / D) - mnB * mnB, 0.f) + LN_EPS); \
            P9_OUT(tA, r0 + (ii), mnA, rsA); P9_OUT(tB, r0 + (ii) + 1, mnB, rsB); } while (0)
        for (int i = 0; i < 16; i += 4) {
            { ROWP(i, a0, a1, aw); LD_ROW3(rb[0], r0 + i, a0, a1, aw); } { ROWP(i + 1, a0, a1, aw); LD_ROW3(rb[1], r0 + i + 1, a0, a1, aw); }
            { ROWP(i + 2, a0, a1, aw); LD_ROW3(rb[2], r0 + i + 2, a0, a1, aw); } { ROWP(i + 3, a0, a1, aw); LD_ROW3(rb[3], r0 + i + 3, a0, a1, aw); }
            P9_PAIR(rb[0], rb[1], i); __builtin_amdgcn_sched_barrier(0); P9_PAIR(rb[2], rb[3], i + 2); __builtin_amdgcn_sched_barrier(0); }
#undef P9_PAIR
#undef P9_OUT
#undef P9_T
#undef LD_ROW3
#undef ROWP
        __syncthreads();
    }
}
__device__ __forceinline__ void p_kmean(const Frame& F, const bf16* K, float* kmean) {
    const int gw = F.vcu * NWAVES + F.wave, NGW = F.G * NWAVES;
    for (int it = gw; it < 1024; it += NGW) { const int b = it >> 6, blk = (it >> 3) & 7, h = it & 7;
        const bf16* kp = K + (size_t)(b * T + blk * 256) * D + h * 128 + 2 * F.lane; float s0 = 0.f, s1 = 0.f;
#pragma unroll 8
        for (int r = 0; r < 256; ++r) { const unsigned w = *(const unsigned*)(kp + (size_t)r * D); s0 += bflo(w); s1 += bfhi(w); }
        *(f32x2*)(kmean + ((size_t)(b * 8 + h) * 8 + blk) * 128 + 2 * F.lane) = (f32x2){s0 * (1.0f / 256.0f), s1 * (1.0f / 256.0f)}; }
}
__device__ __forceinline__ void p_gate(const Frame& F, const bf16* Q, const float* kmean, unsigned char* sel) {
    LAS float* km = (LAS float*)F.lds;
    for (int it = F.vcu; it < 1024; it += F.G) { const int b = it >> 6, qb = (it >> 3) & 7, h = it & 7;
        const int tl = F.tid >> 1, half = F.tid & 1; const size_t row = (size_t)b * T + qb * 256 + tl;
        if (qb < 4) { if (half == 0) sel[row * 8 + h] = (unsigned char)((1u << qb) - 1u); continue; }
        for (int i = F.tid; i < qb * 128; i += 512) km[i] = kmean[((size_t)(b * 8 + h) * 8) * 128 + i];
        __syncthreads();
        float gt[7];
#pragma unroll
        for (int n = 0; n < 7; ++n) gt[n] = 0.f;
        const bf16* qp = Q + row * D + h * 128 + half * 64;
#pragma unroll
        for (int c8 = 0; c8 < 8; ++c8) { const v4u raw = *(const v4u*)(qp + 8 * c8);
            const float qv[8] = {bflo(raw.x), bfhi(raw.x), bflo(raw.y), bfhi(raw.y), bflo(raw.z), bfhi(raw.z), bflo(raw.w), bfhi(raw.w)};
#pragma unroll
            for (int n = 0; n < 7; ++n) if (n < qb) { const LAS f32x4* kk = (const LAS f32x4*)(km + n * 128 + half * 64 + 8 * c8); const f32x4 k0 = kk[0], k1 = kk[1];
                gt[n] += (qv[0] * k0[0] + qv[1] * k0[1]) + (qv[2] * k0[2] + qv[3] * k0[3]) + (qv[4] * k1[0] + qv[5] * k1[1]) + (qv[6] * k1[2] + qv[7] * k1[3]); } }
        unsigned mask = 0u;
#pragma unroll
        for (int n = 0; n < 7; ++n) gt[n] += __shfl_xor(gt[n], 1);
#pragma unroll
        for (int pick = 0; pick < 3; ++pick) { int bi = -1; float bv = -__builtin_inff();
#pragma unroll
            for (int n = 0; n < 7; ++n) if (n < qb && !((mask >> n) & 1u) && gt[n] > bv) { bv = gt[n]; bi = n; }
            if (bi >= 0) mask |= 1u << bi; }
        if (half == 0) sel[row * 8 + h] = (unsigned char)mask;
        __syncthreads();
    }
}
__device__ __forceinline__ att::BlockRef att_ref(int L, int pass, const bf16* Q, const unsigned char* Q8, const unsigned char* K8, const unsigned char* V8, unsigned char* O, const float* kmean, bool lmap) {
    const int v_ = L & 255, bh = lmap ? ((2 * (v_ >> 5) + (L >> 8)) * 8 + ((v_ >> 2) & 7)) : (L >> 2), x = L & 3, qb = pass ? 7 - x : x, b = bh >> 3, h = bh & 7; const size_t base = (size_t)b * T * D + h * 128;
    att::BlockRef r; r.Q = Q + base + (size_t)qb * 256 * D; r.Q8 = Q8 + base + (size_t)qb * 256 * D; r.O = O + base + (size_t)qb * 256 * D; r.K8 = K8 + base; r.V8 = V8 + base; r.Kmean = kmean + (size_t)bh * 8 * 128; r.P0 = qb * 256; return r;
}
__device__ __forceinline__ void p_attention(const Frame& F, const bf16* Q, const unsigned char* Q8, const unsigned char* K8, const unsigned char* V8, unsigned char* O, const float* sel, bool lmap) {
    constexpr int total = 512; int L = F.vcu; if (L >= total) return; int pass = 0;
    att::BlockRef cur = att_ref(L, 0, Q, Q8, K8, V8, O, sel, lmap); att::Seam S;
    att::moba_prime(cur, (char*)F.lds, S);
    for (;;) {
        const bool more_pass = pass == 0, more_item = L + F.G < total, last = !more_pass && !more_item;
        int passn = pass + 1, Ln = L; if (!more_pass) { passn = 0; Ln = more_item ? L + F.G : L; }
        const att::BlockRef nxt = last ? cur : att_ref(Ln, passn, Q, Q8, K8, V8, O, sel, lmap);
        att::moba_block(cur, nxt, (char*)F.lds, S);
        if (last) break;
        cur = nxt; pass = passn; L = Ln;
    }
}
constexpr int RING_BYTES = 131072, LDSCTL_OFF = RING_BYTES, MISC_OFF = LDSCTL_OFF + 320, LDS_BYTES = 147456;
constexpr int NPHASE = 20;
#ifndef NO_SGU
#define SGU_CALL p_sgu_item(F, P, it, U, V, YC);
#else
#define SGU_CALL
#endif
#ifndef NO_CONV
#define CONV_CALL p_conv_item(F, P, ci, (ci + cstep < cend) ? ci + cstep : -1, Gb, YC, cv, cc);
#else
#define CONV_CALL
#endif
#ifndef PROBE_DUP
#define PROBE_DUP 0u
#endif
#define DUP(k) (((PROBE_DUP) >> (k)) & 1u)
#define RUN(k, ...) do { __VA_ARGS__ if (DUP(k)) { __VA_ARGS__ } } while (0)
#if MK_ONE_LAUNCH
#define GRID_BAR() xcd_barrier(bar)
#define GRID_BAR_OV(...) xcd_barrier_ov(bar, [&]() { __VA_ARGS__ })
#define SEAM_BAR_OV(s, ...) do { if (local_ok) local_barrier_ov(bar.bar, (unsigned*)(ws + WS_CTL) + CW_LBAR + (s) * 512 + (F.vcu >> 5) * 64, 32u, [&]() { __VA_ARGS__ }); else xcd_barrier_ov(bar, [&]() { __VA_ARGS__ }); } while (0)
#define SEAM_BAR(s) SEAM_BAR_OV(s, )
#else
#define GRID_BAR() do { } while (0)
#define GRID_BAR_OV(...) do { } while (0)
#define SEAM_BAR_OV(s, ...) do { } while (0)
#define SEAM_BAR(s) do { } while (0)
#endif
template <int LAYER, int pbase>
__device__ __forceinline__ void moe_phases(const Frame& F, const Params& P, XcdBarrier& bar, int lo, int hi, const bf16* Ymix, float* out_final) {
    unsigned char* ws = P.ws;
    bf16* H = (bf16*)(ws + WS_H); unsigned char* YS = ws + WS_BIG;   unsigned char* HID = (unsigned char*)P.out; unsigned char* H8 = ws + WS_H8;
    LAS int* tl = (LAS int*)(F.lds + LDSCTL_OFF + 8192);
    unsigned* gcnt = (unsigned*)(ws + WS_CTL) + CW_MOE + LAYER * 2048;
#ifdef PH_SEL
#define IN(k) ((k) == PH_SEL && lo <= (k) && (k) < hi)
#else
#define IN(k) (lo <= (k) && (k) < hi)
#endif
#define BOTH(k) (IN(k) && IN((k) + 1))
    if (IN(pbase + 0)) { p_ln_route<LAYER == 1>(F, P, LAYER, Ymix, H, H, H8, MK_ONE_LAUNCH && IN(pbase - 1)); if (BOTH(pbase + 0)) GRID_BAR(); }
    if (IN(pbase + 2)) {
        moe_table(F, gcnt, tl); const int nt = __builtin_amdgcn_readfirstlane(tl[32]) >> 8;
        pg8::Gemm g{(const bf16*)H8, (const bf16*)(ws + WS_WGU + (size_t)LAYER * NEXP * 1024 * 1024), MSORT, 1024, 1024}; pg8::GroupedOrder<true> S; S.init(tl + 64, nt, 4, F.G, (int)blockIdx.x, (size_t)1024 * 1024); S.stage_rows((const int*)(ws + WS_INV), INV_CAP, tl + 16, tl, (LAS int*)(F.lds + LDSCTL_OFF + 1024));
        pg8::EpiSwiGLU8 E{HID};
        RUN(pbase + 2, pg8::gemm_phase<pg8::EpiSwiGLU8, pg8::GroupedOrder<true>, true, true, true>(F.lds, g, S, E););
        if (LAYER == 0) { const int nfull = S.nwg % F.G; if (nfull == 0) bg_convert(F, P, S.c, F.G, 0, 8192); else if (S.c >= nfull) bg_convert(F, P, S.c - nfull, F.G - nfull, 0, 8192); }
        if (BOTH(pbase + 2)) { if (MK_ONE_LAUNCH && (F.G & 3) == 0) group4_barrier(bar.bar, (unsigned*)(ws + WS_CTL) + CW_GBAR + LAYER * 4096 + (F.vcu >> 2) * 64, (unsigned*)(ws + WS_CTL) + CW_XMAP + (F.vcu & ~3)); else GRID_BAR(); } }
    if (IN(pbase + 3)) {
        if (!(MK_ONE_LAUNCH && IN(pbase + 2))) moe_table(F, gcnt, tl);
        const int nt = __builtin_amdgcn_readfirstlane(tl[32]) >> 8;
        pg8::Gemm g{(const bf16*)HID, (const bf16*)(ws + WS_WD + (size_t)LAYER * NEXP * 1024 * 512), MSORT, 1024, 512}; pg8::GroupedOrder<false> S; S.init(tl + 64, nt, 4, F.G, (int)blockIdx.x, (size_t)1024 * 512);
        pg8::EpiYsF8 E{YS, pg8::W8INV * 16.0f};
        RUN(pbase + 3, pg8::gemm_phase<pg8::EpiYsF8, pg8::GroupedOrder<false>, true, true, true>(F.lds, g, S, E););
        if (LAYER == 0) { const int nfull = S.nwg % F.G; if (nfull == 0) bg_convert(F, P, S.c, F.G, 8192, 12288); else if (S.c >= nfull) bg_convert(F, P, S.c - nfull, F.G - nfull, 8192, 12288); }
        if (BOTH(pbase + 3)) GRID_BAR_OV(p9_fill_mv<LAYER == 1>(F, P, LAYER, F.vcu, F.tid - 64); p9_fill_start(gcnt, (LAS int*)(F.lds + 20480), F.tid - 320););     }
    if (IN(pbase + 4)) { p_combine_ln<LAYER == 1>(F, P, LAYER, YS, H, H, H8, out_final, MK_ONE_LAUNCH && IN(pbase + 3)); if (BOTH(pbase + 4)) GRID_BAR(); }
#undef IN
#undef BOTH
}
__global__ void __launch_bounds__(NWAVES * 64, 2) fwd_kernel(Params P) {
    extern __shared__ __attribute__((aligned(16))) unsigned char lds_raw[];
    Frame F; F.lds = (LAS unsigned char*)lds_raw;
    F.tid = threadIdx.x; F.lane = F.tid & 63; F.wave = __builtin_amdgcn_readfirstlane(F.tid >> 6);
    F.G = gridDim.x; { const int bx = blockIdx.x; F.vcu = (F.G % 8 == 0) ? (bx % 8) * (F.G / 8) + bx / 8 : bx; }
    unsigned char* ws = P.ws;
    volatile LAS unsigned* MISC = (volatile LAS unsigned*)(F.lds + MISC_OFF);
    for (int u = F.tid; u < (LDS_BYTES - LDSCTL_OFF) / 4; u += NWAVES * 64) ((LAS unsigned*)(F.lds + LDSCTL_OFF))[u] = 0u;
    __syncthreads();
    XcdBarrier bar; bar.bar = (unsigned*)(ws + WS_CTL) + CW_BAR; bar.x = 0; bar.st = nullptr;
#if MK_ONE_LAUNCH
    bar = xcd_barrier_post((unsigned*)(ws + WS_CTL) + CW_BAR, MISC + 8);
    if (F.tid == 0) __hip_atomic_store((unsigned*)(ws + WS_CTL) + CW_XMAP + F.vcu, xb_xcc_id() + 1u, __ATOMIC_RELAXED, __HIP_MEMORY_SCOPE_AGENT);
#endif
    const int lo = P.ph_lo, hi = P.ph_hi;
#ifdef PH_SEL
#define IN(k) ((k) == PH_SEL && lo <= (k) && (k) < hi)
#else
#define IN(k) (lo <= (k) && (k) < hi)
#endif
#define BOTH(k) (IN(k) && IN((k) + 1))
    float* cond = (float*)(ws + WS_COND); bf16* H = (bf16*)(ws + WS_H);
    unsigned char* big = ws + WS_BIG;
    if (IN(0)) { RUN(0, p0_cond(F, P.in[I_C], P.in[I_ADAW], P.in[I_ADAB], cond); p0_weights(F, P); __syncthreads();); if (BOTH(0)) GRID_BAR(); }
    bool local_ok = false;
#if MK_ONE_LAUNCH
    if (lo == 0 && hi >= 20 && F.G == 256) { if (F.tid == 0) MISC[16] = 1u; __syncthreads();
        if (F.tid < 256) { unsigned* xm = (unsigned*)(ws + WS_CTL) + CW_XMAP; const unsigned a = xb_ld(xm + F.tid), b = xb_ld(xm + (F.tid & ~31)); if (a == 0u || a != b) MISC[16] = 0u; }
        __syncthreads(); local_ok = __builtin_amdgcn_readfirstlane((int)MISC[16]) != 0; }
#endif
    if (IN(1)) { RUN(1, p_modulate(F, P.in[I_X], cond, 0, H);); if (BOTH(1)) SEAM_BAR(0); }
    if (IN(2)) { bf16* U = (bf16*)big; bf16* V = (bf16*)(big + 32 * MiB); bf16* Gb = (bf16*)(big + 64 * MiB);
        pg8::Gemm g{H, (const bf16*)(ws + WS_WIN), M, 2048, 1024}; pg8::StaticOrder S; S.init(M, 2048, F.G, (int)blockIdx.x);
        pg8::EpiIn E{U, V, Gb};
        RUN(2, pg8::gemm_phase<pg8::EpiIn, pg8::StaticOrder, true, true>(F.lds, g, S, E););
        if (BOTH(2)) SEAM_BAR(1); }
    if (IN(3)) { const bf16* U = (const bf16*)big; const bf16* V = (const bf16*)(big + 32 * MiB); const bf16* Gb = (const bf16*)(big + 64 * MiB); bf16* YC = (bf16*)(big + 96 * MiB);
        RUN(20, for (int it = F.vcu; it < 256; it += F.G) { SGU_CALL }); RUN(21, { v4u cv[8]; ConvConst cc; conv_const(F, P, cc); const int cstep = local_ok ? 1 : F.G, c0 = local_ok ? 4 * F.vcu : F.vcu, cend = local_ok ? 4 * F.vcu + 4 : 1024;
            if (c0 < cend) conv_load(F, c0, Gb, cv); for (int ci = c0; ci < cend; ci += cstep) { CONV_CALL } });
        if (BOTH(3)) SEAM_BAR(2); }
    if (IN(4)) { const bf16* YC = (const bf16*)(big + 96 * MiB); bf16* YM = (bf16*)(ws + WS_XA);
        pg8::Gemm g{YC, (const bf16*)(ws + WS_WOUT), M, 1024, 1024}; pg8::StaticOrder S; S.init(M, 1024, F.G, (int)blockIdx.x);
        pg8::EpiBf16<0> E{YM, 1024, nullptr, 0, 0, 1.f};
        RUN(4, pg8::gemm_phase<pg8::EpiBf16<0>, pg8::StaticOrder, true, true>(F.lds, g, S, E););
        if (BOTH(4)) SEAM_BAR_OV(3, p5_fill_w(F, P, 0, F.tid - 64, 448); p5_fill_mv(F, P, 0, F.vcu, F.tid - 64);); }
    moe_phases<0, 5>(F, P, bar, lo, hi, (const bf16*)(ws + WS_XA), nullptr);
    bf16* Qb = (bf16*)big; unsigned char* Q8b = big + 64 * MiB; unsigned char* K8b = big + 96 * MiB; unsigned char* V8b = big + 128 * MiB;
    if (IN(10)) { pg8::Gemm g{(const bf16*)(ws + WS_H8), (const bf16*)(ws + WS_WQKV), M, 3072, 1024};
        pg8::StaticOrder S; S.init(M, 3072, F.G, (int)blockIdx.x);
        pg8::EpiQKV E{Qb, (size_t)M * D, (float*)(ws + WS_KMEAN), Q8b};
        RUN(10, pg8::gemm_phase<pg8::EpiQKV, pg8::StaticOrder, true, true, true>(F.lds, g, S, E););
        if (BOTH(10)) SEAM_BAR(4); }
    if (IN(13)) { RUN(13, p_attention(F, Qb, Q8b, K8b, V8b, ws + WS_XA  , (const float*)(ws + WS_KMEAN), local_ok);); if (BOTH(13)) SEAM_BAR(5); }
    if (IN(14)) { bf16* YM = (bf16*)(ws + WS_XA + 32 * MiB);
        pg8::Gemm g{(const bf16*)(ws + WS_XA), (const bf16*)(ws + WS_WO2), M, 1024, 1024}; pg8::StaticOrder S; S.init(M, 1024, F.G, (int)blockIdx.x);
        pg8::EpiYsF8 E{(unsigned char*)YM, pg8::W8INV * (1.0f / 16.0f) * 64.0f};
        RUN(14, pg8::gemm_phase<pg8::EpiYsF8, pg8::StaticOrder, true, true, true>(F.lds, g, S, E););
        if (BOTH(14)) SEAM_BAR_OV(6, p5_fill_w(F, P, 1, F.tid - 64, 448); p5_fill_mv(F, P, 1, F.vcu, F.tid - 64);); }
    moe_phases<1, 15>(F, P, bar, lo, hi, (const bf16*)(ws + WS_XA + 32 * MiB), P.out);
#undef IN
#undef BOTH
}

extern "C" void kernel_launch(void* const* d_in, const int* in_sizes, int n_in, void* d_out, int out_size, void* d_ws, size_t ws_size, hipStream_t stream) {
    static int grid = 0;
    if (grid == 0) {
        if (n_in != 27 || in_sizes[0] != M * D || out_size != M * D || ws_size < WS_END) { fprintf(stderr, "kernel_launch: unexpected shapes (n_in %d, in0 %d, out %d, ws %zu); nothing launched\n", n_in, n_in > 0 ? in_sizes[0] : -1, out_size, ws_size); grid = -1; return; }
        int dev = 0, cus = 0, per_cu = 0;
        if (hipGetDevice(&dev) != hipSuccess || hipDeviceGetAttribute(&cus, hipDeviceAttributeMultiprocessorCount, dev) != hipSuccess) { grid = -1; return; }
        if (hipFuncSetAttribute((const void*)fwd_kernel, hipFuncAttributeMaxDynamicSharedMemorySize, LDS_BYTES) != hipSuccess) { fprintf(stderr, "kernel_launch: hipFuncSetAttribute failed\n"); grid = -1; return; }
        if (hipOccupancyMaxActiveBlocksPerMultiprocessor(&per_cu, (const void*)fwd_kernel, NWAVES * 64, LDS_BYTES) != hipSuccess || per_cu < 1) fprintf(stderr, "kernel_launch: occupancy query reports %d workgroups per CU\n", per_cu);
        (void)hipGetLastError();
        grid = cus;
    }
    if (grid < 0) return;
    if (hipMemsetAsync((char*)d_ws + WS_CTL, 0, CTL_ZERO_BYTES, stream) != hipSuccess) return;
    Params p{};
    for (int i = 0; i < 27; ++i) p.in[i] = (const float*)d_in[i];
    p.out = (float*)d_out; p.ws = (unsigned char*)d_ws;
#if MK_ONE_LAUNCH
    p.ph_lo = 0; p.ph_hi = NPHASE; p.li = 0;
    hipLaunchKernelGGL(fwd_kernel, dim3(grid), dim3(NWAVES * 64), LDS_BYTES, stream, p);
#else
    for (int k = 0; k < NPHASE; ++k) { p.ph_lo = k; p.ph_hi = k + 1; p.li = k; hipLaunchKernelGGL(fwd_kernel, dim3(grid), dim3(NWAVES * 64), LDS_BYTES, stream, p); }
#endif
}
```

```cpp
#include <hip/hip_runtime.h>
#include <cstdio>
#include <cstdint>
#ifndef MK_ONE_LAUNCH
#define MK_ONE_LAUNCH 1
#endif
namespace pg8 {
#define PG8_LAS __attribute__((address_space(3)))
typedef unsigned short bf16_t;
typedef short bf16x8 __attribute__((ext_vector_type(8)));
typedef float f32x4 __attribute__((ext_vector_type(4)));
typedef unsigned u32x4 __attribute__((ext_vector_type(4)));
typedef int i32x4 __attribute__((ext_vector_type(4)));
typedef int i32x8 __attribute__((ext_vector_type(8)));
constexpr int BM = 256, BK = 64, HALF = 128, HTB = HALF * BK * 2  , STAGE_BYTES = 8 * HTB, NXCD = 8, WGM = 8;

__host__ __device__ __forceinline__ int lds_byte(int r, int c) { const int st = (r >> 4) * 2 + (c >> 5), rr = r & 15, cc = c & 31, ob = rr * 64 + cc * 2; return st * 1024 + (ob ^ (((ob >> 9) & 1) << 5)); }
__host__ __device__ __forceinline__ void stage_rc(int b, int& R, int& C) { const int st = b / 1024, sb = b % 1024, swz = sb ^ (((sb >> 9) & 1) << 5); R = (st >> 1) * 16 + swz / 64; C = (st & 1) * 32 + (swz % 64) / 2; }
__host__ __device__ __forceinline__ int perm32(int rho) { const int n = rho >> 4, i = rho & 15; return 8 * (i >> 2) + 4 * n + (i & 3); }

struct Unit { int pm, pn; };
struct Gemm { const bf16_t* A; const bf16_t* Bt; int M, N, K; };

struct StaticOrder {
    static constexpr bool GATHER = false, ABLK = false;
    __device__ __forceinline__ int rowof(const Unit&, int, int) const { return 0; }
    int nM, nN, nwg, G, c;
    __host__ __device__ void init(int M, int N, int G_, int c_) { nM = M / BM; nN = N / BM; nwg = nM * nN; G = G_; c = c_; }
    __host__ __device__ bool next(int i, Unit& u) const {
        const long L = (long)i * G + c; if (L >= nwg) return false;
        int wgid = (int)L; { const int q = nwg / NXCD, r = nwg % NXCD, xcd = wgid % NXCD, off = wgid / NXCD; wgid = (xcd < r ? xcd * (q + 1) : r * (q + 1) + (xcd - r) * q) + off; }
        const int nig = WGM * nN, gid = wgid / nig, fm = gid * WGM, gsz = (nM - fm) < WGM ? (nM - fm) : WGM;
        u.pm = fm + ((wgid % nig) % gsz); u.pn = (wgid % nig) / gsz; return true;
    }
    __device__ __forceinline__ void a_ready(const Unit&) const {}
    __device__ __forceinline__ const char* bptr(const Gemm& g, const Unit& u, size_t tstep) const { return (const char*)g.Bt + (size_t)u.pn * tstep; }
    __device__ __forceinline__ void done(const Unit&) const {}
};

__device__ __forceinline__ unsigned cvt_pk_bf16(float lo, float hi) { unsigned r; asm volatile("v_cvt_pk_bf16_f32 %0, %1, %2" : "=v"(r) : "v"(lo), "v"(hi)); return r; }
typedef float f32x2 __attribute__((ext_vector_type(2)));
__device__ __forceinline__ f32x2 gelu_pk(f32x2 v) {
    const f32x2 av = __builtin_elementwise_abs(v), d = av * 0.2316418882f + 1.0f;
    f32x2 t; t.x = __builtin_amdgcn_rcpf(d.x); t.y = __builtin_amdgcn_rcpf(d.y);
    f32x2 q = t * 0.5307027145f + (-0.7265760135f); q = q * t + 0.7107068705f; q = q * t + (-0.142248368f); q = q * t + 0.127414796f; q = q * t;
    const f32x2 s = (v * v) * (-0.72134752044f);
    f32x2 e; e.x = __builtin_amdgcn_exp2f(s.x); e.y = __builtin_amdgcn_exp2f(s.y);
    const f32x2 m = v * (q * e), r = v - m;
    f32x2 o; o.x = v.x < 0.f ? m.x : r.x; o.y = v.y < 0.f ? m.y : r.y; return o;
}

template <int ACT  > struct EpiBf16 {
    static constexpr bool PERM = true, AFTER_DRAIN = false, BADJ = true;     static_assert(ACT == 0 || ACT == 1, "EpiBf16: ACT is 0 (none) or 1 (gelu_pk)");
    bf16_t* O; int ldc; const float* bias; int split_cols; size_t split_stride; float scale0;
    __device__ __forceinline__ void operator()(const f32x4 (&acc)[2][2][4][2], const Unit& u, int wr, int wc, int fr, int fq) const {
        const int row0 = u.pm * BM + wr * 64 + fr; int colt = u.pn * BM; bf16_t* base = O;
        float sc = 1.f; if (split_cols) { const int t = colt / split_cols; base += (size_t)t * split_stride; colt -= t * split_cols; if (t == 0) sc = scale0; }
        const int col0 = colt + wc * 64 + 8 * fq, bcol0 = u.pn * BM + wc * 64 + 8 * fq;
        f32x4 bv[2][2];
#pragma unroll
        for (int bj = 0; bj < 2; ++bj)
#pragma unroll
            for (int n = 0; n < 2; ++n) bv[bj][n] = bias ? *(const f32x4*)(bias + bcol0 + bj * 32 + 4 * n) : (f32x4){0.f, 0.f, 0.f, 0.f};
#pragma unroll
        for (int ai = 0; ai < 2; ++ai)
#pragma unroll
            for (int m = 0; m < 4; ++m) { bf16_t* rowp = base + (size_t)(row0 + ai * HALF + m * 16) * ldc + col0; u32x4 wv[2];
#pragma unroll
                for (int bj = 0; bj < 2; ++bj) { f32x4 v0 = acc[ai][bj][m][0] + bv[bj][0], v1 = acc[ai][bj][m][1] + bv[bj][1];
                    if (ACT == 1) { f32x2 a = gelu_pk((f32x2){v0[0], v0[1]}), b = gelu_pk((f32x2){v0[2], v0[3]}), c = gelu_pk((f32x2){v1[0], v1[1]}), d = gelu_pk((f32x2){v1[2], v1[3]});
                        v0 = (f32x4){a.x, a.y, b.x, b.y}; v1 = (f32x4){c.x, c.y, d.x, d.y}; }
                    v0 = v0 * sc; v1 = v1 * sc; u32x4 w; w.x = cvt_pk_bf16(v0[0], v0[1]); w.y = cvt_pk_bf16(v0[2], v0[3]); w.z = cvt_pk_bf16(v1[0], v1[1]); w.w = cvt_pk_bf16(v1[2], v1[3]); wv[bj] = w; }
                { const bool odd = (fr & 1) != 0; const u32x4 snd = odd ? wv[0] : wv[1];
#define EB_DPP(x) ((unsigned)__builtin_amdgcn_update_dpp(0, (int)(x), 0xB1, 0xF, 0xF, true))
                  const u32x4 rcv = {EB_DPP(snd.x), EB_DPP(snd.y), EB_DPP(snd.z), EB_DPP(snd.w)};
#undef EB_DPP
                  *(u32x4*)(odd ? rowp - ldc + 32 : rowp) = odd ? rcv : wv[0];
                  *(u32x4*)(odd ? rowp + 32 : rowp + ldc) = odd ? wv[1] : rcv; } }
    }
};
template <class Epi, class Sched, bool ALIGN_EPI = false, bool SP2 = false, bool ELT8 = false>
__device__ __forceinline__ void gemm_phase(PG8_LAS unsigned char* lds, const Gemm g, const Sched& S, const Epi& E) {
    const int tid = threadIdx.x, wid = __builtin_amdgcn_readfirstlane(tid >> 6), lane = tid & 63, wr = wid >> 2, wc = wid & 3, fr = lane & 15, fq = lane >> 4;
    const int K = g.K, rowb = ELT8 ? K : 2 * K  , nt = rowb / (2 * BK);
    constexpr bool GATHER = Sched::GATHER; static_assert(!GATHER || SP2, "gathered A: SP2 loop only");
    unsigned voffA[2], voffB[2]; int gR[2]; unsigned gC2[2];
#pragma unroll
    for (int i = 0; i < 2; ++i) { int R, C; stage_rc(tid * 16 + i * 8192, R, C); const int Rb = Epi::PERM ? ((Epi::BADJ ? (R >> 5) * 64 : (R & ~31)) + perm32(R & 31)) : R;
        voffA[i] = Sched::ABLK ? (unsigned)((R >> 2) * 512 + ((C * 2) >> 5) * 128 + (R & 3) * 32 + ((C * 2) & 31)) : (unsigned)(R * rowb + C * 2); voffB[i] = (unsigned)(Rb * rowb + C * 2); gR[i] = R; gC2[i] = (unsigned)C * 2u; }
    unsigned gc0[2] = {0u, 0u}, gc1[2] = {0u, 0u}, gn0[2] = {0u, 0u}, gn1[2] = {0u, 0u};
#define PG8_GOFF(dst0, dst1, u, ord) do { _Pragma("unroll") for (int _i = 0; _i < 2; ++_i) { dst0[_i] = (unsigned)S.rowof((u), (ord), gR[_i]) * (unsigned)rowb + gC2[_i]; dst1[_i] = (unsigned)S.rowof((u), (ord), HALF + gR[_i]) * (unsigned)rowb + gC2[_i]; } } while (0)
#define PG8_STAGE_A(bufoff, base, h, G0, G1) do { if constexpr (GATHER) { if constexpr ((h) != 0) PG8_STAGE(bufoff, base, G1); else PG8_STAGE(bufoff, base, G0); } else { PG8_STAGE(bufoff, (base) + (h) * hstepA, voffA); } } while (0)
    const size_t kstep = (size_t)(BK * 2);
    const size_t kstepA = Sched::ABLK ? (size_t)BM * 128 : kstep;
    const size_t hstep = (size_t)HALF * rowb;
    const size_t tstep = 2 * hstep; const size_t hstepA = Sched::ABLK ? (size_t)32 * 512 : hstep; const size_t hstepB = Epi::BADJ ? (size_t)32 * rowb : hstep;
    const unsigned ldsw = (unsigned)wid * 1024u;
    const int aoff = lds_byte(wr * 64 + fr, fq * 8), boff = lds_byte(wc * 32 + fr, fq * 8);
#define PG8_SA(b, h) (((b) * 2 + (h)) * HTB)
#define PG8_SB(b, h) ((4 + (b) * 2 + (h)) * HTB)
#define PG8_STAGE(bufoff, gbase, voff) do { _Pragma("unroll") for (int _i = 0; _i < 2; ++_i) \
        __builtin_amdgcn_global_load_lds((const unsigned*)((const char*)(gbase) + (voff)[_i]), (PG8_LAS unsigned*)(lds + (bufoff) + ldsw + _i * 8192), 16, 0, 0); } while (0)
#define PG8_RD16(off) (*(const PG8_LAS i32x4*)(lds + (off)))
#define PG8_LDA(dst, b, h) do { _Pragma("unroll") for (int m = 0; m < 4; ++m) { const i32x4 lo_ = PG8_RD16(PG8_SA(b, h) + aoff + m * 2048), hi_ = PG8_RD16(PG8_SA(b, h) + aoff + m * 2048 + 1024); dst[m] = __builtin_shufflevector(lo_, hi_, 0, 1, 2, 3, 4, 5, 6, 7); } } while (0)
#define PG8_LDB(dst, b, h) do { _Pragma("unroll") for (int n = 0; n < 2; ++n) { const i32x4 lo_ = PG8_RD16(PG8_SB(b, h) + boff + n * 2048), hi_ = PG8_RD16(PG8_SB(b, h) + boff + n * 2048 + 1024); dst[n] = __builtin_shufflevector(lo_, hi_, 0, 1, 2, 3, 4, 5, 6, 7); } } while (0)
#define PG8_MMA(ai, bj, At, Bt) do { __builtin_amdgcn_s_setprio(1); _Pragma("unroll") for (int m = 0; m < 4; ++m) _Pragma("unroll") for (int n = 0; n < 2; ++n) { \
        if constexpr (ELT8) { asm volatile("v_mfma_scale_f32_16x16x128_f8f6f4 %0, %1, %2, %0, %3, %3 op_sel_hi:[0,0,0]" : "+v"(acc[ai][bj][m][n]) : "v"(Bt[n]), "v"(At[m]), "v"(scale1)); }     \
        else { acc[ai][bj][m][n] = __builtin_amdgcn_mfma_f32_16x16x32_bf16(__builtin_bit_cast(bf16x8, __builtin_shufflevector(Bt[n], Bt[n], 0, 1, 2, 3)), __builtin_bit_cast(bf16x8, __builtin_shufflevector(At[m], At[m], 0, 1, 2, 3)), acc[ai][bj][m][n], 0, 0, 0); \
               acc[ai][bj][m][n] = __builtin_amdgcn_mfma_f32_16x16x32_bf16(__builtin_bit_cast(bf16x8, __builtin_shufflevector(Bt[n], Bt[n], 4, 5, 6, 7)), __builtin_bit_cast(bf16x8, __builtin_shufflevector(At[m], At[m], 4, 5, 6, 7)), acc[ai][bj][m][n], 0, 0, 0); } } \
        __builtin_amdgcn_s_setprio(0); } while (0)
#define PG8_WAIT_V(n) asm volatile("s_waitcnt vmcnt(" #n ")" ::: "memory")
#define PG8_WAIT_L(n) asm volatile("s_waitcnt lgkmcnt(" #n ")" ::: "memory")
#define PG8_BAR __builtin_amdgcn_s_barrier()
#define PG8_SCHED __builtin_amdgcn_sched_barrier(0)
    Unit cur, nxt; int ui = 0;
    if (!S.next(0, cur)) return;
    f32x4 acc[2][2][4][2];
#pragma unroll
    for (int a = 0; a < 2; ++a)
#pragma unroll
        for (int b = 0; b < 2; ++b)
#pragma unroll
            for (int m = 0; m < 4; ++m)
#pragma unroll
                for (int n = 0; n < 2; ++n) acc[a][b][m][n] = (f32x4){0.f, 0.f, 0.f, 0.f};
    const int scale1 = 0x7f7f7f7f;
    i32x8 At[4], B0[2], B1[2];
    const char* cA = GATHER ? (const char*)g.A : (const char*)g.A + (size_t)cur.pm * tstep; const char* cB = S.bptr(g, cur, tstep);
    if constexpr (GATHER) PG8_GOFF(gc0, gc1, cur, 0);
    S.a_ready(cur);
    if constexpr (SP2) {
        PG8_STAGE(PG8_SB(0, 0), cB, voffB); PG8_STAGE(PG8_SB(0, 1), cB + hstepB, voffB); PG8_STAGE_A(PG8_SA(0, 0), cA, 0, gc0, gc1); PG8_STAGE_A(PG8_SA(0, 1), cA, 1, gc0, gc1);
        if (wr == 1) PG8_BAR;
        PG8_WAIT_V(2); PG8_BAR;
        PG8_STAGE(PG8_SB(1, 0), cB + kstep, voffB); PG8_STAGE_A(PG8_SA(1, 0), cA + kstepA, 0, gc0, gc1); PG8_STAGE(PG8_SB(1, 1), cB + hstepB + kstep, voffB);
        PG8_WAIT_V(6); PG8_BAR;
    } else {
        PG8_STAGE(PG8_SB(0, 0), cB, voffB); PG8_STAGE(PG8_SA(0, 0), cA, voffA); PG8_STAGE(PG8_SB(0, 1), cB + hstepB, voffB); PG8_STAGE(PG8_SA(0, 1), cA + hstep, voffA);
        if (wr == 1) PG8_BAR;
        PG8_WAIT_V(4); PG8_BAR;
        PG8_STAGE(PG8_SB(1, 0), cB + kstep, voffB); PG8_STAGE(PG8_SA(1, 0), cA + kstep, voffA); PG8_STAGE(PG8_SB(1, 1), cB + hstepB + kstep, voffB);
        PG8_WAIT_V(6); PG8_BAR;
    }
    for (;;) {
        const bool has_next = S.next(ui + 1, nxt);
        const char* nA = has_next ? (GATHER ? (const char*)g.A : (const char*)g.A + (size_t)nxt.pm * tstep) : cA; const char* nB = has_next ? S.bptr(g, nxt, tstep) : cB;
        if constexpr (GATHER) { if (has_next) PG8_GOFF(gn0, gn1, nxt, ui + 1); else { gn0[0] = gc0[0]; gn0[1] = gc0[1]; gn1[0] = gc1[0]; gn1[1] = gc1[1]; } }
#pragma unroll 1
        for (int t = 0; t < nt; t += 2) {
            const bool last = (t == nt - 2);
            const char* a1 = cA + (size_t)(t + 1) * kstepA;
            const char* a2 = last ? nA : cA + (size_t)(t + 2) * kstepA; const char* b2 = last ? nB : cB + (size_t)(t + 2) * kstep;
            const char* a3 = a2 + kstepA; const char* b3 = b2 + kstep;
            if (last && has_next) S.a_ready(nxt);
            unsigned o20[2] = {0u, 0u}, o21[2] = {0u, 0u};
            if constexpr (GATHER) { o20[0] = last ? gn0[0] : gc0[0]; o20[1] = last ? gn0[1] : gc0[1]; o21[0] = last ? gn1[0] : gc1[0]; o21[1] = last ? gn1[1] : gc1[1]; }
            if constexpr (SP2) {
            PG8_LDB(B0, 0, 0); PG8_LDB(B1, 0, 1); PG8_SCHED; PG8_LDA(At, 0, 0); PG8_STAGE_A(PG8_SA(1, 1), a1, 1, gc0, gc1);
            PG8_WAIT_V(8); PG8_WAIT_L(0); PG8_BAR; PG8_MMA(0, 0, At, B0); PG8_MMA(0, 1, At, B1); PG8_BAR; PG8_SCHED;
            PG8_LDA(At, 0, 1); PG8_STAGE(PG8_SB(0, 0), b2, voffB); PG8_STAGE(PG8_SB(0, 1), b2 + hstepB, voffB); PG8_STAGE_A(PG8_SA(0, 0), a2, 0, o20, o21);
            PG8_WAIT_V(8); PG8_WAIT_L(0); PG8_BAR; PG8_MMA(1, 0, At, B0); PG8_MMA(1, 1, At, B1); PG8_BAR; PG8_SCHED;
            PG8_LDB(B0, 1, 0); PG8_LDB(B1, 1, 1); PG8_SCHED; PG8_LDA(At, 1, 0); PG8_STAGE_A(PG8_SA(0, 1), a2, 1, o20, o21);
            PG8_WAIT_V(8); PG8_WAIT_L(0); PG8_BAR; PG8_MMA(0, 0, At, B0); PG8_MMA(0, 1, At, B1); PG8_BAR; PG8_SCHED;
            PG8_LDA(At, 1, 1); PG8_STAGE(PG8_SB(1, 0), b3, voffB); PG8_STAGE(PG8_SB(1, 1), b3 + hstepB, voffB); PG8_STAGE_A(PG8_SA(1, 0), a3, 0, o20, o21);
            PG8_WAIT_V(8); PG8_WAIT_L(0); PG8_BAR; PG8_MMA(1, 0, At, B0); PG8_MMA(1, 1, At, B1); PG8_BAR; PG8_SCHED;
            } else {
            PG8_LDB(B0, 0, 0); PG8_SCHED; PG8_LDA(At, 0, 0); PG8_STAGE(PG8_SA(1, 1), a1 + hstep, voffA);
            PG8_WAIT_L(8); PG8_BAR; PG8_WAIT_L(0); PG8_MMA(0, 0, At, B0); PG8_BAR; PG8_SCHED;
            PG8_LDB(B1, 0, 1); PG8_STAGE(PG8_SB(0, 0), b2, voffB);
            PG8_BAR; PG8_WAIT_L(0); PG8_MMA(0, 1, At, B1); PG8_BAR;
            PG8_LDA(At, 0, 1); PG8_STAGE(PG8_SA(0, 0), a2, voffA);
            PG8_BAR; PG8_WAIT_L(0); PG8_MMA(1, 0, At, B0); PG8_BAR; PG8_SCHED;
            PG8_STAGE(PG8_SB(0, 1), b2 + hstepB, voffB);
            PG8_WAIT_V(6); PG8_BAR; PG8_MMA(1, 1, At, B1); PG8_BAR;
            PG8_LDB(B0, 1, 0); PG8_SCHED; PG8_LDA(At, 1, 0); PG8_STAGE(PG8_SA(0, 1), a2 + hstep, voffA);
            PG8_WAIT_L(8); PG8_BAR; PG8_WAIT_L(0); PG8_MMA(0, 0, At, B0); PG8_BAR; PG8_SCHED;
            PG8_LDB(B1, 1, 1); PG8_STAGE(PG8_SB(1, 0), b3, voffB);
            PG8_BAR; PG8_WAIT_L(0); PG8_MMA(0, 1, At, B1); PG8_BAR;
            PG8_LDA(At, 1, 1); PG8_STAGE(PG8_SA(1, 0), a3, voffA);
            PG8_BAR; PG8_WAIT_L(0); PG8_MMA(1, 0, At, B0); PG8_BAR; PG8_SCHED;
            PG8_STAGE(PG8_SB(1, 1), b3 + hstepB, voffB);
            PG8_WAIT_V(6); PG8_BAR; PG8_MMA(1, 1, At, B1); PG8_BAR;
            }
        }
        if constexpr (ALIGN_EPI) { if (wr == 0) PG8_BAR; }
        if constexpr (ELT8) asm volatile("s_nop 15\n\ts_nop 15" ::: "memory");
        if constexpr (!Epi::AFTER_DRAIN) { E(acc, cur, wr, wc, fr, fq); S.done(cur); }
        if (!has_next) break;
#pragma unroll
        for (int a = 0; a < 2; ++a)
#pragma unroll
            for (int b = 0; b < 2; ++b)
#pragma unroll
                for (int m = 0; m < 4; ++m)
#pragma unroll
                    for (int n = 0; n < 2; ++n) acc[a][b][m][n] = (f32x4){0.f, 0.f, 0.f, 0.f};
        cur = nxt; cA = nA; cB = nB; ++ui;
        if constexpr (GATHER) { gc0[0] = gn0[0]; gc0[1] = gn0[1]; gc1[0] = gn1[0]; gc1[1] = gn1[1]; }
        if constexpr (ALIGN_EPI) { if (wr == 1) PG8_BAR; }
    }
    PG8_WAIT_V(0);
    if constexpr (!ALIGN_EPI) { if (wr == 0) PG8_BAR; }
    PG8_BAR;
    if constexpr (Epi::AFTER_DRAIN) { E.fused(acc, cur, wr, wc, fr, fq, lds, wid, lane); S.done(cur); }
#undef PG8_SA
#undef PG8_SB
#undef PG8_STAGE
#undef PG8_STAGE_A
#undef PG8_GOFF
#undef PG8_LDA
#undef PG8_RD16
#undef PG8_LDB
#undef PG8_MMA
#undef PG8_WAIT_V
#undef PG8_WAIT_L
#undef PG8_BAR
#undef PG8_SCHED
}
}
namespace pg8 {
__device__ __forceinline__ float sigm(float v) { return __builtin_amdgcn_rcpf(1.0f + __builtin_amdgcn_exp2f(-1.4426950408889634f * v)); }
struct EpiIn {
    static constexpr bool PERM = true, AFTER_DRAIN = false, BADJ = true;
    bf16_t* U; bf16_t* V; bf16_t* G;
    __device__ __forceinline__ void operator()(const f32x4 (&acc)[2][2][4][2], const Unit& u, int wr, int wc, int fr, int fq) const {
        const int row0 = u.pm * BM + wr * 64 + fr;
        if (u.pn < 4) {
            bf16_t* base = (u.pn < 2) ? U : V; const int col0 = (u.pn & 1) * 256 + wc * 64 + 8 * fq;
#pragma unroll
            for (int ai = 0; ai < 2; ++ai)
#pragma unroll
                for (int m = 0; m < 4; ++m) { bf16_t* rowp = base + (size_t)(row0 + ai * HALF + m * 16) * 512 + col0; u32x4 wv[2];
#pragma unroll
                    for (int bj = 0; bj < 2; ++bj) { f32x4 v0 = acc[ai][bj][m][0], v1 = acc[ai][bj][m][1];
                        f32x2 a = gelu_pk((f32x2){v0[0], v0[1]}), b = gelu_pk((f32x2){v0[2], v0[3]}), c = gelu_pk((f32x2){v1[0], v1[1]}), d = gelu_pk((f32x2){v1[2], v1[3]});
                        u32x4 w; w.x = cvt_pk_bf16(a.x, a.y); w.y = cvt_pk_bf16(b.x, b.y); w.z = cvt_pk_bf16(c.x, c.y); w.w = cvt_pk_bf16(d.x, d.y); wv[bj] = w; }
                    { const bool odd = (fr & 1) != 0; const u32x4 snd = odd ? wv[0] : wv[1];
#define EB_DPP(x) ((unsigned)__builtin_amdgcn_update_dpp(0, (int)(x), 0xB1, 0xF, 0xF, true))
                      const u32x4 rcv = {EB_DPP(snd.x), EB_DPP(snd.y), EB_DPP(snd.z), EB_DPP(snd.w)};
#undef EB_DPP
                      *(u32x4*)(odd ? rowp - 512 + 32 : rowp) = odd ? rcv : wv[0];
                      *(u32x4*)(odd ? rowp + 32 : rowp + 512) = odd ? wv[1] : rcv; } }
        } else {
            const int col0 = (u.pn - 4) * 128 + wc * 32 + 8 * fq;
#pragma unroll
            for (int ai = 0; ai < 2; ++ai)
#pragma unroll
                for (int m = 0; m < 4; ++m) { bf16_t* rowp = G + (size_t)(row0 + ai * HALF + m * 16) * 512 + col0;
                    const f32x4 a0 = acc[ai][0][m][0], a1 = acc[ai][0][m][1], g0 = acc[ai][1][m][0], g1 = acc[ai][1][m][1];
                    u32x4 w; w.x = cvt_pk_bf16(a0[0] * sigm(g0[0]), a0[1] * sigm(g0[1])); w.y = cvt_pk_bf16(a0[2] * sigm(g0[2]), a0[3] * sigm(g0[3]));
                    w.z = cvt_pk_bf16(a1[0] * sigm(g1[0]), a1[1] * sigm(g1[1])); w.w = cvt_pk_bf16(a1[2] * sigm(g1[2]), a1[3] * sigm(g1[3]));
                    *(u32x4*)rowp = w; }
        }
    }
};
__device__ __forceinline__ unsigned pk_fp8x4(float a, float b, float c, float d);
__device__ __forceinline__ void st8x2_wide(unsigned char* pa, unsigned ax, unsigned ay, unsigned char* pb, unsigned bx, unsigned by, int fq) {
    auto rx = __builtin_amdgcn_permlane16_swap(ax, bx, false, false); auto ry = __builtin_amdgcn_permlane16_swap(ay, by, false, false);
    const u32x4 w = {rx[0], ry[0], rx[1], ry[1]};
    *(u32x4*)((fq & 1) ? pb - 8 : pa) = w;
}
struct EpiQKV {
    static constexpr bool PERM = true, AFTER_DRAIN = false, BADJ = true;
    bf16_t* Q; size_t tstride; float* kmean; static constexpr float sc = 0.03125f;
    unsigned char* QK8;
    __device__ __forceinline__ void operator()(const f32x4 (&acc)[2][2][4][2], const Unit& u, int wr, int wc, int fr, int fq) const {
        const int row0 = u.pm * BM + wr * 64 + fr; const int t = u.pn >> 2; bf16_t* base = Q + (size_t)t * tstride; const int col0 = (u.pn & 3) * 256 + wc * 64 + 8 * fq;
#pragma unroll
        for (int ai = 0; ai < 2; ++ai)
#pragma unroll
            for (int m = 0; m < 4; ++m) { bf16_t* rowp = base + (size_t)(row0 + ai * HALF + m * 16) * 1024 + col0; unsigned w8x[2], w8y[2];
#pragma unroll
                for (int bj = 0; bj < 2; ++bj) { const f32x4 v0 = acc[ai][bj][m][0] * sc, v1 = acc[ai][bj][m][1] * sc;
                    if (t == 0 && (u.pm & 4)) { u32x4 w; w.x = cvt_pk_bf16(v0[0], v0[1]);     w.y = cvt_pk_bf16(v0[2], v0[3]); w.z = cvt_pk_bf16(v1[0], v1[1]); w.w = cvt_pk_bf16(v1[2], v1[3]);
                        *(u32x4*)(rowp + bj * 32) = w; }
                    w8x[bj] = pk_fp8x4(v0[0], v0[1], v0[2], v0[3]); w8y[bj] = pk_fp8x4(v1[0], v1[1], v1[2], v1[3]); }
                { unsigned char* p8 = QK8 + (size_t)t * ((size_t)32 << 20) + (size_t)(row0 + ai * HALF + m * 16) * 1024 + col0; st8x2_wide(p8, w8x[0], w8y[0], p8 + 32, w8x[1], w8y[1], fq); } }
        if (t == 1) { const int b = u.pm >> 3, blk = u.pm & 7;
#pragma unroll
            for (int bj = 0; bj < 2; ++bj)
#pragma unroll
                for (int n = 0; n < 2; ++n) { f32x4 s = (f32x4){0.f, 0.f, 0.f, 0.f};
#pragma unroll
                    for (int ai = 0; ai < 2; ++ai)
#pragma unroll
                        for (int m = 0; m < 4; ++m) s += acc[ai][bj][m][n];
#pragma unroll
                    for (int j = 0; j < 4; ++j) { float v = s[j]; v += __shfl_xor(v, 1); v += __shfl_xor(v, 2); v += __shfl_xor(v, 4); v += __shfl_xor(v, 8); s[j] = v; }
                    if (fr == 0) { const int kc = (u.pn & 3) * 256 + wc * 64 + bj * 32 + 8 * fq + 4 * n, h = kc >> 7, d = kc & 127; float* kp = kmean + ((size_t)(b * 8 + h) * 8 + blk) * 128 + d;
#pragma unroll
                        for (int j = 0; j < 4; ++j) atomicAdd(kp + j, s[j] * (sc * (1.0f / 256.0f))); } }
        }
    }
};
struct EpiSwiGLU {
    static constexpr bool PERM = true, AFTER_DRAIN = false, BADJ = false;
    bf16_t* Hid;
    __device__ __forceinline__ void operator()(const f32x4 (&acc)[2][2][4][2], const Unit& u, int wr, int wc, int fr, int fq) const {
        const int row0 = u.pm * BM + wr * 64 + fr, col0 = u.pn * 128 + wc * 32 + 8 * fq;
#pragma unroll
        for (int ai = 0; ai < 2; ++ai)
#pragma unroll
            for (int m = 0; m < 4; ++m) { bf16_t* rowp = Hid + (size_t)(row0 + ai * HALF + m * 16) * 512 + col0;
                const f32x4 g0 = acc[ai][0][m][0], g1 = acc[ai][0][m][1], u0 = acc[ai][1][m][0], u1 = acc[ai][1][m][1];
                u32x4 w; w.x = cvt_pk_bf16(g0[0] * sigm(g0[0]) * u0[0], g0[1] * sigm(g0[1]) * u0[1]); w.y = cvt_pk_bf16(g0[2] * sigm(g0[2]) * u0[2], g0[3] * sigm(g0[3]) * u0[3]);
                w.z = cvt_pk_bf16(g1[0] * sigm(g1[0]) * u1[0], g1[1] * sigm(g1[1]) * u1[1]); w.w = cvt_pk_bf16(g1[2] * sigm(g1[2]) * u1[2], g1[3] * sigm(g1[3]) * u1[3]);
                *(u32x4*)rowp = w; }
    }
};
constexpr float W8SCALE = 32.0f, W8INV = 1.0f / 32.0f;
__device__ __forceinline__ unsigned pk_fp8x4(float a, float b, float c, float d) { int w = __builtin_amdgcn_cvt_pk_fp8_f32(a, b, 0, false); w = __builtin_amdgcn_cvt_pk_fp8_f32(c, d, w, true); return (unsigned)w; }
struct EpiSwiGLU8 {
    static constexpr bool PERM = true, AFTER_DRAIN = false, BADJ = false;
    unsigned char* Hid;
    __device__ __forceinline__ void operator()(const f32x4 (&acc)[2][2][4][2], const Unit& u, int wr, int wc, int fr, int fq) const {
        const unsigned off0 = (unsigned)(u.pm * (BM * 512) + u.pn * (BM * 128) + wc * 128 + 8 * fq + (wr * 16 + (fr >> 2)) * 512 + (fr & 3) * 32);
#pragma unroll
        for (int ai = 0; ai < 2; ++ai)
#pragma unroll
            for (int m2 = 0; m2 < 4; m2 += 2) { unsigned wx[2], wy[2];
#pragma unroll
                for (int mm = 0; mm < 2; ++mm) { const int m = m2 + mm;
                    const f32x4 g0 = acc[ai][0][m][0] * W8INV, g1 = acc[ai][0][m][1] * W8INV, u0 = acc[ai][1][m][0] * W8INV, u1 = acc[ai][1][m][1] * W8INV;
                    wx[mm] = pk_fp8x4(g0[0] * sigm(g0[0]) * u0[0], g0[1] * sigm(g0[1]) * u0[1], g0[2] * sigm(g0[2]) * u0[2], g0[3] * sigm(g0[3]) * u0[3]);
                    wy[mm] = pk_fp8x4(g1[0] * sigm(g1[0]) * u1[0], g1[1] * sigm(g1[1]) * u1[1], g1[2] * sigm(g1[2]) * u1[2], g1[3] * sigm(g1[3]) * u1[3]); }
                unsigned char* rowp = Hid + (size_t)(off0 + (unsigned)((ai * (HALF / 4) + m2 * 4) * 512));
                st8x2_wide(rowp, wx[0], wy[0], rowp + 4 * 512, wx[1], wy[1], fq); }
    }
};
struct EpiYs8 {
    static constexpr bool PERM = true, AFTER_DRAIN = false, BADJ = false;
    bf16_t* O; float sc;
    __device__ __forceinline__ void operator()(const f32x4 (&acc)[2][2][4][2], const Unit& u, int wr, int wc, int fr, int fq) const {
        const int row0 = u.pm * BM + wr * 64 + fr, col0 = u.pn * BM + wc * 32 + 8 * fq;
#pragma unroll
        for (int ai = 0; ai < 2; ++ai)
#pragma unroll
            for (int m = 0; m < 4; ++m) { bf16_t* rowp = O + (size_t)(row0 + ai * HALF + m * 16) * 1024 + col0;
#pragma unroll
                for (int bj = 0; bj < 2; ++bj) { const f32x4 v0 = acc[ai][bj][m][0] * sc, v1 = acc[ai][bj][m][1] * sc;
                    u32x4 w; w.x = cvt_pk_bf16(v0[0], v0[1]); w.y = cvt_pk_bf16(v0[2], v0[3]); w.z = cvt_pk_bf16(v1[0], v1[1]); w.w = cvt_pk_bf16(v1[2], v1[3]);
                    *(u32x4*)(rowp + bj * HALF) = w; } }
    }
};
struct EpiYsF8 {
    static constexpr bool PERM = true, AFTER_DRAIN = false, BADJ = true;
    unsigned char* O; float sc;
    __device__ __forceinline__ void operator()(const f32x4 (&acc)[2][2][4][2], const Unit& u, int wr, int wc, int fr, int fq) const {
        const int row0 = u.pm * BM + wr * 64 + fr, col0 = u.pn * BM + wc * 64 + 8 * fq; typedef unsigned u32x2 __attribute__((ext_vector_type(2)));
#pragma unroll
        for (int ai = 0; ai < 2; ++ai)
#pragma unroll
            for (int m = 0; m < 4; ++m) { unsigned char* rowp = O + (size_t)(row0 + ai * HALF + m * 16) * 1024 + col0;
                unsigned wx[2], wy[2];
#pragma unroll
                for (int bj = 0; bj < 2; ++bj) { const f32x4 v0 = acc[ai][bj][m][0] * sc, v1 = acc[ai][bj][m][1] * sc; wx[bj] = pk_fp8x4(v0[0], v0[1], v0[2], v0[3]); wy[bj] = pk_fp8x4(v1[0], v1[1], v1[2], v1[3]); }
                st8x2_wide(rowp, wx[0], wy[0], rowp + 32, wx[1], wy[1], fq); }
    }
};
template <bool GATHER_> struct GroupedOrder {
    static constexpr bool GATHER = GATHER_, ABLK = !GATHER_;
    const PG8_LAS int* rowlds = nullptr;
    __device__ __forceinline__ int rowof(const Unit&, int ord, int r) const { return rowlds[ord * BM + r]; }
    static constexpr int MAXU = 6;
    __device__ __forceinline__ void stage_rows(const int* inv  , int cap, const PG8_LAS int* start, const PG8_LAS int* tot, PG8_LAS int* dst) { rowlds = dst; Unit u;
        for (int i = 0; i < MAXU && next(i, u); ++i) if (threadIdx.x < BM) { const int e = tile_e[u.pm], off = u.pm * BM - start[e] + (int)threadIdx.x; dst[i * BM + threadIdx.x] = off < tot[e] ? inv[e * cap + off] : 0; }
        __syncthreads(); }
    const PG8_LAS int* tile_e;   int nwg, nN, G, c; size_t estride;
    __device__ __forceinline__ void init(const PG8_LAS int* te, int ntiles, int nN_, int G_, int blk, size_t es) { tile_e = te; nN = nN_; nwg = ntiles * nN_; G = G_; estride = es;
        c = (G_ % 8 == 0) ? (blk % 8) * (G_ / 8) + blk / 8 : blk; }
    __device__ __forceinline__ bool next(int i, Unit& u) const { const long L = (long)i * G + c; if (L >= nwg) return false; u.pm = (int)(L / nN); u.pn = (int)(L % nN); return true; }
    __device__ __forceinline__ void a_ready(const Unit&) const {}
    __device__ __forceinline__ const char* bptr(const Gemm& g, const Unit& u, size_t tstep) const {
        const int e = __builtin_amdgcn_readfirstlane(tile_e[u.pm]); return (const char*)g.Bt + (size_t)e * estride + (size_t)u.pn * tstep; }
    __device__ __forceinline__ void done(const Unit&) const {}
};
}
namespace att {
typedef unsigned short bf16;
constexpr int D = 128, PITCH = 1024;
constexpr float SCALE = 0.08838834764831845f;
constexpr float THR = 0.f;
constexpr int NW = 8, QBLK = 32, KVBLK = 64, QB = NW * QBLK;
constexpr int SHM_V = KVBLK * D * 2, SHM_K = KVBLK * D * 2;
constexpr int LDS_BYTES = 2 * SHM_V + 2 * SHM_K + NW * 64 * 4;
typedef short bf16x8 __attribute__((ext_vector_type(8)));
typedef short s16x4 __attribute__((ext_vector_type(4)));
typedef float f32x16 __attribute__((ext_vector_type(16)));
typedef float f32x4 __attribute__((ext_vector_type(4)));
typedef unsigned u32x4 __attribute__((ext_vector_type(4)));
#define KSWZ(row, colB) ((row) * 256 + ((colB) ^ (((row) & 7) << 4)))
#define SBAR() __builtin_amdgcn_sched_barrier(0)
__device__ __forceinline__ int v_st(int k, int c) { const int kk = (k & ~0xC) | ((k & 4) << 1) | ((k & 8) >> 1); return ((kk >> 3) * 4 + (c >> 5)) * 512 + ((kk & 7) * 32 + (c & 31)) * 2; }
__device__ __forceinline__ int v_rd_base(int lane) { return ((lane & 3) << 3) | (((lane >> 2) & 3) << 6) | (((lane >> 4) & 1) << 5) | (((lane >> 5) & 1) << 8); }
constexpr int v_rd_off(int d0, int ks, int half) { return d0 * 512 + ks * 4096 + half * 2048; }
__device__ __forceinline__ int crow(int r, int hi) { return (r & 3) + 8 * (r >> 2) + 4 * hi; }
__device__ __forceinline__ unsigned cvtpk(float lo, float hi) { unsigned r; asm volatile("v_cvt_pk_bf16_f32 %0, %1, %2" : "=v"(r) : "v"(lo), "v"(hi)); return r; }
__device__ __forceinline__ bf16x8 load8(const bf16* p) { return *reinterpret_cast<const bf16x8*>(p); }
__device__ __forceinline__ void mask_tile(f32x16& p0, f32x16& p1, int dq) {
    const float NEG = -__builtin_inff();
#pragma unroll
    for (int r = 0; r < 16; ++r) {
        const int c = (r & 3) + 8 * (r >> 2);
        if (dq - c < 0) p0[r] = NEG;
        if (dq - c - 32 < 0) p1[r] = NEG;
    }
}
__device__ __forceinline__ void partialSM(f32x16& p0, f32x16& p1, float& m_reg, float& mn, float& alpha, bool keep) {
    float pmax = p0[0]; for (int r = 1; r < 16; ++r) pmax = fmaxf(pmax, p0[r]); for (int r = 0; r < 16; ++r) pmax = fmaxf(pmax, p1[r]);
    pmax = keep ? pmax : -__builtin_inff();
    { auto rr = __builtin_amdgcn_permlane32_swap(__float_as_uint(pmax), __float_as_uint(pmax), false, false);
      pmax = fmaxf(__uint_as_float(rr[0]), __uint_as_float(rr[1])); }
    constexpr float C2 = 1.4426950408889634f * SCALE;
    if (__builtin_expect(__all((pmax - m_reg) * SCALE <= THR), 1)) { mn = m_reg; alpha = 1.f; }
    else { mn = fmaxf(m_reg, pmax); alpha = __builtin_amdgcn_exp2f((m_reg - mn) * C2); m_reg = mn; }
    const float mnL = keep ? 8.0f - mn * C2 : -__builtin_inff();
    { typedef float f2_ __attribute__((ext_vector_type(2))); const f2_ c2 = {C2, C2}, ml = {mnL, mnL};
      for (int r = 0; r < 16; r += 2) { const f2_ a = __builtin_elementwise_fma((f2_){p0[r], p0[r + 1]}, c2, ml), b = __builtin_elementwise_fma((f2_){p1[r], p1[r + 1]}, c2, ml); p0[r] = a[0]; p0[r + 1] = a[1]; p1[r] = b[0]; p1[r + 1] = b[1]; } }
    for (int r = 0; r < 16; ++r) p0[r] = __builtin_amdgcn_exp2f(p0[r]);
}
__device__ __forceinline__ void finishSM(f32x16& p0, f32x16& p1, float alpha, float& l_reg, bf16x8& pa0, bf16x8& pa1, bf16x8& pa2, bf16x8& pa3) {
    for (int r = 0; r < 16; ++r) p1[r] = __builtin_amdgcn_exp2f(p1[r]);
    float ps = 0; for (int r = 0; r < 16; ++r) ps += p0[r]; for (int r = 0; r < 16; ++r) ps += p1[r];
    { auto rr = __builtin_amdgcn_permlane32_swap(__float_as_uint(ps), __float_as_uint(ps), false, false);
      ps = __uint_as_float(rr[0]) + __uint_as_float(rr[1]); }
    l_reg = l_reg * alpha + ps;
#define PK4(P, B_, OUT) do { unsigned a0 = cvtpk(P[B_+0], P[B_+1]), a1 = cvtpk(P[B_+2], P[B_+3]);                          \
        unsigned b0 = cvtpk(P[B_+4], P[B_+5]), b1 = cvtpk(P[B_+6], P[B_+7]);                                             \
        auto r0 = __builtin_amdgcn_permlane32_swap(a0, b0, false, false); auto r1 = __builtin_amdgcn_permlane32_swap(a1, b1, false, false); \
        u32x4 w = {r0[0], r1[0], r0[1], r1[1]}; OUT = *reinterpret_cast<bf16x8*>(&w); } while (0)
    PK4(p0, 0, pa0); PK4(p0, 8, pa1); PK4(p1, 0, pa2); PK4(p1, 8, pa3);
#undef PK4
}
template <int KB>
__device__ __forceinline__ void qkt(f32x16& p0, f32x16& p1, const char* K_lds, int r32, int hi, const bf16x8* qr) {
    p0 = f32x16{}; p1 = f32x16{};
    const char* kb[4];
#pragma unroll
    for (int dd = 0; dd < 4; ++dd) kb[dd] = K_lds + KB * SHM_K + KSWZ(r32, (dd * 16 + hi * 8) * 2);
#pragma unroll
    for (int d0 = 0; d0 < 8; ++d0) { const char* a = kb[d0 & 3] + (d0 >> 2) * 128;
        bf16x8 b0 = *reinterpret_cast<const bf16x8*>(a);
        bf16x8 b1 = *reinterpret_cast<const bf16x8*>(a + 32 * 256);
        p0 = __builtin_amdgcn_mfma_f32_32x32x16_bf16(b0, qr[d0], p0, 0, 0, 0);
        p1 = __builtin_amdgcn_mfma_f32_32x32x16_bf16(b1, qr[d0], p1, 0, 0, 0); }
}
typedef int i32x8_ __attribute__((ext_vector_type(8)));
template <int KB>
__device__ __forceinline__ void qkt8(f32x16& p0, f32x16& p1, const char* K_lds, int r32, int hi, const u32x4* q8) {
    p0 = f32x16{}; p1 = f32x16{};
    const char* kr = K_lds + KB * SHM_K + r32 * 128; const int kx = r32 & 7;
#pragma unroll
    for (int j = 0; j < 2; ++j) { const int c0 = ((4 * j + 2 * hi) ^ kx) << 4, c1 = ((4 * j + 2 * hi + 1) ^ kx) << 4;
        const u32x4 a0 = *(const u32x4*)(kr + c0), a1 = *(const u32x4*)(kr + c1), b0 = *(const u32x4*)(kr + 32 * 128 + c0), b1 = *(const u32x4*)(kr + 32 * 128 + c1);
        const i32x8_ qa = {(int)q8[2 * j][0], (int)q8[2 * j][1], (int)q8[2 * j][2], (int)q8[2 * j][3], (int)q8[2 * j + 1][0], (int)q8[2 * j + 1][1], (int)q8[2 * j + 1][2], (int)q8[2 * j + 1][3]};
        const i32x8_ ka = {(int)a0[0], (int)a0[1], (int)a0[2], (int)a0[3], (int)a1[0], (int)a1[1], (int)a1[2], (int)a1[3]}, kb = {(int)b0[0], (int)b0[1], (int)b0[2], (int)b0[3], (int)b1[0], (int)b1[1], (int)b1[2], (int)b1[3]};
        p0 = __builtin_amdgcn_mfma_scale_f32_32x32x64_f8f6f4(ka, qa, p0, 0, 0, 0, 0x7f7f7f7f, 0, 0x7f7f7f7f);
        p1 = __builtin_amdgcn_mfma_scale_f32_32x32x64_f8f6f4(kb, qa, p1, 0, 0, 0, 0x7f7f7f7f, 0, 0x7f7f7f7f); }
}
template <int VB>
__device__ __forceinline__ void pv_tile(f32x16* o, int vb0, bf16x8 pa0, bf16x8 pa1, bf16x8 pa2, bf16x8 pa3) {
#define TRRD(dst, off) asm volatile("ds_read_b64_tr_b16 %0, %1 offset:%2" : "=&v"(dst) : "v"(vb0), "i"(off) : "memory")
#define PV_D0(d0) do { s16x4 l0, l1, l2, l3, h0, h1, h2, h3; constexpr int b_ = VB * SHM_V + v_rd_off(d0, 0, 0);  \
        TRRD(l0, b_); TRRD(h0, b_ + 2048); TRRD(l1, b_ + 4096); TRRD(h1, b_ + 6144); TRRD(l2, b_ + 8192); TRRD(h2, b_ + 10240); TRRD(l3, b_ + 12288); TRRD(h3, b_ + 14336); \
        asm volatile("s_waitcnt lgkmcnt(0)" ::: "memory"); SBAR();   \
        o[d0] = __builtin_amdgcn_mfma_f32_32x32x16_bf16(pa0, (bf16x8){l0[0], l0[1], l0[2], l0[3], h0[0], h0[1], h0[2], h0[3]}, o[d0], 0, 0, 0);   \
        o[d0] = __builtin_amdgcn_mfma_f32_32x32x16_bf16(pa1, (bf16x8){l1[0], l1[1], l1[2], l1[3], h1[0], h1[1], h1[2], h1[3]}, o[d0], 0, 0, 0);   \
        o[d0] = __builtin_amdgcn_mfma_f32_32x32x16_bf16(pa2, (bf16x8){l2[0], l2[1], l2[2], l2[3], h2[0], h2[1], h2[2], h2[3]}, o[d0], 0, 0, 0);   \
        o[d0] = __builtin_amdgcn_mfma_f32_32x32x16_bf16(pa3, (bf16x8){l3[0], l3[1], l3[2], l3[3], h3[0], h3[1], h3[2], h3[3]}, o[d0], 0, 0, 0); } while (0)
    PV_D0(0); PV_D0(1); PV_D0(2); PV_D0(3);
#undef PV_D0
#undef TRRD
}
typedef int i32x8v __attribute__((ext_vector_type(8)));
__device__ __forceinline__ unsigned pk8(float a, float b, float c, float d) { int w = __builtin_amdgcn_cvt_pk_fp8_f32(a, b, 0, false); w = __builtin_amdgcn_cvt_pk_fp8_f32(c, d, w, true); return (unsigned)w; }
__device__ __forceinline__ void finishSM8(f32x16& p0, f32x16& p1, float alpha, float& l_reg, i32x8v& pa) {
    for (int r = 0; r < 16; ++r) p1[r] = __builtin_amdgcn_exp2f(p1[r]);
    float ps; { typedef float f2_ __attribute__((ext_vector_type(2))); f2_ s2 = {0.f, 0.f};
      for (int r = 0; r < 16; r += 2) { s2 += (f2_){p0[r], p0[r + 1]}; s2 += (f2_){p1[r], p1[r + 1]}; } ps = s2[0] + s2[1]; }
    { auto rr = __builtin_amdgcn_permlane32_swap(__float_as_uint(ps), __float_as_uint(ps), false, false);
      ps = __uint_as_float(rr[0]) + __uint_as_float(rr[1]); }
    l_reg = l_reg * alpha + ps;
#pragma unroll
    for (int j = 0; j < 4; ++j) { const unsigned w0 = pk8(p0[4 * j], p0[4 * j + 1], p0[4 * j + 2], p0[4 * j + 3]), w1 = pk8(p1[4 * j], p1[4 * j + 1], p1[4 * j + 2], p1[4 * j + 3]);
        auto rr = __builtin_amdgcn_permlane32_swap(w0, w1, false, false); pa[j] = (int)rr[0]; pa[4 + j] = (int)rr[1]; }
}
template <int VB>
__device__ __forceinline__ void pv_tile8(f32x16* o, int vb0, i32x8v pa) {
    typedef int v2i_ __attribute__((ext_vector_type(2))); typedef __attribute__((address_space(3))) v2i_ lds_v2i;
#define TR8(off) __builtin_amdgcn_ds_read_tr8_b64_v2i32((lds_v2i*)(unsigned)(vb0 + (off)))
#pragma unroll
    for (int d0 = 0; d0 < 4; ++d0) { constexpr int R0 = 0 * 32, R1 = 16 * 32, R2 = 8 * 32, R3 = 24 * 32; const int b_ = VB * SHM_V + d0 * 2048;
        const v2i_ t0 = TR8(b_ + R0), t1 = TR8(b_ + R1), t2 = TR8(b_ + R2), t3 = TR8(b_ + R3);
        const i32x8v vb = {t0[0], t0[1], t1[0], t1[1], t2[0], t2[1], t3[0], t3[1]};
        o[d0] = __builtin_amdgcn_mfma_scale_f32_32x32x64_f8f6f4(pa, vb, o[d0], 0, 0, 0, 0x77777777, 0, 0x7f7f7f7f); }
#undef TR8
}
struct BlockRef { const bf16* Q;   const unsigned char* Q8; const unsigned char* K8;   const unsigned char* V8;   unsigned char* O;     const float* Kmean; int P0; };
struct Seam { u32x4 q8[4];   u32x4 st_v; u32x4 st_k; };
#define ROW(p, k0, rr) ((p) + (unsigned)(((k0) + (rr)) * PITCH + sc))
#define VMW() asm volatile("s_waitcnt vmcnt(0)" ::: "memory")
#define VMWN(n) asm volatile("s_waitcnt vmcnt(%0)" :: "i"(n) : "memory")
#define SLOAD_H(Kp, Vp, k0) do { S.st_v = *(const u32x4*)((Vp) + (unsigned)(((k0) + krow) * PITCH + kch * 16));              \
                         S.st_k = *(const u32x4*)((Kp) + (unsigned)(((k0) + krow) * PITCH + kch * 16)); } while (0)
#define SWRITE_HK(bf) do { *(u32x4*)(K_lds + (bf) * SHM_K + kw8) = S.st_k; } while (0)
#define SWRITE_HV(bf) do { *(u32x4*)(V_lds + (bf) * SHM_V + vw8) = S.st_v; } while (0)
#define SWRITE_H(bf) do { SWRITE_HV(bf); SWRITE_HK(bf); } while (0)
__device__ __forceinline__ void moba_prime(const BlockRef& cur, char* lds, Seam& S) {
    const int tid = threadIdx.x, wid = __builtin_amdgcn_readfirstlane(tid >> 6), lane = tid & 63, r32 = lane & 31, hi = lane >> 5;
    const int sr = tid >> 4, sc = (tid & 15) * 8, krow = tid >> 3, kch = tid & 7, kw8 = krow * 128 + ((kch ^ (krow & 7)) << 4); char* K_lds = lds + 2 * SHM_V;
#pragma unroll
    for (int i = 0; i < 4; ++i) S.q8[i] = *(const u32x4*)(cur.Q8 + (unsigned)((wid * QBLK + r32) * PITCH + 64 * (i >> 1) + 32 * hi + 16 * (i & 1)));
    SLOAD_H(cur.K8, cur.V8, 0); VMW(); SWRITE_HK(0);
    __syncthreads();
}
__device__ __forceinline__ void moba_block(const BlockRef& cur, const BlockRef& nxt, char* lds, Seam& S) {
    const int tid = threadIdx.x, wid = __builtin_amdgcn_readfirstlane(tid >> 6), lane = tid & 63, r32 = lane & 31, hi = lane >> 5;
    const int NT = cur.P0 / KVBLK + 4;
    const int qlo = cur.P0 + wid * QBLK, qm = qlo + r32 - 4 * hi;
    unsigned selfull = 0xFFu;
    { const int qb = cur.P0 >> 8;
      if (qb >= 4) { float b1 = -__builtin_inff(), b2 = b1, b3 = b1; int i1 = 0, i2 = 0, i3 = 0;
        bf16x8 qg[8];
#pragma unroll
        for (int d0 = 0; d0 < 8; ++d0) qg[d0] = load8(cur.Q + (unsigned)((wid * QBLK + r32) * PITCH + hi * 8) + d0 * 16);
        float* kml = (float*)(lds + LDS_BYTES);
        for (int i = tid; i < qb * 128; i += NW * 64) kml[i] = cur.Kmean[i];
        __syncthreads();
#pragma unroll 1
        for (int n = 0; n < qb; ++n) { float g = 0.f; const float* kmn = kml + n * 128 + 8 * hi;
#pragma unroll
            for (int d0 = 0; d0 < 8; ++d0) { const u32x4 qw = *reinterpret_cast<const u32x4*>(&qg[d0]); const f32x4 k0 = *(const f32x4*)(kmn + 16 * d0), k1 = *(const f32x4*)(kmn + 16 * d0 + 4);
                g += (__uint_as_float(qw.x << 16) * k0[0] + __uint_as_float(qw.x & 0xffff0000u) * k0[1]) + (__uint_as_float(qw.y << 16) * k0[2] + __uint_as_float(qw.y & 0xffff0000u) * k0[3])
                   + (__uint_as_float(qw.z << 16) * k1[0] + __uint_as_float(qw.z & 0xffff0000u) * k1[1]) + (__uint_as_float(qw.w << 16) * k1[2] + __uint_as_float(qw.w & 0xffff0000u) * k1[3]); }
            g += __shfl_xor(g, 32);
            if (g > b1) { b3 = b2; i3 = i2; b2 = b1; i2 = i1; b1 = g; i1 = n; } else if (g > b2) { b3 = b2; i3 = i2; b2 = g; i2 = n; } else if (g > b3) { b3 = g; i3 = n; } }
        const unsigned mask = (1u << i1) | (1u << i2) | (1u << i3);
        selfull = mask | (0xFFu << qb); } }
    char* V_lds = lds; char* K_lds = lds + 2 * SHM_V;
    float* ws = (float*)(lds + 2 * SHM_V + 2 * SHM_K) + wid * 64; float* li_l = ws, * al_l = ws + 32;
    float m_reg = -1e30f, l_reg = 0; f32x16 o[4] = {};
    const int sr = tid >> 4, sc = (tid & 15) * 8, krow = tid >> 3, kch = tid & 7, kw8 = krow * 128 + ((kch ^ (krow & 7)) << 4), vw8 = (kch >> 1) * 2048 + ((krow & ~12) | ((krow & 4) << 1) | ((krow & 8) >> 1)) * 32 + (kch & 1) * 16;
    const int vb0 = (int)(uintptr_t)V_lds + (32 * hi + ((lane & 15) >> 1)) * 32 + 16 * ((lane >> 4) & 1) + 8 * (lane & 1);
    const unsigned char* Kh = cur.K8; const unsigned char* Vh = cur.V8;
#define RESC(a) do { if (__any((a) < 1.f)) { if (hi == 0) al_l[r32] = (a); asm volatile("s_waitcnt lgkmcnt(0)" ::: "memory");              \
                     for (int d_ = 0; d_ < 4; ++d_) for (int r = 0; r < 16; ++r) o[d_][r] *= al_l[crow(r, hi)]; } } while (0)
#define KBASE(t) ((t) * KVBLK)
#define KEEP(t) (((selfull >> (KBASE(t) >> 8)) & 1u) != 0u)
#define MASKT(P0_, P1_, t) do { const int kb_ = KBASE(t); if (kb_ + KVBLK - 1 > qlo) mask_tile(P0_, P1_, qm - kb_); } while (0)
    constexpr int NQL = 4;
#define SEAM_K0() do { VMWN(NQL); SWRITE_HK(0); SBAR(); } while (0)
    f32x16 pA0, pA1, pB0, pB1; float mnA, mnB, alA, alB; i32x8v pa;
    SWRITE_HV(0); SBAR();
    if (NT > 1) { SLOAD_H(Kh, Vh, KBASE(1)); }
    SBAR(); qkt8<0>(pA0, pA1, K_lds, r32, hi, S.q8);
    MASKT(pA0, pA1, 0); partialSM(pA0, pA1, m_reg, mnA, alA, KEEP(0));
    if (NT > 1) { VMW(); SWRITE_H(1); }
    __syncthreads();
#define HALF_STEP(PX0, PX1, mnX, alX, PY0, PY1, alY, t, KB, VB, SB) do {                                                      \
        SBAR(); qkt8<KB>(PX0, PX1, K_lds, r32, hi, S.q8);                                             \
        finishSM8(PY0, PY1, alY, l_reg, pa); SBAR();                                                           \
        if ((t) + 1 < NT) { SLOAD_H(Kh, Vh, KBASE((t) + 1)); SBAR(); }                                               \
        pv_tile8<VB>(o, vb0, pa); MASKT(PX0, PX1, (t)); partialSM(PX0, PX1, m_reg, mnX, alX, KEEP(t));                                        \
        __syncthreads();                                                                                                      \
        if ((t) + 1 < NT) { VMW(); SWRITE_H(SB); }                                                                          \
        RESC(alX); __syncthreads(); } while (0)
    for (int t = 1; t + 1 < NT; t += 2) {
        HALF_STEP(pB0, pB1, mnB, alB, pA0, pA1, alA, t, 1, 0, 0);
        HALF_STEP(pA0, pA1, mnA, alA, pB0, pB1, alB, t + 1, 0, 1, 1);
    }
    const bool even = (NT & 1) == 0;
    if (even) { SBAR(); qkt8<1>(pB0, pB1, K_lds, r32, hi, S.q8); SBAR(); }
    SLOAD_H(nxt.K8, nxt.V8, 0); SBAR();
#pragma unroll
    for (int i = 0; i < 4; ++i) S.q8[i] = *(const u32x4*)(nxt.Q8 + (unsigned)((wid * QBLK + r32) * PITCH + 64 * (i >> 1) + 32 * hi + 16 * (i & 1)));
    SBAR();
    finishSM8(pA0, pA1, alA, l_reg, pa); SBAR();
    pv_tile8<0>(o, vb0, pa);
    if (even) { MASKT(pB0, pB1, NT - 1); partialSM(pB0, pB1, m_reg, mnB, alB, KEEP(NT - 1)); __syncthreads(); RESC(alB);
        finishSM8(pB0, pB1, alB, l_reg, pa); SBAR(); pv_tile8<1>(o, vb0, pa); }
    SBAR(); SEAM_K0();
    if (hi == 0) li_l[r32] = l_reg; asm volatile("s_waitcnt lgkmcnt(0)" ::: "memory");
    float rli[16];
#pragma unroll
    for (int r = 0; r < 16; ++r) rli[r] = __builtin_amdgcn_rcpf(li_l[crow(r, hi)]);
    unsigned char* ost = (unsigned char*)lds + 73728 + wid * 4096;
#pragma unroll
    for (int r = 0; r < 16; ++r) { const float sc16 = rli[r] * (16.0f * 256.0f);     unsigned char* orow = ost + crow(r, hi) * 128 + r32;
#pragma unroll
        for (int d0 = 0; d0 < 4; ++d0) { const float v = o[d0][r] * sc16; orow[d0 * 32] = (unsigned char)__builtin_amdgcn_cvt_pk_fp8_f32(v, v, 0, false); } }
#pragma unroll
    for (int i = 0; i < 4; ++i) { const int ch = lane + 64 * i, row = ch >> 3, c16 = ch & 7;
        const u32x4 d = *(const u32x4*)(ost + row * 128 + c16 * 16);
        *(u32x4*)(cur.O + (unsigned)((wid * QBLK + row) * PITCH + c16 * 16)) = d; }
    __syncthreads();
#undef RESC
#undef KBASE
#undef KEEP
#undef MASKT
#undef SEAM_K0
#undef HALF_STEP
}
#undef ROW
#undef VMW
#undef VMWN
#undef SLOAD_H
#undef SWRITE_HK
#undef SWRITE_HV
#undef SWRITE_H
}
#define GAS __attribute__((address_space(1)))
#define LAS __attribute__((address_space(3)))
typedef unsigned short bf16;
typedef unsigned v4u __attribute__((ext_vector_type(4)));
typedef float f32x4 __attribute__((ext_vector_type(4)));
typedef short bf16x8 __attribute__((ext_vector_type(8)));
typedef GAS unsigned gu32;
typedef GAS unsigned long long gu64;
#define RLX_AGENT __ATOMIC_RELAXED, __HIP_MEMORY_SCOPE_AGENT
#define LDS_WAIT() asm volatile("s_waitcnt lgkmcnt(0)" ::: "memory")
#define VM_WAIT() asm volatile("s_waitcnt vmcnt(0)" ::: "memory")
__device__ __forceinline__ unsigned long long rt() { return __builtin_amdgcn_s_memrealtime(); }
__device__ __forceinline__ unsigned f2bf(float f) { unsigned u = __builtin_bit_cast(unsigned, f); return (u + 0x7fffu + ((u >> 16) & 1u)) >> 16; }
__device__ __forceinline__ unsigned pk2(float lo, float hi) { unsigned r; asm("v_cvt_pk_bf16_f32 %0, %1, %2" : "=v"(r) : "v"(lo), "v"(hi)); return r; }

#define XB_TMO      128
#define XB_XCNT(j)  (256  + 64 * (j))
#define XB_XSUB(j)  (1280 + 64 * (j))
#define XB_XGEN(j)  (2304 + 64 * (j))
#define XB_TOP      3328
#define XB_TOPGEN   3392
#define XCD_BAR_WORDS 3456
#define XB_SPIN_CAP (1u << 18)

__device__ __forceinline__ unsigned xb_ld(unsigned* p)              { return __hip_atomic_load(p, __ATOMIC_RELAXED, __HIP_MEMORY_SCOPE_AGENT); }
__device__ __forceinline__ unsigned xb_add(unsigned* p, unsigned v) { return __hip_atomic_fetch_add(p, v, __ATOMIC_RELAXED, __HIP_MEMORY_SCOPE_AGENT); }
__device__ __forceinline__ unsigned xb_xcc_id() { return (unsigned)__builtin_amdgcn_s_getreg((3 << 11) | 20) & 0xFu; }
#define XB_SPIN(cond, bar) do { unsigned _sp = 0; while (cond) { __builtin_amdgcn_s_sleep(1); \
    if ((++_sp & 255u) == 0u) { if (xb_ld(&(bar)[XB_TMO])) break; if (_sp > XB_SPIN_CAP) { atomicAdd(&(bar)[XB_TMO], 1u); break; } } } } while (0)

struct XcdBarrier {
    unsigned* bar; unsigned x;
    volatile LAS unsigned* st;
};

__device__ __forceinline__ XcdBarrier xcd_barrier_post(unsigned* bar, volatile LAS unsigned* st) {
    XcdBarrier b; b.bar = bar; b.x = xb_xcc_id(); b.st = st;
    if (threadIdx.x == 0) (void)xb_add(&bar[XB_XCNT(b.x)], 1u);
    return b;
}
__device__ __forceinline__ void xcd_barrier_complete(unsigned* bar, unsigned x, unsigned& nloc, unsigned& nx) {
    const unsigned G = gridDim.x * gridDim.y * gridDim.z;
    unsigned sum, cnt, mine, sp = 0u;
    for (;;) {
        sum = 0u; cnt = 0u; mine = 0u;
#pragma unroll
        for (unsigned j = 0; j < 16; ++j) { const unsigned c = xb_ld(&bar[XB_XCNT(j)]); sum += c; cnt += (c > 0u) ? 1u : 0u; mine = (j == x) ? c : mine; }
        if (sum == G) break;
        __builtin_amdgcn_s_sleep(1);
        if ((++sp & 255u) == 0u) { if (xb_ld(&bar[XB_TMO])) break; if (sp > XB_SPIN_CAP) { atomicAdd(&bar[XB_TMO], 1u); break; } }
    }
    nloc = mine > 0u ? mine : 1u; nx = cnt > 0u ? cnt : 1u;
}

__device__ __forceinline__ void xcd_barrier(const XcdBarrier& b) {
    asm volatile("s_waitcnt vmcnt(0)" ::: "memory");
    __syncthreads();
    if (threadIdx.x == 0) {
        unsigned* bar = b.bar;
        __builtin_amdgcn_s_waitcnt(0);
        unsigned nloc = b.st[0], nx = b.st[1];
        if (nloc == 0u) { xcd_barrier_complete(bar, b.x, nloc, nx); b.st[0] = nloc; b.st[1] = nx; }
        const unsigned old = xb_add(&bar[XB_XSUB(b.x)], 1u);
        const unsigned gen = old / nloc;
        if (old + 1u == (gen + 1u) * nloc) {
            __builtin_amdgcn_fence(__ATOMIC_RELEASE, "agent");
            asm volatile("s_waitcnt vmcnt(0)" ::: "memory");
            const unsigned og = xb_add(&bar[XB_TOP], 1u);
            const unsigned tg = og / nx;
            if (og + 1u == (tg + 1u) * nx) xb_add(&bar[XB_TOPGEN], 1u);
            else XB_SPIN(xb_ld(&bar[XB_TOPGEN]) == tg, bar);
            __builtin_amdgcn_fence(__ATOMIC_ACQUIRE, "agent");
            xb_add(&bar[XB_XGEN(b.x)], 1u);
            asm volatile("s_waitcnt vmcnt(0)" ::: "memory");
        } else {
            XB_SPIN(xb_ld(&bar[XB_XGEN(b.x)]) == gen, bar);
            __builtin_amdgcn_fence(__ATOMIC_ACQUIRE, "agent");
            asm volatile("s_waitcnt vmcnt(0)" ::: "memory");
        }
    }
    __syncthreads();
}
__device__ __forceinline__ void group4_barrier(unsigned* bar, unsigned* gword, unsigned* xmap4) {
    asm volatile("s_waitcnt vmcnt(0)" ::: "memory");
    __syncthreads();
    if (threadIdx.x == 0) {
        const unsigned x0 = xb_ld(xmap4), x1 = xb_ld(xmap4 + 1), x2 = xb_ld(xmap4 + 2), x3 = xb_ld(xmap4 + 3);
        if (!(x0 != 0u && x0 == x1 && x1 == x2 && x2 == x3)) { __builtin_amdgcn_fence(__ATOMIC_RELEASE, "agent"); asm volatile("s_waitcnt vmcnt(0)" ::: "memory"); }
        (void)xb_add(gword, 1u);
        XB_SPIN(xb_ld(gword) < 4u, bar);
        __builtin_amdgcn_fence(__ATOMIC_ACQUIRE, "agent");
        asm volatile("s_waitcnt vmcnt(0)" ::: "memory");
    }
    __syncthreads();
}
template <class Fn> __device__ __forceinline__ void local_barrier_ov(unsigned* bar, unsigned* word, unsigned n, Fn fn) {
    asm volatile("s_waitcnt vmcnt(0)" ::: "memory");
    __syncthreads();
    if (threadIdx.x == 0) {
        (void)xb_add(word, 1u);
        XB_SPIN(xb_ld(word) < n, bar);
        __builtin_amdgcn_fence(__ATOMIC_ACQUIRE, "agent");
        asm volatile("s_waitcnt vmcnt(0)" ::: "memory");
    } else if (threadIdx.x >= 64) { fn(); }
    __syncthreads();
}
template <class Fn> __device__ __forceinline__ void xcd_barrier_ov(const XcdBarrier& b, Fn fn) {
    asm volatile("s_waitcnt vmcnt(0)" ::: "memory");
    __syncthreads();
    if (threadIdx.x == 0) {
        unsigned* bar = b.bar;
        __builtin_amdgcn_s_waitcnt(0);
        unsigned nloc = b.st[0], nx = b.st[1];
        if (nloc == 0u) { xcd_barrier_complete(bar, b.x, nloc, nx); b.st[0] = nloc; b.st[1] = nx; }
        const unsigned old = xb_add(&bar[XB_XSUB(b.x)], 1u);
        const unsigned gen = old / nloc;
        if (old + 1u == (gen + 1u) * nloc) {
            __builtin_amdgcn_fence(__ATOMIC_RELEASE, "agent");
            asm volatile("s_waitcnt vmcnt(0)" ::: "memory");
            const unsigned og = xb_add(&bar[XB_TOP], 1u);
            const unsigned tg = og / nx;
            if (og + 1u == (tg + 1u) * nx) xb_add(&bar[XB_TOPGEN], 1u);
            else XB_SPIN(xb_ld(&bar[XB_TOPGEN]) == tg, bar);
            __builtin_amdgcn_fence(__ATOMIC_ACQUIRE, "agent");
            xb_add(&bar[XB_XGEN(b.x)], 1u);
            asm volatile("s_waitcnt vmcnt(0)" ::: "memory");
        } else {
            XB_SPIN(xb_ld(&bar[XB_XGEN(b.x)]) == gen, bar);
            __builtin_amdgcn_fence(__ATOMIC_ACQUIRE, "agent");
            asm volatile("s_waitcnt vmcnt(0)" ::: "memory");
        }
    } else if (threadIdx.x >= 64) { fn(); }
    __syncthreads();
}
constexpr int NB = 16, T = 2048, D = 1024, M = NB * T;
constexpr int NEXP = 16, DEXP = 512;
constexpr int MAXT = 272, MSORT = MAXT * 256;
constexpr float LN_EPS = 1e-5f, DN_ALPHA = 1.4142135623730951f;
constexpr int NWAVES = 8;
constexpr size_t MiB = 1u << 20;
constexpr size_t WS_CTL = 0, CTL_ZERO_BYTES = 1 * MiB;
constexpr size_t WS_COND = 1 * MiB;
constexpr size_t WS_KMEAN = 512 * 1024;
constexpr size_t WS_ROUTE_E = 3 * MiB;
constexpr size_t WS_ROUTE_W = WS_ROUTE_E + 128 * 1024;
constexpr size_t WS_POS = WS_ROUTE_W + 256 * 1024;
constexpr size_t WS_CNT = WS_POS + 256 * 1024;
constexpr size_t WS_TILE = WS_CNT + 16 * 1024;
constexpr size_t WS_SEL = 4 * MiB;
constexpr size_t WS_INV = 5 * MiB;
constexpr size_t WS_WIN = 8 * MiB, WS_WOUT = 12 * MiB, WS_WQKV = 14 * MiB, WS_WO2 = 20 * MiB;
constexpr size_t WS_WGU = 22 * MiB;
constexpr size_t WS_WD = 86 * MiB;
constexpr size_t WS_XA = 118 * MiB;
constexpr size_t WS_H8 = 118 * MiB + 128 * MiB - 32 * MiB;
constexpr size_t WS_H = 246 * MiB;
constexpr size_t WS_BIG = 310 * MiB;
constexpr size_t WS_END = 502 * MiB;
constexpr int CW_BAR = 4096;
constexpr int CW_LBAR = 49152;
constexpr int CW_XMAP = 24576;
constexpr int CW_GBAR = 32768;
constexpr int CW_MOE = 16384;
constexpr int TAB_START = 512, TAB_TOT = 544, INV_CAP = 32768;

typedef unsigned v2u __attribute__((ext_vector_type(2)));
typedef float f32x2 __attribute__((ext_vector_type(2)));
__device__ __forceinline__ float bflo(unsigned w) { return __builtin_bit_cast(float, w << 16); }
__device__ __forceinline__ float bfhi(unsigned w) { return __builtin_bit_cast(float, w & 0xffff0000u); }
__device__ __forceinline__ float dpp_add(float v, float src_holder, int ctrl_unused) { return v; }
#define WS_DPP(v, ctrl, rmask) (v) += __builtin_bit_cast(float, __builtin_amdgcn_update_dpp(0, __builtin_bit_cast(int, (v)), (ctrl), (rmask), 0xF, true))
__device__ __forceinline__ float wave_sum(float v) {
    WS_DPP(v, 0xB1, 0xF);
    WS_DPP(v, 0x4E, 0xF);
    WS_DPP(v, 0x141, 0xF);
    WS_DPP(v, 0x140, 0xF);
    WS_DPP(v, 0x142, 0xA);
    WS_DPP(v, 0x143, 0xC);
    return __builtin_bit_cast(float, __builtin_amdgcn_readlane(__builtin_bit_cast(int, v), 63));
}

#define DPPF(v, ctrl) __builtin_bit_cast(float, __builtin_amdgcn_update_dpp(0, __builtin_bit_cast(int, (v)), (ctrl), 0xF, 0xF, true))
__device__ __forceinline__ float xrow_sum(float r) {
    { float x = r, y = r; asm volatile("s_nop 1\n\tv_permlane16_swap_b32 %0, %1" : "+v"(x), "+v"(y)); r = x + y; }
    { float x = r, y = r; asm volatile("s_nop 1\n\tv_permlane32_swap_b32 %0, %1" : "+v"(x), "+v"(y)); r = x + y; }
    return r;
}
__device__ __forceinline__ void wave_sum4(float a, float b, float c, float d, float& s0, float& s1, float& s2, float& s3, int lane) {
    const bool odd = (lane & 1) != 0, hi2 = (lane & 2) != 0;
    const float rab = (odd ? b : a) + DPPF(odd ? a : b, 0xB1);
    const float rcd = (odd ? d : c) + DPPF(odd ? c : d, 0xB1);
    float r = (hi2 ? rcd : rab) + DPPF(hi2 ? rab : rcd, 0x4E);
    r += DPPF(r, 0x124); r += DPPF(r, 0x128);
    r = xrow_sum(r);
    s0 = __builtin_bit_cast(float, __builtin_amdgcn_readlane(__builtin_bit_cast(int, r), 0)); s1 = __builtin_bit_cast(float, __builtin_amdgcn_readlane(__builtin_bit_cast(int, r), 1));
    s2 = __builtin_bit_cast(float, __builtin_amdgcn_readlane(__builtin_bit_cast(int, r), 2)); s3 = __builtin_bit_cast(float, __builtin_amdgcn_readlane(__builtin_bit_cast(int, r), 3));
}
struct Params { const float* in[27]; float* out; unsigned char* ws; int ph_lo, ph_hi, li, pad; };
enum { I_X = 0, I_C, I_ADAW, I_ADAB, I_LNMG, I_LNMB, I_LNFG, I_LNFB, I_WIN, I_SLNG, I_SLNB, I_WS, I_BS, I_WDW, I_BDW, I_CLNG, I_CLNB, I_WOUT, I_WQKV, I_WO2,
       I_WGRP, I_BGRP, I_WER, I_BER, I_WGATE, I_WUP, I_WDOWN };
struct Frame {
    LAS unsigned char* lds;
    int tid, lane, wave, vcu, G;
};

__device__ __forceinline__ void p0_cond(const Frame& F, const float* c, const float* ada_w, const float* ada_b, float* cond) {
    LAS float* sc = (LAS float*)F.lds;
    LAS float* red = (LAS float*)(F.lds + 65536);
    bool loaded = false;
    for (int it = blockIdx.x; it < 192; it += F.G) {
        if (!loaded) { for (int i = F.tid; i < 16384; i += 512) { const int b = i >> 10, k = i & 1023; const float v = c[i]; sc[k * 16 + b] = v / (1.0f + __expf(-v)); } __syncthreads(); loaded = true; }
        const int L = it / 96, j0 = (it % 96) * 64, col = F.tid & 63, ks = F.tid >> 6;
        float acc[16];
#pragma unroll
        for (int b = 0; b < 16; ++b) acc[b] = 0.f;
        const float* w = ada_w + (size_t)L * 1024 * 6144 + (size_t)(ks * 128) * 6144 + j0 + col;
        for (int kb = 0; kb < 128; kb += 32) { float wv[32];
#pragma unroll
            for (int k = 0; k < 32; ++k) wv[k] = __builtin_nontemporal_load(w + (size_t)(kb + k) * 6144);
#pragma unroll
            for (int k = 0; k < 32; ++k) { const LAS f32x4* s4 = (const LAS f32x4*)(sc + (ks * 128 + kb + k) * 16);
#pragma unroll
                for (int q = 0; q < 4; ++q) { const f32x4 s = s4[q]; acc[4 * q + 0] += s[0] * wv[k]; acc[4 * q + 1] += s[1] * wv[k]; acc[4 * q + 2] += s[2] * wv[k]; acc[4 * q + 3] += s[3] * wv[k]; } } }
#pragma unroll
        for (int b = 0; b < 16; ++b) red[(ks * 16 + b) * 64 + col] = acc[b];
        __syncthreads();
        for (int o = F.tid; o < 1024; o += 512) { const int b = o >> 6, cc = o & 63; float s = ada_b[L * 6144 + j0 + cc];
#pragma unroll
            for (int k2 = 0; k2 < 8; ++k2) s += red[(k2 * 16 + b) * 64 + cc];
            cond[(size_t)(L * 16 + b) * 6144 + j0 + cc] = s; }
        __syncthreads();
    }
}
__device__ __forceinline__ void transpose_item(const float* W, int srcN, bf16* WT, int dstK, int k0, int n0, int drow0, LAS float* scr, int lane) {
    { const int kr = lane >> 3, n4 = (lane & 7) * 4; f32x4 v[8];
#pragma unroll
        for (int i = 0; i < 8; ++i) v[i] = __builtin_nontemporal_load((const f32x4*)(W + (size_t)(k0 + kr + 8 * i) * srcN + n0 + n4));
#pragma unroll
        for (int i = 0; i < 8; ++i) { LAS float* d = scr + (kr + 8 * i) * 33 + n4; d[0] = v[i][0]; d[1] = v[i][1]; d[2] = v[i][2]; d[3] = v[i][3]; } }
    LDS_WAIT(); asm volatile("" ::: "memory");
    const int c = lane & 7;
#pragma unroll
    for (int j = 0; j < 4; ++j) { const int n = (lane >> 3) + 8 * j; const LAS float* s = scr + (8 * c) * 33 + n;
        v4u o; o.x = pk2(s[0 * 33], s[1 * 33]); o.y = pk2(s[2 * 33], s[3 * 33]); o.z = pk2(s[4 * 33], s[5 * 33]); o.w = pk2(s[6 * 33], s[7 * 33]);
        *(GAS v4u*)(WT + (size_t)(drow0 + n) * dstK + k0 + 8 * c) = o; }
    LDS_WAIT(); asm volatile("" ::: "memory");
}
__device__ __forceinline__ void transpose_item_fp8(const float* W, int srcN, unsigned char* WT, int dstK, int k0, int n0, int drow0, LAS float* scr, int lane) {
    { const int kr = lane >> 3, n4 = (lane & 7) * 4; f32x4 v[8];
#pragma unroll
        for (int i = 0; i < 8; ++i) v[i] = __builtin_nontemporal_load((const f32x4*)(W + (size_t)(k0 + kr + 8 * i) * srcN + n0 + n4));
#pragma unroll
        for (int i = 0; i < 8; ++i) { LAS float* d = scr + (kr + 8 * i) * 33 + n4; d[0] = v[i][0] * 32.0f; d[1] = v[i][1] * 32.0f; d[2] = v[i][2] * 32.0f; d[3] = v[i][3] * 32.0f; } }
    LDS_WAIT(); asm volatile("" ::: "memory");
    const int c = lane & 3;
#pragma unroll
    for (int j = 0; j < 2; ++j) { const int n = (lane >> 2) + 16 * j; const LAS float* s = scr + (16 * c) * 33 + n;
        v4u o; o.x = pg8::pk_fp8x4(s[0 * 33], s[1 * 33], s[2 * 33], s[3 * 33]); o.y = pg8::pk_fp8x4(s[4 * 33], s[5 * 33], s[6 * 33], s[7 * 33]);
        o.z = pg8::pk_fp8x4(s[8 * 33], s[9 * 33], s[10 * 33], s[11 * 33]); o.w = pg8::pk_fp8x4(s[12 * 33], s[13 * 33], s[14 * 33], s[15 * 33]);
        *(GAS v4u*)(WT + (size_t)(drow0 + n) * dstK + k0 + 16 * c) = o; }
    LDS_WAIT(); asm volatile("" ::: "memory");
}
constexpr int CV_S0 = 1024, CV_S1 = CV_S0 + 512, CV_S2 = CV_S1 + 1536, CV_S3 = CV_S2 + 512, CV_S4 = CV_S3 + 8192, CV_S5 = CV_S4 + 8192, CV_S6 = CV_S5 + 8192;
__device__ __forceinline__ void convert_item(const Params& P, int it, LAS float* scr, int lane) {
    unsigned char* ws = P.ws;
    if (it < CV_S0) { const int r = it, kb = r >> 6, nb = r & 63, n0 = nb * 32;
        const int drow = n0 < 1024 ? n0 : (n0 < 1536 ? (4 + ((n0 - 1024) >> 7)) * 256 + (((n0 - 1024) & 127) >> 5) * 64 : (4 + ((n0 - 1536) >> 7)) * 256 + (((n0 - 1536) & 127) >> 5) * 64 + 32);
        transpose_item(P.in[I_WIN], 2048, (bf16*)(ws + WS_WIN), 1024, kb * 64, n0, drow, scr, lane); }
    else if (it < CV_S1) { const int r = it - CV_S0, kb = r >> 5, nb = r & 31; transpose_item(P.in[I_WOUT], 1024, (bf16*)(ws + WS_WOUT), 1024, kb * 64, nb * 32, nb * 32, scr, lane); }
    else if (it < CV_S2) { const int r = it - CV_S1, kb = r / 96, nb = r % 96; transpose_item_fp8(P.in[I_WQKV], 3072, ws + WS_WQKV, 1024, kb * 64, nb * 32, nb * 32, scr, lane); }
    else if (it < CV_S3) { const int r = it - CV_S2, kb = r >> 5, nb = r & 31; transpose_item_fp8(P.in[I_WO2], 1024, ws + WS_WO2, 1024, kb * 64, nb * 32, nb * 32, scr, lane); }
    else if (it < CV_S5) { const bool up = it >= CV_S4; const int r = it - (up ? CV_S4 : CV_S3), le = r >> 8, q = r & 255, kb = q >> 4, nb = q & 15, n0 = nb * 32;
        const int drow = (n0 >> 7) * 256 + (up ? 128 : 0) + (n0 & 127);
        transpose_item_fp8(P.in[up ? I_WUP : I_WGATE] + (size_t)le * 1024 * 512, 512, ws + WS_WGU + (size_t)le * 1024 * 1024, 1024, kb * 64, n0, drow, scr, lane); }
    else { const int r = it - CV_S5, le = r >> 8, q = r & 255, kb = q >> 5, nb = q & 31;
        transpose_item_fp8(P.in[I_WDOWN] + (size_t)le * 512 * 1024, 1024, ws + WS_WD + (size_t)le * 1024 * 512, 512, kb * 64, nb * 32, nb * 32, scr, lane); }
}
struct CvD { const float* src;   int srcN; unsigned char* dst;   int dstB;   int f8; };
__device__ __forceinline__ CvD cv_desc(const float* W, int srcN, unsigned char* WT, int dstK, int k0, int n0, int drow0, int f8) {
    CvD d; d.src = W + (size_t)k0 * srcN + n0; d.srcN = srcN; d.f8 = f8; d.dstB = f8 ? dstK : 2 * dstK; d.dst = WT + ((size_t)drow0 * dstK + k0) * (f8 ? 1 : 2); return d; }
__device__ __forceinline__ CvD cv_decode(const Params& P, int it) {
    unsigned char* ws = P.ws;
    if (it < CV_S0) { const int r = it, kb = r >> 6, nb = r & 63, n0 = nb * 32;
        const int drow = n0 < 1024 ? n0 : (n0 < 1536 ? (4 + ((n0 - 1024) >> 7)) * 256 + (((n0 - 1024) & 127) >> 5) * 64 : (4 + ((n0 - 1536) >> 7)) * 256 + (((n0 - 1536) & 127) >> 5) * 64 + 32);
        return cv_desc(P.in[I_WIN], 2048, ws + WS_WIN, 1024, kb * 64, n0, drow, 0); }
    else if (it < CV_S1) { const int r = it - CV_S0, kb = r >> 5, nb = r & 31; return cv_desc(P.in[I_WOUT], 1024, ws + WS_WOUT, 1024, kb * 64, nb * 32, nb * 32, 0); }
    else if (it < CV_S2) { const int r = it - CV_S1, kb = r / 96, nb = r % 96; return cv_desc(P.in[I_WQKV], 3072, ws + WS_WQKV, 1024, kb * 64, nb * 32, nb * 32, 1); }
    else if (it < CV_S3) { const int r = it - CV_S2, kb = r >> 5, nb = r & 31; return cv_desc(P.in[I_WO2], 1024, ws + WS_WO2, 1024, kb * 64, nb * 32, nb * 32, 1); }
    else if (it < CV_S5) { const bool up = it >= CV_S4; const int r = it - (up ? CV_S4 : CV_S3), le = r >> 8, q = r & 255, kb = q >> 4, nb = q & 15, n0 = nb * 32;
        const int drow = (n0 >> 7) * 256 + (up ? 128 : 0) + (n0 & 127);
        return cv_desc(P.in[up ? I_WUP : I_WGATE] + (size_t)le * 1024 * 512, 512, ws + WS_WGU + (size_t)le * 1024 * 1024, 1024, kb * 64, n0, drow, 1); }
    else { const int r = it - CV_S5, le = r >> 8, q = r & 255, kb = q >> 5, nb = q & 31;
        return cv_desc(P.in[I_WDOWN] + (size_t)le * 512 * 1024, 1024, ws + WS_WD + (size_t)le * 1024 * 512, 512, kb * 64, nb * 32, nb * 32, 1); }
}
__device__ __forceinline__ void cv_load(const CvD& d, f32x4 (&v)[8], int lane) { const int kr = lane >> 3, n4 = (lane & 7) * 4;
#pragma unroll
    for (int i = 0; i < 8; ++i) v[i] = __builtin_nontemporal_load((const f32x4*)(d.src + (size_t)(kr + 8 * i) * d.srcN + n4)); }
__device__ __forceinline__ void cv_finish(const CvD& d, const f32x4 (&v)[8], LAS float* scr, int lane) {
    { const int kr = lane >> 3, n4 = (lane & 7) * 4; const float sc = d.f8 ? 32.0f : 1.0f;
#pragma unroll
        for (int i = 0; i < 8; ++i) { LAS float* p = scr + (kr + 8 * i) * 33 + n4; p[0] = v[i][0] * sc; p[1] = v[i][1] * sc; p[2] = v[i][2] * sc; p[3] = v[i][3] * sc; } }
    LDS_WAIT(); asm volatile("" ::: "memory");
    if (d.f8) { const int c = lane & 3;
#pragma unroll
        for (int j = 0; j < 2; ++j) { const int n = (lane >> 2) + 16 * j; const LAS float* s = scr + (16 * c) * 33 + n;
            v4u o; o.x = pg8::pk_fp8x4(s[0 * 33], s[1 * 33], s[2 * 33], s[3 * 33]); o.y = pg8::pk_fp8x4(s[4 * 33], s[5 * 33], s[6 * 33], s[7 * 33]);
            o.z = pg8::pk_fp8x4(s[8 * 33], s[9 * 33], s[10 * 33], s[11 * 33]); o.w = pg8::pk_fp8x4(s[12 * 33], s[13 * 33], s[14 * 33], s[15 * 33]);
            *(GAS v4u*)(d.dst + (size_t)n * d.dstB + 16 * c) = o; } }
    else { const int c = lane & 7;
#pragma unroll
        for (int j = 0; j < 4; ++j) { const int n = (lane >> 3) + 8 * j; const LAS float* s = scr + (8 * c) * 33 + n;
            v4u o; o.x = pk2(s[0 * 33], s[1 * 33]); o.y = pk2(s[2 * 33], s[3 * 33]); o.z = pk2(s[4 * 33], s[5 * 33]); o.w = pk2(s[6 * 33], s[7 * 33]);
            *(GAS v4u*)(d.dst + (size_t)n * d.dstB + 16 * c) = o; } }
    LDS_WAIT(); asm volatile("" ::: "memory");
}
template <class MapFn> __device__ __forceinline__ void cv_stream(const Params& P, LAS float* scr, int lane, int j, int j1, int step, MapFn map) {
    if (j >= j1) return;
    CvD da = cv_decode(P, map(j)), db = da; f32x4 va[8], vb[8]; cv_load(da, va, lane);
    for (;;) {
        int jn = j + step; bool hn = jn < j1; if (hn) { db = cv_decode(P, map(jn)); cv_load(db, vb, lane); }
        cv_finish(da, va, scr, lane); if (!hn) break;
        j = jn; jn = j + step; hn = jn < j1; if (hn) { da = cv_decode(P, map(jn)); cv_load(da, va, lane); }
        cv_finish(db, vb, scr, lane); if (!hn) break;
        j = jn; }
}
__device__ __forceinline__ void p0_weights(const Frame& F, const Params& P) {
    LAS float* scr = (LAS float*)(F.lds + F.wave * 16384);
    int gw = F.vcu * NWAVES + F.wave, NGW = F.G * NWAVES;
    if (F.G == 256) { if (blockIdx.x < 192) return; gw = ((int)blockIdx.x - 192) * NWAVES + F.wave; NGW = 64 * NWAVES; }
    cv_stream(P, scr, F.lane, gw, CV_S1, NGW, [](int j) { return j; });
}
__device__ __forceinline__ void cv_moe_l0(const Frame& F, const Params& P) {
    LAS float* scr = (LAS float*)(F.lds + F.wave * 16384);
    cv_stream(P, scr, F.lane, F.vcu * NWAVES + F.wave, 3 * 4096 + (CV_S3 - CV_S1), F.G * NWAVES, [](int j) { return j < 4096 ? CV_S3 + j : (j < 8192 ? CV_S4 + (j - 4096) : (j < 12288 ? CV_S5 + (j - 8192) : CV_S1 + (j - 12288))); });
}
__device__ __forceinline__ void bg_convert(const Frame& F, const Params& P, int rank, int ns, int j0, int j1) {
    LAS float* scr = (LAS float*)(F.lds + F.wave * 16384);
    cv_stream(P, scr, F.lane, j0 + rank * NWAVES + F.wave, j1, ns * NWAVES, [](int j) { return j < 4096 ? CV_S3 + 4096 + j : (j < 8192 ? CV_S4 + 4096 + (j - 4096) : CV_S5 + 4096 + (j - 8192)); });
}
__device__ __forceinline__ void p_modulate(const Frame& F, const float* x, const float* cond_l  , int sh_off, bf16* H) {
    const int gw = F.vcu * NWAVES + F.wave, NGW = F.G * NWAVES;
    for (int ch = gw; ch < M / 16; ch += NGW) {
        const int r0 = ch * 16, b = r0 / T; const float* cb = cond_l + (size_t)b * 6144 + sh_off;
        f32x4 sh[4], sc[4];
#pragma unroll
        for (int j = 0; j < 4; ++j) { sh[j] = *(const f32x4*)(cb + 4 * F.lane + 256 * j); sc[j] = *(const f32x4*)(cb + 1024 + 4 * F.lane + 256 * j) + 1.0f; }
#pragma unroll 4
        for (int i = 0; i < 16; ++i) { const float* xr = x + (size_t)(r0 + i) * D + 4 * F.lane; bf16* hr = H + (size_t)(r0 + i) * D + 4 * F.lane;
#pragma unroll
            for (int j = 0; j < 4; j += 2) { v2u o[2];
#pragma unroll
                for (int k = 0; k < 2; ++k) { const f32x4 v = __builtin_nontemporal_load((const f32x4*)(xr + 256 * (j + k))) * sc[j + k] + sh[j + k]; o[k].x = pk2(v[0], v[1]); o[k].y = pk2(v[2], v[3]); }
                const bool odd = (F.lane & 1) != 0; const unsigned sx = odd ? o[0].x : o[1].x, sy = odd ? o[0].y : o[1].y;
                const unsigned nx = (unsigned)__builtin_amdgcn_update_dpp(0, (int)sx, 0xB1, 0xF, 0xF, true), ny = (unsigned)__builtin_amdgcn_update_dpp(0, (int)sy, 0xB1, 0xF, 0xF, true);
                const v4u w = odd ? (v4u){nx, ny, o[1].x, o[1].y} : (v4u){o[0].x, o[0].y, nx, ny};
                *(v4u*)(hr + 256 * (j + (odd ? 1 : 0)) - (odd ? 4 : 0)) = w; } }
    }
}
__device__ __forceinline__ void p_sgu_item(const Frame& F, const Params& P, int bc, const bf16* U, const bf16* V, bf16* YC) {
    const int r0 = bc * 128;
    LAS bf16* Vt = (LAS bf16*)F.lds;
    LAS bf16* Wl = (LAS bf16*)(F.lds + 34816);
    const float* lng = P.in[I_SLNG]; const float* lnb = P.in[I_SLNB];
    const int fr = F.lane & 15, fq = F.lane >> 4, w16 = F.wave * 16;
    v4u raw[16];
#pragma unroll
    for (int i = 0; i < 16; ++i) raw[i] = __builtin_nontemporal_load((const v4u*)(V + (size_t)(r0 + w16 + i) * 512 + 8 * F.lane));
    const f32x4 g0 = *(const f32x4*)(lng + 8 * F.lane), g1 = *(const f32x4*)(lng + 8 * F.lane + 4), b0 = *(const f32x4*)(lnb + 8 * F.lane), b1 = *(const f32x4*)(lnb + 8 * F.lane + 4);
#pragma unroll
    for (int i4 = 0; i4 < 16; i4 += 4) {
        float sv[4], qv[4];
#pragma unroll
        for (int k = 0; k < 4; ++k) { const v4u rw = raw[i4 + k];
            const float v[8] = {bflo(rw.x), bfhi(rw.x), bflo(rw.y), bfhi(rw.y), bflo(rw.z), bfhi(rw.z), bflo(rw.w), bfhi(rw.w)};
            sv[k] = ((v[0] + v[1]) + (v[2] + v[3])) + ((v[4] + v[5]) + (v[6] + v[7]));
            qv[k] = ((v[0] * v[0] + v[1] * v[1]) + (v[2] * v[2] + v[3] * v[3])) + ((v[4] * v[4] + v[5] * v[5]) + (v[6] * v[6] + v[7] * v[7])); }
        wave_sum4(sv[0], sv[1], sv[2], sv[3], sv[0], sv[1], sv[2], sv[3], F.lane); wave_sum4(qv[0], qv[1], qv[2], qv[3], qv[0], qv[1], qv[2], qv[3], F.lane);
#pragma unroll
        for (int k = 0; k < 4; ++k) { const v4u rw = raw[i4 + k];
            const float v[8] = {bflo(rw.x), bfhi(rw.x), bflo(rw.y), bfhi(rw.y), bflo(rw.z), bfhi(rw.z), bflo(rw.w), bfhi(rw.w)};
            const float mu = sv[k] * (1.0f / 512.0f), rs = __builtin_amdgcn_rsqf(fmaxf(qv[k] * (1.0f / 512.0f) - mu * mu, 0.f) + LN_EPS);
            v4u nw; nw.x = pk2((v[0] - mu) * rs * g0[0] + b0[0], (v[1] - mu) * rs * g0[1] + b0[1]); nw.y = pk2((v[2] - mu) * rs * g0[2] + b0[2], (v[3] - mu) * rs * g0[3] + b0[3]);
            nw.z = pk2((v[4] - mu) * rs * g1[0] + b1[0], (v[5] - mu) * rs * g1[1] + b1[1]); nw.w = pk2((v[6] - mu) * rs * g1[2] + b1[2], (v[7] - mu) * rs * g1[3] + b1[3]); raw[i4 + k] = nw; } }
    f32x4 w[8];
#pragma unroll
    for (int k = 0; k < 8; ++k) w[k] = *(const f32x4*)(P.in[I_WS] + (size_t)(F.tid + 512 * k) * 4);
    for (int g = 0; g < 4; ++g) {
        if (fq == g) { const int d0 = 8 * fr;
#define SGU_W(rw, jp) ((jp) == 0 ? (rw).x : (jp) == 1 ? (rw).y : (jp) == 2 ? (rw).z : (rw).w)
#pragma unroll
            for (int i4 = 0; i4 < 16; i4 += 4)
#pragma unroll
                for (int jp = 0; jp < 4; ++jp) { const unsigned w0 = SGU_W(raw[i4], jp), w1 = SGU_W(raw[i4 + 1], jp), w2 = SGU_W(raw[i4 + 2], jp), w3 = SGU_W(raw[i4 + 3], jp);
                    v2u lo, hi; lo.x = __builtin_amdgcn_perm(w1, w0, 0x05040100u); lo.y = __builtin_amdgcn_perm(w3, w2, 0x05040100u); hi.x = __builtin_amdgcn_perm(w1, w0, 0x07060302u); hi.y = __builtin_amdgcn_perm(w3, w2, 0x07060302u);
                    const int qs = 8 * (((w16 + i4) >> 3) ^ (fr >> 1)) + (i4 & 4);
                    *(LAS v2u*)(Vt + (d0 + 2 * jp) * 136 + qs) = lo; *(LAS v2u*)(Vt + (d0 + 2 * jp + 1) * 136 + qs) = hi; }
#undef SGU_W
        }
        {
#pragma unroll
            for (int k = 0; k < 8; ++k) { const int i = F.tid + 512 * k, p = i >> 5, q4 = (i & 31) * 4;
                v2u o; o.x = pk2(q4 + 0 <= p ? w[k][0] : 0.f, q4 + 1 <= p ? w[k][1] : 0.f); o.y = pk2(q4 + 2 <= p ? w[k][2] : 0.f, q4 + 3 <= p ? w[k][3] : 0.f);
                *(LAS v2u*)(Wl + p * 136 + q4) = o; }
            if (g < 3) { const float* wsn = P.in[I_WS] + (size_t)(g + 1) * 128 * 128;
#pragma unroll
                for (int k = 0; k < 8; ++k) w[k] = *(const f32x4*)(wsn + (size_t)(F.tid + 512 * k) * 4); } }
        const int row = r0 + w16 + fr; const float bs = P.in[I_BS][g * 128 + w16 + fr];
        v2u uu[8];
#pragma unroll
        for (int nt = 0; nt < 8; nt += 2) { const v4u ld = __builtin_nontemporal_load((const v4u*)(U + (size_t)row * 512 + 128 * g + 16 * (nt + (fq & 1)) + 4 * (fq & ~1)));
            auto rx = __builtin_amdgcn_permlane16_swap(ld.x, ld.z, false, false); auto ry = __builtin_amdgcn_permlane16_swap(ld.y, ld.w, false, false);
            uu[nt] = (v2u){rx[0], ry[0]}; uu[nt + 1] = (v2u){rx[1], ry[1]}; }
        __syncthreads();
        f32x4 acc[8];
#pragma unroll
        for (int nt = 0; nt < 8; ++nt) acc[nt] = (f32x4){0.f, 0.f, 0.f, 0.f};
#pragma unroll
        for (int ks = 0; ks < 4; ++ks) { if (32 * ks <= w16 + 15) {
            const bf16x8 wf = *(const LAS bf16x8*)(Wl + (w16 + fr) * 136 + 32 * ks + 8 * fq);
#pragma unroll
            for (int nt = 0; nt < 8; ++nt) { const bf16x8 vf = *(const LAS bf16x8*)(Vt + (16 * nt + fr) * 136 + 8 * ((4 * ks + fq) ^ nt));
                acc[nt] = __builtin_amdgcn_mfma_f32_16x16x32_bf16(vf, wf, acc[nt], 0, 0, 0); } } }
#pragma unroll
        for (int nt = 0; nt < 8; nt += 2) { v2u o[2];
#pragma unroll
            for (int k = 0; k < 2; ++k) { o[k].x = pk2(bflo(uu[nt + k].x) * (acc[nt + k][0] + bs), bfhi(uu[nt + k].x) * (acc[nt + k][1] + bs)); o[k].y = pk2(bflo(uu[nt + k].y) * (acc[nt + k][2] + bs), bfhi(uu[nt + k].y) * (acc[nt + k][3] + bs)); }
            auto rx = __builtin_amdgcn_permlane16_swap(o[0].x, o[1].x, false, false); auto ry = __builtin_amdgcn_permlane16_swap(o[0].y, o[1].y, false, false);
            *(v4u*)(YC + (size_t)row * D + 128 * g + 16 * (nt + (fq & 1)) + 4 * (fq & ~1)) = (v4u){rx[0], ry[0], rx[1], ry[1]}; }
        __syncthreads();
    }
}
__device__ __forceinline__ void conv_load(const Frame& F, int ci, const bf16* Gb, v4u (&v)[8]) {
    const int R0 = ci * 32, b = R0 / T, t0 = R0 % T;
#pragma unroll
    for (int k = 0; k < 8; ++k) { const int i = F.tid + 512 * k, r = i >> 6, cc = i & 63, t = t0 - 30 + r; const int tc = t < 0 ? 0 : (r > 61 ? t0 : t);
        v[k] = *(const v4u*)(Gb + (size_t)(b * T + tc) * 512 + cc * 8); if (t < 0) v[k] = (v4u){0u, 0u, 0u, 0u}; }
}
struct ConvConst { f32x2 w2[31]; f32x2 bd; f32x4 g0, g1, b0, b1; };
__device__ __forceinline__ void conv_const(const Frame& F, const Params& P, ConvConst& C) { const int cp = F.tid & 255; const float* wdw = P.in[I_WDW];
#pragma unroll
    for (int k = 0; k < 31; ++k) C.w2[k] = *(const f32x2*)(wdw + k * 512 + 2 * cp);
    C.bd = *(const f32x2*)(P.in[I_BDW] + 2 * cp); const float* lng = P.in[I_CLNG]; const float* lnb = P.in[I_CLNB];
    C.g0 = *(const f32x4*)(lng + 8 * F.lane); C.g1 = *(const f32x4*)(lng + 8 * F.lane + 4); C.b0 = *(const f32x4*)(lnb + 8 * F.lane); C.b1 = *(const f32x4*)(lnb + 8 * F.lane + 4); }
__device__ __forceinline__ void p_conv_item(const Frame& F, const Params& P, int ci, int ci_next, const bf16* Gb, bf16* YC, v4u (&v)[8], const ConvConst& C) {
    const int R0 = ci * 32;
    LAS bf16* Gin = (LAS bf16*)F.lds;
    LAS float* Yc = (LAS float*)(F.lds + 63488);
#pragma unroll
    for (int k = 0; k < 8; ++k) { const int i = F.tid + 512 * k, r = i >> 6, cc = i & 63; if (i < 62 * 64) *(LAS v4u*)(Gin + r * 512 + cc * 8) = v[k]; }
    if (ci_next >= 0) conv_load(F, ci_next, Gb, v);
    __syncthreads();
    { const int cp = F.tid & 255, th = F.tid >> 8;
        const f32x2 bd = C.bd;
#pragma unroll 1
        for (int blk = 0; blk < 2; ++blk) { const int o0 = 16 * th + 8 * blk; f32x2 a2[8];
#pragma unroll
            for (int o = 0; o < 8; ++o) a2[o] = bd;
#pragma unroll
            for (int i = 0; i < 38; ++i) { const unsigned pr = *(const LAS unsigned*)(Gin + (o0 + i) * 512 + 2 * cp); const f32x2 vv = (f32x2){bflo(pr), bfhi(pr)};
#pragma unroll
                for (int o = 0; o < 8; ++o) { const int k = i - o; if (k >= 0 && k < 31) a2[o] = __builtin_elementwise_fma(C.w2[k], vv, a2[o]); } }
#pragma unroll
            for (int o = 0; o < 8; ++o) *(LAS f32x2*)(Yc + (o0 + o) * 512 + 2 * cp) = a2[o]; }
    }
    __syncthreads();
    { const f32x4 g0 = C.g0, g1 = C.g1, b0 = C.b0, b1 = C.b1;
        f32x4 y[4][2]; float s[4], q[4];
#pragma unroll
        for (int i = 0; i < 4; ++i) { const int r = F.wave * 4 + i; y[i][0] = *(const LAS f32x4*)(Yc + r * 512 + 8 * F.lane); y[i][1] = *(const LAS f32x4*)(Yc + r * 512 + 8 * F.lane + 4); }
#pragma unroll
        for (int i = 0; i < 4; ++i) { const f32x4 a = y[i][0], b = y[i][1]; s[i] = ((a[0] + a[1]) + (a[2] + a[3])) + ((b[0] + b[1]) + (b[2] + b[3]));
            q[i] = ((a[0] * a[0] + a[1] * a[1]) + (a[2] * a[2] + a[3] * a[3])) + ((b[0] * b[0] + b[1] * b[1]) + (b[2] * b[2] + b[3] * b[3])); }
        wave_sum4(s[0], s[1], s[2], s[3], s[0], s[1], s[2], s[3], F.lane); wave_sum4(q[0], q[1], q[2], q[3], q[0], q[1], q[2], q[3], F.lane);
#pragma unroll
        for (int i = 0; i < 4; ++i) { const int r = F.wave * 4 + i; const float mean = s[i] * (1.0f / 512.0f), rstd = 1.0f / sqrtf(fmaxf(q[i] * (1.0f / 512.0f) - mean * mean, 0.f) + LN_EPS);
            float v8[8] = {y[i][0][0], y[i][0][1], y[i][0][2], y[i][0][3], y[i][1][0], y[i][1][1], y[i][1][2], y[i][1][3]};
#pragma unroll
            for (int j = 0; j < 8; ++j) { const float z = (v8[j] - mean) * rstd * (j < 4 ? g0[j & 3] : g1[j & 3]) + (j < 4 ? b0[j & 3] : b1[j & 3]); v8[j] = z * __builtin_amdgcn_rcpf(1.0f + __expf(-z)); }
            v4u o; o.x = pk2(v8[0], v8[1]); o.y = pk2(v8[2], v8[3]); o.z = pk2(v8[4], v8[5]); o.w = pk2(v8[6], v8[7]);
            *(v4u*)(YC + (size_t)(R0 + r) * D + 512 + 8 * F.lane) = o; }
    }
    __syncthreads();
}
#define COL8(q) (512 * ((q) >> 1) + 8 * F.lane + 4 * ((q) & 1))
struct RowVec { f32x4 v[4]; };
__device__ __forceinline__ f32x4 up4(v2u w) { return (f32x4){bflo(w.x), bfhi(w.x), bflo(w.y), bfhi(w.y)}; }
__device__ __forceinline__ f32x4 up4f8(unsigned w) { const f32x2 lo = __builtin_amdgcn_cvt_pk_f32_fp8((int)w, false), hi = __builtin_amdgcn_cvt_pk_f32_fp8((int)w, true); return (f32x4){lo[0], lo[1], hi[0], hi[1]}; }
__device__ __forceinline__ void ln_stats(RowVec& t, float& rstd) {
    float s = 0.f;
#pragma unroll
    for (int j = 0; j < 4; ++j) s += (t.v[j][0] + t.v[j][1]) + (t.v[j][2] + t.v[j][3]);
    const float mean = wave_sum(s) * (1.0f / D); float s2 = 0.f;
#pragma unroll
    for (int j = 0; j < 4; ++j) { t.v[j] = t.v[j] - mean; s2 += (t.v[j][0] * t.v[j][0] + t.v[j][1] * t.v[j][1]) + (t.v[j][2] * t.v[j][2] + t.v[j][3] * t.v[j][3]); }
    rstd = 1.0f / sqrtf(wave_sum(s2) * (1.0f / D) + LN_EPS);
}
struct ModVecs { f32x4 A[4], B[4], G[4], C[4], Dv[4]; };
__device__ __forceinline__ void mod_vecs(const Frame& F, ModVecs& mv, const float* cin, int sh_in, int g_off, const float* lng, const float* lnb, const float* cout, int sh_out) {
#pragma unroll
    for (int q = 0; q < 4; ++q) { const int col = COL8(q);
        const f32x4 sh = *(const f32x4*)(cin + sh_in + col), sc1 = *(const f32x4*)(cin + sh_in + 1024 + col) + 1.0f;
        f32x4 a; a[0] = DN_ALPHA / sc1[0]; a[1] = DN_ALPHA / sc1[1]; a[2] = DN_ALPHA / sc1[2]; a[3] = DN_ALPHA / sc1[3];
        mv.A[q] = a; mv.B[q] = -sh * a; mv.G[q] = *(const f32x4*)(cin + g_off + col) + 1.0f;
        const f32x4 g = *(const f32x4*)(lng + col), b = *(const f32x4*)(lnb + col);
        if (cout) { const f32x4 so = *(const f32x4*)(cout + sh_out + 1024 + col) + 1.0f; mv.C[q] = g * so; mv.Dv[q] = b * so + *(const f32x4*)(cout + sh_out + col); }
        else { mv.C[q] = g; mv.Dv[q] = b; } }
}
__device__ __forceinline__ int slot8(int c) { return (((c >> 9) << 1) | ((c >> 2) & 1)) * 256 + ((c & 511) >> 3) * 4 + (c & 3); }
__device__ __forceinline__ void moe_table(const Frame& F, unsigned* gcnt, LAS int* tl) {
    if (F.tid < 16) tl[F.tid] = (int)((__hip_atomic_load((unsigned long long*)(gcnt + 64 * (F.tid >> 2)), __ATOMIC_RELAXED, __HIP_MEMORY_SCOPE_AGENT) >> (16 * (F.tid & 3))) & 0xffffu);
    __syncthreads();
    if (F.tid == 0) { int s = 0; for (int e = 0; e < 16; ++e) { tl[16 + e] = s; s += (tl[e] + 255) & ~255; } tl[32] = s; }
    __syncthreads();
    if (F.tid < MAXT) { const int r = F.tid * 256; int e = 15; for (int k = 15; k >= 0; --k) if (r < tl[16 + k + 1]) e = k; tl[64 + F.tid] = e; }
    __syncthreads();
}
__device__ __forceinline__ void p9_fill_start(unsigned* gcnt, LAS int* dst, int t) {
    if ((unsigned)t < 64u) { const int e = t & 15;
        const int tot = (int)((__hip_atomic_load((unsigned long long*)(gcnt + 64 * (e >> 2)), __ATOMIC_RELAXED, __HIP_MEMORY_SCOPE_AGENT) >> (16 * (e & 3))) & 0xffffu), pad = (tot + 255) & ~255;
        int s = pad;
#pragma unroll
        for (int d = 1; d < 16; d <<= 1) { const int v = __shfl_up(s, d, 16); if (e >= d) s += v; }
        if (t < 16) dst[e] = s - pad; }
}
__device__ __forceinline__ void p5_fill_w(const Frame& F, const Params& P, int layer, int t, int nthr) {
    LAS float* Wr = (LAS float*)F.lds;
    const float* wg = P.in[I_WGRP] + (size_t)layer * D * 4; const float* we = P.in[I_WER] + (size_t)layer * 4 * D * 4;
    for (int d = t; d < D; d += nthr) { const f32x4 a = *(const f32x4*)(wg + d * 4); const int s = slot8(d);
#pragma unroll
        for (int o = 0; o < 4; ++o) Wr[o * D + s] = a[o];
#pragma unroll
        for (int g = 0; g < 4; ++g) { const f32x4 e = *(const f32x4*)(we + ((size_t)g * D + d) * 4);
#pragma unroll
            for (int o = 0; o < 4; ++o) Wr[(4 + 4 * g + o) * D + s] = e[o]; } }
    LAS float* bg = (LAS float*)(F.lds + 81920 + 64); LAS float* be = bg + 4;
    if (t < 4) bg[t] = P.in[I_BGRP][layer * 4 + t]; if (t >= 64 && t < 80) be[t - 64] = P.in[I_BER][layer * 16 + t - 64];
}
__device__ __forceinline__ void p5_fill_mv(const Frame& F, const Params& P, int layer, int it, int t) {
    LAS int* cntl = (LAS int*)(F.lds + 81920); LAS float* MV = (LAS float*)(F.lds + 82944);
    const float* cond_l = (const float*)(P.ws + WS_COND) + (size_t)layer * 16 * 6144; const float* lng = P.in[I_LNMG] + layer * D; const float* lnb = P.in[I_LNMB] + layer * D;
    const int b = (it * 128) / T; const float* cb = cond_l + (size_t)b * 6144;
        if (t < 16) cntl[t] = 0;
        if (t < 256) { const int col = 4 * t, s = slot8(col); const f32x4 sh = *(const f32x4*)(cb + col), sc1 = *(const f32x4*)(cb + 1024 + col) + 1.0f;
            f32x4 a; a[0] = DN_ALPHA / sc1[0]; a[1] = DN_ALPHA / sc1[1]; a[2] = DN_ALPHA / sc1[2]; a[3] = DN_ALPHA / sc1[3];
            const f32x4 g = *(const f32x4*)(lng + col), bb = *(const f32x4*)(lnb + col), so = *(const f32x4*)(cb + 4096 + col) + 1.0f;
            *(LAS f32x4*)(MV + s) = a; *(LAS f32x4*)(MV + 1024 + s) = -sh * a; *(LAS f32x4*)(MV + 2048 + s) = *(const f32x4*)(cb + 2048 + col) + 1.0f;
            *(LAS f32x4*)(MV + 3072 + s) = g * so; *(LAS f32x4*)(MV + 4096 + s) = bb * so + *(const f32x4*)(cb + 3072 + col); }
}
struct RowRaw { v4u h[2]; v4u y[2]; };
template <bool Y8> __device__ __forceinline__ void p_ln_route(const Frame& F, const Params& P, int layer, const void* Yv, bf16* H, bf16* Hout, unsigned char* H8, bool pre) {
    const bf16* Y = (const bf16*)Yv; const unsigned char* Yb = (const unsigned char*)Yv;
    unsigned char* ws = P.ws;
    LAS float* Wr = (LAS float*)F.lds;
    LAS int* cntl = (LAS int*)(F.lds + 81920);
    LAS float* MV = (LAS float*)(F.lds + 82944);
    if (!pre) p5_fill_w(F, P, layer, F.tid, 512);
    LAS float* bg = (LAS float*)(F.lds + 81920 + 64); LAS float* be = bg + 4;
    const float* cond_l = (const float*)(ws + WS_COND) + (size_t)layer * 16 * 6144;
    const float* lng = P.in[I_LNMG] + layer * D; const float* lnb = P.in[I_LNMB] + layer * D;
    int* route_e = (int*)(ws + WS_ROUTE_E); f32x2* route_w = (f32x2*)(ws + WS_ROUTE_W);
    LAS int* ael = (LAS int*)(F.lds + 103424)  ; LAS int* basel = ael + 256  ; LAS int* totl = basel + 16  ; LAS int* startl = totl + 16  ; LAS int* lastf = startl + 32;
    unsigned* gcnt = (unsigned*)(ws + WS_CTL) + CW_MOE + layer * 2048;
    int* pos = (int*)(ws + WS_POS); int* inv = (int*)(ws + WS_INV); int* tab = (int*)(ws + WS_TILE);
    for (int it = F.vcu; it < 256; it += F.G) {
        const int rbase = it * 128 + F.wave * 16, b = rbase / T; const float* cb = cond_l + (size_t)b * 6144;
        RowRaw rb[4];
#define LD_ROW(dst, r) do { _Pragma("unroll") for (int j = 0; j < 2; ++j) { (dst).h[j] = __builtin_nontemporal_load((const v4u*)(H + (size_t)(r) * D + 8 * F.lane + 512 * j)); if constexpr (Y8) { const v2u y8_ = __builtin_nontemporal_load((const v2u*)(Yb + (size_t)(r) * D + 8 * F.lane + 512 * j)); (dst).y[j] = (v4u){y8_.x, y8_.y, 0u, 0u}; } else (dst).y[j] = __builtin_nontemporal_load((const v4u*)(Y + (size_t)(r) * D + 8 * F.lane + 512 * j)); } } while (0)
        if (!(pre && it == F.vcu)) p5_fill_mv(F, P, layer, it, F.tid);
        __syncthreads();
#define P5_PAIR(bA, bB, ii, REA_, WA0_, WA1_, REB_, WB0_, WB1_) do { const int r = rbase + (ii); RowVec tA, tB; float rsA, rsB; \
            _Pragma("unroll") for (int q = 0; q < 4; ++q) { const int s = 256 * q + 4 * F.lane; const f32x4 mA = *(const LAS f32x4*)(MV + s), mB = *(const LAS f32x4*)(MV + 1024 + s), mG = *(const LAS f32x4*)(MV + 2048 + s); \
                { const v4u hw = (bA).h[q >> 1], yw = (bA).y[q >> 1]; const v2u h2 = (q & 1) ? (v2u){hw.z, hw.w} : (v2u){hw.x, hw.y}, y2 = (q & 1) ? (v2u){yw.z, yw.w} : (v2u){yw.x, yw.y}; f32x4 yv; if constexpr (Y8) yv = up4f8((q & 1) ? yw.y : yw.x) * 0.015625f; else yv = up4(y2); tA.v[q] = up4(h2) * mA + mB + mG * yv; } \
                { const v4u hw = (bB).h[q >> 1], yw = (bB).y[q >> 1]; const v2u h2 = (q & 1) ? (v2u){hw.z, hw.w} : (v2u){hw.x, hw.y}, y2 = (q & 1) ? (v2u){yw.z, yw.w} : (v2u){yw.x, yw.y}; f32x4 yv; if constexpr (Y8) yv = up4f8((q & 1) ? yw.y : yw.x) * 0.015625f; else yv = up4(y2); tB.v[q] = up4(h2) * mA + mB + mG * yv; } } \
            float sA_ = 0.f, qA_ = 0.f, sB_ = 0.f, qB_ = 0.f; \
            _Pragma("unroll") for (int q = 0; q < 4; ++q) { const f32x4 xa = tA.v[q], xb = tB.v[q]; sA_ += (xa[0] + xa[1]) + (xa[2] + xa[3]); qA_ += (xa[0] * xa[0] + xa[1] * xa[1]) + (xa[2] * xa[2] + xa[3] * xa[3]); \
                sB_ += (xb[0] + xb[1]) + (xb[2] + xb[3]); qB_ += (xb[0] * xb[0] + xb[1] * xb[1]) + (xb[2] * xb[2] + xb[3] * xb[3]); } \
            float tsA, tqA, tsB, tqB; wave_sum4(sA_, qA_, sB_, qB_, tsA, tqA, tsB, tqB, F.lane);     \
            const float mnA = tsA * (1.0f / D), mnB = tsB * (1.0f / D); rsA = __builtin_amdgcn_rsqf(fmaxf(tqA * (1.0f / D) - mnA * mnA, 0.f) + LN_EPS); rsB = __builtin_amdgcn_rsqf(fmaxf(tqB * (1.0f / D) - mnB * mnB, 0.f) + LN_EPS); \
            f32x4 aA[4] = {}, aB[4] = {}; unsigned owA[8], o8A[4], owB[8], o8B[4];     \
            _Pragma("unroll") for (int q = 0; q < 4; ++q) { const int s = 256 * q + 4 * F.lane; const f32x4 mC = *(const LAS f32x4*)(MV + 3072 + s), mD = *(const LAS f32x4*)(MV + 4096 + s); \
                const f32x4 hA = (tA.v[q] - mnA) * rsA * mC + mD, hB = (tB.v[q] - mnB) * rsB * mC + mD; tA.v[q] = hA; tB.v[q] = hB; \
                owA[2 * q] = pk2(hA[0], hA[1]); owA[2 * q + 1] = pk2(hA[2], hA[3]); o8A[q] = pg8::pk_fp8x4(hA[0], hA[1], hA[2], hA[3]); \
                owB[2 * q] = pk2(hB[0], hB[1]); owB[2 * q + 1] = pk2(hB[2], hB[3]); o8B[q] = pg8::pk_fp8x4(hB[0], hB[1], hB[2], hB[3]); \
                _Pragma("unroll") for (int o = 0; o < 4; ++o) { const f32x4 w = *(const LAS f32x4*)(Wr + o * D + s); \
                    aA[o] = __builtin_elementwise_fma(hA, w, aA[o]); aB[o] = __builtin_elementwise_fma(hB, w, aB[o]); } } \
            *(v4u*)(Hout + (size_t)r * D + 8 * F.lane) = (v4u){owA[0], owA[1], owA[2], owA[3]}; *(v4u*)(Hout + (size_t)r * D + 8 * F.lane + 512) = (v4u){owA[4], owA[5], owA[6], owA[7]}; \
            *(v4u*)(Hout + (size_t)(r + 1) * D + 8 * F.lane) = (v4u){owB[0], owB[1], owB[2], owB[3]}; *(v4u*)(Hout + (size_t)(r + 1) * D + 8 * F.lane + 512) = (v4u){owB[4], owB[5], owB[6], owB[7]}; \
            *(v2u*)(H8 + (size_t)r * D + 8 * F.lane) = (v2u){o8A[0], o8A[1]}; *(v2u*)(H8 + (size_t)r * D + 8 * F.lane + 512) = (v2u){o8A[2], o8A[3]}; \
            *(v2u*)(H8 + (size_t)(r + 1) * D + 8 * F.lane) = (v2u){o8B[0], o8B[1]}; *(v2u*)(H8 + (size_t)(r + 1) * D + 8 * F.lane + 512) = (v2u){o8B[2], o8B[3]}; \
            __builtin_amdgcn_sched_barrier(0); \
            float lA[4], lB[4]; _Pragma("unroll") for (int o = 0; o < 4; ++o) { lA[o] = (aA[o][0] + aA[o][1]) + (aA[o][2] + aA[o][3]); lB[o] = (aB[o][0] + aB[o][1]) + (aB[o][2] + aB[o][3]); } \
            wave_sum4(lA[0], lA[1], lA[2], lA[3], lA[0], lA[1], lA[2], lA[3], F.lane); wave_sum4(lB[0], lB[1], lB[2], lB[3], lB[0], lB[1], lB[2], lB[3], F.lane); \
            _Pragma("unroll") for (int o = 0; o < 4; ++o) { lA[o] += bg[o]; lB[o] += bg[o]; } \
            int gA = 0, gB = 0; float mxA = lA[0], mxB = lB[0]; \
            _Pragma("unroll") for (int j = 1; j < 4; ++j) { const bool ca = lA[j] > mxA, cb = lB[j] > mxB; mxA = ca ? lA[j] : mxA; gA = ca ? j : gA; mxB = cb ? lB[j] : mxB; gB = cb ? j : gB; }     \
            gA = __builtin_amdgcn_readfirstlane(gA); gB = __builtin_amdgcn_readfirstlane(gB); \
            float dA = 0.f, dB = 0.f; \
            _Pragma("unroll") for (int j = 0; j < 4; ++j) { dA += __expf(lA[j] - mxA); dB += __expf(lB[j] - mxB); } \
            const float gwA = __builtin_amdgcn_rcpf(dA), gwB = __builtin_amdgcn_rcpf(dB); \
            f32x4 cA[4] = {}, cB[4] = {}; const LAS float* WeA = Wr + (4 + 4 * gA) * D; const LAS float* WeB = Wr + (4 + 4 * gB) * D; \
            _Pragma("unroll") for (int q = 0; q < 4; ++q) { const int s = 256 * q + 4 * F.lane; const f32x4 hA = tA.v[q], hB = tB.v[q]; \
                _Pragma("unroll") for (int o = 0; o < 4; ++o) { const f32x4 wA = *(const LAS f32x4*)(WeA + o * D + s), wB = *(const LAS f32x4*)(WeB + o * D + s); \
                    cA[o] = __builtin_elementwise_fma(hA, wA, cA[o]); cB[o] = __builtin_elementwise_fma(hB, wB, cB[o]); } } \
            __builtin_amdgcn_sched_barrier(0); \
            float eA[4], eB[4]; _Pragma("unroll") for (int o = 0; o < 4; ++o) { eA[o] = (cA[o][0] + cA[o][1]) + (cA[o][2] + cA[o][3]); eB[o] = (cB[o][0] + cB[o][1]) + (cB[o][2] + cB[o][3]); } \
            wave_sum4(eA[0], eA[1], eA[2], eA[3], eA[0], eA[1], eA[2], eA[3], F.lane); wave_sum4(eB[0], eB[1], eB[2], eB[3], eB[0], eB[1], eB[2], eB[3], F.lane); \
            _Pragma("unroll") for (int o = 0; o < 4; ++o) { eA[o] += be[gA * 4 + o]; eB[o] += be[gB * 4 + o]; } \
            { int i0 = 0; float m0 = eA[0]; _Pragma("unroll") for (int e2 = 1; e2 < 4; ++e2) { const bool c = eA[e2] > m0; m0 = c ? eA[e2] : m0; i0 = c ? e2 : i0; } \
              int i1 = 0; float m1 = -__builtin_inff(); _Pragma("unroll") for (int e2 = 0; e2 < 4; ++e2) { const bool c = (e2 != i0) & (eA[e2] > m1); m1 = c ? eA[e2] : m1; i1 = c ? e2 : i1; } \
              WA0_ = gwA * __builtin_amdgcn_rcpf(1.0f + __expf(m1 - m0)); WA1_ = gwA - WA0_; REA_ = (gA * 4 + i0) | ((gA * 4 + i1) << 8); } \
            { int i0 = 0; float m0 = eB[0]; _Pragma("unroll") for (int e2 = 1; e2 < 4; ++e2) { const bool c = eB[e2] > m0; m0 = c ? eB[e2] : m0; i0 = c ? e2 : i0; } \
              int i1 = 0; float m1 = -__builtin_inff(); _Pragma("unroll") for (int e2 = 0; e2 < 4; ++e2) { const bool c = (e2 != i0) & (eB[e2] > m1); m1 = c ? eB[e2] : m1; i1 = c ? e2 : i1; } \
              WB0_ = gwB * __builtin_amdgcn_rcpf(1.0f + __expf(m1 - m0)); WB1_ = gwB - WB0_; REB_ = (gB * 4 + i0) | ((gB * 4 + i1) << 8); } } while (0)
        LD_ROW(rb[0], rbase); LD_ROW(rb[1], rbase + 1);
        for (int i = 0; i < 16; i += 4) { asm volatile("" ::: "memory"); LD_ROW(rb[2], rbase + i + 2); LD_ROW(rb[3], rbase + i + 3);
            int re0, re1, re2, re3; float wa0, wa1, wa2, wa3, wb0, wb1, wb2, wb3;
            __builtin_amdgcn_sched_barrier(0); P5_PAIR(rb[0], rb[1], i, re0, wa0, wb0, re1, wa1, wb1); __builtin_amdgcn_sched_barrier(0);
            if (i + 4 < 16) { LD_ROW(rb[0], rbase + i + 4); LD_ROW(rb[1], rbase + i + 5); }
            __builtin_amdgcn_sched_barrier(0); P5_PAIR(rb[2], rb[3], i + 2, re2, wa2, wb2, re3, wa3, wb3);
            if (F.lane == 0) { const int r = rbase + i; *(v4u*)(route_e + r) = (v4u){(unsigned)re0, (unsigned)re1, (unsigned)re2, (unsigned)re3};
                { LAS int* ap = ael + 2 * (F.wave * 16 + i); ap[0] = re0 & 0xff; ap[1] = re0 >> 8; ap[2] = re1 & 0xff; ap[3] = re1 >> 8; ap[4] = re2 & 0xff; ap[5] = re2 >> 8; ap[6] = re3 & 0xff; ap[7] = re3 >> 8; }
                *(f32x4*)(route_w + r) = (f32x4){wa0, wb0, wa1, wb1}; *(f32x4*)(route_w + r + 2) = (f32x4){wa2, wb2, wa3, wb3};
                __hip_atomic_fetch_add(&cntl[re0 & 0xff], 1, __ATOMIC_RELAXED, __HIP_MEMORY_SCOPE_WORKGROUP); __hip_atomic_fetch_add(&cntl[re0 >> 8], 1, __ATOMIC_RELAXED, __HIP_MEMORY_SCOPE_WORKGROUP);
                __hip_atomic_fetch_add(&cntl[re1 & 0xff], 1, __ATOMIC_RELAXED, __HIP_MEMORY_SCOPE_WORKGROUP); __hip_atomic_fetch_add(&cntl[re1 >> 8], 1, __ATOMIC_RELAXED, __HIP_MEMORY_SCOPE_WORKGROUP);
                __hip_atomic_fetch_add(&cntl[re2 & 0xff], 1, __ATOMIC_RELAXED, __HIP_MEMORY_SCOPE_WORKGROUP); __hip_atomic_fetch_add(&cntl[re2 >> 8], 1, __ATOMIC_RELAXED, __HIP_MEMORY_SCOPE_WORKGROUP);
                __hip_atomic_fetch_add(&cntl[re3 & 0xff], 1, __ATOMIC_RELAXED, __HIP_MEMORY_SCOPE_WORKGROUP); __hip_atomic_fetch_add(&cntl[re3 >> 8], 1, __ATOMIC_RELAXED, __HIP_MEMORY_SCOPE_WORKGROUP); } }
#undef P5_PAIR
#undef LD_ROW
        __syncthreads();
        if (F.tid < 4) { const unsigned long long c = (unsigned long long)(unsigned)cntl[4 * F.tid] | ((unsigned long long)(unsigned)cntl[4 * F.tid + 1] << 16) | ((unsigned long long)(unsigned)cntl[4 * F.tid + 2] << 32) | ((unsigned long long)(unsigned)cntl[4 * F.tid + 3] << 48);
            const unsigned long long o = __hip_atomic_fetch_add((unsigned long long*)(gcnt + 64 * F.tid), c, __ATOMIC_RELAXED, __HIP_MEMORY_SCOPE_AGENT);
            basel[4 * F.tid] = (int)(o & 0xffffu); basel[4 * F.tid + 1] = (int)((o >> 16) & 0xffffu); basel[4 * F.tid + 2] = (int)((o >> 32) & 0xffffu); basel[4 * F.tid + 3] = (int)(o >> 48); }
        __syncthreads();
        { LAS int* wc = lastf + 16;
          int me = 0, rin = 0;
          if (F.tid < 256) { me = ael[F.tid]; int wcount = 0;
#pragma unroll 1
              for (int e = 0; e < 16; ++e) { const unsigned long long m = __ballot(me == e); const int below = (int)__builtin_amdgcn_mbcnt_hi((unsigned)(m >> 32), __builtin_amdgcn_mbcnt_lo((unsigned)m, 0u));
                  if (me == e) rin = below; if (F.lane == e) wcount = __popcll(m); }
              if (F.lane < 16) wc[F.wave * 16 + F.lane] = wcount; }
          __syncthreads();
          if (F.tid < 256) { int rank = rin; for (int w = 0; w < 3; ++w) if (w < F.wave) rank += wc[w * 16 + me];
              const int off = basel[me] + rank, token = it * 128 + (F.tid >> 1); pos[token * 2 + (F.tid & 1)] = off; inv[me * INV_CAP + off] = token; } }
        __syncthreads();
    }
}
__device__ __forceinline__ void p_positions(const Frame& F, const Params& P) {
    unsigned char* ws = P.ws;
    LAS int* part = (LAS int*)F.lds;
    LAS int* tot = part + 512; LAS int* pre = tot + 16; LAS int* start = pre + 16  ; LAS int* ae = start + 32  ; LAS int* inpart = ae + 256  ;
    const int* cnt = (const int*)(ws + WS_CNT); const int* route_e = (const int*)(ws + WS_ROUTE_E); int* pos = (int*)(ws + WS_POS); int* tile_e = (int*)(ws + WS_TILE); int* inv = (int*)(ws + WS_INV);
    for (int it = F.vcu; it < 256; it += F.G) {
        { const int e = F.tid & 15, pt = F.tid >> 4; int s = 0, pp = 0;
#pragma unroll
            for (int c = 0; c < 8; ++c) { const int v = cnt[(pt * 8 + c) * 16 + e]; s += v; if (pt * 8 + c < it) pp += v; }
            part[pt * 16 + e] = s; if (pt == (it >> 3)) inpart[e] = pp; }
        __syncthreads();
        if (F.tid < 16) { const int e = F.tid; int s = 0, p = 0;
            for (int q = 0; q < 32; ++q) { const int v = part[q * 16 + e]; s += v; if (q < (it >> 3)) p += v; }
            tot[e] = s; pre[e] = p + inpart[e]; }
        __syncthreads();
        if (F.tid == 0) { int s = 0; for (int e = 0; e < 16; ++e) { start[e] = s; s += (tot[e] + 255) & ~255; } start[16] = s; }
        if (F.tid < 256) { const int token = it * 128 + (F.tid >> 1); ae[F.tid] = (route_e[token] >> (8 * (F.tid & 1))) & 0xff; }
        __syncthreads();
        if (F.tid < 256) { const int me = ae[F.tid]; int rank = 0; for (int a = 0; a < F.tid; ++a) rank += (ae[a] == me) ? 1 : 0;
            const int p = start[me] + pre[me] + rank, token = it * 128 + (F.tid >> 1); pos[token * 2 + (F.tid & 1)] = p; inv[p] = token; }
        if (it < 16) { const int e = it; for (int p = start[e] + tot[e] + F.tid; p < start[e + 1]; p += 512) inv[p] = 0; }
        if (it == 0) { if (F.tid < MAXT) { const int r = F.tid * 256; int e = 15; for (int k = 15; k >= 0; --k) if (r < start[k + 1]) e = k; tile_e[F.tid] = e; } if (F.tid == 0) tile_e[511] = start[16] >> 8; }
        __syncthreads();
    }
}
struct Raw3 { v4u h[2]; v2u ya[2], yb[2]; f32x2 rw; };
template <bool FINAL> __device__ __forceinline__ void p9_fill_mv(const Frame& F, const Params& P, int layer, int it, int t) {
    unsigned char* ws = P.ws; LAS float* MV = (LAS float*)F.lds;
    const float* lng = P.in[I_LNFG] + layer * D; const float* lnb = P.in[I_LNFB] + layer * D;
    const int b = (it * 128) / T; const float* cb = (const float*)(ws + WS_COND) + ((size_t)layer * 16 + b) * 6144; const float* cbn = FINAL ? nullptr : (const float*)(ws + WS_COND) + ((size_t)(layer + 1) * 16 + b) * 6144;
        if (t < 256) { const int col = 4 * t, s = slot8(col); const f32x4 sh = *(const f32x4*)(cb + 3072 + col), sc1 = *(const f32x4*)(cb + 4096 + col) + 1.0f;
            f32x4 a; a[0] = DN_ALPHA / sc1[0]; a[1] = DN_ALPHA / sc1[1]; a[2] = DN_ALPHA / sc1[2]; a[3] = DN_ALPHA / sc1[3];
            const f32x4 g = *(const f32x4*)(lng + col), bb = *(const f32x4*)(lnb + col);
            *(LAS f32x4*)(MV + s) = a; *(LAS f32x4*)(MV + 1024 + s) = -sh * a; *(LAS f32x4*)(MV + 2048 + s) = *(const f32x4*)(cb + 5120 + col) + 1.0f;
            if (cbn) { const f32x4 so = *(const f32x4*)(cbn + 1024 + col) + 1.0f; *(LAS f32x4*)(MV + 3072 + s) = g * so; *(LAS f32x4*)(MV + 4096 + s) = bb * so + *(const f32x4*)(cbn + col); }
            else { *(LAS f32x4*)(MV + 3072 + s) = g; *(LAS f32x4*)(MV + 4096 + s) = bb; } }
}
template <bool FINAL> __device__ __forceinline__ void p_combine_ln(const Frame& F, const Params& P, int layer, const unsigned char* Ys, bf16* H, bf16* Hout, unsigned char* H8, float* out  , bool pre) {
    unsigned char* ws = P.ws;
    LAS float* MV = (LAS float*)F.lds;
    const float* lng = P.in[I_LNFG] + layer * D; const float* lnb = P.in[I_LNFB] + layer * D;
    const int* pos = (const int*)(ws + WS_POS); const f32x2* route_w = (const f32x2*)(ws + WS_ROUTE_W);
    for (int it = F.vcu; it < 256; it += F.G) {
        const int r0 = it * 128 + F.wave * 16, b = r0 / T; const float* cb = (const float*)(ws + WS_COND) + ((size_t)layer * 16 + b) * 6144; const float* cbn = FINAL ? nullptr : (const float*)(ws + WS_COND) + ((size_t)(layer + 1) * 16 + b) * 6144;
        const int pv = pos[2 * r0 + (F.lane & 31)] + ((const LAS int*)(F.lds + 20480))[(((const int*)(ws + WS_ROUTE_E))[r0 + ((F.lane & 31) >> 1)] >> (8 * (F.lane & 1))) & 0xff];
        const f32x2 rwv = route_w[r0 + (F.lane & 15)];
#define ROWP(i_, p0_, p1_, rw_) const int p0_ = __shfl(pv, 2 * (i_)), p1_ = __shfl(pv, 2 * (i_) + 1); const f32x2 rw_ = (f32x2){__shfl(rwv[0], (i_)) * 0.0625f, __shfl(rwv[1], (i_)) * 0.0625f}
#define LD_ROW3(dst, r, p0_, p1_, rw_) do { (dst).rw = (rw_); _Pragma("unroll") for (int j = 0; j < 2; ++j) { const int col = 8 * F.lane + 512 * j; \
            (dst).h[j] = __builtin_nontemporal_load((const v4u*)(H + (size_t)(r) * D + col)); (dst).ya[j] = __builtin_nontemporal_load((const v2u*)(Ys + (size_t)(p0_) * D + col)); (dst).yb[j] = __builtin_nontemporal_load((const v2u*)(Ys + (size_t)(p1_) * D + col)); } } while (0)
        Raw3 rb[4];
        if (!(pre && it == F.vcu)) p9_fill_mv<FINAL>(F, P, layer, it, F.tid);
        if (!pre && it == F.vcu) p9_fill_start((unsigned*)(ws + WS_CTL) + CW_MOE + layer * 2048, (LAS int*)(F.lds + 20480), F.tid);
        __syncthreads();
#define P9_T(buf, t) _Pragma("unroll") for (int q = 0; q < 4; ++q) { const v4u hw = (buf).h[q >> 1]; const v2u aw_ = (buf).ya[q >> 1], bw_ = (buf).yb[q >> 1]; \
                const v2u h2 = (q & 1) ? (v2u){hw.z, hw.w} : (v2u){hw.x, hw.y}; const unsigned a1 = (q & 1) ? aw_.y : aw_.x, b1 = (q & 1) ? bw_.y : bw_.x; \
                const int s = 256 * q + 4 * F.lane; t.v[q] = up4(h2) * *(const LAS f32x4*)(MV + s) + *(const LAS f32x4*)(MV + 1024 + s) + *(const LAS f32x4*)(MV + 2048 + s) * (up4f8(a1) * (buf).rw[0] + up4f8(b1) * (buf).rw[1]); }
#define P9_OUT(t, r, mn, rstd) do { \
            if constexpr (FINAL) { LAS float* ob = (LAS float*)(F.lds + 24576 + F.wave * 8192 + (((r) & 1) ? 4096 : 0));     \
                _Pragma("unroll") for (int q = 0; q < 4; ++q) { const int s = 256 * q + 4 * F.lane; *(LAS f32x4*)(ob + COL8(q)) = (t.v[q] - mn) * rstd * *(const LAS f32x4*)(MV + 3072 + s) + *(const LAS f32x4*)(MV + 4096 + s); } \
                asm volatile("s_waitcnt lgkmcnt(0)" ::: "memory"); \
                _Pragma("unroll") for (int j = 0; j < 4; ++j) { const f32x4 v_ = *(const LAS f32x4*)(ob + 256 * j + 4 * F.lane); *(f32x4*)(out + (size_t)(r) * D + 256 * j + 4 * F.lane) = v_; } } \
            else { unsigned ow[8], o8[4]; _Pragma("unroll") for (int q = 0; q < 4; ++q) { const int s = 256 * q + 4 * F.lane; const f32x4 o = (t.v[q] - mn) * rstd * *(const LAS f32x4*)(MV + 3072 + s) + *(const LAS f32x4*)(MV + 4096 + s); ow[2 * q] = pk2(o[0], o[1]); ow[2 * q + 1] = pk2(o[2], o[3]); o8[q] = pg8::pk_fp8x4(o[0], o[1], o[2], o[3]); } \
                *(v2u*)(H8 + (size_t)(r) * D + 8 * F.lane) = (v2u){o8[0], o8[1]}; *(v2u*)(H8 + (size_t)(r) * D + 8 * F.lane + 512) = (v2u){o8[2], o8[3]};     \
                *(v4u*)(Hout + (size_t)(r) * D + 8 * F.lane) = (v4u){ow[0], ow[1], ow[2], ow[3]}; *(v4u*)(Hout + (size_t)(r) * D + 8 * F.lane + 512) = (v4u){ow[4], ow[5], ow[6], ow[7]}; } } while (0)
#define P9_PAIR(bA, bB, ii) do { RowVec tA, tB; P9_T(bA, tA) P9_T(bB, tB) \
            float sA_ = 0.f, qA_ = 0.f, sB_ = 0.f, qB_ = 0.f; \
            _Pragma("unroll") for (int q = 0; q < 4; ++q) { const f32x4 xa = tA.v[q], xb = tB.v[q]; sA_ += (xa[0] + xa[1]) + (xa[2] + xa[3]); qA_ += (xa[0] * xa[0] + xa[1] * xa[1]) + (xa[2] * xa[2] + xa[3] * xa[3]); \
                sB_ += (xb[0] + xb[1]) + (xb[2] + xb[3]); qB_ += (xb[0] * xb[0] + xb[1] * xb[1]) + (xb[2] * xb[2] + xb[3] * xb[3]); } \
            float tsA, tqA, tsB, tqB; wave_sum4(sA_, qA_, sB_, qB_, tsA, tqA, tsB, tqB, F.lane); \
            const float mnA = tsA * (1.0f / D), mnB = tsB * (1.0f / D); const float rsA = 1.0f / sqrtf(fmaxf(tqA * (1.0f / D) - mnA * mnA, 0.f) + LN_EPS), rsB = 1.0f / sqrtf(fmaxf(tqB * (1.0f / D) - mnB * mnB, 0.f) + LN_EPS); \
            P9_OUT(tA, r0 + (ii), mnA, rsA); P9_OUT(tB, r0 + (ii) + 1, mnB, rsB); } while (0)
        { ROWP(0, a0, a1, aw); LD_ROW3(rb[0], r0, a0, a1, aw); } { ROWP(1, a0, a1, aw); LD_ROW3(rb[1], r0 + 1, a0, a1, aw); }
        for (int i = 0; i < 16; i += 4) {
            { ROWP(i + 2, a0, a1, aw); LD_ROW3(rb[2], r0 + i + 2, a0, a1, aw); } { ROWP(i + 3, a0, a1, aw); LD_ROW3(rb[3], r0 + i + 3, a0, a1, aw); }
            __builtin_amdgcn_sched_barrier(0); P9_PAIR(rb[0], rb[1], i); __builtin_amdgcn_sched_barrier(0);
            if (i + 4 < 16) { { ROWP(i + 4, a0, a1, aw); LD_ROW3(rb[0], r0 + i + 4, a0, a1, aw); } { ROWP(i + 5, a0, a1, aw); LD_ROW3(rb[1], r0 + i + 5, a0, a1, aw); } }
            __builtin_amdgcn_sched_barrier(0); P9_PAIR(rb[2], rb[3], i + 2); __builtin_amdgcn_sched_barrier(0); }
#undef P9_PAIR
#undef P9_OUT
#undef P9_T
#undef LD_ROW3
#undef ROWP
        __syncthreads();
    }
}
__device__ __forceinline__ void p_kmean(const Frame& F, const bf16* K, float* kmean) {
    const int gw = F.vcu * NWAVES + F.wave, NGW = F.G * NWAVES;
    for (int it = gw; it < 1024; it += NGW) { const int b = it >> 6, blk = (it >> 3) & 7, h = it & 7;
        const bf16* kp = K + (size_t)(b * T + blk * 256) * D + h * 128 + 2 * F.lane; float s0 = 0.f, s1 = 0.f;
#pragma unroll 8
        for (int r = 0; r < 256; ++r) { const unsigned w = *(const unsigned*)(kp + (size_t)r * D); s0 += bflo(w); s1 += bfhi(w); }
        *(f32x2*)(kmean + ((size_t)(b * 8 + h) * 8 + blk) * 128 + 2 * F.lane) = (f32x2){s0 * (1.0f / 256.0f), s1 * (1.0f / 256.0f)}; }
}
__device__ __forceinline__ void p_gate(const Frame& F, const bf16* Q, const float* kmean, unsigned char* sel) {
    LAS float* km = (LAS float*)F.lds;
    for (int it = F.vcu; it < 1024; it += F.G) { const int b = it >> 6, qb = (it >> 3) & 7, h = it & 7;
        const int tl = F.tid >> 1, half = F.tid & 1; const size_t row = (size_t)b * T + qb * 256 + tl;
        if (qb < 4) { if (half == 0) sel[row * 8 + h] = (unsigned char)((1u << qb) - 1u); continue; }
        for (int i = F.tid; i < qb * 128; i += 512) km[i] = kmean[((size_t)(b * 8 + h) * 8) * 128 + i];
        __syncthreads();
        float gt[7];
#pragma unroll
        for (int n = 0; n < 7; ++n) gt[n] = 0.f;
        const bf16* qp = Q + row * D + h * 128 + half * 64;
#pragma unroll
        for (int c8 = 0; c8 < 8; ++c8) { const v4u raw = *(const v4u*)(qp + 8 * c8);
            const float qv[8] = {bflo(raw.x), bfhi(raw.x), bflo(raw.y), bfhi(raw.y), bflo(raw.z), bfhi(raw.z), bflo(raw.w), bfhi(raw.w)};
#pragma unroll
            for (int n = 0; n < 7; ++n) if (n < qb) { const LAS f32x4* kk = (const LAS f32x4*)(km + n * 128 + half * 64 + 8 * c8); const f32x4 k0 = kk[0], k1 = kk[1];
                gt[n] += (qv[0] * k0[0] + qv[1] * k0[1]) + (qv[2] * k0[2] + qv[3] * k0[3]) + (qv[4] * k1[0] + qv[5] * k1[1]) + (qv[6] * k1[2] + qv[7] * k1[3]); } }
        unsigned mask = 0u;
#pragma unroll
        for (int n = 0; n < 7; ++n) gt[n] += __shfl_xor(gt[n], 1);
#pragma unroll
        for (int pick = 0; pick < 3; ++pick) { int bi = -1; float bv = -__builtin_inff();
#pragma unroll
            for (int n = 0; n < 7; ++n) if (n < qb && !((mask >> n) & 1u) && gt[n] > bv) { bv = gt[n]; bi = n; }
            if (bi >= 0) mask |= 1u << bi; }
        if (half == 0) sel[row * 8 + h] = (unsigned char)mask;
        __syncthreads();
    }
}
__device__ __forceinline__ att::BlockRef att_ref(int L, int pass, const bf16* Q, const unsigned char* Q8, const unsigned char* K8, const unsigned char* V8, unsigned char* O, const float* kmean, bool lmap) {
    const int v_ = L & 255, bh = lmap ? ((2 * (v_ >> 5) + (L >> 8)) * 8 + ((v_ >> 2) & 7)) : (L >> 2), x = L & 3, qb = pass ? 7 - x : x, b = bh >> 3, h = bh & 7; const size_t base = (size_t)b * T * D + h * 128;
    att::BlockRef r; r.Q = Q + base + (size_t)qb * 256 * D; r.Q8 = Q8 + base + (size_t)qb * 256 * D; r.O = O + base + (size_t)qb * 256 * D; r.K8 = K8 + base; r.V8 = V8 + base; r.Kmean = kmean + (size_t)bh * 8 * 128; r.P0 = qb * 256; return r;
}
__device__ __forceinline__ void p_attention(const Frame& F, const bf16* Q, const unsigned char* Q8, const unsigned char* K8, const unsigned char* V8, unsigned char* O, const float* sel, bool lmap) {
    constexpr int total = 512; int L = F.vcu; if (L >= total) return; int pass = 0;
    att::BlockRef cur = att_ref(L, 0, Q, Q8, K8, V8, O, sel, lmap); att::Seam S;
    att::moba_prime(cur, (char*)F.lds, S);
    for (;;) {
        const bool more_pass = pass == 0, more_item = L + F.G < total, last = !more_pass && !more_item;
        int passn = pass + 1, Ln = L; if (!more_pass) { passn = 0; Ln = more_item ? L + F.G : L; }
        const att::BlockRef nxt = last ? cur : att_ref(Ln, passn, Q, Q8, K8, V8, O, sel, lmap);
        att::moba_block(cur, nxt, (char*)F.lds, S);
        if (last) break;
        cur = nxt; pass = passn; L = Ln;
    }
}
constexpr int RING_BYTES = 131072, LDSCTL_OFF = RING_BYTES, MISC_OFF = LDSCTL_OFF + 320, LDS_BYTES = 147456;
constexpr int NPHASE = 20;
#ifndef NO_SGU
#define SGU_CALL p_sgu_item(F, P, it, U, V, YC);
#else
#define SGU_CALL
#endif
#ifndef NO_CONV
#define CONV_CALL p_conv_item(F, P, ci, (ci + cstep < cend) ? ci + cstep : -1, Gb, YC, cv, cc);
#else
#define CONV_CALL
#endif
#ifndef PROBE_DUP
#define PROBE_DUP 0u
#endif
#define DUP(k) (((PROBE_DUP) >> (k)) & 1u)
#define RUN(k, ...) do { __VA_ARGS__ if (DUP(k)) { __VA_ARGS__ } } while (0)
#if MK_ONE_LAUNCH
#define GRID_BAR() xcd_barrier(bar)
#define GRID_BAR_OV(...) xcd_barrier_ov(bar, [&]() { __VA_ARGS__ })
#define SEAM_BAR_OV(s, ...) do { if (local_ok) local_barrier_ov(bar.bar, (unsigned*)(ws + WS_CTL) + CW_LBAR + (s) * 512 + (F.vcu >> 5) * 64, 32u, [&]() { __VA_ARGS__ }); else xcd_barrier_ov(bar, [&]() { __VA_ARGS__ }); } while (0)
#define SEAM_BAR(s) SEAM_BAR_OV(s, )
#else
#define GRID_BAR() do { } while (0)
#define GRID_BAR_OV(...) do { } while (0)
#define SEAM_BAR_OV(s, ...) do { } while (0)
#define SEAM_BAR(s) do { } while (0)
#endif
template <int LAYER, int pbase>
__device__ __forceinline__ void moe_phases(const Frame& F, const Params& P, XcdBarrier& bar, int lo, int hi, const bf16* Ymix, float* out_final) {
    unsigned char* ws = P.ws;
    bf16* H = (bf16*)(ws + WS_H); unsigned char* YS = ws + WS_BIG;   unsigned char* HID = (unsigned char*)P.out; unsigned char* H8 = ws + WS_H8;
    LAS int* tl = (LAS int*)(F.lds + LDSCTL_OFF + 8192);
    unsigned* gcnt = (unsigned*)(ws + WS_CTL) + CW_MOE + LAYER * 2048;
#ifdef PH_SEL
#define IN(k) ((k) == PH_SEL && lo <= (k) && (k) < hi)
#else
#define IN(k) (lo <= (k) && (k) < hi)
#endif
#define BOTH(k) (IN(k) && IN((k) + 1))
    if (IN(pbase + 0)) { p_ln_route<LAYER == 1>(F, P, LAYER, Ymix, H, H, H8, MK_ONE_LAUNCH && IN(pbase - 1)); if (BOTH(pbase + 0)) GRID_BAR(); }
    if (IN(pbase + 2)) {
        moe_table(F, gcnt, tl); const int nt = __builtin_amdgcn_readfirstlane(tl[32]) >> 8;
        pg8::Gemm g{(const bf16*)H8, (const bf16*)(ws + WS_WGU + (size_t)LAYER * NEXP * 1024 * 1024), MSORT, 1024, 1024}; pg8::GroupedOrder<true> S; S.init(tl + 64, nt, 4, F.G, (int)blockIdx.x, (size_t)1024 * 1024); S.stage_rows((const int*)(ws + WS_INV), INV_CAP, tl + 16, tl, (LAS int*)(F.lds + LDSCTL_OFF + 1024));
        pg8::EpiSwiGLU8 E{HID};
        RUN(pbase + 2, pg8::gemm_phase<pg8::EpiSwiGLU8, pg8::GroupedOrder<true>, true, true, true>(F.lds, g, S, E););
        if (LAYER == 0) { const int nfull = S.nwg % F.G; if (nfull == 0) bg_convert(F, P, S.c, F.G, 0, 8192); else if (S.c >= nfull) bg_convert(F, P, S.c - nfull, F.G - nfull, 0, 8192); }
        if (BOTH(pbase + 2)) { if (MK_ONE_LAUNCH && (F.G & 3) == 0) group4_barrier(bar.bar, (unsigned*)(ws + WS_CTL) + CW_GBAR + LAYER * 4096 + (F.vcu >> 2) * 64, (unsigned*)(ws + WS_CTL) + CW_XMAP + (F.vcu & ~3)); else GRID_BAR(); } }
    if (IN(pbase + 3)) {
        if (!(MK_ONE_LAUNCH && IN(pbase + 2))) moe_table(F, gcnt, tl);
        const int nt = __builtin_amdgcn_readfirstlane(tl[32]) >> 8;
        pg8::Gemm g{(const bf16*)HID, (const bf16*)(ws + WS_WD + (size_t)LAYER * NEXP * 1024 * 512), MSORT, 1024, 512}; pg8::GroupedOrder<false> S; S.init(tl + 64, nt, 4, F.G, (int)blockIdx.x, (size_t)1024 * 512);
        pg8::EpiYsF8 E{YS, pg8::W8INV * 16.0f};
        RUN(pbase + 3, pg8::gemm_phase<pg8::EpiYsF8, pg8::GroupedOrder<false>, true, true, true>(F.lds, g, S, E););
        if (LAYER == 0) { const int nfull = S.nwg % F.G; if (nfull == 0) bg_convert(F, P, S.c, F.G, 8192, 12288); else if (S.c >= nfull) bg_convert(F, P, S.c - nfull, F.G - nfull, 8192, 12288); }
        if (BOTH(pbase + 3)) GRID_BAR_OV(p9_fill_mv<LAYER == 1>(F, P, LAYER, F.vcu, F.tid - 64); p9_fill_start(gcnt, (LAS int*)(F.lds + 20480), F.tid - 320););     }
    if (IN(pbase + 4)) { p_combine_ln<LAYER == 1>(F, P, LAYER, YS, H, H, H8, out_final, MK_ONE_LAUNCH && IN(pbase + 3)); if (BOTH(pbase + 4)) GRID_BAR(); }
#undef IN
#undef BOTH
}
__global__ void __launch_bounds__(NWAVES * 64, 2) fwd_kernel(Params P) {
    extern __shared__ __attribute__((aligned(16))) unsigned char lds_raw[];
    Frame F; F.lds = (LAS unsigned char*)lds_raw;
    F.tid = threadIdx.x; F.lane = F.tid & 63; F.wave = __builtin_amdgcn_readfirstlane(F.tid >> 6);
    F.G = gridDim.x; { const int bx = blockIdx.x; F.vcu = (F.G % 8 == 0) ? (bx % 8) * (F.G / 8) + bx / 8 : bx; }
    unsigned char* ws = P.ws;
    volatile LAS unsigned* MISC = (volatile LAS unsigned*)(F.lds + MISC_OFF);
    for (int u = F.tid; u < (LDS_BYTES - LDSCTL_OFF) / 4; u += NWAVES * 64) ((LAS unsigned*)(F.lds + LDSCTL_OFF))[u] = 0u;
    __syncthreads();
    XcdBarrier bar; bar.bar = (unsigned*)(ws + WS_CTL) + CW_BAR; bar.x = 0; bar.st = nullptr;
#if MK_ONE_LAUNCH
    bar = xcd_barrier_post((unsigned*)(ws + WS_CTL) + CW_BAR, MISC + 8);
    if (F.tid == 0) __hip_atomic_store((unsigned*)(ws + WS_CTL) + CW_XMAP + F.vcu, xb_xcc_id() + 1u, __ATOMIC_RELAXED, __HIP_MEMORY_SCOPE_AGENT);
#endif
    const int lo = P.ph_lo, hi = P.ph_hi;
#ifdef PH_SEL
#define IN(k) ((k) == PH_SEL && lo <= (k) && (k) < hi)
#else
#define IN(k) (lo <= (k) && (k) < hi)
#endif
#define BOTH(k) (IN(k) && IN((k) + 1))
    float* cond = (float*)(ws + WS_COND); bf16* H = (bf16*)(ws + WS_H);
    unsigned char* big = ws + WS_BIG;
    if (IN(0)) { RUN(0, p0_cond(F, P.in[I_C], P.in[I_ADAW], P.in[I_ADAB], cond); p0_weights(F, P); __syncthreads();); if (BOTH(0)) GRID_BAR(); }
    bool local_ok = false;
#if MK_ONE_LAUNCH
    if (lo == 0 && hi >= 20 && F.G == 256) { if (F.tid == 0) MISC[16] = 1u; __syncthreads();
        if (F.tid < 256) { unsigned* xm = (unsigned*)(ws + WS_CTL) + CW_XMAP; const unsigned a = xb_ld(xm + F.tid), b = xb_ld(xm + (F.tid & ~31)); if (a == 0u || a != b) MISC[16] = 0u; }
        __syncthreads(); local_ok = __builtin_amdgcn_readfirstlane((int)MISC[16]) != 0; }
#endif
    if (IN(1)) { RUN(1, p_modulate(F, P.in[I_X], cond, 0, H);); if (BOTH(1)) SEAM_BAR(0); }
    if (IN(2)) { bf16* U = (bf16*)big; bf16* V = (bf16*)(big + 32 * MiB); bf16* Gb = (bf16*)(big + 64 * MiB);
        pg8::Gemm g{H, (const bf16*)(ws + WS_WIN), M, 2048, 1024}; pg8::StaticOrder S; S.init(M, 2048, F.G, (int)blockIdx.x);
        pg8::EpiIn E{U, V, Gb};
        if (F.vcu & 1) { cv_moe_l0(F, P); __syncthreads(); }
        RUN(2, pg8::gemm_phase<pg8::EpiIn, pg8::StaticOrder, true, true>(F.lds, g, S, E););
        if (!(F.vcu & 1)) { __syncthreads(); cv_moe_l0(F, P); __syncthreads(); }
        if (BOTH(2)) SEAM_BAR(1); }
    if (IN(3)) { const bf16* U = (const bf16*)big; const bf16* V = (const bf16*)(big + 32 * MiB); const bf16* Gb = (const bf16*)(big + 64 * MiB); bf16* YC = (bf16*)(big + 96 * MiB);
#define P3_SGU RUN(20, for (int it = F.vcu; it < 256; it += F.G) { SGU_CALL });
#define P3_CONV RUN(21, { v4u cv[8]; ConvConst cc; conv_const(F, P, cc); const int cstep = local_ok ? 1 : F.G, c0 = local_ok ? 4 * F.vcu : F.vcu, cend = local_ok ? 4 * F.vcu + 4 : 1024;     \
            if (c0 < cend) conv_load(F, c0, Gb, cv); for (int ci = c0; ci < cend; ci += cstep) { CONV_CALL } });
        if (F.vcu & 1) { P3_CONV __builtin_amdgcn_sched_barrier(0); P3_SGU } else { P3_SGU __builtin_amdgcn_sched_barrier(0); P3_CONV }
#undef P3_SGU
#undef P3_CONV
        if (BOTH(3)) SEAM_BAR(2); }
    if (IN(4)) { const bf16* YC = (const bf16*)(big + 96 * MiB); bf16* YM = (bf16*)(ws + WS_XA);
        pg8::Gemm g{YC, (const bf16*)(ws + WS_WOUT), M, 1024, 1024}; pg8::StaticOrder S; S.init(M, 1024, F.G, (int)blockIdx.x);
        pg8::EpiBf16<0> E{YM, 1024, nullptr, 0, 0, 1.f};
        RUN(4, pg8::gemm_phase<pg8::EpiBf16<0>, pg8::StaticOrder, true, true>(F.lds, g, S, E););
        if (BOTH(4)) SEAM_BAR_OV(3, p5_fill_w(F, P, 0, F.tid - 64, 448); p5_fill_mv(F, P, 0, F.vcu, F.tid - 64);); }
    moe_phases<0, 5>(F, P, bar, lo, hi, (const bf16*)(ws + WS_XA), nullptr);
    bf16* Qb = (bf16*)big; unsigned char* Q8b = big + 64 * MiB; unsigned char* K8b = big + 96 * MiB; unsigned char* V8b = big + 128 * MiB;
    if (IN(10)) { pg8::Gemm g{(const bf16*)(ws + WS_H8), (const bf16*)(ws + WS_WQKV), M, 3072, 1024};
        pg8::StaticOrder S; S.init(M, 3072, F.G, (int)blockIdx.x);
        pg8::EpiQKV E{Qb, (size_t)M * D, (float*)(ws + WS_KMEAN), Q8b};
        RUN(10, pg8::gemm_phase<pg8::EpiQKV, pg8::StaticOrder, true, true, true>(F.lds, g, S, E););
        if (BOTH(10)) SEAM_BAR(4); }
    if (IN(13)) { RUN(13, p_attention(F, Qb, Q8b, K8b, V8b, ws + WS_XA  , (const float*)(ws + WS_KMEAN), local_ok);); if (BOTH(13)) SEAM_BAR(5); }
    if (IN(14)) { bf16* YM = (bf16*)(ws + WS_XA + 32 * MiB);
        pg8::Gemm g{(const bf16*)(ws + WS_XA), (const bf16*)(ws + WS_WO2), M, 1024, 1024}; pg8::StaticOrder S; S.init(M, 1024, F.G, (int)blockIdx.x);
        pg8::EpiYsF8 E{(unsigned char*)YM, pg8::W8INV * (1.0f / 16.0f) * 64.0f};
        RUN(14, pg8::gemm_phase<pg8::EpiYsF8, pg8::StaticOrder, true, true, true>(F.lds, g, S, E););
        if (BOTH(14)) SEAM_BAR_OV(6, p5_fill_w(F, P, 1, F.tid - 64, 448); p5_fill_mv(F, P, 1, F.vcu, F.tid - 64);); }
    moe_phases<1, 15>(F, P, bar, lo, hi, (const bf16*)(ws + WS_XA + 32 * MiB), P.out);
#undef IN
#undef BOTH
}

extern "C" void kernel_launch(void* const* d_in, const int* in_sizes, int n_in, void* d_out, int out_size, void* d_ws, size_t ws_size, hipStream_t stream) {
    static int grid = 0;
    if (grid == 0) {
        if (n_in != 27 || in_sizes[0] != M * D || out_size != M * D || ws_size < WS_END) { fprintf(stderr, "kernel_launch: unexpected shapes (n_in %d, in0 %d, out %d, ws %zu); nothing launched\n", n_in, n_in > 0 ? in_sizes[0] : -1, out_size, ws_size); grid = -1; return; }
        int dev = 0, cus = 0, per_cu = 0;
        if (hipGetDevice(&dev) != hipSuccess || hipDeviceGetAttribute(&cus, hipDeviceAttributeMultiprocessorCount, dev) != hipSuccess) { grid = -1; return; }
        if (hipFuncSetAttribute((const void*)fwd_kernel, hipFuncAttributeMaxDynamicSharedMemorySize, LDS_BYTES) != hipSuccess) { fprintf(stderr, "kernel_launch: hipFuncSetAttribute failed\n"); grid = -1; return; }
        if (hipOccupancyMaxActiveBlocksPerMultiprocessor(&per_cu, (const void*)fwd_kernel, NWAVES * 64, LDS_BYTES) != hipSuccess || per_cu < 1) fprintf(stderr, "kernel_launch: occupancy query reports %d workgroups per CU\n", per_cu);
        (void)hipGetLastError();
        grid = cus;
    }
    if (grid < 0) return;
    if (hipMemsetAsync((char*)d_ws + WS_CTL, 0, CTL_ZERO_BYTES, stream) != hipSuccess) return;
    Params p{};
    for (int i = 0; i < 27; ++i) p.in[i] = (const float*)d_in[i];
    p.out = (float*)d_out; p.ws = (unsigned char*)d_ws;
#if MK_ONE_LAUNCH
    p.ph_lo = 0; p.ph_hi = NPHASE; p.li = 0;
    hipLaunchKernelGGL(fwd_kernel, dim3(grid), dim3(NWAVES * 64), LDS_BYTES, stream, p);
#else
    for (int k = 0; k < NPHASE; ++k) { p.ph_lo = k; p.ph_hi = k + 1; p.li = k; hipLaunchKernelGGL(fwd_kernel, dim3(grid), dim3(NWAVES * 64), LDS_BYTES, stream, p); }
#endif
}
```
